# Optimizing an MI355X kernel written in HIP

```python
import jax, jax.numpy as jnp
from jax import lax
import numpy as np

D_MODEL = 1024
BATCH = 4
SEQ = 8192
DEPTH = 1

GRID_W = 64
CTX_LEN = 256
D_MIX = D_MODEL
A_W = D_MIX // 2
A_GROUPS = 8
A_HEAD = A_W // A_GROUPS
CHUNK = 128
B_W = D_MIX - A_W
B_HEADS = 8
B_HEAD = B_W // B_HEADS
DECAY_LORA = 64
AAA_LORA = 64
GATE_LORA = 128
CONV_K = 3
OFF_K = 0
OFF_V = B_W
OFF_R = 2 * B_W
OFF_WD = 3 * B_W
OFF_AD = OFF_WD + 2 * DECAY_LORA
OFF_GD = OFF_AD + 2 * AAA_LORA
OFF_U = OFF_GD + GATE_LORA
OFF_VA = OFF_U + A_W
D_IN = OFF_VA + A_W
N_GROUPS = 4
EXPERTS_PER_GROUP = 8
N_EXPERTS = N_GROUPS * EXPERTS_PER_GROUP
TOP_K_IN_GROUP = 2
D_EXPERT = 256
NORM_EPS = 1e-6
LN_EPS = 1e-5
GN_EPS = 64e-5

kernel_name = "hymba_gmlp_rwkv7_hmoe_dit_layer"


def rms_norm(x, g):
    x32 = x.astype(jnp.float32)
    y = x32 * lax.rsqrt(jnp.mean(x32 * x32, axis=-1, keepdims=True) + NORM_EPS)
    return (y * g.astype(jnp.float32)).astype(x.dtype)


def adaln(cond, w_mod, b_mod, n_chunks):
    m = jax.nn.silu(cond) @ w_mod[:, : n_chunks * D_MODEL] + b_mod[: n_chunks * D_MODEL]
    return jnp.split(m, n_chunks, axis=-1)


def modulate(h, shift, scale):
    return h * (1.0 + scale) + shift


def grid_dwconv(z, kernel, width):
    b, t, ch = z.shape
    rows = t // width
    img = z.reshape(b, rows, width, ch)
    out = lax.conv_general_dilated(
        img, kernel[:, :, None, :].astype(z.dtype), (1, 1), "SAME",
        dimension_numbers=("NHWC", "HWIO", "NHWC"), feature_group_count=ch)
    return out.reshape(b, t, ch)


def chunk_gmlp(u, v, ln_g, ln_b, w_s, b_s):
    b, t, _ = u.shape
    n_chunks = t // CHUNK
    uh = jax.nn.gelu(u).reshape(b, n_chunks, CHUNK, A_GROUPS, A_HEAD)
    v32 = jax.nn.gelu(v).astype(jnp.float32).reshape(b, n_chunks, CHUNK, A_GROUPS, A_HEAD)
    mu = jnp.mean(v32, axis=-1, keepdims=True)
    var = jnp.mean(jnp.square(v32 - mu), axis=-1, keepdims=True)
    vn = (v32 - mu) * lax.rsqrt(var + LN_EPS)
    vn = (vn * ln_g.reshape(A_GROUPS, A_HEAD) + ln_b.reshape(A_GROUPS, A_HEAD)).astype(u.dtype)
    s = jnp.einsum("gpq,bcqgd->bcpgd", w_s, vn) + b_s.T[:, :, None]
    return (uh * s).reshape(b, t, A_W)


def to_heads(z):
    return z.reshape(z.shape[0], z.shape[1], B_HEADS, B_HEAD)


def zero_state(b):
    return jnp.zeros((b, B_HEADS, B_HEAD, B_HEAD), jnp.float32)


def rwkv_prepare(k, lora, p):
    kk = to_heads(k * p["k_k"]).astype(jnp.float32)
    kk = kk * lax.rsqrt(jnp.maximum(jnp.sum(kk * kk, axis=-1, keepdims=True), 1e-24))
    dirs = []
    for d in range(2):
        lw = lora[..., d * DECAY_LORA:(d + 1) * DECAY_LORA]
        la = lora[..., 2 * DECAY_LORA + d * AAA_LORA: 2 * DECAY_LORA + (d + 1) * AAA_LORA]
        w = -jax.nn.softplus(-(p["decay_w0"][d] + jnp.tanh(lw) @ p["decay_up"][d])) - 0.5
        decay = jnp.exp(-jnp.exp(w.astype(jnp.float32)))
        a = jax.nn.sigmoid(p["iclr_a0"][d] + la @ p["iclr_up"][d])
        k_mod = k * (1.0 + (a - 1.0) * p["k_a"][d])
        dirs.append((to_heads(decay), to_heads(a), to_heads(k_mod)))
    return kk, dirs


def _state_update(S, w_t, kk_t, kka_t, k_t, v_t):
    s_kk = jnp.einsum("bhvk,bhk->bhv", S, kk_t)
    return (S * w_t[:, :, None, :] - s_kk[..., None] * kka_t[:, :, None, :]
            + v_t[..., None] * k_t[:, :, None, :])


def _time_major(a):
    return jnp.moveaxis(a.astype(jnp.float32), 1, 0)


def rwkv_scan(state0, decay, kk, kka, k, v, r, reverse):
    xs = (_time_major(decay), _time_major(kk), _time_major(kka), _time_major(k),
          _time_major(v), _time_major(r))

    def step(S, inp):
        S = _state_update(S, *inp[:5])
        return S, jnp.einsum("bhvk,bhk->bhv", S, inp[5])

    s_final, ys = lax.scan(step, state0, xs, reverse=reverse)
    return jnp.moveaxis(ys, 0, 1), s_final


def rwkv_final_state(state0, decay, kk, kka, k, v, reverse):
    xs = (_time_major(decay), _time_major(kk), _time_major(kka), _time_major(k), _time_major(v))

    def step(S, inp):
        return _state_update(S, *inp), None

    s_final, _ = lax.scan(step, state0, xs, reverse=reverse)
    return s_final


def rwkv_mix(k, v, r, lora, gd, p, states0):
    b, t, _ = k.shape
    kk, dirs = rwkv_prepare(k, lora, p)
    vh, rh = to_heads(v), to_heads(r)
    ys, bonus, finals = [], [], []
    for d, (decay, a, k_mod) in enumerate(dirs):
        y_d, s_d = rwkv_scan(states0[d], decay, kk, kk * a, k_mod, vh, rh, reverse=(d == 1))
        ys.append(y_d)
        finals.append(s_d)
        bonus.append(jnp.sum(rh * k_mod * p["r_k"], axis=-1, keepdims=True))
    y = ys[0] + ys[1]
    mu = jnp.mean(y, axis=-1, keepdims=True)
    var = jnp.mean(jnp.square(y - mu), axis=-1, keepdims=True)
    y = (y - mu) * lax.rsqrt(var + GN_EPS)
    y = y * p["lnx_g"].reshape(B_HEADS, B_HEAD) + p["lnx_b"].reshape(B_HEADS, B_HEAD)
    y = y.astype(k.dtype) + (bonus[0] + bonus[1]) * vh
    gate = jax.nn.sigmoid(gd) @ p["outgate_up"]
    return y.reshape(b, t, B_W) * gate, finals


def token_mixer(h, p, width, states0):
    z = h @ p["w_in"]
    rkv = grid_dwconv(z[..., OFF_K:OFF_WD], p["conv_rkv"], width)
    k, v, r = rkv[..., :B_W], rkv[..., B_W:2 * B_W], rkv[..., 2 * B_W:]
    out_b, finals = rwkv_mix(k, v, r, z[..., OFF_WD:OFF_GD], z[..., OFF_GD:OFF_U], p, states0)
    out_a = chunk_gmlp(z[..., OFF_U:OFF_VA], z[..., OFF_VA:], p["gm_ln_g"], p["gm_ln_b"],
                       p["w_spatial"], p["b_spatial"])
    return jnp.concatenate([out_a, out_b], axis=-1) @ p["w_out"], finals


def context_states(h_ctx, p):
    kv = grid_dwconv(h_ctx @ p["w_in"][:, OFF_K:OFF_R], p["conv_rkv"][..., OFF_K:OFF_R], CTX_LEN)
    k, v = kv[..., :B_W], kv[..., B_W:]
    kk, dirs = rwkv_prepare(k, h_ctx @ p["w_in"][:, OFF_WD:OFF_GD], p)
    s0 = zero_state(h_ctx.shape[0])
    vh = to_heads(v)
    return [rwkv_final_state(s0, decay, kk, kk * a, k_mod, vh, reverse=(d == 1))
            for d, (decay, a, k_mod) in enumerate(dirs)]


def hier_moe(h, p):
    shape = h.shape
    h2 = h.reshape(-1, D_MODEL)
    n = h2.shape[0]
    grp_logits = (h2 @ p["w_router_grp"] + p["b_router_grp"]).astype(jnp.float32)
    g_w, g_i = lax.top_k(jax.nn.softmax(grp_logits, axis=-1), 1)
    exp_logits = (h2 @ p["w_router_exp"] + p["b_router_exp"]).astype(jnp.float32)
    exp_logits = exp_logits.reshape(n, N_GROUPS, EXPERTS_PER_GROUP)
    sel = jnp.take_along_axis(exp_logits, g_i[:, :, None], axis=1)[:, 0]
    e_w, e_i = lax.top_k(jax.nn.softmax(sel, axis=-1), TOP_K_IN_GROUP)
    e_w = e_w / jnp.sum(e_w, axis=-1, keepdims=True)
    weights = g_w * e_w
    expert_id = g_i * EXPERTS_PER_GROUP + e_i
    combine = jnp.einsum("nke,nk->ne", jax.nn.one_hot(expert_id, N_EXPERTS, dtype=jnp.float32),
                         weights).astype(h.dtype)
    y = jnp.zeros_like(h2)
    for e in range(N_EXPERTS):
        hid = jax.nn.silu(h2 @ p["w_gate"][e]) * (h2 @ p["w_up"][e])
        y = y + combine[:, e:e + 1] * (hid @ p["w_down"][e])
    return y.reshape(shape)


def setup_inputs(seed: int = 0) -> dict:
    key = jax.random.key(seed)
    ks = iter(jax.random.split(key, 40))

    def nrm(shape, scale):
        return scale * jax.random.normal(next(ks), shape, jnp.float32)

    L, D = DEPTH, D_MODEL
    return {
        "x": nrm((BATCH, SEQ, D), 1.0),
        "c": nrm((BATCH, D), 1.0),
        "ctx": nrm((BATCH, CTX_LEN, D), 1.0),
        "c_ctx": nrm((D,), 1.0),
        "w_mod": nrm((L, D, 6 * D), 0.5 * D ** -0.5),
        "b_mod": nrm((L, 6 * D), 0.01),
        "g_pre1": 1.0 + nrm((L, D), 0.05),
        "g_post1": 1.0 + nrm((L, D), 0.05),
        "g_pre2": 1.0 + nrm((L, D), 0.05),
        "g_post2": 1.0 + nrm((L, D), 0.05),
        "w_in": nrm((L, D, D_IN), D ** -0.5),
        "conv_rkv": nrm((L, CONV_K, CONV_K, 3 * B_W), 1.0 / 3.0),
        "gm_ln_g": 1.0 + nrm((L, A_W), 0.05),
        "gm_ln_b": nrm((L, A_W), 0.01),
        "w_spatial": nrm((L, A_GROUPS, CHUNK, CHUNK), CHUNK ** -0.5),
        "b_spatial": 1.0 + nrm((L, A_GROUPS, CHUNK), 0.05),
        "decay_w0": jax.random.uniform(next(ks), (L, 2, B_W), jnp.float32, -6.0, 0.0),
        "decay_up": nrm((L, 2, DECAY_LORA, B_W), 0.5 * DECAY_LORA ** -0.5),
        "iclr_a0": nrm((L, 2, B_W), 0.5),
        "iclr_up": nrm((L, 2, AAA_LORA, B_W), 0.5 * AAA_LORA ** -0.5),
        "k_k": 1.0 + nrm((L, B_W), 0.1),
        "k_a": 1.0 + nrm((L, 2, B_W), 0.1),
        "r_k": nrm((L, B_HEADS, B_HEAD), 0.1),
        "outgate_up": nrm((L, GATE_LORA, B_W), GATE_LORA ** -0.5),
        "lnx_g": 1.0 + nrm((L, B_W), 0.05),
        "lnx_b": nrm((L, B_W), 0.01),
        "w_out": nrm((L, D_MIX, D), D_MIX ** -0.5),
        "w_router_grp": nrm((L, D, N_GROUPS), D ** -0.5),
        "b_router_grp": nrm((L, N_GROUPS), 0.01),
        "w_router_exp": nrm((L, D, N_EXPERTS), D ** -0.5),
        "b_router_exp": nrm((L, N_EXPERTS), 0.01),
        "w_gate": nrm((L, N_EXPERTS, D, D_EXPERT), D ** -0.5),
        "w_up": nrm((L, N_EXPERTS, D, D_EXPERT), D ** -0.5),
        "w_down": nrm((L, N_EXPERTS, D_EXPERT, D), D_EXPERT ** -0.5),
    }


def reference(x, c, ctx, c_ctx, w_mod, b_mod, g_pre1, g_post1, g_pre2, g_post2, w_in, conv_rkv,
              gm_ln_g, gm_ln_b, w_spatial, b_spatial, decay_w0, decay_up, iclr_a0, iclr_up,
              k_k, k_a, r_k, outgate_up, lnx_g, lnx_b, w_out, w_router_grp, b_router_grp,
              w_router_exp, b_router_exp, w_gate, w_up, w_down):
    for layer in range(DEPTH):
        p = {
            "w_in": w_in[layer], "conv_rkv": conv_rkv[layer],
            "gm_ln_g": gm_ln_g[layer], "gm_ln_b": gm_ln_b[layer],
            "w_spatial": w_spatial[layer], "b_spatial": b_spatial[layer],
            "decay_w0": decay_w0[layer], "decay_up": decay_up[layer],
            "iclr_a0": iclr_a0[layer], "iclr_up": iclr_up[layer],
            "k_k": k_k[layer], "k_a": k_a[layer], "r_k": r_k[layer],
            "outgate_up": outgate_up[layer], "lnx_g": lnx_g[layer], "lnx_b": lnx_b[layer],
            "w_out": w_out[layer],
            "w_router_grp": w_router_grp[layer], "b_router_grp": b_router_grp[layer],
            "w_router_exp": w_router_exp[layer], "b_router_exp": b_router_exp[layer],
            "w_gate": w_gate[layer], "w_up": w_up[layer], "w_down": w_down[layer],
        }
        last = layer == DEPTH - 1
        shift1, scale1, gate1, shift2, scale2, gate2 = adaln(c[:, None, :], w_mod[layer], b_mod[layer], 6)
        if last:
            cshift1, cscale1 = adaln(c_ctx, w_mod[layer], b_mod[layer], 2)
            h_ctx = modulate(rms_norm(ctx, g_pre1[layer]), cshift1, cscale1)
            states = context_states(h_ctx, p)
        else:
            cshift1, cscale1, cgate1, cshift2, cscale2, cgate2 = adaln(c_ctx, w_mod[layer], b_mod[layer], 6)
            h_ctx = modulate(rms_norm(ctx, g_pre1[layer]), cshift1, cscale1)
            zs = zero_state(ctx.shape[0])
            y_ctx, states = token_mixer(h_ctx, p, CTX_LEN, [zs, zs])
            ctx = ctx + cgate1 * rms_norm(y_ctx, g_post1[layer])
            h_ctx = modulate(rms_norm(ctx, g_pre2[layer]), cshift2, cscale2)
            ctx = ctx + cgate2 * rms_norm(hier_moe(h_ctx, p), g_post2[layer])
        h = modulate(rms_norm(x, g_pre1[layer]), shift1, scale1)
        y, _ = token_mixer(h, p, GRID_W, states)
        x = x + gate1 * rms_norm(y, g_post1[layer])
        h = modulate(rms_norm(x, g_pre2[layer]), shift2, scale2)
        x = x + gate2 * rms_norm(hier_moe(h, p), g_post2[layer])
    return x
```

```cpp
#include <hip/hip_runtime.h>
#include <hip/hip_cooperative_groups.h>
#include <cstdio>
#include <cstdint>
namespace cg = cooperative_groups;

#ifndef ONE_LAUNCH
#define ONE_LAUNCH 0
#endif

#define DI __device__ __forceinline__
#define LAS __attribute__((address_space(3)))
typedef unsigned short bf16_t;
typedef short bf16x8 __attribute__((ext_vector_type(8)));
typedef short s16x4 __attribute__((ext_vector_type(4)));
typedef float f32x4 __attribute__((ext_vector_type(4)));
typedef float f32x2 __attribute__((ext_vector_type(2)));
typedef unsigned u32x4 __attribute__((ext_vector_type(4)));
typedef unsigned u32x2 __attribute__((ext_vector_type(2)));

constexpr int D = 1024, BATCH = 4, SEQ = 8192, CTXL = 256;
constexpr int NT = BATCH * SEQ;
constexpr int NCX = BATCH * CTXL;
constexpr int MR = NT + NCX;
constexpr int BW = 512, AW = 512, NH = 8, HD = 64;
constexpr int DIN = 2944, DINP = 3072;
constexpr int OFF_K = 0, OFF_V = 512, OFF_R = 1024, OFF_WD = 1536, OFF_AD = 1664, OFF_GD = 1792, OFF_U = 1920, OFF_VA = 2432;
constexpr int NEXP = 32, DEXP = 256;
constexpr int NWAVES = 8, NTHREADS = 512;
constexpr int LDS_BYTES = 147456;

constexpr size_t MiB = 1u << 20;
constexpr size_t WS_CTL = 0, CTL_BYTES = 64 * 1024;
constexpr size_t WS_MOD = 1 * MiB;
constexpr size_t WS_DUPT = 2 * MiB;
constexpr size_t WS_AUPT = WS_DUPT + 131072;
constexpr size_t WS_GUPT = WS_AUPT + 131072;
constexpr size_t WS_WSP = WS_GUPT + 131072;
constexpr size_t WS_WINT = 3 * MiB;
constexpr size_t WS_WOUTT = 9 * MiB;
constexpr size_t WS_WGUT = 11 * MiB;
constexpr size_t WS_WDT = 43 * MiB;
constexpr size_t WS_H = 60 * MiB;
constexpr size_t WS_Z = 126 * MiB;
constexpr size_t ROWB = (size_t)MR * 512 * 2;
constexpr size_t WS_KC = 324 * MiB, WS_VC = WS_KC + ROWB, WS_RC = WS_VC + ROWB, WS_A0 = WS_RC + ROWB, WS_A1 = WS_A0 + ROWB;
constexpr size_t WS_L0 = 60 * MiB, WS_L1 = WS_L0 + ROWB;
constexpr size_t WS_YS = 126 * MiB;
constexpr size_t WS_Y = 126 * MiB;
constexpr size_t WS_H2 = 60 * MiB;
constexpr size_t WS_EIDX = 254 * MiB;
constexpr size_t WS_EW = 255 * MiB;
constexpr size_t WS_PERM = 256 * MiB;
constexpr size_t WS_HID = 260 * MiB;
constexpr size_t WS_YMOE = 296 * MiB;
constexpr size_t DO_MIXED = 0, DO_GATE = 64 * MiB, DO_BV = 96 * MiB;

struct Params { const float* in[34]; float* out; unsigned char* ws; };
enum { I_X = 0, I_C, I_CTX, I_CCTX, I_WMOD, I_BMOD, I_GPRE1, I_GPOST1, I_GPRE2, I_GPOST2, I_WIN, I_CONV, I_GMLNG, I_GMLNB, I_WSP, I_BSP,
       I_DW0, I_DUP, I_A0, I_AUP, I_KK, I_KA, I_RK, I_GUP, I_LNXG, I_LNXB, I_WOUT, I_WRG, I_BRG, I_WRE, I_BRE, I_WG, I_WU, I_WD };

DI unsigned f2bf(float f) { unsigned u = __builtin_bit_cast(unsigned, f); return (u + 0x7fffu + ((u >> 16) & 1u)) >> 16; }
DI unsigned pk2(float lo, float hi) { return f2bf(lo) | (f2bf(hi) << 16); }
DI float bf2f(unsigned b) { return __builtin_bit_cast(float, b << 16); }
DI float bflo(unsigned w) { return __builtin_bit_cast(float, w << 16); }
DI float bfhi(unsigned w) { return __builtin_bit_cast(float, w & 0xffff0000u); }
DI unsigned cvt_pk_bf16(float lo, float hi) { unsigned r; asm volatile("v_cvt_pk_bf16_f32 %0, %1, %2" : "=v"(r) : "v"(lo), "v"(hi)); return r; }
DI float wave_sum(float v) {
#pragma unroll
    for (int o = 1; o < 64; o <<= 1) v += __shfl_xor(v, o);
    return v;
}
DI float sigmoidf_(float x) { return 1.f / (1.f + __expf(-x)); }
DI float siluf_(float x) { return x / (1.f + __expf(-x)); }
DI float softplusf_(float x) { return x > 20.f ? x : log1pf(__expf(x)); }
DI float gelu_tanh(float x) { const float u = 0.7978845608028654f * (x + 0.044715f * x * x * x); return 0.5f * x * (1.f + tanhf(u)); }
#define LDS_WAIT() asm volatile("s_waitcnt lgkmcnt(0)" ::: "memory")

namespace pg8 {
constexpr int BM = 256, BK = 64, HALF = 128, HTB = HALF * BK * 2, STAGE_BYTES = 8 * HTB, NXCD = 8, WGM = 8;
__host__ __device__ __forceinline__ int lds_byte(int r, int c) { const int st = (r >> 4) * 2 + (c >> 5), rr = r & 15, cc = c & 31, ob = rr * 64 + cc * 2; return st * 1024 + (ob ^ (((ob >> 9) & 1) << 5)); }
__host__ __device__ __forceinline__ void stage_rc(int b, int& R, int& C) { const int st = b / 1024, sb = b % 1024, swz = sb ^ (((sb >> 9) & 1) << 5); R = (st >> 1) * 16 + swz / 64; C = (st & 1) * 32 + (swz % 64) / 2; }
__host__ __device__ __forceinline__ int perm32(int rho) { const int n = rho >> 4, i = rho & 15; return 8 * (i >> 2) + 4 * n + (i & 3); }

struct Unit { const char* A; const char* B; const int* ridx; int pm, pn, e, lt, nvalid; };

struct StaticOrder {
    const char* A; const char* Bt; int K; int nM, nN, nwg, G, c;
    __device__ void init(const void* A_, const void* Bt_, int M, int N, int K_, int G_, int c_) { A = (const char*)A_; Bt = (const char*)Bt_; K = K_; nM = M / BM; nN = N / BM; nwg = nM * nN; G = G_; c = c_; }
    __device__ bool next(int i, Unit& u) const {
        const long L = (long)i * G + c; if (L >= nwg) return false;
        int wgid = (int)L; { const int q = nwg / NXCD, r = nwg % NXCD, xcd = wgid % NXCD, off = wgid / NXCD; wgid = (xcd < r ? xcd * (q + 1) : r * (q + 1) + (xcd - r) * q) + off; }
        const int nig = WGM * nN, gid = wgid / nig, fm = gid * WGM, gsz = (nM - fm) < WGM ? (nM - fm) : WGM;
        u.pm = fm + ((wgid % nig) % gsz); u.pn = (wgid % nig) / gsz;
        u.A = A + (size_t)u.pm * BM * K * 2; u.B = Bt + (size_t)u.pn * BM * K * 2; u.ridx = nullptr; u.e = 0; u.lt = 0; u.nvalid = BM; return true;
    }
};

DI int gidx(const Unit& u, int r) { return r < u.nvalid ? (u.ridx[r] >> 1) : 0; }

template <class Epi, class Sched, bool GATHER>
DI void gemm_phase(LAS unsigned char* lds, const int K, const Sched& S, const Epi& E) {
    const int tid = threadIdx.x, wid = __builtin_amdgcn_readfirstlane(tid >> 6), lane = tid & 63, wr = wid >> 2, wc = wid & 3, fr = lane & 15, fq = lane >> 4;
    const int nt = K / BK;
    int Rr[2], Cc[2];
    unsigned voffB[2], vA[2][2], vAn[2][2];
#pragma unroll
    for (int i = 0; i < 2; ++i) { int R, C; stage_rc(tid * 16 + i * 8192, R, C); Rr[i] = R; Cc[i] = C; const int Rb = (R & ~31) + perm32(R & 31);
        voffB[i] = (unsigned)(Rb * K + C) * 2u;
        vA[0][i] = (unsigned)(R * K + C) * 2u; vA[1][i] = (unsigned)((R + HALF) * K + C) * 2u; vAn[0][i] = vA[0][i]; vAn[1][i] = vA[1][i]; }
    const size_t kstep = (size_t)(BK * 2);
    const size_t hstep = (size_t)HALF * K * 2;
    const unsigned ldsw = (unsigned)wid * 1024u;
    const int aoff = lds_byte(wr * 64 + fr, fq * 8), boff = lds_byte(wc * 32 + fr, fq * 8);
#define PG8_SA(b, h) (((b) * 2 + (h)) * HTB)
#define PG8_SB(b, h) ((4 + (b) * 2 + (h)) * HTB)
#define PG8_STAGE(bufoff, gbase, voff) do { _Pragma("unroll") for (int _i = 0; _i < 2; ++_i) \
        __builtin_amdgcn_global_load_lds((const unsigned*)((const char*)(gbase) + (voff)[_i]), (LAS unsigned*)(lds + (bufoff) + ldsw + _i * 8192), 16, 0, 0); } while (0)
#define PG8_LDA(dst, b, h) do { _Pragma("unroll") for (int m = 0; m < 4; ++m) _Pragma("unroll") for (int k = 0; k < 2; ++k) dst[m][k] = *(const LAS bf16x8*)(lds + PG8_SA(b, h) + aoff + m * 2048 + k * 1024); } while (0)
#define PG8_LDB(dst, b, h) do { _Pragma("unroll") for (int n = 0; n < 2; ++n) _Pragma("unroll") for (int k = 0; k < 2; ++k) dst[n][k] = *(const LAS bf16x8*)(lds + PG8_SB(b, h) + boff + n * 2048 + k * 1024); } while (0)
#define PG8_MMA(ai, bj, At, Bt) do { __builtin_amdgcn_s_setprio(1); _Pragma("unroll") for (int m = 0; m < 4; ++m) _Pragma("unroll") for (int n = 0; n < 2; ++n) _Pragma("unroll") for (int k = 0; k < 2; ++k) \
        acc[ai][bj][m][n] = __builtin_amdgcn_mfma_f32_16x16x32_bf16(Bt[n][k], At[m][k], acc[ai][bj][m][n], 0, 0, 0); __builtin_amdgcn_s_setprio(0); } while (0)
#define PG8_WAIT_V(n) asm volatile("s_waitcnt vmcnt(" #n ")" ::: "memory")
#define PG8_WAIT_L(n) asm volatile("s_waitcnt lgkmcnt(" #n ")" ::: "memory")
#define PG8_BAR __builtin_amdgcn_s_barrier()
#define PG8_SCHED __builtin_amdgcn_sched_barrier(0)
    Unit cur, nxt; int ui = 0;
    if (!S.next(0, cur)) return;
    if constexpr (GATHER) {
#pragma unroll
        for (int i = 0; i < 2; ++i) { vA[0][i] = (unsigned)(gidx(cur, Rr[i]) * K + Cc[i]) * 2u; vA[1][i] = (unsigned)(gidx(cur, Rr[i] + HALF) * K + Cc[i]) * 2u; }
    }
    f32x4 acc[2][2][4][2];
#pragma unroll
    for (int a = 0; a < 2; ++a)
#pragma unroll
        for (int b = 0; b < 2; ++b)
#pragma unroll
            for (int m = 0; m < 4; ++m)
#pragma unroll
                for (int n = 0; n < 2; ++n) acc[a][b][m][n] = (f32x4){0.f, 0.f, 0.f, 0.f};
    bf16x8 At[4][2], B0[2][2], B1[2][2];
    const char* cA = cur.A; const char* cB = cur.B;
    PG8_STAGE(PG8_SB(0, 0), cB, voffB); PG8_STAGE(PG8_SB(0, 1), cB + hstep, voffB); PG8_STAGE(PG8_SA(0, 0), cA, vA[0]); PG8_STAGE(PG8_SA(0, 1), cA, vA[1]);
    if (wr == 1) PG8_BAR;
    PG8_WAIT_V(2); PG8_BAR;
    PG8_STAGE(PG8_SB(1, 0), cB + kstep, voffB); PG8_STAGE(PG8_SA(1, 0), cA + kstep, vA[0]); PG8_STAGE(PG8_SB(1, 1), cB + hstep + kstep, voffB);
    PG8_WAIT_V(6); PG8_BAR;
    for (;;) {
        const bool has_next = S.next(ui + 1, nxt);
        const char* nA = has_next ? nxt.A : cA; const char* nB = has_next ? nxt.B : cB;
        if constexpr (GATHER) {
            if (has_next) {
#pragma unroll
                for (int i = 0; i < 2; ++i) { vAn[0][i] = (unsigned)(gidx(nxt, Rr[i]) * K + Cc[i]) * 2u; vAn[1][i] = (unsigned)(gidx(nxt, Rr[i] + HALF) * K + Cc[i]) * 2u; }
            } else {
#pragma unroll
                for (int i = 0; i < 2; ++i) { vAn[0][i] = vA[0][i]; vAn[1][i] = vA[1][i]; }
            }
        }
#pragma unroll 1
        for (int t = 0; t < nt; t += 2) {
            const bool last = (t == nt - 2);
            const char* a1 = cA + (size_t)(t + 1) * kstep;
            const char* a2 = last ? nA : cA + (size_t)(t + 2) * kstep; const char* b2 = last ? nB : cB + (size_t)(t + 2) * kstep;
            const char* a3 = a2 + kstep; const char* b3 = b2 + kstep;
            unsigned w0[2], w1[2];
            if constexpr (GATHER) { w0[0] = last ? vAn[0][0] : vA[0][0]; w0[1] = last ? vAn[0][1] : vA[0][1]; w1[0] = last ? vAn[1][0] : vA[1][0]; w1[1] = last ? vAn[1][1] : vA[1][1]; }
            else { w0[0] = vA[0][0]; w0[1] = vA[0][1]; w1[0] = vA[1][0]; w1[1] = vA[1][1]; }
            PG8_LDB(B0, 0, 0); PG8_LDB(B1, 0, 1); PG8_SCHED; PG8_LDA(At, 0, 0); PG8_STAGE(PG8_SA(1, 1), a1, vA[1]);
            PG8_WAIT_V(8); PG8_WAIT_L(0); PG8_BAR; PG8_MMA(0, 0, At, B0); PG8_MMA(0, 1, At, B1); PG8_BAR; PG8_SCHED;
            PG8_LDA(At, 0, 1); PG8_STAGE(PG8_SB(0, 0), b2, voffB); PG8_STAGE(PG8_SB(0, 1), b2 + hstep, voffB); PG8_STAGE(PG8_SA(0, 0), a2, w0);
            PG8_WAIT_V(8); PG8_WAIT_L(0); PG8_BAR; PG8_MMA(1, 0, At, B0); PG8_MMA(1, 1, At, B1); PG8_BAR; PG8_SCHED;
            PG8_LDB(B0, 1, 0); PG8_LDB(B1, 1, 1); PG8_SCHED; PG8_LDA(At, 1, 0); PG8_STAGE(PG8_SA(0, 1), a2, w1);
            PG8_WAIT_V(8); PG8_WAIT_L(0); PG8_BAR; PG8_MMA(0, 0, At, B0); PG8_MMA(0, 1, At, B1); PG8_BAR; PG8_SCHED;
            PG8_LDA(At, 1, 1); PG8_STAGE(PG8_SB(1, 0), b3, voffB); PG8_STAGE(PG8_SB(1, 1), b3 + hstep, voffB); PG8_STAGE(PG8_SA(1, 0), a3, w0);
            PG8_WAIT_V(8); PG8_WAIT_L(0); PG8_BAR; PG8_MMA(1, 0, At, B0); PG8_MMA(1, 1, At, B1); PG8_BAR; PG8_SCHED;
        }
        if (wr == 0) PG8_BAR;
        E(acc, cur, wr, wc, fr, fq);
        if (!has_next) break;
#pragma unroll
        for (int a = 0; a < 2; ++a)
#pragma unroll
            for (int b = 0; b < 2; ++b)
#pragma unroll
                for (int m = 0; m < 4; ++m)
#pragma unroll
                    for (int n = 0; n < 2; ++n) acc[a][b][m][n] = (f32x4){0.f, 0.f, 0.f, 0.f};
        cur = nxt; cA = nA; cB = nB; ++ui;
        if constexpr (GATHER) {
#pragma unroll
            for (int i = 0; i < 2; ++i) { vA[0][i] = vAn[0][i]; vA[1][i] = vAn[1][i]; }
        }
        if (wr == 1) PG8_BAR;
    }
    PG8_WAIT_V(0);
    PG8_BAR;
#undef PG8_SA
#undef PG8_SB
#undef PG8_STAGE
#undef PG8_LDA
#undef PG8_LDB
#undef PG8_MMA
#undef PG8_WAIT_V
#undef PG8_WAIT_L
#undef PG8_BAR
#undef PG8_SCHED
}

struct EpiBf16 {
    bf16_t* O; int ldc;
    DI void operator()(const f32x4 (&acc)[2][2][4][2], const Unit& u, int wr, int wc, int fr, int fq) const {
        const int row0 = u.pm * BM + wr * 64 + fr, col0 = u.pn * BM + wc * 32 + 8 * fq;
#pragma unroll
        for (int ai = 0; ai < 2; ++ai)
#pragma unroll
            for (int m = 0; m < 4; ++m) { bf16_t* rowp = O + (size_t)(row0 + ai * HALF + m * 16) * ldc + col0;
#pragma unroll
                for (int bj = 0; bj < 2; ++bj) { const f32x4 v0 = acc[ai][bj][m][0], v1 = acc[ai][bj][m][1];
                    u32x4 w; w.x = cvt_pk_bf16(v0[0], v0[1]); w.y = cvt_pk_bf16(v0[2], v0[3]); w.z = cvt_pk_bf16(v1[0], v1[1]); w.w = cvt_pk_bf16(v1[2], v1[3]);
                    *(u32x4*)(rowp + bj * HALF) = w; } }
    }
};
struct EpiF32 {
    float* O; int ldc;
    DI void operator()(const f32x4 (&acc)[2][2][4][2], const Unit& u, int wr, int wc, int fr, int fq) const {
        const int row0 = u.pm * BM + wr * 64 + fr, col0 = u.pn * BM + wc * 32 + 8 * fq;
#pragma unroll
        for (int ai = 0; ai < 2; ++ai)
#pragma unroll
            for (int m = 0; m < 4; ++m) { float* rowp = O + (size_t)(row0 + ai * HALF + m * 16) * ldc + col0;
#pragma unroll
                for (int bj = 0; bj < 2; ++bj) { *(f32x4*)(rowp + bj * HALF) = acc[ai][bj][m][0]; *(f32x4*)(rowp + bj * HALF + 4) = acc[ai][bj][m][1]; } }
    }
};
struct EpiMoeUp {
    bf16_t* HID;
    DI void operator()(const f32x4 (&acc)[2][2][4][2], const Unit& u, int wr, int wc, int fr, int fq) const {
        const int row0 = u.pm * BM + wr * 64 + fr, col0 = u.pn * HALF + wc * 32 + 8 * fq;
#pragma unroll
        for (int ai = 0; ai < 2; ++ai)
#pragma unroll
            for (int m = 0; m < 4; ++m) { bf16_t* rowp = HID + (size_t)(row0 + ai * HALF + m * 16) * DEXP + col0;
                float h[8];
#pragma unroll
                for (int n = 0; n < 2; ++n)
#pragma unroll
                    for (int j = 0; j < 4; ++j) { const float g = acc[ai][0][m][n][j], up = acc[ai][1][m][n][j]; h[n * 4 + j] = siluf_(g) * up; }
                u32x4 w; w.x = cvt_pk_bf16(h[0], h[1]); w.y = cvt_pk_bf16(h[2], h[3]); w.z = cvt_pk_bf16(h[4], h[5]); w.w = cvt_pk_bf16(h[6], h[7]);
                *(u32x4*)rowp = w; }
    }
};
struct EpiMoeDown {
    bf16_t* YM; const int* perm; const float* ew;
    DI void operator()(const f32x4 (&acc)[2][2][4][2], const Unit& u, int wr, int wc, int fr, int fq) const {
        const int col0 = u.pn * BM + wc * 32 + 8 * fq;
#pragma unroll
        for (int ai = 0; ai < 2; ++ai)
#pragma unroll
            for (int m = 0; m < 4; ++m) { const int r = ai * HALF + wr * 64 + m * 16 + fr;
                if (r < u.nvalid) { const int pr = perm[(size_t)u.e * NT + u.lt * BM + r]; const int tok = pr >> 1, slot = pr & 1; const float wgt = ew[pr];
                    bf16_t* rowp = YM + ((size_t)slot * NT + tok) * D + col0;
#pragma unroll
                    for (int bj = 0; bj < 2; ++bj) { const f32x4 v0 = acc[ai][bj][m][0] * wgt, v1 = acc[ai][bj][m][1] * wgt;
                        u32x4 w; w.x = cvt_pk_bf16(v0[0], v0[1]); w.y = cvt_pk_bf16(v0[2], v0[3]); w.z = cvt_pk_bf16(v1[0], v1[1]); w.w = cvt_pk_bf16(v1[2], v1[3]);
                        *(u32x4*)(rowp + bj * HALF) = w; } }
                asm volatile("" ::: "memory"); }
    }
};
}

struct MoeOrder {
    const LAS int* tp; const int* cnt; int npn, G, c, K; const char* A; const char* Bbase; size_t bstride_e, bstride_pn; const int* perm; bool gather;
    __device__ bool next(int i, pg8::Unit& u) const {
        const int TT = __builtin_amdgcn_readfirstlane(tp[32]); const long L = (long)i * G + c; if (L >= (long)TT * npn) return false;
        const int rt = (int)(L / npn), pn = (int)(L % npn);
        int e = 0;
#pragma unroll 1
        for (int j = 1; j < 32; ++j) e += (__builtin_amdgcn_readfirstlane(tp[j]) <= rt) ? 1 : 0;
        const int lt = rt - __builtin_amdgcn_readfirstlane(tp[e]);
        u.pm = rt; u.pn = pn; u.e = e; u.lt = lt; const int rem = cnt[e] - lt * 256; u.nvalid = rem < 256 ? rem : 256;
        u.ridx = perm + (size_t)e * NT + lt * 256;
        u.A = gather ? A : A + (size_t)rt * 256 * K * 2;
        u.B = Bbase + (size_t)e * bstride_e + (size_t)pn * bstride_pn;
        return true;
    }
};

struct Ctx {
    LAS unsigned char* lds; int tid, lane, wave, G, bid;
};

DI void phase_adaln(const Params& p, const Ctx& F) {
    LAS float* s = (LAS float*)F.lds;
    LAS float* red = (LAS float*)(F.lds + 20480);
    const float* c = p.in[I_C]; const float* cc = p.in[I_CCTX]; const float* wm = p.in[I_WMOD]; const float* bm = p.in[I_BMOD];
    float* mod = (float*)(p.ws + WS_MOD);
    for (int i = F.tid; i < 5 * 1024; i += NTHREADS) { const float v = i < 4096 ? c[i] : cc[i - 4096]; s[i] = siluf_(v); }
    __syncthreads();
    for (int grp = F.bid; grp < 256; grp += F.G) {
        const int col0 = grp * 24, q = F.tid % 6, ks = F.tid / 6;
        float acc[5][4];
#pragma unroll
        for (int b = 0; b < 5; ++b)
#pragma unroll
            for (int j = 0; j < 4; ++j) acc[b][j] = 0.f;
        if (F.tid < 510) {
            for (int k = ks; k < 1024; k += 85) {
                const f32x4 w = *(const f32x4*)(wm + (size_t)k * 6144 + col0 + 4 * q);
#pragma unroll
                for (int b = 0; b < 5; ++b) { const float sv = s[b * 1024 + k];
#pragma unroll
                    for (int j = 0; j < 4; ++j) acc[b][j] += sv * w[j]; }
            }
#pragma unroll
            for (int b = 0; b < 5; ++b)
#pragma unroll
                for (int j = 0; j < 4; ++j) red[ks * 120 + q * 20 + b * 4 + j] = acc[b][j];
        }
        __syncthreads();
        if (F.tid < 120) {
            float sum = 0.f;
            for (int k2 = 0; k2 < 85; ++k2) sum += red[k2 * 120 + F.tid];
            const int qq = F.tid / 20, b = (F.tid % 20) / 4, j = F.tid % 4, col = col0 + 4 * qq + j;
            mod[b * 6144 + col] = sum + bm[col];
        }
        __syncthreads();
    }
}

DI void transpose_item(const float* W, int K, int N, bf16_t* WT, int row_off, LAS float* scr, int item, int lane) {
    const int nblk = N / 32, kb = item / nblk, nb = item % nblk, k0 = 64 * kb, n0 = 32 * nb;
#pragma unroll 8
    for (int i = 0; i < 32; ++i) { const int kk = 2 * i + (lane >> 5); scr[kk * 33 + (lane & 31)] = W[(size_t)(k0 + kk) * N + n0 + (lane & 31)]; }
    LDS_WAIT(); asm volatile("" ::: "memory");
    const int c = lane & 7;
#pragma unroll
    for (int j = 0; j < 4; ++j) { const int n = (lane >> 3) + 8 * j; const LAS float* s = scr + (8 * c) * 33 + n;
        u32x4 o; o.x = pk2(s[0 * 33], s[1 * 33]); o.y = pk2(s[2 * 33], s[3 * 33]); o.z = pk2(s[4 * 33], s[5 * 33]); o.w = pk2(s[6 * 33], s[7 * 33]);
        *(u32x4*)(WT + (size_t)(row_off + n0 + n) * K + k0 + 8 * c) = o; }
    LDS_WAIT(); asm volatile("" ::: "memory");
}
DI void phase_convert(const Params& p, const Ctx& F) {
    __syncthreads();
    LAS float* scr = (LAS float*)(F.lds + F.wave * 16384);
    const int gw = F.bid * NWAVES + F.wave, NGW = F.G * NWAVES;
    bf16_t* WinT = (bf16_t*)(p.ws + WS_WINT); bf16_t* WoutT = (bf16_t*)(p.ws + WS_WOUTT); bf16_t* WguT = (bf16_t*)(p.ws + WS_WGUT); bf16_t* WdT = (bf16_t*)(p.ws + WS_WDT);
    constexpr int I_IN = 16 * 92, I_OUT = 16 * 32, I_GU = 16 * 8, I_DN = 4 * 32;
    constexpr int NITEMS = I_IN + I_OUT + 32 * 2 * I_GU + 32 * I_DN;
    for (int it = gw; it < NITEMS; it += NGW) {
        int r = it;
        if (r < I_IN) { transpose_item(p.in[I_WIN], 1024, DIN, WinT, 0, scr, r, F.lane); continue; } r -= I_IN;
        if (r < I_OUT) { transpose_item(p.in[I_WOUT], 1024, 1024, WoutT, 0, scr, r, F.lane); continue; } r -= I_OUT;
        if (r < 32 * 2 * I_GU) { const int e = r / (2 * I_GU), r2 = r % (2 * I_GU), up = r2 / I_GU, item = r2 % I_GU;
            const int nb = item % 8, n0 = 32 * nb;
            const int tgt = (n0 / 128) * 256 + (n0 % 128) + (up ? 128 : 0);
            transpose_item((up ? p.in[I_WU] : p.in[I_WG]) + (size_t)e * 1024 * 256, 1024, 256, WguT + (size_t)e * 512 * 1024, tgt - n0, scr, item, F.lane); continue; }
        r -= 32 * 2 * I_GU;
        { const int e = r / I_DN, item = r % I_DN; transpose_item(p.in[I_WD] + (size_t)e * 256 * 1024, 256, 1024, WdT + (size_t)e * 1024 * 256, 0, scr, item, F.lane); }
    }
    { const int gt = F.bid * NTHREADS + F.tid, NG = F.G * NTHREADS; u32x4 z = {0u, 0u, 0u, 0u};
      for (int i = gt; i < 128 * 1024 / 8; i += NG) *(u32x4*)(WinT + (size_t)DIN * 1024 + (size_t)i * 8) = z;
      bf16_t* DupT = (bf16_t*)(p.ws + WS_DUPT); bf16_t* AupT = (bf16_t*)(p.ws + WS_AUPT); bf16_t* GupT = (bf16_t*)(p.ws + WS_GUPT); bf16_t* Wsp = (bf16_t*)(p.ws + WS_WSP);
      for (int i = gt; i < 2 * 512 * 64; i += NG) { const int d = i / (512 * 64), ch = (i / 64) % 512, l = i % 64;
          DupT[i] = (bf16_t)f2bf(p.in[I_DUP][(size_t)(d * 64 + l) * 512 + ch]); AupT[i] = (bf16_t)f2bf(p.in[I_AUP][(size_t)(d * 64 + l) * 512 + ch]); }
      for (int i = gt; i < 512 * 128; i += NG) { const int ch = i / 128, l = i % 128; GupT[i] = (bf16_t)f2bf(p.in[I_GUP][(size_t)l * 512 + ch]); }
      for (int i = gt; i < 8 * 128 * 128; i += NG) Wsp[i] = (bf16_t)f2bf(p.in[I_WSP][i]); }
}

DI void phase_hrows(const Params& p, const Ctx& F) {
    const float* mod = (const float*)(p.ws + WS_MOD); const float* g = p.in[I_GPRE1]; bf16_t* H = (bf16_t*)(p.ws + WS_H);
    const int gw = F.bid * NWAVES + F.wave, NGW = F.G * NWAVES;
    for (int row = gw; row < MR; row += NGW) {
        const float* src = row < NT ? p.in[I_X] + (size_t)row * D : p.in[I_CTX] + (size_t)(row - NT) * D;
        const int bt = row < NT ? row / SEQ : 4;
        const f32x4* xr = (const f32x4*)src + F.lane;
        f32x4 v[4]; float ss = 0.f;
#pragma unroll
        for (int j = 0; j < 4; ++j) { v[j] = xr[64 * j]; ss += (v[j].x * v[j].x + v[j].y * v[j].y) + (v[j].z * v[j].z + v[j].w * v[j].w); }
        const float rstd = 1.f / sqrtf(wave_sum(ss) * (1.f / D) + 1e-6f);
        unsigned long long* o8 = (unsigned long long*)(H + (size_t)row * D) + F.lane;
#pragma unroll
        for (int j = 0; j < 4; ++j) { const int col = 4 * (F.lane + 64 * j);
            const f32x4 gg = *(const f32x4*)(g + col), sh = *(const f32x4*)(mod + bt * 6144 + col), sc = *(const f32x4*)(mod + bt * 6144 + 1024 + col);
            const f32x4 h = v[j] * rstd * gg * (sc + 1.f) + sh;
            o8[64 * j] = (unsigned long long)pk2(h.x, h.y) | ((unsigned long long)pk2(h.z, h.w) << 32); }
    }
}

DI void phase_gemm1(const Params& p, const Ctx& F) {
    pg8::StaticOrder S; S.init(p.ws + WS_H, p.ws + WS_WINT, MR, DINP, 1024, F.G, F.bid);
    pg8::EpiBf16 E{(bf16_t*)(p.ws + WS_Z), DINP};
    pg8::gemm_phase<pg8::EpiBf16, pg8::StaticOrder, false>(F.lds, 1024, S, E);
}

DI void phase_prep(const Params& p, const Ctx& F) {
    const bf16_t* Z = (const bf16_t*)(p.ws + WS_Z);
    bf16_t* Kc = (bf16_t*)(p.ws + WS_KC); bf16_t* Vc = (bf16_t*)(p.ws + WS_VC); bf16_t* Rc = (bf16_t*)(p.ws + WS_RC);
    bf16_t* A0 = (bf16_t*)(p.ws + WS_A0); bf16_t* A1 = (bf16_t*)(p.ws + WS_A1); bf16_t* L0 = (bf16_t*)(p.ws + WS_L0); bf16_t* L1 = (bf16_t*)(p.ws + WS_L1);
    bf16_t* GATE = (bf16_t*)((unsigned char*)p.out + DO_GATE); bf16_t* BV = (bf16_t*)((unsigned char*)p.out + DO_BV);
    const float* conv = p.in[I_CONV];
    LAS float* sl = (LAS float*)F.lds;
    const int t = F.tid;
    for (int it = F.bid; it < MR / 8; it += F.G) {
        const int row0 = it * 8;
        __syncthreads();
        for (int i = t; i < 8 * 384; i += NTHREADS) { const int rr = i / 384, c = i % 384; const float zv = bf2f(Z[(size_t)(row0 + rr) * DINP + OFF_WD + c]);
            sl[i] = c < 128 ? tanhf(zv) : (c < 256 ? zv : sigmoidf_(zv)); }
        __syncthreads();
        float dw0[8], dw1[8], da0[8], da1[8], gt[8];
#pragma unroll
        for (int r = 0; r < 8; ++r) { dw0[r] = dw1[r] = da0[r] = da1[r] = gt[r] = 0.f; }
        for (int l = 0; l < 64; ++l) {
            const float u0 = p.in[I_DUP][(size_t)l * 512 + t], u1 = p.in[I_DUP][(size_t)(64 + l) * 512 + t];
            const float v0 = p.in[I_AUP][(size_t)l * 512 + t], v1 = p.in[I_AUP][(size_t)(64 + l) * 512 + t];
            const float g0 = p.in[I_GUP][(size_t)l * 512 + t], g1 = p.in[I_GUP][(size_t)(64 + l) * 512 + t];
#pragma unroll
            for (int r = 0; r < 8; ++r) { const LAS float* s = sl + r * 384;
                dw0[r] += s[l] * u0; dw1[r] += s[64 + l] * u1; da0[r] += s[128 + l] * v0; da1[r] += s[192 + l] * v1; gt[r] += s[256 + l] * g0 + s[320 + l] * g1; }
        }
        const float w00 = p.in[I_DW0][t], w01 = p.in[I_DW0][512 + t], a00 = p.in[I_A0][t], a01 = p.in[I_A0][512 + t];
        const float ka0 = p.in[I_KA][t], ka1 = p.in[I_KA][512 + t], rk = p.in[I_RK][t];
#pragma unroll 1
        for (int r = 0; r < 8; ++r) {
            const int row = row0 + r;
            float cv[3] = {0.f, 0.f, 0.f};
            if (row < NT) {
                const int tb = row % SEQ, gy = tb / 64, gx = tb % 64;
#pragma unroll
                for (int dy = 0; dy < 3; ++dy) { const int ny = gy + dy - 1; if (ny < 0 || ny >= 128) continue;
#pragma unroll
                    for (int dx = 0; dx < 3; ++dx) { const int nx = gx + dx - 1; if (nx < 0 || nx >= 64) continue;
                        const size_t nrow = (size_t)(row + (dy - 1) * 64 + (dx - 1));
#pragma unroll
                        for (int s3 = 0; s3 < 3; ++s3) cv[s3] += bf2f(Z[nrow * DINP + s3 * 512 + t]) * conv[(dy * 3 + dx) * 1536 + s3 * 512 + t]; } }
            } else {
                const int tb = (row - NT) % CTXL;
#pragma unroll
                for (int dx = 0; dx < 3; ++dx) { const int nx = tb + dx - 1; if (nx < 0 || nx >= CTXL) continue;
                    const size_t nrow = (size_t)(row + dx - 1);
#pragma unroll
                    for (int s3 = 0; s3 < 3; ++s3) cv[s3] += bf2f(Z[nrow * DINP + s3 * 512 + t]) * conv[(3 + dx) * 1536 + s3 * 512 + t]; }
            }
            const float k = cv[0], v = cv[1], rr = cv[2];
            const float wl0 = w00 + dw0[r], wl1 = w01 + dw1[r];
            const float lg0 = -__expf(-softplusf_(-wl0) - 0.5f), lg1 = -__expf(-softplusf_(-wl1) - 0.5f);
            const float a0 = sigmoidf_(a00 + da0[r]), a1 = sigmoidf_(a01 + da1[r]);
            const size_t o = (size_t)row * 512 + t;
            Kc[o] = (bf16_t)f2bf(k); Vc[o] = (bf16_t)f2bf(v); Rc[o] = (bf16_t)f2bf(rr);
            A0[o] = (bf16_t)f2bf(a0); A1[o] = (bf16_t)f2bf(a1); L0[o] = (bf16_t)f2bf(lg0); L1[o] = (bf16_t)f2bf(lg1);
            if (row < NT) {
                const float km0 = k * (1.f + (a0 - 1.f) * ka0), km1 = k * (1.f + (a1 - 1.f) * ka1);
                const float bon = wave_sum(rr * (km0 + km1) * rk);
                GATE[o] = (bf16_t)f2bf(gt[r]); BV[o] = (bf16_t)f2bf(bon * v);
            }
        }
    }
}

DI void phase_gmlp(const Params& p, const Ctx& F) {
    const bf16_t* Z = (const bf16_t*)(p.ws + WS_Z); const bf16_t* Wsp = (const bf16_t*)(p.ws + WS_WSP);
    bf16_t* MIXED = (bf16_t*)((unsigned char*)p.out + DO_MIXED);
    constexpr int LDV = 136;
    LAS bf16_t* vnT = (LAS bf16_t*)F.lds;
    LAS float* gu = (LAS float*)(F.lds + 17408);
    constexpr int LDG = 68;
    const int fr = F.lane & 15, fq = F.lane >> 4;
    for (int un = F.bid; un < 4 * 64 * 8; un += F.G) {
        const int g = un & 7, cc = (un >> 3) & 63, b = un >> 9;
        const size_t tok0 = (size_t)b * SEQ + cc * 128;
        __syncthreads();
        { const int pq = F.tid >> 2, seg = F.tid & 3;
          const bf16_t* zr = Z + (tok0 + pq) * DINP;
          const u32x4 ua = *(const u32x4*)(zr + OFF_U + 64 * g + 16 * seg), ub = *(const u32x4*)(zr + OFF_U + 64 * g + 16 * seg + 8);
          const u32x4 va = *(const u32x4*)(zr + OFF_VA + 64 * g + 16 * seg), vb = *(const u32x4*)(zr + OFF_VA + 64 * g + 16 * seg + 8);
          float u[16], v[16];
#pragma unroll
          for (int j = 0; j < 4; ++j) { u[2 * j] = bflo(ua[j]); u[2 * j + 1] = bfhi(ua[j]); u[8 + 2 * j] = bflo(ub[j]); u[8 + 2 * j + 1] = bfhi(ub[j]);
              v[2 * j] = bflo(va[j]); v[2 * j + 1] = bfhi(va[j]); v[8 + 2 * j] = bflo(vb[j]); v[8 + 2 * j + 1] = bfhi(vb[j]); }
          float s = 0.f;
#pragma unroll
          for (int j = 0; j < 16; ++j) { u[j] = gelu_tanh(u[j]); v[j] = gelu_tanh(v[j]); s += v[j]; }
          s += __shfl_xor(s, 1); s += __shfl_xor(s, 2);
          const float mu = s * (1.f / 64.f); float q = 0.f;
#pragma unroll
          for (int j = 0; j < 16; ++j) { v[j] -= mu; q += v[j] * v[j]; }
          q += __shfl_xor(q, 1); q += __shfl_xor(q, 2);
          const float rstd = 1.f / sqrtf(q * (1.f / 64.f) + 1e-5f);
#pragma unroll
          for (int j = 0; j < 16; ++j) { const int ch = 16 * seg + j; const float vn = v[j] * rstd * p.in[I_GMLNG][64 * g + ch] + p.in[I_GMLNB][64 * g + ch];
              vnT[ch * LDV + pq] = (bf16_t)f2bf(vn); gu[pq * LDG + ch] = u[j]; }
        }
        __syncthreads();
        f32x4 acc[4];
#pragma unroll
        for (int n = 0; n < 4; ++n) acc[n] = (f32x4){0.f, 0.f, 0.f, 0.f};
        const int pp = 16 * F.wave + fr;
#pragma unroll
        for (int s = 0; s < 4; ++s) {
            const bf16x8 bfrag = *(const bf16x8*)(Wsp + ((size_t)(g * 128 + pp)) * 128 + 32 * s + 8 * fq);
#pragma unroll
            for (int n = 0; n < 4; ++n) { const bf16x8 afrag = *(const LAS bf16x8*)(vnT + (16 * n + fr) * LDV + 32 * s + 8 * fq);
                acc[n] = __builtin_amdgcn_mfma_f32_16x16x32_bf16(afrag, bfrag, acc[n], 0, 0, 0); }
        }
        const float bs = p.in[I_BSP][g * 128 + pp];
#pragma unroll
        for (int n = 0; n < 4; ++n) { const int d0 = 16 * n + 4 * fq; const f32x4 gv = *(const LAS f32x4*)(gu + pp * LDG + d0);
            const f32x4 o = gv * (acc[n] + bs);
            u32x2 w; w.x = pk2(o[0], o[1]); w.y = pk2(o[2], o[3]);
            *(u32x2*)(MIXED + (tok0 + pp) * D + 64 * g + d0) = w; }
    }
}

DI void phase_scan_seq(const Params& p, const Ctx& F) {
    const bf16_t* Kc = (const bf16_t*)(p.ws + WS_KC); const bf16_t* Vc = (const bf16_t*)(p.ws + WS_VC); const bf16_t* Rc = (const bf16_t*)(p.ws + WS_RC);
    float* YS = (float*)(p.ws + WS_YS);
    const int vrow = F.tid >> 3, q = F.tid & 7;
    for (int ch = F.bid; ch < 64; ch += F.G) {
        const int d = ch & 1, h = (ch >> 1) & 7, b = ch >> 4;
        const bf16_t* Ad = (const bf16_t*)(p.ws + (d ? WS_A1 : WS_A0)); const bf16_t* Ld = (const bf16_t*)(p.ws + (d ? WS_L1 : WS_L0));
        float kkw[8], kaw[8];
#pragma unroll
        for (int j = 0; j < 8; ++j) { kkw[j] = p.in[I_KK][64 * h + 8 * q + j]; kaw[j] = p.in[I_KA][d * 512 + 64 * h + 8 * q + j]; }
        float S[8];
#pragma unroll
        for (int j = 0; j < 8; ++j) S[j] = 0.f;
        const int TOT = CTXL + SEQ;
        for (int step = 0; step < TOT; ++step) {
            size_t row;
            if (step < CTXL) { const int tc = d ? (CTXL - 1 - step) : step; row = (size_t)NT + b * CTXL + tc; }
            else { const int tl = d ? (SEQ - 1 - (step - CTXL)) : (step - CTXL); row = (size_t)b * SEQ + tl; }
            const size_t o = row * 512 + 64 * h + 8 * q;
            const u32x4 kq = *(const u32x4*)(Kc + o), rq = *(const u32x4*)(Rc + o), aq = *(const u32x4*)(Ad + o), lq = *(const u32x4*)(Ld + o);
            const float vv = bf2f(Vc[row * 512 + 64 * h + vrow]);
            float k[8], r[8], a[8], l[8];
#pragma unroll
            for (int j = 0; j < 4; ++j) { k[2 * j] = bflo(kq[j]); k[2 * j + 1] = bfhi(kq[j]); r[2 * j] = bflo(rq[j]); r[2 * j + 1] = bfhi(rq[j]);
                a[2 * j] = bflo(aq[j]); a[2 * j + 1] = bfhi(aq[j]); l[2 * j] = bflo(lq[j]); l[2 * j + 1] = bfhi(lq[j]); }
            float kk[8], ss = 0.f;
#pragma unroll
            for (int j = 0; j < 8; ++j) { kk[j] = k[j] * kkw[j]; ss += kk[j] * kk[j]; }
            ss += __shfl_xor(ss, 1); ss += __shfl_xor(ss, 2); ss += __shfl_xor(ss, 4);
            const float rn = 1.f / sqrtf(fmaxf(ss, 1e-24f));
            float dot = 0.f;
#pragma unroll
            for (int j = 0; j < 8; ++j) { kk[j] *= rn; dot += S[j] * kk[j]; }
            dot += __shfl_xor(dot, 1); dot += __shfl_xor(dot, 2); dot += __shfl_xor(dot, 4);
            float y = 0.f;
#pragma unroll
            for (int j = 0; j < 8; ++j) { const float w = __expf(l[j]); const float km = k[j] * (1.f + (a[j] - 1.f) * kaw[j]);
                S[j] = S[j] * w - dot * (kk[j] * a[j]) + vv * km; y += S[j] * r[j]; }
            y += __shfl_xor(y, 1); y += __shfl_xor(y, 2); y += __shfl_xor(y, 4);
            if (step >= CTXL && q == 0) YS[((size_t)d * NT + row) * 512 + 64 * h + vrow] = y;
        }
    }
}

DI void phase_post(const Params& p, const Ctx& F) {
    const float* YS = (const float*)(p.ws + WS_YS);
    const bf16_t* GATE = (const bf16_t*)((unsigned char*)p.out + DO_GATE); const bf16_t* BV = (const bf16_t*)((unsigned char*)p.out + DO_BV);
    bf16_t* MIXED = (bf16_t*)((unsigned char*)p.out + DO_MIXED);
    const int t = F.tid; const float lg = p.in[I_LNXG][t], lb = p.in[I_LNXB][t];
    for (int row = F.bid; row < NT; row += F.G) {
        const size_t o = (size_t)row * 512 + t;
        const float y = YS[o] + YS[(size_t)NT * 512 + o];
        const float mu = wave_sum(y) * (1.f / 64.f); const float dd = y - mu; const float var = wave_sum(dd * dd) * (1.f / 64.f);
        const float yn = dd * (1.f / sqrtf(var + 64e-5f)) * lg + lb;
        const float ob = (yn + bf2f(BV[o])) * bf2f(GATE[o]);
        MIXED[(size_t)row * D + 512 + t] = (bf16_t)f2bf(ob);
    }
}

DI void phase_gemm2(const Params& p, const Ctx& F) {
    pg8::StaticOrder S; S.init((unsigned char*)p.out + DO_MIXED, p.ws + WS_WOUTT, NT, 1024, 1024, F.G, F.bid);
    pg8::EpiF32 E{(float*)(p.ws + WS_Y), 1024};
    pg8::gemm_phase<pg8::EpiF32, pg8::StaticOrder, false>(F.lds, 1024, S, E);
}

DI void phase_route(const Params& p, const Ctx& F) {
    LAS float* wr_ = (LAS float*)F.lds;
    for (int i = F.tid; i < 36 * 1024; i += NTHREADS) { const int o = i / 1024, k = i % 1024; wr_[i] = o < 4 ? p.in[I_WRG][k * 4 + o] : p.in[I_WRE][k * 32 + (o - 4)]; }
    __syncthreads();
    const float* mod = (const float*)(p.ws + WS_MOD); const float* Y = (const float*)(p.ws + WS_Y);
    bf16_t* H2 = (bf16_t*)(p.ws + WS_H2); int* cnt = (int*)(p.ws + WS_CTL); int* perm = (int*)(p.ws + WS_PERM); float* ew = (float*)(p.ws + WS_EW);
    const int gw = F.bid * NWAVES + F.wave, NGW = F.G * NWAVES;
    for (int row = gw; row < NT; row += NGW) {
        const int bt = row / SEQ;
        const f32x4* yr = (const f32x4*)(Y + (size_t)row * D) + F.lane; const f32x4* xr = (const f32x4*)(p.in[I_X] + (size_t)row * D) + F.lane;
        f32x4 v[4]; float ss = 0.f;
#pragma unroll
        for (int j = 0; j < 4; ++j) { v[j] = yr[64 * j]; ss += (v[j].x * v[j].x + v[j].y * v[j].y) + (v[j].z * v[j].z + v[j].w * v[j].w); }
        const float rstd = 1.f / sqrtf(wave_sum(ss) * (1.f / D) + 1e-6f);
        float s2 = 0.f;
        f32x4* xo = (f32x4*)(p.out + (size_t)row * D) + F.lane;
#pragma unroll
        for (int j = 0; j < 4; ++j) { const int col = 4 * (F.lane + 64 * j);
            const f32x4 g1 = *(const f32x4*)(mod + bt * 6144 + 2048 + col), gp = *(const f32x4*)(p.in[I_GPOST1] + col);
            v[j] = xr[64 * j] + g1 * (v[j] * rstd * gp);
            xo[64 * j] = v[j];
            s2 += (v[j].x * v[j].x + v[j].y * v[j].y) + (v[j].z * v[j].z + v[j].w * v[j].w); }
        const float rstd2 = 1.f / sqrtf(wave_sum(s2) * (1.f / D) + 1e-6f);
        unsigned long long* o8 = (unsigned long long*)(H2 + (size_t)row * D) + F.lane;
#pragma unroll
        for (int j = 0; j < 4; ++j) { const int col = 4 * (F.lane + 64 * j);
            const f32x4 gg = *(const f32x4*)(p.in[I_GPRE2] + col), sh = *(const f32x4*)(mod + bt * 6144 + 3072 + col), sc = *(const f32x4*)(mod + bt * 6144 + 4096 + col);
            v[j] = v[j] * rstd2 * gg * (sc + 1.f) + sh;
            o8[64 * j] = (unsigned long long)pk2(v[j].x, v[j].y) | ((unsigned long long)pk2(v[j].z, v[j].w) << 32); }
        float mylg = 0.f;
#pragma unroll 2
        for (int o = 0; o < 36; ++o) { float a = 0.f;
#pragma unroll
            for (int j = 0; j < 4; ++j) { const f32x4 w = *(const LAS f32x4*)(wr_ + o * 1024 + 4 * (F.lane + 64 * j)); a += (v[j].x * w.x + v[j].y * w.y) + (v[j].z * w.z + v[j].w * w.w); }
            a = wave_sum(a); mylg = (F.lane == o) ? a : mylg; }
        mylg += (F.lane < 4) ? p.in[I_BRG][F.lane & 3] : p.in[I_BRE][(F.lane - 4) & 31];
        float gl[4];
#pragma unroll
        for (int j = 0; j < 4; ++j) gl[j] = __shfl(mylg, j);
        int gi = 0; float gm = gl[0];
#pragma unroll
        for (int j = 1; j < 4; ++j) if (gl[j] > gm) { gm = gl[j]; gi = j; }
        float gsum = 0.f;
#pragma unroll
        for (int j = 0; j < 4; ++j) gsum += __expf(gl[j] - gm);
        const float gw_ = 1.f / gsum;
        float el[8];
#pragma unroll
        for (int j = 0; j < 8; ++j) el[j] = __shfl(mylg, 4 + gi * 8 + j);
        int i1 = 0; float m1 = el[0];
#pragma unroll
        for (int j = 1; j < 8; ++j) if (el[j] > m1) { m1 = el[j]; i1 = j; }
        int i2 = 0; float m2 = -3.0e38f;
#pragma unroll
        for (int j = 0; j < 8; ++j) if (j != i1 && el[j] > m2) { m2 = el[j]; i2 = j; }
        const float p2 = __expf(m2 - m1);
        const float w1 = gw_ / (1.f + p2), w2 = gw_ * p2 / (1.f + p2);
        if (F.lane == 0) {
            const int e1 = gi * 8 + i1, e2 = gi * 8 + i2;
            const int p1 = atomicAdd(&cnt[e1], 1); perm[(size_t)e1 * NT + p1] = row * 2;
            const int q2 = atomicAdd(&cnt[e2], 1); perm[(size_t)e2 * NT + q2] = row * 2 + 1;
            ew[row * 2] = w1; ew[row * 2 + 1] = w2;
        }
    }
}

DI void moe_tile_prefix(const Params& p, const Ctx& F, LAS int* tp) {
    __syncthreads();
    if (F.tid == 0) { const int* cnt = (const int*)(p.ws + WS_CTL); int acc = 0; for (int e = 0; e < 32; ++e) { tp[e] = acc; acc += (cnt[e] + 255) / 256; } tp[32] = acc; }
    __syncthreads();
}
DI void phase_moe_up(const Params& p, const Ctx& F) {
    LAS int* tp = (LAS int*)(F.lds + pg8::STAGE_BYTES);
    moe_tile_prefix(p, F, tp);
    MoeOrder S{tp, (const int*)(p.ws + WS_CTL), 2, F.G, F.bid, 1024, (const char*)(p.ws + WS_H2), (const char*)(p.ws + WS_WGUT), (size_t)512 * 1024 * 2, (size_t)256 * 1024 * 2, (const int*)(p.ws + WS_PERM), true};
    pg8::EpiMoeUp E{(bf16_t*)(p.ws + WS_HID)};
    pg8::gemm_phase<pg8::EpiMoeUp, MoeOrder, true>(F.lds, 1024, S, E);
}
DI void phase_moe_down(const Params& p, const Ctx& F) {
    LAS int* tp = (LAS int*)(F.lds + pg8::STAGE_BYTES);
    moe_tile_prefix(p, F, tp);
    MoeOrder S{tp, (const int*)(p.ws + WS_CTL), 4, F.G, F.bid, 256, (const char*)(p.ws + WS_HID), (const char*)(p.ws + WS_WDT), (size_t)1024 * 256 * 2, (size_t)256 * 256 * 2, (const int*)(p.ws + WS_PERM), false};
    pg8::EpiMoeDown E{(bf16_t*)(p.ws + WS_YMOE), (const int*)(p.ws + WS_PERM), (const float*)(p.ws + WS_EW)};
    pg8::gemm_phase<pg8::EpiMoeDown, MoeOrder, false>(F.lds, 256, S, E);
}

DI void phase_final(const Params& p, const Ctx& F) {
    const float* mod = (const float*)(p.ws + WS_MOD); const bf16_t* YM = (const bf16_t*)(p.ws + WS_YMOE);
    const int gw = F.bid * NWAVES + F.wave, NGW = F.G * NWAVES;
    for (int row = gw; row < NT; row += NGW) {
        const int bt = row / SEQ;
        const u32x2* y0 = (const u32x2*)(YM + (size_t)row * D) + F.lane; const u32x2* y1 = (const u32x2*)(YM + ((size_t)NT + row) * D) + F.lane;
        f32x4 v[4]; float ss = 0.f;
#pragma unroll
        for (int j = 0; j < 4; ++j) { const u32x2 a = y0[64 * j], b = y1[64 * j];
            v[j] = (f32x4){bflo(a.x) + bflo(b.x), bfhi(a.x) + bfhi(b.x), bflo(a.y) + bflo(b.y), bfhi(a.y) + bfhi(b.y)};
            ss += (v[j].x * v[j].x + v[j].y * v[j].y) + (v[j].z * v[j].z + v[j].w * v[j].w); }
        const float rstd = 1.f / sqrtf(wave_sum(ss) * (1.f / D) + 1e-6f);
        f32x4* xo = (f32x4*)(p.out + (size_t)row * D) + F.lane;
#pragma unroll
        for (int j = 0; j < 4; ++j) { const int col = 4 * (F.lane + 64 * j);
            const f32x4 g2 = *(const f32x4*)(mod + bt * 6144 + 5120 + col), gp = *(const f32x4*)(p.in[I_GPOST2] + col);
            xo[64 * j] = xo[64 * j] + g2 * (v[j] * rstd * gp); }
    }
}

constexpr int NPHASES = 12;
template <int PH> DI void run_phase(const Params& p, const Ctx& F) {
    if constexpr (PH == 0) phase_adaln(p, F);
    if constexpr (PH == 1) phase_convert(p, F);
    if constexpr (PH == 2) phase_hrows(p, F);
    if constexpr (PH == 3) phase_gemm1(p, F);
    if constexpr (PH == 4) { phase_prep(p, F); __syncthreads(); phase_gmlp(p, F); }
    if constexpr (PH == 5) phase_scan_seq(p, F);
    if constexpr (PH == 6) phase_post(p, F);
    if constexpr (PH == 7) phase_gemm2(p, F);
    if constexpr (PH == 8) phase_route(p, F);
    if constexpr (PH == 9) phase_moe_up(p, F);
    if constexpr (PH == 10) phase_moe_down(p, F);
    if constexpr (PH == 11) phase_final(p, F);
}
DI Ctx make_ctx(unsigned char* lds) {
    Ctx F; F.lds = (LAS unsigned char*)lds; F.tid = threadIdx.x; F.lane = F.tid & 63; F.wave = __builtin_amdgcn_readfirstlane(F.tid >> 6); F.G = gridDim.x; F.bid = blockIdx.x; return F;
}
template <int PH> __global__ void __launch_bounds__(NTHREADS, 2) k_phase(Params p) {
    extern __shared__ __attribute__((aligned(16))) unsigned char lds[];
    const Ctx F = make_ctx(lds);
    run_phase<PH>(p, F);
}
__global__ void __launch_bounds__(NTHREADS, 2) k_mega(Params p) {
    extern __shared__ __attribute__((aligned(16))) unsigned char lds[];
    const Ctx F = make_ctx(lds);
    cg::grid_group grid = cg::this_grid();
    run_phase<0>(p, F); run_phase<1>(p, F); grid.sync();
    run_phase<2>(p, F); grid.sync();
    run_phase<3>(p, F); grid.sync();
    run_phase<4>(p, F); grid.sync();
    run_phase<5>(p, F); grid.sync();
    run_phase<6>(p, F); grid.sync();
    run_phase<7>(p, F); grid.sync();
    run_phase<8>(p, F); grid.sync();
    run_phase<9>(p, F); grid.sync();
    run_phase<10>(p, F); grid.sync();
    run_phase<11>(p, F);
}

template <int PH> static void launch_phase(const Params& p, int grid, hipStream_t stream) {
    static bool attr = false;
    if (!attr) { (void)hipFuncSetAttribute((const void*)k_phase<PH>, hipFuncAttributeMaxDynamicSharedMemorySize, LDS_BYTES); attr = true; }
    hipLaunchKernelGGL(k_phase<PH>, dim3(grid), dim3(NTHREADS), LDS_BYTES, stream, p);
}

extern "C" void kernel_launch(void* const* d_in, const int* in_sizes, int n_in, void* d_out, int out_size, void* d_ws, size_t ws_size, hipStream_t stream) {
    static int grid = 0;
    if (grid == 0) {
        int dev = 0, cus = 0, per_cu = 0;
        (void)hipGetDevice(&dev); (void)hipDeviceGetAttribute(&cus, hipDeviceAttributeMultiprocessorCount, dev);
        (void)hipFuncSetAttribute((const void*)k_mega, hipFuncAttributeMaxDynamicSharedMemorySize, LDS_BYTES);
        (void)hipOccupancyMaxActiveBlocksPerMultiprocessor(&per_cu, (const void*)k_mega, NTHREADS, LDS_BYTES);
        (void)hipGetLastError();
        grid = cus > 0 ? cus : 256;
        if (n_in != 34 || ws_size < 512 * MiB) fprintf(stderr, "kernel_launch: unexpected n_in %d / ws_size %zu\n", n_in, ws_size);
    }
    Params p{};
    for (int i = 0; i < 34; ++i) p.in[i] = (const float*)d_in[i];
    p.out = (float*)d_out; p.ws = (unsigned char*)d_ws;
    (void)hipMemsetAsync((char*)d_ws + WS_CTL, 0, CTL_BYTES, stream);
#if ONE_LAUNCH
    void* args[] = {&p};
    hipError_t e = hipLaunchCooperativeKernel((const void*)k_mega, dim3(grid), dim3(NTHREADS), args, LDS_BYTES, stream);
    if (e != hipSuccess) fprintf(stderr, "cooperative launch failed: %s (grid %d)\n", hipGetErrorString(e), grid);
#else
    launch_phase<0>(p, grid, stream); launch_phase<1>(p, grid, stream); launch_phase<2>(p, grid, stream); launch_phase<3>(p, grid, stream);
    launch_phase<4>(p, grid, stream); launch_phase<5>(p, grid, stream); launch_phase<6>(p, grid, stream); launch_phase<7>(p, grid, stream);
    launch_phase<8>(p, grid, stream); launch_phase<9>(p, grid, stream); launch_phase<10>(p, grid, stream); launch_phase<11>(p, grid, stream);
#endif
}
```

```cpp
#include <hip/hip_runtime.h>
#include <hip/hip_cooperative_groups.h>
#include <cstdio>
#include <cstdint>
namespace cg = cooperative_groups;

#ifndef ONE_LAUNCH
#define ONE_LAUNCH 1
#endif

#define DI __device__ __forceinline__
#define LAS __attribute__((address_space(3)))
typedef unsigned short bf16_t;
typedef short bf16x8 __attribute__((ext_vector_type(8)));
typedef short s16x4 __attribute__((ext_vector_type(4)));
typedef float f32x4 __attribute__((ext_vector_type(4)));
typedef float f32x2 __attribute__((ext_vector_type(2)));
typedef unsigned u32x4 __attribute__((ext_vector_type(4)));
typedef unsigned u32x2 __attribute__((ext_vector_type(2)));

constexpr int D = 1024, BATCH = 4, SEQ = 8192, CTXL = 256;
constexpr int NT = BATCH * SEQ;
constexpr int NCX = BATCH * CTXL;
constexpr int MR = NT + NCX;
constexpr int BW = 512, AW = 512, NH = 8, HD = 64;
constexpr int DIN = 2944, DINP = 3072;
constexpr int OFF_K = 0, OFF_V = 512, OFF_R = 1024, OFF_WD = 1536, OFF_AD = 1664, OFF_GD = 1792, OFF_U = 1920, OFF_VA = 2432;
constexpr int NEXP = 32, DEXP = 256;
constexpr int NWAVES = 8, NTHREADS = 512;
constexpr int LDS_BYTES = 147456;

constexpr size_t MiB = 1u << 20;
constexpr size_t WS_CTL = 0, CTL_BYTES = 64 * 1024;
constexpr size_t WS_MOD = 1 * MiB;
constexpr size_t WS_DUPT = 2 * MiB;
constexpr size_t WS_AUPT = WS_DUPT + 131072;
constexpr size_t WS_GUPT = WS_AUPT + 131072;
constexpr size_t WS_WSP = WS_GUPT + 131072;
constexpr size_t WS_WINT = 3 * MiB;
constexpr size_t WS_WOUTT = 9 * MiB;
constexpr size_t WS_WGUT = 11 * MiB;
constexpr size_t WS_WDT = 43 * MiB;
constexpr size_t WS_H = 60 * MiB;
constexpr size_t WS_Z = 126 * MiB;
constexpr size_t ROWB = (size_t)MR * 512 * 2;
constexpr size_t WS_KC = 324 * MiB, WS_VC = WS_KC + ROWB, WS_RC = WS_VC + ROWB, WS_A0 = WS_RC + ROWB, WS_A1 = WS_A0 + ROWB;
constexpr size_t WS_L0 = 60 * MiB, WS_L1 = WS_L0 + ROWB;
constexpr size_t WS_YS = 126 * MiB;
constexpr size_t WS_Y = 126 * MiB;
constexpr size_t WS_H2 = 60 * MiB;
constexpr size_t WS_EIDX = 254 * MiB;
constexpr size_t WS_EW = 255 * MiB;
constexpr size_t WS_PERM = 256 * MiB;
constexpr size_t WS_HID = 260 * MiB;
constexpr size_t WS_YMOE = 296 * MiB;
constexpr size_t DO_MIXED = 0, DO_GATE = 64 * MiB, DO_BV = 96 * MiB;

struct Params { const float* in[34]; float* out; unsigned char* ws; };
enum { I_X = 0, I_C, I_CTX, I_CCTX, I_WMOD, I_BMOD, I_GPRE1, I_GPOST1, I_GPRE2, I_GPOST2, I_WIN, I_CONV, I_GMLNG, I_GMLNB, I_WSP, I_BSP,
       I_DW0, I_DUP, I_A0, I_AUP, I_KK, I_KA, I_RK, I_GUP, I_LNXG, I_LNXB, I_WOUT, I_WRG, I_BRG, I_WRE, I_BRE, I_WG, I_WU, I_WD };

DI unsigned f2bf(float f) { unsigned u = __builtin_bit_cast(unsigned, f); return (u + 0x7fffu + ((u >> 16) & 1u)) >> 16; }
DI unsigned pk2(float lo, float hi) { return f2bf(lo) | (f2bf(hi) << 16); }
DI float bf2f(unsigned b) { return __builtin_bit_cast(float, b << 16); }
DI float bflo(unsigned w) { return __builtin_bit_cast(float, w << 16); }
DI float bfhi(unsigned w) { return __builtin_bit_cast(float, w & 0xffff0000u); }
DI unsigned cvt_pk_bf16(float lo, float hi) { unsigned r; asm volatile("v_cvt_pk_bf16_f32 %0, %1, %2" : "=v"(r) : "v"(lo), "v"(hi)); return r; }
DI float wave_sum(float v) {
#pragma unroll
    for (int o = 1; o < 64; o <<= 1) v += __shfl_xor(v, o);
    return v;
}
DI float sigmoidf_(float x) { return 1.f / (1.f + __expf(-x)); }
DI float siluf_(float x) { return x / (1.f + __expf(-x)); }
DI float softplusf_(float x) { return x > 20.f ? x : log1pf(__expf(x)); }
DI float gelu_tanh(float x) { const float u = 0.7978845608028654f * (x + 0.044715f * x * x * x); return 0.5f * x * (1.f + tanhf(u)); }
#define LDS_WAIT() asm volatile("s_waitcnt lgkmcnt(0)" ::: "memory")

namespace pg8 {
constexpr int BM = 256, BK = 64, HALF = 128, HTB = HALF * BK * 2, STAGE_BYTES = 8 * HTB, NXCD = 8, WGM = 8;
__host__ __device__ __forceinline__ int lds_byte(int r, int c) { const int st = (r >> 4) * 2 + (c >> 5), rr = r & 15, cc = c & 31, ob = rr * 64 + cc * 2; return st * 1024 + (ob ^ (((ob >> 9) & 1) << 5)); }
__host__ __device__ __forceinline__ void stage_rc(int b, int& R, int& C) { const int st = b / 1024, sb = b % 1024, swz = sb ^ (((sb >> 9) & 1) << 5); R = (st >> 1) * 16 + swz / 64; C = (st & 1) * 32 + (swz % 64) / 2; }
__host__ __device__ __forceinline__ int perm32(int rho) { const int n = rho >> 4, i = rho & 15; return 8 * (i >> 2) + 4 * n + (i & 3); }

struct Unit { const char* A; const char* B; const int* ridx; int pm, pn, e, lt, nvalid; };

struct StaticOrder {
    const char* A; const char* Bt; int K; int nM, nN, nwg, G, c;
    __device__ void init(const void* A_, const void* Bt_, int M, int N, int K_, int G_, int c_) { A = (const char*)A_; Bt = (const char*)Bt_; K = K_; nM = M / BM; nN = N / BM; nwg = nM * nN; G = G_; c = c_; }
    __device__ bool next(int i, Unit& u) const {
        const long L = (long)i * G + c; if (L >= nwg) return false;
        int wgid = (int)L; { const int q = nwg / NXCD, r = nwg % NXCD, xcd = wgid % NXCD, off = wgid / NXCD; wgid = (xcd < r ? xcd * (q + 1) : r * (q + 1) + (xcd - r) * q) + off; }
        const int nig = WGM * nN, gid = wgid / nig, fm = gid * WGM, gsz = (nM - fm) < WGM ? (nM - fm) : WGM;
        u.pm = fm + ((wgid % nig) % gsz); u.pn = (wgid % nig) / gsz;
        u.A = A + (size_t)u.pm * BM * K * 2; u.B = Bt + (size_t)u.pn * BM * K * 2; u.ridx = nullptr; u.e = 0; u.lt = 0; u.nvalid = BM; return true;
    }
};

DI int gidx(const Unit& u, int r) { return r < u.nvalid ? (u.ridx[r] >> 1) : 0; }

template <class Epi, class Sched, bool GATHER>
DI void gemm_phase(LAS unsigned char* lds, const int K, const Sched& S, const Epi& E) {
    const int tid = threadIdx.x, wid = __builtin_amdgcn_readfirstlane(tid >> 6), lane = tid & 63, wr = wid >> 2, wc = wid & 3, fr = lane & 15, fq = lane >> 4;
    const int nt = K / BK;
    int Rr[2], Cc[2];
    unsigned voffB[2], vA[2][2], vAn[2][2];
#pragma unroll
    for (int i = 0; i < 2; ++i) { int R, C; stage_rc(tid * 16 + i * 8192, R, C); Rr[i] = R; Cc[i] = C; const int Rb = (R & ~31) + perm32(R & 31);
        voffB[i] = (unsigned)(Rb * K + C) * 2u;
        vA[0][i] = (unsigned)(R * K + C) * 2u; vA[1][i] = (unsigned)((R + HALF) * K + C) * 2u; vAn[0][i] = vA[0][i]; vAn[1][i] = vA[1][i]; }
    const size_t kstep = (size_t)(BK * 2);
    const size_t hstep = (size_t)HALF * K * 2;
    const unsigned ldsw = (unsigned)wid * 1024u;
    const int aoff = lds_byte(wr * 64 + fr, fq * 8), boff = lds_byte(wc * 32 + fr, fq * 8);
#define PG8_SA(b, h) (((b) * 2 + (h)) * HTB)
#define PG8_SB(b, h) ((4 + (b) * 2 + (h)) * HTB)
#define PG8_STAGE(bufoff, gbase, voff) do { _Pragma("unroll") for (int _i = 0; _i < 2; ++_i) \
        __builtin_amdgcn_global_load_lds((const unsigned*)((const char*)(gbase) + (voff)[_i]), (LAS unsigned*)(lds + (bufoff) + ldsw + _i * 8192), 16, 0, 0); } while (0)
#define PG8_LDA(dst, b, h) do { _Pragma("unroll") for (int m = 0; m < 4; ++m) _Pragma("unroll") for (int k = 0; k < 2; ++k) dst[m][k] = *(const LAS bf16x8*)(lds + PG8_SA(b, h) + aoff + m * 2048 + k * 1024); } while (0)
#define PG8_LDB(dst, b, h) do { _Pragma("unroll") for (int n = 0; n < 2; ++n) _Pragma("unroll") for (int k = 0; k < 2; ++k) dst[n][k] = *(const LAS bf16x8*)(lds + PG8_SB(b, h) + boff + n * 2048 + k * 1024); } while (0)
#define PG8_MMA(ai, bj, At, Bt) do { __builtin_amdgcn_s_setprio(1); _Pragma("unroll") for (int m = 0; m < 4; ++m) _Pragma("unroll") for (int n = 0; n < 2; ++n) _Pragma("unroll") for (int k = 0; k < 2; ++k) \
        acc[ai][bj][m][n] = __builtin_amdgcn_mfma_f32_16x16x32_bf16(Bt[n][k], At[m][k], acc[ai][bj][m][n], 0, 0, 0); __builtin_amdgcn_s_setprio(0); } while (0)
#define PG8_WAIT_V(n) asm volatile("s_waitcnt vmcnt(" #n ")" ::: "memory")
#define PG8_WAIT_L(n) asm volatile("s_waitcnt lgkmcnt(" #n ")" ::: "memory")
#define PG8_BAR __builtin_amdgcn_s_barrier()
#define PG8_SCHED __builtin_amdgcn_sched_barrier(0)
    Unit cur, nxt; int ui = 0;
    if (!S.next(0, cur)) return;
    if constexpr (GATHER) {
#pragma unroll
        for (int i = 0; i < 2; ++i) { vA[0][i] = (unsigned)(gidx(cur, Rr[i]) * K + Cc[i]) * 2u; vA[1][i] = (unsigned)(gidx(cur, Rr[i] + HALF) * K + Cc[i]) * 2u; }
    }
    f32x4 acc[2][2][4][2];
#pragma unroll
    for (int a = 0; a < 2; ++a)
#pragma unroll
        for (int b = 0; b < 2; ++b)
#pragma unroll
            for (int m = 0; m < 4; ++m)
#pragma unroll
                for (int n = 0; n < 2; ++n) acc[a][b][m][n] = (f32x4){0.f, 0.f, 0.f, 0.f};
    bf16x8 At[4][2], B0[2][2], B1[2][2];
    const char* cA = cur.A; const char* cB = cur.B;
    PG8_STAGE(PG8_SB(0, 0), cB, voffB); PG8_STAGE(PG8_SB(0, 1), cB + hstep, voffB); PG8_STAGE(PG8_SA(0, 0), cA, vA[0]); PG8_STAGE(PG8_SA(0, 1), cA, vA[1]);
    if (wr == 1) PG8_BAR;
    PG8_WAIT_V(2); PG8_BAR;
    PG8_STAGE(PG8_SB(1, 0), cB + kstep, voffB); PG8_STAGE(PG8_SA(1, 0), cA + kstep, vA[0]); PG8_STAGE(PG8_SB(1, 1), cB + hstep + kstep, voffB);
    PG8_WAIT_V(6); PG8_BAR;
    for (;;) {
        const bool has_next = S.next(ui + 1, nxt);
        const char* nA = has_next ? nxt.A : cA; const char* nB = has_next ? nxt.B : cB;
        if constexpr (GATHER) {
            if (has_next) {
#pragma unroll
                for (int i = 0; i < 2; ++i) { vAn[0][i] = (unsigned)(gidx(nxt, Rr[i]) * K + Cc[i]) * 2u; vAn[1][i] = (unsigned)(gidx(nxt, Rr[i] + HALF) * K + Cc[i]) * 2u; }
            } else {
#pragma unroll
                for (int i = 0; i < 2; ++i) { vAn[0][i] = vA[0][i]; vAn[1][i] = vA[1][i]; }
            }
        }
#pragma unroll 1
        for (int t = 0; t < nt; t += 2) {
            const bool last = (t == nt - 2);
            const char* a1 = cA + (size_t)(t + 1) * kstep;
            const char* a2 = last ? nA : cA + (size_t)(t + 2) * kstep; const char* b2 = last ? nB : cB + (size_t)(t + 2) * kstep;
            const char* a3 = a2 + kstep; const char* b3 = b2 + kstep;
            unsigned w0[2], w1[2];
            if constexpr (GATHER) { w0[0] = last ? vAn[0][0] : vA[0][0]; w0[1] = last ? vAn[0][1] : vA[0][1]; w1[0] = last ? vAn[1][0] : vA[1][0]; w1[1] = last ? vAn[1][1] : vA[1][1]; }
            else { w0[0] = vA[0][0]; w0[1] = vA[0][1]; w1[0] = vA[1][0]; w1[1] = vA[1][1]; }
            PG8_LDB(B0, 0, 0); PG8_LDB(B1, 0, 1); PG8_SCHED; PG8_LDA(At, 0, 0); PG8_STAGE(PG8_SA(1, 1), a1, vA[1]);
            PG8_WAIT_V(8); PG8_WAIT_L(0); PG8_BAR; PG8_MMA(0, 0, At, B0); PG8_MMA(0, 1, At, B1); PG8_BAR; PG8_SCHED;
            PG8_LDA(At, 0, 1); PG8_STAGE(PG8_SB(0, 0), b2, voffB); PG8_STAGE(PG8_SB(0, 1), b2 + hstep, voffB); PG8_STAGE(PG8_SA(0, 0), a2, w0);
            PG8_WAIT_V(8); PG8_WAIT_L(0); PG8_BAR; PG8_MMA(1, 0, At, B0); PG8_MMA(1, 1, At, B1); PG8_BAR; PG8_SCHED;
            PG8_LDB(B0, 1, 0); PG8_LDB(B1, 1, 1); PG8_SCHED; PG8_LDA(At, 1, 0); PG8_STAGE(PG8_SA(0, 1), a2, w1);
            PG8_WAIT_V(8); PG8_WAIT_L(0); PG8_BAR; PG8_MMA(0, 0, At, B0); PG8_MMA(0, 1, At, B1); PG8_BAR; PG8_SCHED;
            PG8_LDA(At, 1, 1); PG8_STAGE(PG8_SB(1, 0), b3, voffB); PG8_STAGE(PG8_SB(1, 1), b3 + hstep, voffB); PG8_STAGE(PG8_SA(1, 0), a3, w0);
            PG8_WAIT_V(8); PG8_WAIT_L(0); PG8_BAR; PG8_MMA(1, 0, At, B0); PG8_MMA(1, 1, At, B1); PG8_BAR; PG8_SCHED;
        }
        if (wr == 0) PG8_BAR;
        E(acc, cur, wr, wc, fr, fq);
        if (!has_next) break;
#pragma unroll
        for (int a = 0; a < 2; ++a)
#pragma unroll
            for (int b = 0; b < 2; ++b)
#pragma unroll
                for (int m = 0; m < 4; ++m)
#pragma unroll
                    for (int n = 0; n < 2; ++n) acc[a][b][m][n] = (f32x4){0.f, 0.f, 0.f, 0.f};
        cur = nxt; cA = nA; cB = nB; ++ui;
        if constexpr (GATHER) {
#pragma unroll
            for (int i = 0; i < 2; ++i) { vA[0][i] = vAn[0][i]; vA[1][i] = vAn[1][i]; }
        }
        if (wr == 1) PG8_BAR;
    }
    PG8_WAIT_V(0);
    PG8_BAR;
#undef PG8_SA
#undef PG8_SB
#undef PG8_STAGE
#undef PG8_LDA
#undef PG8_LDB
#undef PG8_MMA
#undef PG8_WAIT_V
#undef PG8_WAIT_L
#undef PG8_BAR
#undef PG8_SCHED
}

struct EpiBf16 {
    bf16_t* O; int ldc;
    DI void operator()(const f32x4 (&acc)[2][2][4][2], const Unit& u, int wr, int wc, int fr, int fq) const {
        const int row0 = u.pm * BM + wr * 64 + fr, col0 = u.pn * BM + wc * 32 + 8 * fq;
#pragma unroll
        for (int ai = 0; ai < 2; ++ai)
#pragma unroll
            for (int m = 0; m < 4; ++m) { bf16_t* rowp = O + (size_t)(row0 + ai * HALF + m * 16) * ldc + col0;
#pragma unroll
                for (int bj = 0; bj < 2; ++bj) { const f32x4 v0 = acc[ai][bj][m][0], v1 = acc[ai][bj][m][1];
                    u32x4 w; w.x = cvt_pk_bf16(v0[0], v0[1]); w.y = cvt_pk_bf16(v0[2], v0[3]); w.z = cvt_pk_bf16(v1[0], v1[1]); w.w = cvt_pk_bf16(v1[2], v1[3]);
                    *(u32x4*)(rowp + bj * HALF) = w; } }
    }
};
struct EpiF32 {
    float* O; int ldc;
    DI void operator()(const f32x4 (&acc)[2][2][4][2], const Unit& u, int wr, int wc, int fr, int fq) const {
        const int row0 = u.pm * BM + wr * 64 + fr, col0 = u.pn * BM + wc * 32 + 8 * fq;
#pragma unroll
        for (int ai = 0; ai < 2; ++ai)
#pragma unroll
            for (int m = 0; m < 4; ++m) { float* rowp = O + (size_t)(row0 + ai * HALF + m * 16) * ldc + col0;
#pragma unroll
                for (int bj = 0; bj < 2; ++bj) { *(f32x4*)(rowp + bj * HALF) = acc[ai][bj][m][0]; *(f32x4*)(rowp + bj * HALF + 4) = acc[ai][bj][m][1]; } }
    }
};
struct EpiMoeUp {
    bf16_t* HID;
    DI void operator()(const f32x4 (&acc)[2][2][4][2], const Unit& u, int wr, int wc, int fr, int fq) const {
        const int row0 = u.pm * BM + wr * 64 + fr, col0 = u.pn * HALF + wc * 32 + 8 * fq;
#pragma unroll
        for (int ai = 0; ai < 2; ++ai)
#pragma unroll
            for (int m = 0; m < 4; ++m) { bf16_t* rowp = HID + (size_t)(row0 + ai * HALF + m * 16) * DEXP + col0;
                float h[8];
#pragma unroll
                for (int n = 0; n < 2; ++n)
#pragma unroll
                    for (int j = 0; j < 4; ++j) { const float g = acc[ai][0][m][n][j], up = acc[ai][1][m][n][j]; h[n * 4 + j] = siluf_(g) * up; }
                u32x4 w; w.x = cvt_pk_bf16(h[0], h[1]); w.y = cvt_pk_bf16(h[2], h[3]); w.z = cvt_pk_bf16(h[4], h[5]); w.w = cvt_pk_bf16(h[6], h[7]);
                *(u32x4*)rowp = w; }
    }
};
struct EpiMoeDown {
    bf16_t* YM; const int* perm; const float* ew;
    DI void operator()(const f32x4 (&acc)[2][2][4][2], const Unit& u, int wr, int wc, int fr, int fq) const {
        const int col0 = u.pn * BM + wc * 32 + 8 * fq;
#pragma unroll
        for (int ai = 0; ai < 2; ++ai)
#pragma unroll
            for (int m = 0; m < 4; ++m) { const int r = ai * HALF + wr * 64 + m * 16 + fr;
                if (r < u.nvalid) { const int pr = perm[(size_t)u.e * NT + u.lt * BM + r]; const int tok = pr >> 1, slot = pr & 1; const float wgt = ew[pr];
                    bf16_t* rowp = YM + ((size_t)slot * NT + tok) * D + col0;
#pragma unroll
                    for (int bj = 0; bj < 2; ++bj) { const f32x4 v0 = acc[ai][bj][m][0] * wgt, v1 = acc[ai][bj][m][1] * wgt;
                        u32x4 w; w.x = cvt_pk_bf16(v0[0], v0[1]); w.y = cvt_pk_bf16(v0[2], v0[3]); w.z = cvt_pk_bf16(v1[0], v1[1]); w.w = cvt_pk_bf16(v1[2], v1[3]);
                        *(u32x4*)(rowp + bj * HALF) = w; } }
                asm volatile("" ::: "memory"); }
    }
};
}

struct MoeOrder {
    const LAS int* tp; const int* cnt; int npn, G, c, K; const char* A; const char* Bbase; size_t bstride_e, bstride_pn; const int* perm; bool gather;
    __device__ bool next(int i, pg8::Unit& u) const {
        const int TT = __builtin_amdgcn_readfirstlane(tp[32]); const long L = (long)i * G + c; if (L >= (long)TT * npn) return false;
        const int rt = (int)(L / npn), pn = (int)(L % npn);
        int e = 0;
#pragma unroll 1
        for (int j = 1; j < 32; ++j) e += (__builtin_amdgcn_readfirstlane(tp[j]) <= rt) ? 1 : 0;
        const int lt = rt - __builtin_amdgcn_readfirstlane(tp[e]);
        u.pm = rt; u.pn = pn; u.e = e; u.lt = lt; const int rem = cnt[e] - lt * 256; u.nvalid = rem < 256 ? rem : 256;
        u.ridx = perm + (size_t)e * NT + lt * 256;
        u.A = gather ? A : A + (size_t)rt * 256 * K * 2;
        u.B = Bbase + (size_t)e * bstride_e + (size_t)pn * bstride_pn;
        return true;
    }
};

struct Ctx {
    LAS unsigned char* lds; int tid, lane, wave, G, bid;
};

DI void phase_adaln(const Params& p, const Ctx& F) {
    LAS float* s = (LAS float*)F.lds;
    LAS float* red = (LAS float*)(F.lds + 20480);
    const float* c = p.in[I_C]; const float* cc = p.in[I_CCTX]; const float* wm = p.in[I_WMOD]; const float* bm = p.in[I_BMOD];
    float* mod = (float*)(p.ws + WS_MOD);
    for (int i = F.tid; i < 5 * 1024; i += NTHREADS) { const float v = i < 4096 ? c[i] : cc[i - 4096]; s[i] = siluf_(v); }
    __syncthreads();
    for (int grp = F.bid; grp < 256; grp += F.G) {
        const int col0 = grp * 24, q = F.tid % 6, ks = F.tid / 6;
        float acc[5][4];
#pragma unroll
        for (int b = 0; b < 5; ++b)
#pragma unroll
            for (int j = 0; j < 4; ++j) acc[b][j] = 0.f;
        if (F.tid < 510) {
            for (int k = ks; k < 1024; k += 85) {
                const f32x4 w = *(const f32x4*)(wm + (size_t)k * 6144 + col0 + 4 * q);
#pragma unroll
                for (int b = 0; b < 5; ++b) { const float sv = s[b * 1024 + k];
#pragma unroll
                    for (int j = 0; j < 4; ++j) acc[b][j] += sv * w[j]; }
            }
#pragma unroll
            for (int b = 0; b < 5; ++b)
#pragma unroll
                for (int j = 0; j < 4; ++j) red[ks * 120 + q * 20 + b * 4 + j] = acc[b][j];
        }
        __syncthreads();
        if (F.tid < 120) {
            float sum = 0.f;
            for (int k2 = 0; k2 < 85; ++k2) sum += red[k2 * 120 + F.tid];
            const int qq = F.tid / 20, b = (F.tid % 20) / 4, j = F.tid % 4, col = col0 + 4 * qq + j;
            mod[b * 6144 + col] = sum + bm[col];
        }
        __syncthreads();
    }
}

DI void transpose_item(const float* W, int K, int N, bf16_t* WT, int row_off, LAS float* scr, int item, int lane) {
    const int nblk = N / 32, kb = item / nblk, nb = item % nblk, k0 = 64 * kb, n0 = 32 * nb;
#pragma unroll 8
    for (int i = 0; i < 32; ++i) { const int kk = 2 * i + (lane >> 5); scr[kk * 33 + (lane & 31)] = W[(size_t)(k0 + kk) * N + n0 + (lane & 31)]; }
    LDS_WAIT(); asm volatile("" ::: "memory");
    const int c = lane & 7;
#pragma unroll
    for (int j = 0; j < 4; ++j) { const int n = (lane >> 3) + 8 * j; const LAS float* s = scr + (8 * c) * 33 + n;
        u32x4 o; o.x = pk2(s[0 * 33], s[1 * 33]); o.y = pk2(s[2 * 33], s[3 * 33]); o.z = pk2(s[4 * 33], s[5 * 33]); o.w = pk2(s[6 * 33], s[7 * 33]);
        *(u32x4*)(WT + (size_t)(row_off + n0 + n) * K + k0 + 8 * c) = o; }
    LDS_WAIT(); asm volatile("" ::: "memory");
}
DI void phase_convert(const Params& p, const Ctx& F) {
    __syncthreads();
    LAS float* scr = (LAS float*)(F.lds + F.wave * 16384);
    const int gw = F.bid * NWAVES + F.wave, NGW = F.G * NWAVES;
    bf16_t* WinT = (bf16_t*)(p.ws + WS_WINT); bf16_t* WoutT = (bf16_t*)(p.ws + WS_WOUTT); bf16_t* WguT = (bf16_t*)(p.ws + WS_WGUT); bf16_t* WdT = (bf16_t*)(p.ws + WS_WDT);
    constexpr int I_IN = 16 * 92, I_OUT = 16 * 32, I_GU = 16 * 8, I_DN = 4 * 32;
    constexpr int NITEMS = I_IN + I_OUT + 32 * 2 * I_GU + 32 * I_DN;
    for (int it = gw; it < NITEMS; it += NGW) {
        int r = it;
        if (r < I_IN) { transpose_item(p.in[I_WIN], 1024, DIN, WinT, 0, scr, r, F.lane); continue; } r -= I_IN;
        if (r < I_OUT) { transpose_item(p.in[I_WOUT], 1024, 1024, WoutT, 0, scr, r, F.lane); continue; } r -= I_OUT;
        if (r < 32 * 2 * I_GU) { const int e = r / (2 * I_GU), r2 = r % (2 * I_GU), up = r2 / I_GU, item = r2 % I_GU;
            const int nb = item % 8, n0 = 32 * nb;
            const int tgt = (n0 / 128) * 256 + (n0 % 128) + (up ? 128 : 0);
            transpose_item((up ? p.in[I_WU] : p.in[I_WG]) + (size_t)e * 1024 * 256, 1024, 256, WguT + (size_t)e * 512 * 1024, tgt - n0, scr, item, F.lane); continue; }
        r -= 32 * 2 * I_GU;
        { const int e = r / I_DN, item = r % I_DN; transpose_item(p.in[I_WD] + (size_t)e * 256 * 1024, 256, 1024, WdT + (size_t)e * 1024 * 256, 0, scr, item, F.lane); }
    }
    { const int gt = F.bid * NTHREADS + F.tid, NG = F.G * NTHREADS; u32x4 z = {0u, 0u, 0u, 0u};
      for (int i = gt; i < 128 * 1024 / 8; i += NG) *(u32x4*)(WinT + (size_t)DIN * 1024 + (size_t)i * 8) = z;
      bf16_t* DupT = (bf16_t*)(p.ws + WS_DUPT); bf16_t* AupT = (bf16_t*)(p.ws + WS_AUPT); bf16_t* GupT = (bf16_t*)(p.ws + WS_GUPT); bf16_t* Wsp = (bf16_t*)(p.ws + WS_WSP);
      for (int i = gt; i < 2 * 512 * 64; i += NG) { const int d = i / (512 * 64), ch = (i / 64) % 512, l = i % 64;
          DupT[i] = (bf16_t)f2bf(p.in[I_DUP][(size_t)(d * 64 + l) * 512 + ch]); AupT[i] = (bf16_t)f2bf(p.in[I_AUP][(size_t)(d * 64 + l) * 512 + ch]); }
      for (int i = gt; i < 512 * 128; i += NG) { const int ch = i / 128, l = i % 128; GupT[i] = (bf16_t)f2bf(p.in[I_GUP][(size_t)l * 512 + ch]); }
      for (int i = gt; i < 8 * 128 * 128; i += NG) Wsp[i] = (bf16_t)f2bf(p.in[I_WSP][i]); }
}

DI void phase_hrows(const Params& p, const Ctx& F) {
    const float* mod = (const float*)(p.ws + WS_MOD); const float* g = p.in[I_GPRE1]; bf16_t* H = (bf16_t*)(p.ws + WS_H);
    const int gw = F.bid * NWAVES + F.wave, NGW = F.G * NWAVES;
    for (int row = gw; row < MR; row += NGW) {
        const float* src = row < NT ? p.in[I_X] + (size_t)row * D : p.in[I_CTX] + (size_t)(row - NT) * D;
        const int bt = row < NT ? row / SEQ : 4;
        const f32x4* xr = (const f32x4*)src + F.lane;
        f32x4 v[4]; float ss = 0.f;
#pragma unroll
        for (int j = 0; j < 4; ++j) { v[j] = xr[64 * j]; ss += (v[j].x * v[j].x + v[j].y * v[j].y) + (v[j].z * v[j].z + v[j].w * v[j].w); }
        const float rstd = 1.f / sqrtf(wave_sum(ss) * (1.f / D) + 1e-6f);
        unsigned long long* o8 = (unsigned long long*)(H + (size_t)row * D) + F.lane;
#pragma unroll
        for (int j = 0; j < 4; ++j) { const int col = 4 * (F.lane + 64 * j);
            const f32x4 gg = *(const f32x4*)(g + col), sh = *(const f32x4*)(mod + bt * 6144 + col), sc = *(const f32x4*)(mod + bt * 6144 + 1024 + col);
            const f32x4 h = v[j] * rstd * gg * (sc + 1.f) + sh;
            o8[64 * j] = (unsigned long long)pk2(h.x, h.y) | ((unsigned long long)pk2(h.z, h.w) << 32); }
    }
}

DI void phase_gemm1(const Params& p, const Ctx& F) {
    pg8::StaticOrder S; S.init(p.ws + WS_H, p.ws + WS_WINT, MR, DINP, 1024, F.G, F.bid);
    pg8::EpiBf16 E{(bf16_t*)(p.ws + WS_Z), DINP};
    pg8::gemm_phase<pg8::EpiBf16, pg8::StaticOrder, false>(F.lds, 1024, S, E);
}

DI void phase_prep(const Params& p, const Ctx& F) {
    const bf16_t* Z = (const bf16_t*)(p.ws + WS_Z);
    bf16_t* Kc = (bf16_t*)(p.ws + WS_KC); bf16_t* Vc = (bf16_t*)(p.ws + WS_VC); bf16_t* Rc = (bf16_t*)(p.ws + WS_RC);
    bf16_t* A0 = (bf16_t*)(p.ws + WS_A0); bf16_t* A1 = (bf16_t*)(p.ws + WS_A1); bf16_t* L0 = (bf16_t*)(p.ws + WS_L0); bf16_t* L1 = (bf16_t*)(p.ws + WS_L1);
    bf16_t* GATE = (bf16_t*)((unsigned char*)p.out + DO_GATE); bf16_t* BV = (bf16_t*)((unsigned char*)p.out + DO_BV);
    const float* conv = p.in[I_CONV];
    LAS float* sl = (LAS float*)F.lds;
    const int t = F.tid;
    for (int it = F.bid; it < MR / 8; it += F.G) {
        const int row0 = it * 8;
        __syncthreads();
        for (int i = t; i < 8 * 384; i += NTHREADS) { const int rr = i / 384, c = i % 384; const float zv = bf2f(Z[(size_t)(row0 + rr) * DINP + OFF_WD + c]);
            sl[i] = c < 128 ? tanhf(zv) : (c < 256 ? zv : sigmoidf_(zv)); }
        __syncthreads();
        float dw0[8], dw1[8], da0[8], da1[8], gt[8];
#pragma unroll
        for (int r = 0; r < 8; ++r) { dw0[r] = dw1[r] = da0[r] = da1[r] = gt[r] = 0.f; }
        for (int l = 0; l < 64; ++l) {
            const float u0 = p.in[I_DUP][(size_t)l * 512 + t], u1 = p.in[I_DUP][(size_t)(64 + l) * 512 + t];
            const float v0 = p.in[I_AUP][(size_t)l * 512 + t], v1 = p.in[I_AUP][(size_t)(64 + l) * 512 + t];
            const float g0 = p.in[I_GUP][(size_t)l * 512 + t], g1 = p.in[I_GUP][(size_t)(64 + l) * 512 + t];
#pragma unroll
            for (int r = 0; r < 8; ++r) { const LAS float* s = sl + r * 384;
                dw0[r] += s[l] * u0; dw1[r] += s[64 + l] * u1; da0[r] += s[128 + l] * v0; da1[r] += s[192 + l] * v1; gt[r] += s[256 + l] * g0 + s[320 + l] * g1; }
        }
        const float w00 = p.in[I_DW0][t], w01 = p.in[I_DW0][512 + t], a00 = p.in[I_A0][t], a01 = p.in[I_A0][512 + t];
        const float ka0 = p.in[I_KA][t], ka1 = p.in[I_KA][512 + t], rk = p.in[I_RK][t];
#pragma unroll 1
        for (int r = 0; r < 8; ++r) {
            const int row = row0 + r;
            float cv[3] = {0.f, 0.f, 0.f};
            if (row < NT) {
                const int tb = row % SEQ, gy = tb / 64, gx = tb % 64;
#pragma unroll
                for (int dy = 0; dy < 3; ++dy) { const int ny = gy + dy - 1; if (ny < 0 || ny >= 128) continue;
#pragma unroll
                    for (int dx = 0; dx < 3; ++dx) { const int nx = gx + dx - 1; if (nx < 0 || nx >= 64) continue;
                        const size_t nrow = (size_t)(row + (dy - 1) * 64 + (dx - 1));
#pragma unroll
                        for (int s3 = 0; s3 < 3; ++s3) cv[s3] += bf2f(Z[nrow * DINP + s3 * 512 + t]) * conv[(dy * 3 + dx) * 1536 + s3 * 512 + t]; } }
            } else {
                const int tb = (row - NT) % CTXL;
#pragma unroll
                for (int dx = 0; dx < 3; ++dx) { const int nx = tb + dx - 1; if (nx < 0 || nx >= CTXL) continue;
                    const size_t nrow = (size_t)(row + dx - 1);
#pragma unroll
                    for (int s3 = 0; s3 < 3; ++s3) cv[s3] += bf2f(Z[nrow * DINP + s3 * 512 + t]) * conv[(3 + dx) * 1536 + s3 * 512 + t]; }
            }
            const float k = cv[0], v = cv[1], rr = cv[2];
            const float wl0 = w00 + dw0[r], wl1 = w01 + dw1[r];
            const float lg0 = -__expf(-softplusf_(-wl0) - 0.5f), lg1 = -__expf(-softplusf_(-wl1) - 0.5f);
            const float a0 = sigmoidf_(a00 + da0[r]), a1 = sigmoidf_(a01 + da1[r]);
            const size_t o = (size_t)row * 512 + t;
            Kc[o] = (bf16_t)f2bf(k); Vc[o] = (bf16_t)f2bf(v); Rc[o] = (bf16_t)f2bf(rr);
            A0[o] = (bf16_t)f2bf(a0); A1[o] = (bf16_t)f2bf(a1); L0[o] = (bf16_t)f2bf(lg0); L1[o] = (bf16_t)f2bf(lg1);
            if (row < NT) {
                const float km0 = k * (1.f + (a0 - 1.f) * ka0), km1 = k * (1.f + (a1 - 1.f) * ka1);
                const float bon = wave_sum(rr * (km0 + km1) * rk);
                GATE[o] = (bf16_t)f2bf(gt[r]); BV[o] = (bf16_t)f2bf(bon * v);
            }
        }
    }
}

DI void phase_gmlp(const Params& p, const Ctx& F) {
    const bf16_t* Z = (const bf16_t*)(p.ws + WS_Z); const bf16_t* Wsp = (const bf16_t*)(p.ws + WS_WSP);
    bf16_t* MIXED = (bf16_t*)((unsigned char*)p.out + DO_MIXED);
    constexpr int LDV = 136;
    LAS bf16_t* vnT = (LAS bf16_t*)F.lds;
    LAS float* gu = (LAS float*)(F.lds + 17408);
    constexpr int LDG = 68;
    const int fr = F.lane & 15, fq = F.lane >> 4;
    for (int un = F.bid; un < 4 * 64 * 8; un += F.G) {
        const int g = un & 7, cc = (un >> 3) & 63, b = un >> 9;
        const size_t tok0 = (size_t)b * SEQ + cc * 128;
        __syncthreads();
        { const int pq = F.tid >> 2, seg = F.tid & 3;
          const bf16_t* zr = Z + (tok0 + pq) * DINP;
          const u32x4 ua = *(const u32x4*)(zr + OFF_U + 64 * g + 16 * seg), ub = *(const u32x4*)(zr + OFF_U + 64 * g + 16 * seg + 8);
          const u32x4 va = *(const u32x4*)(zr + OFF_VA + 64 * g + 16 * seg), vb = *(const u32x4*)(zr + OFF_VA + 64 * g + 16 * seg + 8);
          float u[16], v[16];
#pragma unroll
          for (int j = 0; j < 4; ++j) { u[2 * j] = bflo(ua[j]); u[2 * j + 1] = bfhi(ua[j]); u[8 + 2 * j] = bflo(ub[j]); u[8 + 2 * j + 1] = bfhi(ub[j]);
              v[2 * j] = bflo(va[j]); v[2 * j + 1] = bfhi(va[j]); v[8 + 2 * j] = bflo(vb[j]); v[8 + 2 * j + 1] = bfhi(vb[j]); }
          float s = 0.f;
#pragma unroll
          for (int j = 0; j < 16; ++j) { u[j] = gelu_tanh(u[j]); v[j] = gelu_tanh(v[j]); s += v[j]; }
          s += __shfl_xor(s, 1); s += __shfl_xor(s, 2);
          const float mu = s * (1.f / 64.f); float q = 0.f;
#pragma unroll
          for (int j = 0; j < 16; ++j) { v[j] -= mu; q += v[j] * v[j]; }
          q += __shfl_xor(q, 1); q += __shfl_xor(q, 2);
          const float rstd = 1.f / sqrtf(q * (1.f / 64.f) + 1e-5f);
#pragma unroll
          for (int j = 0; j < 16; ++j) { const int ch = 16 * seg + j; const float vn = v[j] * rstd * p.in[I_GMLNG][64 * g + ch] + p.in[I_GMLNB][64 * g + ch];
              vnT[ch * LDV + pq] = (bf16_t)f2bf(vn); gu[pq * LDG + ch] = u[j]; }
        }
        __syncthreads();
        f32x4 acc[4];
#pragma unroll
        for (int n = 0; n < 4; ++n) acc[n] = (f32x4){0.f, 0.f, 0.f, 0.f};
        const int pp = 16 * F.wave + fr;
#pragma unroll
        for (int s = 0; s < 4; ++s) {
            const bf16x8 bfrag = *(const bf16x8*)(Wsp + ((size_t)(g * 128 + pp)) * 128 + 32 * s + 8 * fq);
#pragma unroll
            for (int n = 0; n < 4; ++n) { const bf16x8 afrag = *(const LAS bf16x8*)(vnT + (16 * n + fr) * LDV + 32 * s + 8 * fq);
                acc[n] = __builtin_amdgcn_mfma_f32_16x16x32_bf16(afrag, bfrag, acc[n], 0, 0, 0); }
        }
        const float bs = p.in[I_BSP][g * 128 + pp];
#pragma unroll
        for (int n = 0; n < 4; ++n) { const int d0 = 16 * n + 4 * fq; const f32x4 gv = *(const LAS f32x4*)(gu + pp * LDG + d0);
            const f32x4 o = gv * (acc[n] + bs);
            u32x2 w; w.x = pk2(o[0], o[1]); w.y = pk2(o[2], o[3]);
            *(u32x2*)(MIXED + (tok0 + pp) * D + 64 * g + d0) = w; }
    }
}

DI void phase_scan_seq(const Params& p, const Ctx& F) {
    const bf16_t* Kc = (const bf16_t*)(p.ws + WS_KC); const bf16_t* Vc = (const bf16_t*)(p.ws + WS_VC); const bf16_t* Rc = (const bf16_t*)(p.ws + WS_RC);
    float* YS = (float*)(p.ws + WS_YS);
    const int vrow = F.tid >> 3, q = F.tid & 7;
    for (int ch = F.bid; ch < 64; ch += F.G) {
        const int d = ch & 1, h = (ch >> 1) & 7, b = ch >> 4;
        const bf16_t* Ad = (const bf16_t*)(p.ws + (d ? WS_A1 : WS_A0)); const bf16_t* Ld = (const bf16_t*)(p.ws + (d ? WS_L1 : WS_L0));
        float kkw[8], kaw[8];
#pragma unroll
        for (int j = 0; j < 8; ++j) { kkw[j] = p.in[I_KK][64 * h + 8 * q + j]; kaw[j] = p.in[I_KA][d * 512 + 64 * h + 8 * q + j]; }
        float S[8];
#pragma unroll
        for (int j = 0; j < 8; ++j) S[j] = 0.f;
        const int TOT = CTXL + SEQ;
        for (int step = 0; step < TOT; ++step) {
            size_t row;
            if (step < CTXL) { const int tc = d ? (CTXL - 1 - step) : step; row = (size_t)NT + b * CTXL + tc; }
            else { const int tl = d ? (SEQ - 1 - (step - CTXL)) : (step - CTXL); row = (size_t)b * SEQ + tl; }
            const size_t o = row * 512 + 64 * h + 8 * q;
            const u32x4 kq = *(const u32x4*)(Kc + o), rq = *(const u32x4*)(Rc + o), aq = *(const u32x4*)(Ad + o), lq = *(const u32x4*)(Ld + o);
            const float vv = bf2f(Vc[row * 512 + 64 * h + vrow]);
            float k[8], r[8], a[8], l[8];
#pragma unroll
            for (int j = 0; j < 4; ++j) { k[2 * j] = bflo(kq[j]); k[2 * j + 1] = bfhi(kq[j]); r[2 * j] = bflo(rq[j]); r[2 * j + 1] = bfhi(rq[j]);
                a[2 * j] = bflo(aq[j]); a[2 * j + 1] = bfhi(aq[j]); l[2 * j] = bflo(lq[j]); l[2 * j + 1] = bfhi(lq[j]); }
            float kk[8], ss = 0.f;
#pragma unroll
            for (int j = 0; j < 8; ++j) { kk[j] = k[j] * kkw[j]; ss += kk[j] * kk[j]; }
            ss += __shfl_xor(ss, 1); ss += __shfl_xor(ss, 2); ss += __shfl_xor(ss, 4);
            const float rn = 1.f / sqrtf(fmaxf(ss, 1e-24f));
            float dot = 0.f;
#pragma unroll
            for (int j = 0; j < 8; ++j) { kk[j] *= rn; dot += S[j] * kk[j]; }
            dot += __shfl_xor(dot, 1); dot += __shfl_xor(dot, 2); dot += __shfl_xor(dot, 4);
            float y = 0.f;
#pragma unroll
            for (int j = 0; j < 8; ++j) { const float w = __expf(l[j]); const float km = k[j] * (1.f + (a[j] - 1.f) * kaw[j]);
                S[j] = S[j] * w - dot * (kk[j] * a[j]) + vv * km; y += S[j] * r[j]; }
            y += __shfl_xor(y, 1); y += __shfl_xor(y, 2); y += __shfl_xor(y, 4);
            if (step >= CTXL && q == 0) YS[((size_t)d * NT + row) * 512 + 64 * h + vrow] = y;
        }
    }
}

DI void phase_post(const Params& p, const Ctx& F) {
    const float* YS = (const float*)(p.ws + WS_YS);
    const bf16_t* GATE = (const bf16_t*)((unsigned char*)p.out + DO_GATE); const bf16_t* BV = (const bf16_t*)((unsigned char*)p.out + DO_BV);
    bf16_t* MIXED = (bf16_t*)((unsigned char*)p.out + DO_MIXED);
    const int t = F.tid; const float lg = p.in[I_LNXG][t], lb = p.in[I_LNXB][t];
    for (int row = F.bid; row < NT; row += F.G) {
        const size_t o = (size_t)row * 512 + t;
        const float y = YS[o] + YS[(size_t)NT * 512 + o];
        const float mu = wave_sum(y) * (1.f / 64.f); const float dd = y - mu; const float var = wave_sum(dd * dd) * (1.f / 64.f);
        const float yn = dd * (1.f / sqrtf(var + 64e-5f)) * lg + lb;
        const float ob = (yn + bf2f(BV[o])) * bf2f(GATE[o]);
        MIXED[(size_t)row * D + 512 + t] = (bf16_t)f2bf(ob);
    }
}

DI void phase_gemm2(const Params& p, const Ctx& F) {
    pg8::StaticOrder S; S.init((unsigned char*)p.out + DO_MIXED, p.ws + WS_WOUTT, NT, 1024, 1024, F.G, F.bid);
    pg8::EpiF32 E{(float*)(p.ws + WS_Y), 1024};
    pg8::gemm_phase<pg8::EpiF32, pg8::StaticOrder, false>(F.lds, 1024, S, E);
}

DI void phase_route(const Params& p, const Ctx& F) {
    LAS float* wr_ = (LAS float*)F.lds;
    for (int i = F.tid; i < 36 * 1024; i += NTHREADS) { const int o = i / 1024, k = i % 1024; wr_[i] = o < 4 ? p.in[I_WRG][k * 4 + o] : p.in[I_WRE][k * 32 + (o - 4)]; }
    __syncthreads();
    const float* mod = (const float*)(p.ws + WS_MOD); const float* Y = (const float*)(p.ws + WS_Y);
    bf16_t* H2 = (bf16_t*)(p.ws + WS_H2); int* cnt = (int*)(p.ws + WS_CTL); int* perm = (int*)(p.ws + WS_PERM); float* ew = (float*)(p.ws + WS_EW);
    const int gw = F.bid * NWAVES + F.wave, NGW = F.G * NWAVES;
    for (int row = gw; row < NT; row += NGW) {
        const int bt = row / SEQ;
        const f32x4* yr = (const f32x4*)(Y + (size_t)row * D) + F.lane; const f32x4* xr = (const f32x4*)(p.in[I_X] + (size_t)row * D) + F.lane;
        f32x4 v[4]; float ss = 0.f;
#pragma unroll
        for (int j = 0; j < 4; ++j) { v[j] = yr[64 * j]; ss += (v[j].x * v[j].x + v[j].y * v[j].y) + (v[j].z * v[j].z + v[j].w * v[j].w); }
        const float rstd = 1.f / sqrtf(wave_sum(ss) * (1.f / D) + 1e-6f);
        float s2 = 0.f;
        f32x4* xo = (f32x4*)(p.out + (size_t)row * D) + F.lane;
#pragma unroll
        for (int j = 0; j < 4; ++j) { const int col = 4 * (F.lane + 64 * j);
            const f32x4 g1 = *(const f32x4*)(mod + bt * 6144 + 2048 + col), gp = *(const f32x4*)(p.in[I_GPOST1] + col);
            v[j] = xr[64 * j] + g1 * (v[j] * rstd * gp);
            xo[64 * j] = v[j];
            s2 += (v[j].x * v[j].x + v[j].y * v[j].y) + (v[j].z * v[j].z + v[j].w * v[j].w); }
        const float rstd2 = 1.f / sqrtf(wave_sum(s2) * (1.f / D) + 1e-6f);
        unsigned long long* o8 = (unsigned long long*)(H2 + (size_t)row * D) + F.lane;
#pragma unroll
        for (int j = 0; j < 4; ++j) { const int col = 4 * (F.lane + 64 * j);
            const f32x4 gg = *(const f32x4*)(p.in[I_GPRE2] + col), sh = *(const f32x4*)(mod + bt * 6144 + 3072 + col), sc = *(const f32x4*)(mod + bt * 6144 + 4096 + col);
            v[j] = v[j] * rstd2 * gg * (sc + 1.f) + sh;
            o8[64 * j] = (unsigned long long)pk2(v[j].x, v[j].y) | ((unsigned long long)pk2(v[j].z, v[j].w) << 32); }
        float mylg = 0.f;
#pragma unroll 2
        for (int o = 0; o < 36; ++o) { float a = 0.f;
#pragma unroll
            for (int j = 0; j < 4; ++j) { const f32x4 w = *(const LAS f32x4*)(wr_ + o * 1024 + 4 * (F.lane + 64 * j)); a += (v[j].x * w.x + v[j].y * w.y) + (v[j].z * w.z + v[j].w * w.w); }
            a = wave_sum(a); mylg = (F.lane == o) ? a : mylg; }
        mylg += (F.lane < 4) ? p.in[I_BRG][F.lane & 3] : p.in[I_BRE][(F.lane - 4) & 31];
        float gl[4];
#pragma unroll
        for (int j = 0; j < 4; ++j) gl[j] = __shfl(mylg, j);
        int gi = 0; float gm = gl[0];
#pragma unroll
        for (int j = 1; j < 4; ++j) if (gl[j] > gm) { gm = gl[j]; gi = j; }
        float gsum = 0.f;
#pragma unroll
        for (int j = 0; j < 4; ++j) gsum += __expf(gl[j] - gm);
        const float gw_ = 1.f / gsum;
        float el[8];
#pragma unroll
        for (int j = 0; j < 8; ++j) el[j] = __shfl(mylg, 4 + gi * 8 + j);
        int i1 = 0; float m1 = el[0];
#pragma unroll
        for (int j = 1; j < 8; ++j) if (el[j] > m1) { m1 = el[j]; i1 = j; }
        int i2 = 0; float m2 = -3.0e38f;
#pragma unroll
        for (int j = 0; j < 8; ++j) if (j != i1 && el[j] > m2) { m2 = el[j]; i2 = j; }
        const float p2 = __expf(m2 - m1);
        const float w1 = gw_ / (1.f + p2), w2 = gw_ * p2 / (1.f + p2);
        if (F.lane == 0) {
            const int e1 = gi * 8 + i1, e2 = gi * 8 + i2;
            const int p1 = atomicAdd(&cnt[e1], 1); perm[(size_t)e1 * NT + p1] = row * 2;
            const int q2 = atomicAdd(&cnt[e2], 1); perm[(size_t)e2 * NT + q2] = row * 2 + 1;
            ew[row * 2] = w1; ew[row * 2 + 1] = w2;
        }
    }
}

DI void moe_tile_prefix(const Params& p, const Ctx& F, LAS int* tp) {
    __syncthreads();
    if (F.tid == 0) { const int* cnt = (const int*)(p.ws + WS_CTL); int acc = 0; for (int e = 0; e < 32; ++e) { tp[e] = acc; acc += (cnt[e] + 255) / 256; } tp[32] = acc; }
    __syncthreads();
}
DI void phase_moe_up(const Params& p, const Ctx& F) {
    LAS int* tp = (LAS int*)(F.lds + pg8::STAGE_BYTES);
    moe_tile_prefix(p, F, tp);
    MoeOrder S{tp, (const int*)(p.ws + WS_CTL), 2, F.G, F.bid, 1024, (const char*)(p.ws + WS_H2), (const char*)(p.ws + WS_WGUT), (size_t)512 * 1024 * 2, (size_t)256 * 1024 * 2, (const int*)(p.ws + WS_PERM), true};
    pg8::EpiMoeUp E{(bf16_t*)(p.ws + WS_HID)};
    pg8::gemm_phase<pg8::EpiMoeUp, MoeOrder, true>(F.lds, 1024, S, E);
}
DI void phase_moe_down(const Params& p, const Ctx& F) {
    LAS int* tp = (LAS int*)(F.lds + pg8::STAGE_BYTES);
    moe_tile_prefix(p, F, tp);
    MoeOrder S{tp, (const int*)(p.ws + WS_CTL), 4, F.G, F.bid, 256, (const char*)(p.ws + WS_HID), (const char*)(p.ws + WS_WDT), (size_t)1024 * 256 * 2, (size_t)256 * 256 * 2, (const int*)(p.ws + WS_PERM), false};
    pg8::EpiMoeDown E{(bf16_t*)(p.ws + WS_YMOE), (const int*)(p.ws + WS_PERM), (const float*)(p.ws + WS_EW)};
    pg8::gemm_phase<pg8::EpiMoeDown, MoeOrder, false>(F.lds, 256, S, E);
}

DI void phase_final(const Params& p, const Ctx& F) {
    const float* mod = (const float*)(p.ws + WS_MOD); const bf16_t* YM = (const bf16_t*)(p.ws + WS_YMOE);
    const int gw = F.bid * NWAVES + F.wave, NGW = F.G * NWAVES;
    for (int row = gw; row < NT; row += NGW) {
        const int bt = row / SEQ;
        const u32x2* y0 = (const u32x2*)(YM + (size_t)row * D) + F.lane; const u32x2* y1 = (const u32x2*)(YM + ((size_t)NT + row) * D) + F.lane;
        f32x4 v[4]; float ss = 0.f;
#pragma unroll
        for (int j = 0; j < 4; ++j) { const u32x2 a = y0[64 * j], b = y1[64 * j];
            v[j] = (f32x4){bflo(a.x) + bflo(b.x), bfhi(a.x) + bfhi(b.x), bflo(a.y) + bflo(b.y), bfhi(a.y) + bfhi(b.y)};
            ss += (v[j].x * v[j].x + v[j].y * v[j].y) + (v[j].z * v[j].z + v[j].w * v[j].w); }
        const float rstd = 1.f / sqrtf(wave_sum(ss) * (1.f / D) + 1e-6f);
        f32x4* xo = (f32x4*)(p.out + (size_t)row * D) + F.lane;
#pragma unroll
        for (int j = 0; j < 4; ++j) { const int col = 4 * (F.lane + 64 * j);
            const f32x4 g2 = *(const f32x4*)(mod + bt * 6144 + 5120 + col), gp = *(const f32x4*)(p.in[I_GPOST2] + col);
            xo[64 * j] = xo[64 * j] + g2 * (v[j] * rstd * gp); }
    }
}

constexpr int NPHASES = 12;
template <int PH> DI void run_phase(const Params& p, const Ctx& F) {
    if constexpr (PH == 0) phase_adaln(p, F);
    if constexpr (PH == 1) phase_convert(p, F);
    if constexpr (PH == 2) phase_hrows(p, F);
    if constexpr (PH == 3) phase_gemm1(p, F);
    if constexpr (PH == 4) { phase_prep(p, F); __syncthreads(); phase_gmlp(p, F); }
    if constexpr (PH == 5) phase_scan_seq(p, F);
    if constexpr (PH == 6) phase_post(p, F);
    if constexpr (PH == 7) phase_gemm2(p, F);
    if constexpr (PH == 8) phase_route(p, F);
    if constexpr (PH == 9) phase_moe_up(p, F);
    if constexpr (PH == 10) phase_moe_down(p, F);
    if constexpr (PH == 11) phase_final(p, F);
}
DI Ctx make_ctx(unsigned char* lds) {
    Ctx F; F.lds = (LAS unsigned char*)lds; F.tid = threadIdx.x; F.lane = F.tid & 63; F.wave = __builtin_amdgcn_readfirstlane(F.tid >> 6); F.G = gridDim.x; F.bid = blockIdx.x; return F;
}
template <int PH> __global__ void __launch_bounds__(NTHREADS, 2) k_phase(Params p) {
    extern __shared__ __attribute__((aligned(16))) unsigned char lds[];
    const Ctx F = make_ctx(lds);
    run_phase<PH>(p, F);
}
__global__ void __launch_bounds__(NTHREADS, 2) k_mega(Params p) {
    extern __shared__ __attribute__((aligned(16))) unsigned char lds[];
    const Ctx F = make_ctx(lds);
    cg::grid_group grid = cg::this_grid();
    run_phase<0>(p, F); run_phase<1>(p, F); grid.sync();
    run_phase<2>(p, F); grid.sync();
    run_phase<3>(p, F); grid.sync();
    run_phase<4>(p, F); grid.sync();
    run_phase<5>(p, F); grid.sync();
    run_phase<6>(p, F); grid.sync();
    run_phase<7>(p, F); grid.sync();
    run_phase<8>(p, F); grid.sync();
    run_phase<9>(p, F); grid.sync();
    run_phase<10>(p, F); grid.sync();
    run_phase<11>(p, F);
}

template <int PH> static void launch_phase(const Params& p, int grid, hipStream_t stream) {
    static bool attr = false;
    if (!attr) { (void)hipFuncSetAttribute((const void*)k_phase<PH>, hipFuncAttributeMaxDynamicSharedMemorySize, LDS_BYTES); attr = true; }
    hipLaunchKernelGGL(k_phase<PH>, dim3(grid), dim3(NTHREADS), LDS_BYTES, stream, p);
}

extern "C" void kernel_launch(void* const* d_in, const int* in_sizes, int n_in, void* d_out, int out_size, void* d_ws, size_t ws_size, hipStream_t stream) {
    static int grid = 0;
    if (grid == 0) {
        int dev = 0, cus = 0, per_cu = 0;
        (void)hipGetDevice(&dev); (void)hipDeviceGetAttribute(&cus, hipDeviceAttributeMultiprocessorCount, dev);
        (void)hipFuncSetAttribute((const void*)k_mega, hipFuncAttributeMaxDynamicSharedMemorySize, LDS_BYTES);
        (void)hipOccupancyMaxActiveBlocksPerMultiprocessor(&per_cu, (const void*)k_mega, NTHREADS, LDS_BYTES);
        (void)hipGetLastError();
        grid = cus > 0 ? cus : 256;
        if (n_in != 34 || ws_size < 512 * MiB) fprintf(stderr, "kernel_launch: unexpected n_in %d / ws_size %zu\n", n_in, ws_size);
    }
    Params p{};
    for (int i = 0; i < 34; ++i) p.in[i] = (const float*)d_in[i];
    p.out = (float*)d_out; p.ws = (unsigned char*)d_ws;
    (void)hipMemsetAsync((char*)d_ws + WS_CTL, 0, CTL_BYTES, stream);
#if ONE_LAUNCH
    void* args[] = {&p};
    hipError_t e = hipLaunchCooperativeKernel((const void*)k_mega, dim3(grid), dim3(NTHREADS), args, LDS_BYTES, stream);
    if (e != hipSuccess) fprintf(stderr, "cooperative launch failed: %s (grid %d)\n", hipGetErrorString(e), grid);
#else
    launch_phase<0>(p, grid, stream); launch_phase<1>(p, grid, stream); launch_phase<2>(p, grid, stream); launch_phase<3>(p, grid, stream);
    launch_phase<4>(p, grid, stream); launch_phase<5>(p, grid, stream); launch_phase<6>(p, grid, stream); launch_phase<7>(p, grid, stream);
    launch_phase<8>(p, grid, stream); launch_phase<9>(p, grid, stream); launch_phase<10>(p, grid, stream); launch_phase<11>(p, grid, stream);
#endif
}
```

```cpp
#include <hip/hip_runtime.h>
#include <hip/hip_cooperative_groups.h>
#include <cstdio>
#include <cstdint>
namespace cg = cooperative_groups;

#ifndef ONE_LAUNCH
#define ONE_LAUNCH 1
#endif

#define DI __device__ __forceinline__
#define LAS __attribute__((address_space(3)))
typedef unsigned short bf16_t;
typedef short bf16x8 __attribute__((ext_vector_type(8)));
typedef short s16x4 __attribute__((ext_vector_type(4)));
typedef float f32x4 __attribute__((ext_vector_type(4)));
typedef float f32x2 __attribute__((ext_vector_type(2)));
typedef unsigned u32x4 __attribute__((ext_vector_type(4)));
typedef unsigned u32x2 __attribute__((ext_vector_type(2)));

constexpr int D = 1024, BATCH = 4, SEQ = 8192, CTXL = 256;
constexpr int NT = BATCH * SEQ;
constexpr int NCX = BATCH * CTXL;
constexpr int MR = NT + NCX;
constexpr int BW = 512, AW = 512, NH = 8, HD = 64;
constexpr int DIN = 2944, DINP = 3072;
constexpr int OFF_K = 0, OFF_V = 512, OFF_R = 1024, OFF_WD = 1536, OFF_AD = 1664, OFF_GD = 1792, OFF_U = 1920, OFF_VA = 2432;
constexpr int NEXP = 32, DEXP = 256;
constexpr int NWAVES = 8, NTHREADS = 512;
constexpr int LDS_BYTES = 147456;

constexpr size_t MiB = 1u << 20;
constexpr size_t WS_CTL = 0, CTL_BYTES = 64 * 1024;
constexpr size_t WS_MOD = 1 * MiB;
constexpr size_t WS_DUPT = 2 * MiB;
constexpr size_t WS_AUPT = WS_DUPT + 131072;
constexpr size_t WS_GUPT = WS_AUPT + 131072;
constexpr size_t WS_WSP = WS_GUPT + 131072;
constexpr size_t WS_WINT = 3 * MiB;
constexpr size_t WS_WOUTT = 9 * MiB;
constexpr size_t WS_WGUT = 11 * MiB;
constexpr size_t WS_WDT = 43 * MiB;
constexpr size_t WS_H = 60 * MiB;
constexpr size_t WS_Z = 126 * MiB;
constexpr size_t ROWB = (size_t)MR * 512 * 2;
constexpr size_t WS_KC = 324 * MiB, WS_VC = WS_KC + ROWB, WS_RC = WS_VC + ROWB, WS_A0 = WS_RC + ROWB, WS_A1 = WS_A0 + ROWB;
constexpr size_t WS_L0 = 60 * MiB, WS_L1 = WS_L0 + ROWB;
constexpr size_t WS_YS = 126 * MiB;
constexpr size_t WS_OPS = 126 * MiB;
constexpr size_t WS_YIMG = 258 * MiB;
constexpr size_t WS_Y = 126 * MiB;
constexpr size_t WS_H2 = 60 * MiB;
constexpr size_t WS_EIDX = 254 * MiB;
constexpr size_t WS_EW = 255 * MiB;
constexpr size_t WS_PERM = 256 * MiB;
constexpr size_t WS_HID = 260 * MiB;
constexpr size_t WS_YMOE = 296 * MiB;
constexpr size_t DO_MIXED = 0, DO_GATE = 64 * MiB, DO_BV = 96 * MiB;

struct Params { const float* in[34]; float* out; unsigned char* ws; };
enum { I_X = 0, I_C, I_CTX, I_CCTX, I_WMOD, I_BMOD, I_GPRE1, I_GPOST1, I_GPRE2, I_GPOST2, I_WIN, I_CONV, I_GMLNG, I_GMLNB, I_WSP, I_BSP,
       I_DW0, I_DUP, I_A0, I_AUP, I_KK, I_KA, I_RK, I_GUP, I_LNXG, I_LNXB, I_WOUT, I_WRG, I_BRG, I_WRE, I_BRE, I_WG, I_WU, I_WD };

DI unsigned f2bf(float f) { unsigned u = __builtin_bit_cast(unsigned, f); return (u + 0x7fffu + ((u >> 16) & 1u)) >> 16; }
DI unsigned pk2(float lo, float hi) { return f2bf(lo) | (f2bf(hi) << 16); }
DI float bf2f(unsigned b) { return __builtin_bit_cast(float, b << 16); }
DI float bflo(unsigned w) { return __builtin_bit_cast(float, w << 16); }
DI float bfhi(unsigned w) { return __builtin_bit_cast(float, w & 0xffff0000u); }
DI unsigned cvt_pk_bf16(float lo, float hi) { unsigned r; asm volatile("v_cvt_pk_bf16_f32 %0, %1, %2" : "=v"(r) : "v"(lo), "v"(hi)); return r; }
DI float wave_sum(float v) {
#pragma unroll
    for (int o = 1; o < 64; o <<= 1) v += __shfl_xor(v, o);
    return v;
}
DI float sigmoidf_(float x) { return 1.f / (1.f + __expf(-x)); }
DI float siluf_(float x) { return x / (1.f + __expf(-x)); }
DI float softplusf_(float x) { return x > 20.f ? x : log1pf(__expf(x)); }
DI float gelu_tanh(float x) { const float u = 0.7978845608028654f * (x + 0.044715f * x * x * x); return 0.5f * x * (1.f + tanhf(u)); }
#define LDS_WAIT() asm volatile("s_waitcnt lgkmcnt(0)" ::: "memory")

namespace pg8 {
constexpr int BM = 256, BK = 64, HALF = 128, HTB = HALF * BK * 2, STAGE_BYTES = 8 * HTB, NXCD = 8, WGM = 8;
__host__ __device__ __forceinline__ int lds_byte(int r, int c) { const int st = (r >> 4) * 2 + (c >> 5), rr = r & 15, cc = c & 31, ob = rr * 64 + cc * 2; return st * 1024 + (ob ^ (((ob >> 9) & 1) << 5)); }
__host__ __device__ __forceinline__ void stage_rc(int b, int& R, int& C) { const int st = b / 1024, sb = b % 1024, swz = sb ^ (((sb >> 9) & 1) << 5); R = (st >> 1) * 16 + swz / 64; C = (st & 1) * 32 + (swz % 64) / 2; }
__host__ __device__ __forceinline__ int perm32(int rho) { const int n = rho >> 4, i = rho & 15; return 8 * (i >> 2) + 4 * n + (i & 3); }

struct Unit { const char* A; const char* B; const int* ridx; int pm, pn, e, lt, nvalid; };

struct StaticOrder {
    const char* A; const char* Bt; int K; int nM, nN, nwg, G, c;
    __device__ void init(const void* A_, const void* Bt_, int M, int N, int K_, int G_, int c_) { A = (const char*)A_; Bt = (const char*)Bt_; K = K_; nM = M / BM; nN = N / BM; nwg = nM * nN; G = G_; c = c_; }
    __device__ bool next(int i, Unit& u) const {
        const long L = (long)i * G + c; if (L >= nwg) return false;
        int wgid = (int)L; { const int q = nwg / NXCD, r = nwg % NXCD, xcd = wgid % NXCD, off = wgid / NXCD; wgid = (xcd < r ? xcd * (q + 1) : r * (q + 1) + (xcd - r) * q) + off; }
        const int nig = WGM * nN, gid = wgid / nig, fm = gid * WGM, gsz = (nM - fm) < WGM ? (nM - fm) : WGM;
        u.pm = fm + ((wgid % nig) % gsz); u.pn = (wgid % nig) / gsz;
        u.A = A + (size_t)u.pm * BM * K * 2; u.B = Bt + (size_t)u.pn * BM * K * 2; u.ridx = nullptr; u.e = 0; u.lt = 0; u.nvalid = BM; return true;
    }
};

DI int gidx(const Unit& u, int r) { return r < u.nvalid ? (u.ridx[r] >> 1) : 0; }

template <class Epi, class Sched, bool GATHER>
DI void gemm_phase(LAS unsigned char* lds, const int K, const Sched& S, const Epi& E) {
    const int tid = threadIdx.x, wid = __builtin_amdgcn_readfirstlane(tid >> 6), lane = tid & 63, wr = wid >> 2, wc = wid & 3, fr = lane & 15, fq = lane >> 4;
    const int nt = K / BK;
    int Rr[2], Cc[2];
    unsigned voffB[2], vA[2][2], vAn[2][2];
#pragma unroll
    for (int i = 0; i < 2; ++i) { int R, C; stage_rc(tid * 16 + i * 8192, R, C); Rr[i] = R; Cc[i] = C; const int Rb = (R & ~31) + perm32(R & 31);
        voffB[i] = (unsigned)(Rb * K + C) * 2u;
        vA[0][i] = (unsigned)(R * K + C) * 2u; vA[1][i] = (unsigned)((R + HALF) * K + C) * 2u; vAn[0][i] = vA[0][i]; vAn[1][i] = vA[1][i]; }
    const size_t kstep = (size_t)(BK * 2);
    const size_t hstep = (size_t)HALF * K * 2;
    const unsigned ldsw = (unsigned)wid * 1024u;
    const int aoff = lds_byte(wr * 64 + fr, fq * 8), boff = lds_byte(wc * 32 + fr, fq * 8);
#define PG8_SA(b, h) (((b) * 2 + (h)) * HTB)
#define PG8_SB(b, h) ((4 + (b) * 2 + (h)) * HTB)
#define PG8_STAGE(bufoff, gbase, voff) do { _Pragma("unroll") for (int _i = 0; _i < 2; ++_i) \
        __builtin_amdgcn_global_load_lds((const unsigned*)((const char*)(gbase) + (voff)[_i]), (LAS unsigned*)(lds + (bufoff) + ldsw + _i * 8192), 16, 0, 0); } while (0)
#define PG8_LDA(dst, b, h) do { _Pragma("unroll") for (int m = 0; m < 4; ++m) _Pragma("unroll") for (int k = 0; k < 2; ++k) dst[m][k] = *(const LAS bf16x8*)(lds + PG8_SA(b, h) + aoff + m * 2048 + k * 1024); } while (0)
#define PG8_LDB(dst, b, h) do { _Pragma("unroll") for (int n = 0; n < 2; ++n) _Pragma("unroll") for (int k = 0; k < 2; ++k) dst[n][k] = *(const LAS bf16x8*)(lds + PG8_SB(b, h) + boff + n * 2048 + k * 1024); } while (0)
#define PG8_MMA(ai, bj, At, Bt) do { __builtin_amdgcn_s_setprio(1); _Pragma("unroll") for (int m = 0; m < 4; ++m) _Pragma("unroll") for (int n = 0; n < 2; ++n) _Pragma("unroll") for (int k = 0; k < 2; ++k) \
        acc[ai][bj][m][n] = __builtin_amdgcn_mfma_f32_16x16x32_bf16(Bt[n][k], At[m][k], acc[ai][bj][m][n], 0, 0, 0); __builtin_amdgcn_s_setprio(0); } while (0)
#define PG8_WAIT_V(n) asm volatile("s_waitcnt vmcnt(" #n ")" ::: "memory")
#define PG8_WAIT_L(n) asm volatile("s_waitcnt lgkmcnt(" #n ")" ::: "memory")
#define PG8_BAR __builtin_amdgcn_s_barrier()
#define PG8_SCHED __builtin_amdgcn_sched_barrier(0)
    Unit cur, nxt; int ui = 0;
    if (!S.next(0, cur)) return;
    if constexpr (GATHER) {
#pragma unroll
        for (int i = 0; i < 2; ++i) { vA[0][i] = (unsigned)(gidx(cur, Rr[i]) * K + Cc[i]) * 2u; vA[1][i] = (unsigned)(gidx(cur, Rr[i] + HALF) * K + Cc[i]) * 2u; }
    }
    f32x4 acc[2][2][4][2];
#pragma unroll
    for (int a = 0; a < 2; ++a)
#pragma unroll
        for (int b = 0; b < 2; ++b)
#pragma unroll
            for (int m = 0; m < 4; ++m)
#pragma unroll
                for (int n = 0; n < 2; ++n) acc[a][b][m][n] = (f32x4){0.f, 0.f, 0.f, 0.f};
    bf16x8 At[4][2], B0[2][2], B1[2][2];
    const char* cA = cur.A; const char* cB = cur.B;
    PG8_STAGE(PG8_SB(0, 0), cB, voffB); PG8_STAGE(PG8_SB(0, 1), cB + hstep, voffB); PG8_STAGE(PG8_SA(0, 0), cA, vA[0]); PG8_STAGE(PG8_SA(0, 1), cA, vA[1]);
    if (wr == 1) PG8_BAR;
    PG8_WAIT_V(2); PG8_BAR;
    PG8_STAGE(PG8_SB(1, 0), cB + kstep, voffB); PG8_STAGE(PG8_SA(1, 0), cA + kstep, vA[0]); PG8_STAGE(PG8_SB(1, 1), cB + hstep + kstep, voffB);
    PG8_WAIT_V(6); PG8_BAR;
    for (;;) {
        const bool has_next = S.next(ui + 1, nxt);
        const char* nA = has_next ? nxt.A : cA; const char* nB = has_next ? nxt.B : cB;
        if constexpr (GATHER) {
            if (has_next) {
#pragma unroll
                for (int i = 0; i < 2; ++i) { vAn[0][i] = (unsigned)(gidx(nxt, Rr[i]) * K + Cc[i]) * 2u; vAn[1][i] = (unsigned)(gidx(nxt, Rr[i] + HALF) * K + Cc[i]) * 2u; }
            } else {
#pragma unroll
                for (int i = 0; i < 2; ++i) { vAn[0][i] = vA[0][i]; vAn[1][i] = vA[1][i]; }
            }
        }
#pragma unroll 1
        for (int t = 0; t < nt; t += 2) {
            const bool last = (t == nt - 2);
            const char* a1 = cA + (size_t)(t + 1) * kstep;
            const char* a2 = last ? nA : cA + (size_t)(t + 2) * kstep; const char* b2 = last ? nB : cB + (size_t)(t + 2) * kstep;
            const char* a3 = a2 + kstep; const char* b3 = b2 + kstep;
            unsigned w0[2], w1[2];
            if constexpr (GATHER) { w0[0] = last ? vAn[0][0] : vA[0][0]; w0[1] = last ? vAn[0][1] : vA[0][1]; w1[0] = last ? vAn[1][0] : vA[1][0]; w1[1] = last ? vAn[1][1] : vA[1][1]; }
            else { w0[0] = vA[0][0]; w0[1] = vA[0][1]; w1[0] = vA[1][0]; w1[1] = vA[1][1]; }
            PG8_LDB(B0, 0, 0); PG8_LDB(B1, 0, 1); PG8_SCHED; PG8_LDA(At, 0, 0); PG8_STAGE(PG8_SA(1, 1), a1, vA[1]);
            PG8_WAIT_V(8); PG8_WAIT_L(0); PG8_BAR; PG8_MMA(0, 0, At, B0); PG8_MMA(0, 1, At, B1); PG8_BAR; PG8_SCHED;
            PG8_LDA(At, 0, 1); PG8_STAGE(PG8_SB(0, 0), b2, voffB); PG8_STAGE(PG8_SB(0, 1), b2 + hstep, voffB); PG8_STAGE(PG8_SA(0, 0), a2, w0);
            PG8_WAIT_V(8); PG8_WAIT_L(0); PG8_BAR; PG8_MMA(1, 0, At, B0); PG8_MMA(1, 1, At, B1); PG8_BAR; PG8_SCHED;
            PG8_LDB(B0, 1, 0); PG8_LDB(B1, 1, 1); PG8_SCHED; PG8_LDA(At, 1, 0); PG8_STAGE(PG8_SA(0, 1), a2, w1);
            PG8_WAIT_V(8); PG8_WAIT_L(0); PG8_BAR; PG8_MMA(0, 0, At, B0); PG8_MMA(0, 1, At, B1); PG8_BAR; PG8_SCHED;
            PG8_LDA(At, 1, 1); PG8_STAGE(PG8_SB(1, 0), b3, voffB); PG8_STAGE(PG8_SB(1, 1), b3 + hstep, voffB); PG8_STAGE(PG8_SA(1, 0), a3, w0);
            PG8_WAIT_V(8); PG8_WAIT_L(0); PG8_BAR; PG8_MMA(1, 0, At, B0); PG8_MMA(1, 1, At, B1); PG8_BAR; PG8_SCHED;
        }
        if (wr == 0) PG8_BAR;
        E(acc, cur, wr, wc, fr, fq);
        if (!has_next) break;
#pragma unroll
        for (int a = 0; a < 2; ++a)
#pragma unroll
            for (int b = 0; b < 2; ++b)
#pragma unroll
                for (int m = 0; m < 4; ++m)
#pragma unroll
                    for (int n = 0; n < 2; ++n) acc[a][b][m][n] = (f32x4){0.f, 0.f, 0.f, 0.f};
        cur = nxt; cA = nA; cB = nB; ++ui;
        if constexpr (GATHER) {
#pragma unroll
            for (int i = 0; i < 2; ++i) { vA[0][i] = vAn[0][i]; vA[1][i] = vAn[1][i]; }
        }
        if (wr == 1) PG8_BAR;
    }
    PG8_WAIT_V(0);
    PG8_BAR;
#undef PG8_SA
#undef PG8_SB
#undef PG8_STAGE
#undef PG8_LDA
#undef PG8_LDB
#undef PG8_MMA
#undef PG8_WAIT_V
#undef PG8_WAIT_L
#undef PG8_BAR
#undef PG8_SCHED
}

struct EpiBf16 {
    bf16_t* O; int ldc;
    DI void operator()(const f32x4 (&acc)[2][2][4][2], const Unit& u, int wr, int wc, int fr, int fq) const {
        const int row0 = u.pm * BM + wr * 64 + fr, col0 = u.pn * BM + wc * 32 + 8 * fq;
#pragma unroll
        for (int ai = 0; ai < 2; ++ai)
#pragma unroll
            for (int m = 0; m < 4; ++m) { bf16_t* rowp = O + (size_t)(row0 + ai * HALF + m * 16) * ldc + col0;
#pragma unroll
                for (int bj = 0; bj < 2; ++bj) { const f32x4 v0 = acc[ai][bj][m][0], v1 = acc[ai][bj][m][1];
                    u32x4 w; w.x = cvt_pk_bf16(v0[0], v0[1]); w.y = cvt_pk_bf16(v0[2], v0[3]); w.z = cvt_pk_bf16(v1[0], v1[1]); w.w = cvt_pk_bf16(v1[2], v1[3]);
                    *(u32x4*)(rowp + bj * HALF) = w; } }
    }
};
struct EpiF32 {
    float* O; int ldc;
    DI void operator()(const f32x4 (&acc)[2][2][4][2], const Unit& u, int wr, int wc, int fr, int fq) const {
        const int row0 = u.pm * BM + wr * 64 + fr, col0 = u.pn * BM + wc * 32 + 8 * fq;
#pragma unroll
        for (int ai = 0; ai < 2; ++ai)
#pragma unroll
            for (int m = 0; m < 4; ++m) { float* rowp = O + (size_t)(row0 + ai * HALF + m * 16) * ldc + col0;
#pragma unroll
                for (int bj = 0; bj < 2; ++bj) { *(f32x4*)(rowp + bj * HALF) = acc[ai][bj][m][0]; *(f32x4*)(rowp + bj * HALF + 4) = acc[ai][bj][m][1]; } }
    }
};
struct EpiMoeUp {
    bf16_t* HID;
    DI void operator()(const f32x4 (&acc)[2][2][4][2], const Unit& u, int wr, int wc, int fr, int fq) const {
        const int row0 = u.pm * BM + wr * 64 + fr, col0 = u.pn * HALF + wc * 32 + 8 * fq;
#pragma unroll
        for (int ai = 0; ai < 2; ++ai)
#pragma unroll
            for (int m = 0; m < 4; ++m) { bf16_t* rowp = HID + (size_t)(row0 + ai * HALF + m * 16) * DEXP + col0;
                float h[8];
#pragma unroll
                for (int n = 0; n < 2; ++n)
#pragma unroll
                    for (int j = 0; j < 4; ++j) { const float g = acc[ai][0][m][n][j], up = acc[ai][1][m][n][j]; h[n * 4 + j] = siluf_(g) * up; }
                u32x4 w; w.x = cvt_pk_bf16(h[0], h[1]); w.y = cvt_pk_bf16(h[2], h[3]); w.z = cvt_pk_bf16(h[4], h[5]); w.w = cvt_pk_bf16(h[6], h[7]);
                *(u32x4*)rowp = w; }
    }
};
struct EpiMoeDown {
    bf16_t* YM; const int* perm; const float* ew;
    DI void operator()(const f32x4 (&acc)[2][2][4][2], const Unit& u, int wr, int wc, int fr, int fq) const {
        const int col0 = u.pn * BM + wc * 32 + 8 * fq;
#pragma unroll
        for (int ai = 0; ai < 2; ++ai)
#pragma unroll
            for (int m = 0; m < 4; ++m) { const int r = ai * HALF + wr * 64 + m * 16 + fr;
                if (r < u.nvalid) { const int pr = perm[(size_t)u.e * NT + u.lt * BM + r]; const int tok = pr >> 1, slot = pr & 1; const float wgt = ew[pr];
                    bf16_t* rowp = YM + ((size_t)slot * NT + tok) * D + col0;
#pragma unroll
                    for (int bj = 0; bj < 2; ++bj) { const f32x4 v0 = acc[ai][bj][m][0] * wgt, v1 = acc[ai][bj][m][1] * wgt;
                        u32x4 w; w.x = cvt_pk_bf16(v0[0], v0[1]); w.y = cvt_pk_bf16(v0[2], v0[3]); w.z = cvt_pk_bf16(v1[0], v1[1]); w.w = cvt_pk_bf16(v1[2], v1[3]);
                        *(u32x4*)(rowp + bj * HALF) = w; } }
                asm volatile("" ::: "memory"); }
    }
};
}

struct MoeOrder {
    const LAS int* tp; const int* cnt; int npn, G, c, K; const char* A; const char* Bbase; size_t bstride_e, bstride_pn; const int* perm; bool gather;
    __device__ bool next(int i, pg8::Unit& u) const {
        const int TT = __builtin_amdgcn_readfirstlane(tp[32]); const long L = (long)i * G + c; if (L >= (long)TT * npn) return false;
        const int rt = (int)(L / npn), pn = (int)(L % npn);
        int e = 0;
#pragma unroll 1
        for (int j = 1; j < 32; ++j) e += (__builtin_amdgcn_readfirstlane(tp[j]) <= rt) ? 1 : 0;
        const int lt = rt - __builtin_amdgcn_readfirstlane(tp[e]);
        u.pm = rt; u.pn = pn; u.e = e; u.lt = lt; const int rem = cnt[e] - lt * 256; u.nvalid = rem < 256 ? rem : 256;
        u.ridx = perm + (size_t)e * NT + lt * 256;
        u.A = gather ? A : A + (size_t)rt * 256 * K * 2;
        u.B = Bbase + (size_t)e * bstride_e + (size_t)pn * bstride_pn;
        return true;
    }
};

struct Ctx {
    LAS unsigned char* lds; int tid, lane, wave, G, bid;
};

DI void phase_adaln(const Params& p, const Ctx& F) {
    LAS float* s = (LAS float*)F.lds;
    LAS float* red = (LAS float*)(F.lds + 20480);
    const float* c = p.in[I_C]; const float* cc = p.in[I_CCTX]; const float* wm = p.in[I_WMOD]; const float* bm = p.in[I_BMOD];
    float* mod = (float*)(p.ws + WS_MOD);
    for (int i = F.tid; i < 5 * 1024; i += NTHREADS) { const float v = i < 4096 ? c[i] : cc[i - 4096]; s[i] = siluf_(v); }
    __syncthreads();
    for (int grp = F.bid; grp < 256; grp += F.G) {
        const int col0 = grp * 24, q = F.tid % 6, ks = F.tid / 6;
        float acc[5][4];
#pragma unroll
        for (int b = 0; b < 5; ++b)
#pragma unroll
            for (int j = 0; j < 4; ++j) acc[b][j] = 0.f;
        if (F.tid < 510) {
            for (int k = ks; k < 1024; k += 85) {
                const f32x4 w = *(const f32x4*)(wm + (size_t)k * 6144 + col0 + 4 * q);
#pragma unroll
                for (int b = 0; b < 5; ++b) { const float sv = s[b * 1024 + k];
#pragma unroll
                    for (int j = 0; j < 4; ++j) acc[b][j] += sv * w[j]; }
            }
#pragma unroll
            for (int b = 0; b < 5; ++b)
#pragma unroll
                for (int j = 0; j < 4; ++j) red[ks * 120 + q * 20 + b * 4 + j] = acc[b][j];
        }
        __syncthreads();
        if (F.tid < 120) {
            float sum = 0.f;
            for (int k2 = 0; k2 < 85; ++k2) sum += red[k2 * 120 + F.tid];
            const int qq = F.tid / 20, b = (F.tid % 20) / 4, j = F.tid % 4, col = col0 + 4 * qq + j;
            mod[b * 6144 + col] = sum + bm[col];
        }
        __syncthreads();
    }
}

DI void transpose_item(const float* W, int K, int N, bf16_t* WT, int row_off, LAS float* scr, int item, int lane) {
    const int nblk = N / 32, kb = item / nblk, nb = item % nblk, k0 = 64 * kb, n0 = 32 * nb;
#pragma unroll 8
    for (int i = 0; i < 32; ++i) { const int kk = 2 * i + (lane >> 5); scr[kk * 33 + (lane & 31)] = W[(size_t)(k0 + kk) * N + n0 + (lane & 31)]; }
    LDS_WAIT(); asm volatile("" ::: "memory");
    const int c = lane & 7;
#pragma unroll
    for (int j = 0; j < 4; ++j) { const int n = (lane >> 3) + 8 * j; const LAS float* s = scr + (8 * c) * 33 + n;
        u32x4 o; o.x = pk2(s[0 * 33], s[1 * 33]); o.y = pk2(s[2 * 33], s[3 * 33]); o.z = pk2(s[4 * 33], s[5 * 33]); o.w = pk2(s[6 * 33], s[7 * 33]);
        *(u32x4*)(WT + (size_t)(row_off + n0 + n) * K + k0 + 8 * c) = o; }
    LDS_WAIT(); asm volatile("" ::: "memory");
}
DI void phase_convert(const Params& p, const Ctx& F) {
    __syncthreads();
    LAS float* scr = (LAS float*)(F.lds + F.wave * 16384);
    const int gw = F.bid * NWAVES + F.wave, NGW = F.G * NWAVES;
    bf16_t* WinT = (bf16_t*)(p.ws + WS_WINT); bf16_t* WoutT = (bf16_t*)(p.ws + WS_WOUTT); bf16_t* WguT = (bf16_t*)(p.ws + WS_WGUT); bf16_t* WdT = (bf16_t*)(p.ws + WS_WDT);
    constexpr int I_IN = 16 * 92, I_OUT = 16 * 32, I_GU = 16 * 8, I_DN = 4 * 32;
    constexpr int NITEMS = I_IN + I_OUT + 32 * 2 * I_GU + 32 * I_DN;
    for (int it = gw; it < NITEMS; it += NGW) {
        int r = it;
        if (r < I_IN) { transpose_item(p.in[I_WIN], 1024, DIN, WinT, 0, scr, r, F.lane); continue; } r -= I_IN;
        if (r < I_OUT) { transpose_item(p.in[I_WOUT], 1024, 1024, WoutT, 0, scr, r, F.lane); continue; } r -= I_OUT;
        if (r < 32 * 2 * I_GU) { const int e = r / (2 * I_GU), r2 = r % (2 * I_GU), up = r2 / I_GU, item = r2 % I_GU;
            const int nb = item % 8, n0 = 32 * nb;
            const int tgt = (n0 / 128) * 256 + (n0 % 128) + (up ? 128 : 0);
            transpose_item((up ? p.in[I_WU] : p.in[I_WG]) + (size_t)e * 1024 * 256, 1024, 256, WguT + (size_t)e * 512 * 1024, tgt - n0, scr, item, F.lane); continue; }
        r -= 32 * 2 * I_GU;
        { const int e = r / I_DN, item = r % I_DN; transpose_item(p.in[I_WD] + (size_t)e * 256 * 1024, 256, 1024, WdT + (size_t)e * 1024 * 256, 0, scr, item, F.lane); }
    }
    { const int gt = F.bid * NTHREADS + F.tid, NG = F.G * NTHREADS; u32x4 z = {0u, 0u, 0u, 0u};
      for (int i = gt; i < 128 * 1024 / 8; i += NG) *(u32x4*)(WinT + (size_t)DIN * 1024 + (size_t)i * 8) = z;
      bf16_t* DupT = (bf16_t*)(p.ws + WS_DUPT); bf16_t* AupT = (bf16_t*)(p.ws + WS_AUPT); bf16_t* GupT = (bf16_t*)(p.ws + WS_GUPT); bf16_t* Wsp = (bf16_t*)(p.ws + WS_WSP);
      for (int i = gt; i < 2 * 512 * 64; i += NG) { const int d = i / (512 * 64), ch = (i / 64) % 512, l = i % 64;
          DupT[i] = (bf16_t)f2bf(p.in[I_DUP][(size_t)(d * 64 + l) * 512 + ch]); AupT[i] = (bf16_t)f2bf(p.in[I_AUP][(size_t)(d * 64 + l) * 512 + ch]); }
      for (int i = gt; i < 512 * 128; i += NG) { const int ch = i / 128, l = i % 128; GupT[i] = (bf16_t)f2bf(p.in[I_GUP][(size_t)l * 512 + ch]); }
      for (int i = gt; i < 8 * 128 * 128; i += NG) Wsp[i] = (bf16_t)f2bf(p.in[I_WSP][i]); }
}

DI void phase_hrows(const Params& p, const Ctx& F) {
    const float* mod = (const float*)(p.ws + WS_MOD); const float* g = p.in[I_GPRE1]; bf16_t* H = (bf16_t*)(p.ws + WS_H);
    const int gw = F.bid * NWAVES + F.wave, NGW = F.G * NWAVES;
    for (int row = gw; row < MR; row += NGW) {
        const float* src = row < NT ? p.in[I_X] + (size_t)row * D : p.in[I_CTX] + (size_t)(row - NT) * D;
        const int bt = row < NT ? row / SEQ : 4;
        const f32x4* xr = (const f32x4*)src + F.lane;
        f32x4 v[4]; float ss = 0.f;
#pragma unroll
        for (int j = 0; j < 4; ++j) { v[j] = xr[64 * j]; ss += (v[j].x * v[j].x + v[j].y * v[j].y) + (v[j].z * v[j].z + v[j].w * v[j].w); }
        const float rstd = 1.f / sqrtf(wave_sum(ss) * (1.f / D) + 1e-6f);
        unsigned long long* o8 = (unsigned long long*)(H + (size_t)row * D) + F.lane;
#pragma unroll
        for (int j = 0; j < 4; ++j) { const int col = 4 * (F.lane + 64 * j);
            const f32x4 gg = *(const f32x4*)(g + col), sh = *(const f32x4*)(mod + bt * 6144 + col), sc = *(const f32x4*)(mod + bt * 6144 + 1024 + col);
            const f32x4 h = v[j] * rstd * gg * (sc + 1.f) + sh;
            o8[64 * j] = (unsigned long long)pk2(h.x, h.y) | ((unsigned long long)pk2(h.z, h.w) << 32); }
    }
}

DI void phase_gemm1(const Params& p, const Ctx& F) {
    pg8::StaticOrder S; S.init(p.ws + WS_H, p.ws + WS_WINT, MR, DINP, 1024, F.G, F.bid);
    pg8::EpiBf16 E{(bf16_t*)(p.ws + WS_Z), DINP};
    pg8::gemm_phase<pg8::EpiBf16, pg8::StaticOrder, false>(F.lds, 1024, S, E);
}

DI void phase_prep(const Params& p, const Ctx& F) {
    const bf16_t* Z = (const bf16_t*)(p.ws + WS_Z);
    bf16_t* Kc = (bf16_t*)(p.ws + WS_KC); bf16_t* Vc = (bf16_t*)(p.ws + WS_VC); bf16_t* Rc = (bf16_t*)(p.ws + WS_RC);
    bf16_t* A0 = (bf16_t*)(p.ws + WS_A0); bf16_t* A1 = (bf16_t*)(p.ws + WS_A1); bf16_t* L0 = (bf16_t*)(p.ws + WS_L0); bf16_t* L1 = (bf16_t*)(p.ws + WS_L1);
    bf16_t* GATE = (bf16_t*)((unsigned char*)p.out + DO_GATE); bf16_t* BV = (bf16_t*)((unsigned char*)p.out + DO_BV);
    const float* conv = p.in[I_CONV];
    LAS float* sl = (LAS float*)F.lds;
    const int t = F.tid;
    for (int it = F.bid; it < MR / 8; it += F.G) {
        const int row0 = it * 8;
        __syncthreads();
        for (int i = t; i < 8 * 384; i += NTHREADS) { const int rr = i / 384, c = i % 384; const float zv = bf2f(Z[(size_t)(row0 + rr) * DINP + OFF_WD + c]);
            sl[i] = c < 128 ? tanhf(zv) : (c < 256 ? zv : sigmoidf_(zv)); }
        __syncthreads();
        float dw0[8], dw1[8], da0[8], da1[8], gt[8];
#pragma unroll
        for (int r = 0; r < 8; ++r) { dw0[r] = dw1[r] = da0[r] = da1[r] = gt[r] = 0.f; }
        for (int l = 0; l < 64; ++l) {
            const float u0 = p.in[I_DUP][(size_t)l * 512 + t], u1 = p.in[I_DUP][(size_t)(64 + l) * 512 + t];
            const float v0 = p.in[I_AUP][(size_t)l * 512 + t], v1 = p.in[I_AUP][(size_t)(64 + l) * 512 + t];
            const float g0 = p.in[I_GUP][(size_t)l * 512 + t], g1 = p.in[I_GUP][(size_t)(64 + l) * 512 + t];
#pragma unroll
            for (int r = 0; r < 8; ++r) { const LAS float* s = sl + r * 384;
                dw0[r] += s[l] * u0; dw1[r] += s[64 + l] * u1; da0[r] += s[128 + l] * v0; da1[r] += s[192 + l] * v1; gt[r] += s[256 + l] * g0 + s[320 + l] * g1; }
        }
        const float w00 = p.in[I_DW0][t], w01 = p.in[I_DW0][512 + t], a00 = p.in[I_A0][t], a01 = p.in[I_A0][512 + t];
        const float ka0 = p.in[I_KA][t], ka1 = p.in[I_KA][512 + t], rk = p.in[I_RK][t];
#pragma unroll 1
        for (int r = 0; r < 8; ++r) {
            const int row = row0 + r;
            float cv[3] = {0.f, 0.f, 0.f};
            if (row < NT) {
                const int tb = row % SEQ, gy = tb / 64, gx = tb % 64;
#pragma unroll
                for (int dy = 0; dy < 3; ++dy) { const int ny = gy + dy - 1; if (ny < 0 || ny >= 128) continue;
#pragma unroll
                    for (int dx = 0; dx < 3; ++dx) { const int nx = gx + dx - 1; if (nx < 0 || nx >= 64) continue;
                        const size_t nrow = (size_t)(row + (dy - 1) * 64 + (dx - 1));
#pragma unroll
                        for (int s3 = 0; s3 < 3; ++s3) cv[s3] += bf2f(Z[nrow * DINP + s3 * 512 + t]) * conv[(dy * 3 + dx) * 1536 + s3 * 512 + t]; } }
            } else {
                const int tb = (row - NT) % CTXL;
#pragma unroll
                for (int dx = 0; dx < 3; ++dx) { const int nx = tb + dx - 1; if (nx < 0 || nx >= CTXL) continue;
                    const size_t nrow = (size_t)(row + dx - 1);
#pragma unroll
                    for (int s3 = 0; s3 < 3; ++s3) cv[s3] += bf2f(Z[nrow * DINP + s3 * 512 + t]) * conv[(3 + dx) * 1536 + s3 * 512 + t]; }
            }
            const float k = cv[0], v = cv[1], rr = cv[2];
            const float wl0 = w00 + dw0[r], wl1 = w01 + dw1[r];
            const float lg0 = -__expf(-softplusf_(-wl0) - 0.5f), lg1 = -__expf(-softplusf_(-wl1) - 0.5f);
            const float a0 = sigmoidf_(a00 + da0[r]), a1 = sigmoidf_(a01 + da1[r]);
            const size_t o = (size_t)row * 512 + t;
            Kc[o] = (bf16_t)f2bf(k); Vc[o] = (bf16_t)f2bf(v); Rc[o] = (bf16_t)f2bf(rr);
            A0[o] = (bf16_t)f2bf(a0); A1[o] = (bf16_t)f2bf(a1); L0[o] = (bf16_t)f2bf(lg0); L1[o] = (bf16_t)f2bf(lg1);
            if (row < NT) {
                const float km0 = k * (1.f + (a0 - 1.f) * ka0), km1 = k * (1.f + (a1 - 1.f) * ka1);
                const float bon = wave_sum(rr * (km0 + km1) * rk);
                GATE[o] = (bf16_t)f2bf(gt[r]); BV[o] = (bf16_t)f2bf(bon * v);
            }
        }
    }
}

DI void phase_gmlp(const Params& p, const Ctx& F) {
    const bf16_t* Z = (const bf16_t*)(p.ws + WS_Z); const bf16_t* Wsp = (const bf16_t*)(p.ws + WS_WSP);
    bf16_t* MIXED = (bf16_t*)((unsigned char*)p.out + DO_MIXED);
    constexpr int LDV = 136;
    LAS bf16_t* vnT = (LAS bf16_t*)F.lds;
    LAS float* gu = (LAS float*)(F.lds + 17408);
    constexpr int LDG = 68;
    const int fr = F.lane & 15, fq = F.lane >> 4;
    for (int un = F.bid; un < 4 * 64 * 8; un += F.G) {
        const int g = un & 7, cc = (un >> 3) & 63, b = un >> 9;
        const size_t tok0 = (size_t)b * SEQ + cc * 128;
        __syncthreads();
        { const int pq = F.tid >> 2, seg = F.tid & 3;
          const bf16_t* zr = Z + (tok0 + pq) * DINP;
          const u32x4 ua = *(const u32x4*)(zr + OFF_U + 64 * g + 16 * seg), ub = *(const u32x4*)(zr + OFF_U + 64 * g + 16 * seg + 8);
          const u32x4 va = *(const u32x4*)(zr + OFF_VA + 64 * g + 16 * seg), vb = *(const u32x4*)(zr + OFF_VA + 64 * g + 16 * seg + 8);
          float u[16], v[16];
#pragma unroll
          for (int j = 0; j < 4; ++j) { u[2 * j] = bflo(ua[j]); u[2 * j + 1] = bfhi(ua[j]); u[8 + 2 * j] = bflo(ub[j]); u[8 + 2 * j + 1] = bfhi(ub[j]);
              v[2 * j] = bflo(va[j]); v[2 * j + 1] = bfhi(va[j]); v[8 + 2 * j] = bflo(vb[j]); v[8 + 2 * j + 1] = bfhi(vb[j]); }
          float s = 0.f;
#pragma unroll
          for (int j = 0; j < 16; ++j) { u[j] = gelu_tanh(u[j]); v[j] = gelu_tanh(v[j]); s += v[j]; }
          s += __shfl_xor(s, 1); s += __shfl_xor(s, 2);
          const float mu = s * (1.f / 64.f); float q = 0.f;
#pragma unroll
          for (int j = 0; j < 16; ++j) { v[j] -= mu; q += v[j] * v[j]; }
          q += __shfl_xor(q, 1); q += __shfl_xor(q, 2);
          const float rstd = 1.f / sqrtf(q * (1.f / 64.f) + 1e-5f);
#pragma unroll
          for (int j = 0; j < 16; ++j) { const int ch = 16 * seg + j; const float vn = v[j] * rstd * p.in[I_GMLNG][64 * g + ch] + p.in[I_GMLNB][64 * g + ch];
              vnT[ch * LDV + pq] = (bf16_t)f2bf(vn); gu[pq * LDG + ch] = u[j]; }
        }
        __syncthreads();
        f32x4 acc[4];
#pragma unroll
        for (int n = 0; n < 4; ++n) acc[n] = (f32x4){0.f, 0.f, 0.f, 0.f};
        const int pp = 16 * F.wave + fr;
#pragma unroll
        for (int s = 0; s < 4; ++s) {
            const bf16x8 bfrag = *(const bf16x8*)(Wsp + ((size_t)(g * 128 + pp)) * 128 + 32 * s + 8 * fq);
#pragma unroll
            for (int n = 0; n < 4; ++n) { const bf16x8 afrag = *(const LAS bf16x8*)(vnT + (16 * n + fr) * LDV + 32 * s + 8 * fq);
                acc[n] = __builtin_amdgcn_mfma_f32_16x16x32_bf16(afrag, bfrag, acc[n], 0, 0, 0); }
        }
        const float bs = p.in[I_BSP][g * 128 + pp];
#pragma unroll
        for (int n = 0; n < 4; ++n) { const int d0 = 16 * n + 4 * fq; const f32x4 gv = *(const LAS f32x4*)(gu + pp * LDG + d0);
            const f32x4 o = gv * (acc[n] + bs);
            u32x2 w; w.x = pk2(o[0], o[1]); w.y = pk2(o[2], o[3]);
            *(u32x2*)(MIXED + (tok0 + pp) * D + 64 * g + d0) = w; }
    }
}

DI void phase_scan_seq(const Params& p, const Ctx& F) {
    const bf16_t* Kc = (const bf16_t*)(p.ws + WS_KC); const bf16_t* Vc = (const bf16_t*)(p.ws + WS_VC); const bf16_t* Rc = (const bf16_t*)(p.ws + WS_RC);
    float* YS = (float*)(p.ws + WS_YS);
    const int vrow = F.tid >> 3, q = F.tid & 7;
    for (int ch = F.bid; ch < 64; ch += F.G) {
        const int d = ch & 1, h = (ch >> 1) & 7, b = ch >> 4;
        const bf16_t* Ad = (const bf16_t*)(p.ws + (d ? WS_A1 : WS_A0)); const bf16_t* Ld = (const bf16_t*)(p.ws + (d ? WS_L1 : WS_L0));
        float kkw[8], kaw[8];
#pragma unroll
        for (int j = 0; j < 8; ++j) { kkw[j] = p.in[I_KK][64 * h + 8 * q + j]; kaw[j] = p.in[I_KA][d * 512 + 64 * h + 8 * q + j]; }
        float S[8];
#pragma unroll
        for (int j = 0; j < 8; ++j) S[j] = 0.f;
        const int TOT = CTXL + SEQ;
        for (int step = 0; step < TOT; ++step) {
            size_t row;
            if (step < CTXL) { const int tc = d ? (CTXL - 1 - step) : step; row = (size_t)NT + b * CTXL + tc; }
            else { const int tl = d ? (SEQ - 1 - (step - CTXL)) : (step - CTXL); row = (size_t)b * SEQ + tl; }
            const size_t o = row * 512 + 64 * h + 8 * q;
            const u32x4 kq = *(const u32x4*)(Kc + o), rq = *(const u32x4*)(Rc + o), aq = *(const u32x4*)(Ad + o), lq = *(const u32x4*)(Ld + o);
            const float vv = bf2f(Vc[row * 512 + 64 * h + vrow]);
            float k[8], r[8], a[8], l[8];
#pragma unroll
            for (int j = 0; j < 4; ++j) { k[2 * j] = bflo(kq[j]); k[2 * j + 1] = bfhi(kq[j]); r[2 * j] = bflo(rq[j]); r[2 * j + 1] = bfhi(rq[j]);
                a[2 * j] = bflo(aq[j]); a[2 * j + 1] = bfhi(aq[j]); l[2 * j] = bflo(lq[j]); l[2 * j + 1] = bfhi(lq[j]); }
            float kk[8], ss = 0.f;
#pragma unroll
            for (int j = 0; j < 8; ++j) { kk[j] = k[j] * kkw[j]; ss += kk[j] * kk[j]; }
            ss += __shfl_xor(ss, 1); ss += __shfl_xor(ss, 2); ss += __shfl_xor(ss, 4);
            const float rn = 1.f / sqrtf(fmaxf(ss, 1e-24f));
            float dot = 0.f;
#pragma unroll
            for (int j = 0; j < 8; ++j) { kk[j] *= rn; dot += S[j] * kk[j]; }
            dot += __shfl_xor(dot, 1); dot += __shfl_xor(dot, 2); dot += __shfl_xor(dot, 4);
            float y = 0.f;
#pragma unroll
            for (int j = 0; j < 8; ++j) { const float w = __expf(l[j]); const float km = k[j] * (1.f + (a[j] - 1.f) * kaw[j]);
                S[j] = S[j] * w - dot * (kk[j] * a[j]) + vv * km; y += S[j] * r[j]; }
            y += __shfl_xor(y, 1); y += __shfl_xor(y, 2); y += __shfl_xor(y, 4);
            if (step >= CTXL && q == 0) YS[((size_t)d * NT + row) * 512 + 64 * h + vrow] = y;
        }
    }
}


constexpr int LDP = 72;
constexpr int SLOTB = 64 * LDP * 2;
constexpr int CP_CUM = 12 * SLOTB, CP_TOT = CP_CUM + 16384, CP_ADIAG = CP_TOT + 2048, CP_GC = CP_ADIAG + 4096;

DI void mm64(f32x4 (&acc)[2], const LAS bf16_t* P, const LAS bf16_t* Q, int r0, int c0, int fr, int fq) {
#pragma unroll
    for (int s = 0; s < 2; ++s) { const bf16x8 b = *(const LAS bf16x8*)(Q + (c0 + fr) * LDP + 32 * s + 8 * fq);
#pragma unroll
        for (int m = 0; m < 2; ++m) { const bf16x8 a = *(const LAS bf16x8*)(P + (r0 + 16 * m + fr) * LDP + 32 * s + 8 * fq);
            acc[m] = __builtin_amdgcn_mfma_f32_16x16x32_bf16(a, b, acc[m], 0, 0, 0); } }
}
DI void zero2(f32x4 (&a)[2]) { a[0] = (f32x4){0.f, 0.f, 0.f, 0.f}; a[1] = a[0]; }
DI void writeT(LAS bf16_t* dst, const f32x4 (&acc)[2], int r0, int c0, int fr, int fq) {
#pragma unroll
    for (int m = 0; m < 2; ++m) { u32x2 w; w.x = pk2(acc[m][0], acc[m][1]); w.y = pk2(acc[m][2], acc[m][3]); *(LAS u32x2*)(dst + (c0 + fr) * LDP + r0 + 16 * m + 4 * fq) = w; }
}
DI void writeN(LAS bf16_t* dst, const f32x4 (&acc)[2], int r0, int c0, int fr, int fq) {
#pragma unroll
    for (int m = 0; m < 2; ++m)
#pragma unroll
        for (int i = 0; i < 4; ++i) dst[(r0 + 16 * m + 4 * fq + i) * LDP + c0 + fr] = (bf16_t)f2bf(acc[m][i]);
}
DI size_t chunk_row(int d, int b, int pc, int pp) {
    const int base = pc < 4 ? NT + b * CTXL : b * SEQ, len = pc < 4 ? CTXL : SEQ, q = 64 * (pc < 4 ? pc : pc - 4) + pp;
    return (size_t)(d ? base + len - 1 - q : base + q);
}

DI void phase_chunkprep(const Params& p, const Ctx& F, const int d) {
    const bf16_t* Kc = (const bf16_t*)(p.ws + WS_KC); const bf16_t* Vc = (const bf16_t*)(p.ws + WS_VC); const bf16_t* Rc = (const bf16_t*)(p.ws + WS_RC);
    const bf16_t* Ad = (const bf16_t*)(p.ws + (d ? WS_A1 : WS_A0)); const bf16_t* Ld = (const bf16_t*)(p.ws + (d ? WS_L1 : WS_L0));
    unsigned char* OPS = p.ws + WS_OPS;
    LAS bf16_t* SL[12];
#pragma unroll
    for (int i = 0; i < 12; ++i) SL[i] = (LAS bf16_t*)(F.lds + i * SLOTB);
    LAS float* CUM = (LAS float*)(F.lds + CP_CUM); LAS float* TOT = (LAS float*)(F.lds + CP_TOT); LAS float* ADIAG = (LAS float*)(F.lds + CP_ADIAG); LAS float* GC = (LAS float*)(F.lds + CP_GC);
    const int w = F.wave, fr = F.lane & 15, fq = F.lane >> 4, r0 = 32 * (w >> 2), c0 = 16 * (w & 3);
    const int pp = F.tid >> 3, cg8 = F.tid & 7;
    for (int unit = F.bid; unit < 32 * 132; unit += F.G) {
        const int chain = unit / 132, pc = unit % 132, b = chain >> 3, h = chain & 7;
        __syncthreads();
        float kk[8], km[8], ka[8], vv[8], rr[8], ll[8];
        { const size_t o = chunk_row(d, b, pc, pp) * 512 + 64 * h + 8 * cg8;
          const u32x4 kq = *(const u32x4*)(Kc + o), vq = *(const u32x4*)(Vc + o), rq = *(const u32x4*)(Rc + o), aq = *(const u32x4*)(Ad + o), lq = *(const u32x4*)(Ld + o);
          float k[8], a[8]; float ss = 0.f;
#pragma unroll
          for (int j = 0; j < 4; ++j) { k[2 * j] = bflo(kq[j]); k[2 * j + 1] = bfhi(kq[j]); vv[2 * j] = bflo(vq[j]); vv[2 * j + 1] = bfhi(vq[j]); rr[2 * j] = bflo(rq[j]); rr[2 * j + 1] = bfhi(rq[j]);
              a[2 * j] = bflo(aq[j]); a[2 * j + 1] = bfhi(aq[j]); ll[2 * j] = bflo(lq[j]); ll[2 * j + 1] = bfhi(lq[j]); }
#pragma unroll
          for (int j = 0; j < 8; ++j) { kk[j] = k[j] * p.in[I_KK][64 * h + 8 * cg8 + j]; ss += kk[j] * kk[j]; }
          ss += __shfl_xor(ss, 1); ss += __shfl_xor(ss, 2); ss += __shfl_xor(ss, 4);
          const float rn = 1.f / sqrtf(fmaxf(ss, 1e-24f));
#pragma unroll
          for (int j = 0; j < 8; ++j) { kk[j] *= rn; km[j] = k[j] * (1.f + (a[j] - 1.f) * p.in[I_KA][d * 512 + 64 * h + 8 * cg8 + j]); ka[j] = kk[j] * a[j]; }
          *(LAS f32x4*)(CUM + pp * 64 + 8 * cg8) = (f32x4){ll[0], ll[1], ll[2], ll[3]}; *(LAS f32x4*)(CUM + pp * 64 + 8 * cg8 + 4) = (f32x4){ll[4], ll[5], ll[6], ll[7]}; }
        for (int i = F.tid; i < 2 * SLOTB / 4; i += NTHREADS) ((LAS unsigned*)(F.lds + 9 * SLOTB))[i] = 0u;
        __syncthreads();
        { const int ch = F.tid & 63, seg = F.tid >> 6; float run = 0.f;
#pragma unroll
          for (int i = 0; i < 8; ++i) { run += CUM[(8 * seg + i) * 64 + ch]; CUM[(8 * seg + i) * 64 + ch] = run; }
          TOT[seg * 64 + ch] = run; }
        __syncthreads();
        { const int ch = F.tid & 63, seg = F.tid >> 6; float off = 0.f;
          for (int s2 = 0; s2 < seg; ++s2) off += TOT[s2 * 64 + ch];
#pragma unroll
          for (int i = 0; i < 8; ++i) CUM[(8 * seg + i) * 64 + ch] += off;
          if (seg == 7) GC[ch] = off + TOT[7 * 64 + ch]; }
        __syncthreads();
        { float g[8], gc[8];
          { const f32x4 g0 = *(const LAS f32x4*)(CUM + pp * 64 + 8 * cg8), g1 = *(const LAS f32x4*)(CUM + pp * 64 + 8 * cg8 + 4);
            const f32x4 c0v = *(const LAS f32x4*)(GC + 8 * cg8), c1v = *(const LAS f32x4*)(GC + 8 * cg8 + 4);
#pragma unroll
            for (int j = 0; j < 4; ++j) { g[j] = g0[j]; g[4 + j] = g1[j]; gc[j] = c0v[j]; gc[4 + j] = c1v[j]; } }
          float kkg[8], rg[8], ki[8], kai[8], kd[8], kad[8];
#pragma unroll
          for (int j = 0; j < 8; ++j) { const float eg = __expf(g[j]), egp = __expf(g[j] - ll[j]), eng = __expf(-g[j]), ecg = __expf(gc[j] - g[j]);
              kkg[j] = kk[j] * egp; rg[j] = rr[j] * eg; ki[j] = km[j] * eng; kai[j] = ka[j] * eng; kd[j] = km[j] * ecg; kad[j] = ka[j] * ecg; }
          u32x4 w4;
          w4 = (u32x4){pk2(kkg[0], kkg[1]), pk2(kkg[2], kkg[3]), pk2(kkg[4], kkg[5]), pk2(kkg[6], kkg[7])}; *(LAS u32x4*)(SL[0] + pp * LDP + 8 * cg8) = w4;
          w4 = (u32x4){pk2(rg[0], rg[1]), pk2(rg[2], rg[3]), pk2(rg[4], rg[5]), pk2(rg[6], rg[7])}; *(LAS u32x4*)(SL[1] + pp * LDP + 8 * cg8) = w4;
          w4 = (u32x4){pk2(ki[0], ki[1]), pk2(ki[2], ki[3]), pk2(ki[4], ki[5]), pk2(ki[6], ki[7])}; *(LAS u32x4*)(SL[2] + pp * LDP + 8 * cg8) = w4;
          w4 = (u32x4){pk2(kai[0], kai[1]), pk2(kai[2], kai[3]), pk2(kai[4], kai[5]), pk2(kai[6], kai[7])}; *(LAS u32x4*)(SL[3] + pp * LDP + 8 * cg8) = w4;
#pragma unroll
          for (int j = 0; j < 8; ++j) { const int ch = 8 * cg8 + j;
              SL[4][ch * LDP + pp] = (bf16_t)f2bf(kkg[j]); SL[5][ch * LDP + pp] = (bf16_t)f2bf(vv[j]); SL[6][ch * LDP + pp] = (bf16_t)f2bf(kd[j]); SL[7][ch * LDP + pp] = (bf16_t)f2bf(kad[j]); } }
        __syncthreads();
        { f32x4 aAk[2], aAa[2], aBk[2], aBa[2]; zero2(aAk); zero2(aAa); zero2(aBk); zero2(aBa);
          mm64(aAk, SL[2], SL[0], r0, c0, fr, fq);
          mm64(aAa, SL[0], SL[3], r0, c0, fr, fq);
          mm64(aBk, SL[2], SL[1], r0, c0, fr, fq);
          mm64(aBa, SL[3], SL[1], r0, c0, fr, fq);
          __syncthreads();
          const int tcol = c0 + fr;
#pragma unroll
          for (int m = 0; m < 2; ++m)
#pragma unroll
              for (int i = 0; i < 4; ++i) { const int jr = r0 + 16 * m + 4 * fq + i;
                  aAk[m][i] = jr < tcol ? aAk[m][i] : 0.f; aBk[m][i] = jr <= tcol ? aBk[m][i] : 0.f; aBa[m][i] = jr <= tcol ? aBa[m][i] : 0.f; }
          writeT(SL[0], aAk, r0, c0, fr, fq); writeT(SL[8], aBk, r0, c0, fr, fq); writeT(SL[2], aBa, r0, c0, fr, fq);
          const int jb = w & 3;
#pragma unroll
          for (int m = 0; m < 2; ++m) { const int tb = 2 * (w >> 2) + m;
              if (tb == jb) {
#pragma unroll
                  for (int i = 0; i < 4; ++i) ADIAG[tb * 256 + (4 * fq + i) * 16 + fr] = (fr < 4 * fq + i) ? aAa[m][i] : 0.f; }
#pragma unroll
              for (int i = 0; i < 4; ++i) aAa[m][i] = tb > jb ? aAa[m][i] : 0.f; }
          writeT(SL[3], aAa, r0, c0, fr, fq);
        }
        __syncthreads();
        if (F.tid < 64) { const int blk = F.tid >> 4, c = F.tid & 15; const LAS float* A = ADIAG + blk * 256; float x[16];
#pragma unroll
            for (int r = 0; r < 16; ++r) { float sa = (r == c) ? 1.f : 0.f;
#pragma unroll
                for (int j = 0; j < r; ++j) sa -= A[r * 16 + j] * x[j];
                x[r] = sa; }
#pragma unroll
            for (int r = 0; r < 16; ++r) SL[9][(16 * blk + r) * LDP + 16 * blk + c] = (bf16_t)f2bf(x[r]);
            u32x4 lo = (u32x4){pk2(x[0], x[1]), pk2(x[2], x[3]), pk2(x[4], x[5]), pk2(x[6], x[7])}, hi = (u32x4){pk2(x[8], x[9]), pk2(x[10], x[11]), pk2(x[12], x[13]), pk2(x[14], x[15])};
            *(LAS u32x4*)(SL[10] + (16 * blk + c) * LDP + 16 * blk) = lo; *(LAS u32x4*)(SL[10] + (16 * blk + c) * LDP + 16 * blk + 8) = hi; }
        __syncthreads();
        f32x4 a1[2], a2[2], a3[2];
        zero2(a1); mm64(a1, SL[3], SL[9], r0, c0, fr, fq);
        __syncthreads();
        writeT(SL[11], a1, r0, c0, fr, fq);
        writeN(SL[3], a1, r0, c0, fr, fq);
        __syncthreads();
        zero2(a2); mm64(a2, SL[11], SL[3], r0, c0, fr, fq);
#pragma unroll
        for (int m = 0; m < 2; ++m)
#pragma unroll
            for (int i = 0; i < 4; ++i) a2[m][i] += (r0 + 16 * m + 4 * fq + i == c0 + fr) ? 1.f : 0.f;
        writeT(SL[9], a2, r0, c0, fr, fq);
        __syncthreads();
        zero2(a3); mm64(a3, SL[11], SL[9], r0, c0, fr, fq);
        a3[0] = a2[0] - a3[0]; a3[1] = a2[1] - a3[1];
        writeN(SL[3], a3, r0, c0, fr, fq);
        __syncthreads();
        zero2(a1); mm64(a1, SL[3], SL[10], r0, c0, fr, fq);
        zero2(a2); mm64(a2, SL[0], SL[5], r0, c0, fr, fq);
        writeN(SL[9], a1, r0, c0, fr, fq); writeT(SL[11], a2, r0, c0, fr, fq);
        __syncthreads();
        zero2(a1); mm64(a1, SL[9], SL[4], r0, c0, fr, fq);
        zero2(a2); mm64(a2, SL[9], SL[11], r0, c0, fr, fq);
        writeT(SL[3], a1, r0, c0, fr, fq); writeT(SL[10], a2, r0, c0, fr, fq);
        __syncthreads();
        unsigned char* ob = OPS + ((size_t)chain * 132 + pc) * 32768;
        const int fragoff = (((w & 3) * 2 + (w >> 2)) * 64 + F.lane) * 16;
        {
          zero2(a1); mm64(a1, SL[3], SL[2], r0, c0, fr, fq);
          u32x4 o;
#pragma unroll
          for (int m = 0; m < 2; ++m) { const u32x2 rgv = *(const LAS u32x2*)(SL[1] + (c0 + fr) * LDP + r0 + 16 * m + 4 * fq);
              const float q0 = bflo(rgv.x) - a1[m][0], q1 = bfhi(rgv.x) - a1[m][1], q2 = bflo(rgv.y) - a1[m][2], q3 = bfhi(rgv.y) - a1[m][3];
              o[2 * m] = pk2(q0, q1); o[2 * m + 1] = pk2(q2, q3); }
          *(u32x4*)(ob + fragoff) = o; }
        {
          zero2(a1); mm64(a1, SL[3], SL[7], r0, c0, fr, fq);
          const float gcv = __expf(GC[c0 + fr]); u32x4 o;
#pragma unroll
          for (int m = 0; m < 2; ++m) { float q[4];
#pragma unroll
              for (int i = 0; i < 4; ++i) q[i] = ((r0 + 16 * m + 4 * fq + i == c0 + fr) ? gcv : 0.f) - a1[m][i];
              o[2 * m] = pk2(q[0], q[1]); o[2 * m + 1] = pk2(q[2], q[3]); }
          *(u32x4*)(ob + 8192 + fragoff) = o; }
        {
          zero2(a1); mm64(a1, SL[8], SL[5], r0, c0, fr, fq); zero2(a2); mm64(a2, SL[2], SL[10], r0, c0, fr, fq);
#pragma unroll
          for (int m = 0; m < 2; ++m) { const f32x4 q = a1[m] - a2[m]; u32x2 o; o.x = pk2(q[0], q[1]); o.y = pk2(q[2], q[3]);
              *(u32x2*)(ob + 16384 + (((w & 3) * 4 + 2 * (w >> 2) + m) * 64 + F.lane) * 8) = o; } }
        {
          zero2(a1); mm64(a1, SL[6], SL[5], r0, c0, fr, fq); zero2(a2); mm64(a2, SL[7], SL[10], r0, c0, fr, fq);
#pragma unroll
          for (int m = 0; m < 2; ++m) { const f32x4 q = a1[m] - a2[m]; u32x2 o; o.x = pk2(q[0], q[1]); o.y = pk2(q[2], q[3]);
              *(u32x2*)(ob + 24576 + (((w & 3) * 4 + 2 * (w >> 2) + m) * 64 + F.lane) * 8) = o; } }
    }
}

DI void phase_scan_chunk(const Params& p, const Ctx& F, const int d) {
    if (F.wave != 0) return;
    const unsigned char* OPS = p.ws + WS_OPS; unsigned char* YIMG = p.ws + WS_YIMG;
    for (int item = F.bid; item < 128; item += F.G) {
        const int chain = item >> 2, w4 = item & 3;
        const unsigned char* ops = OPS + (size_t)chain * 132 * 32768;
        unsigned char* yim = YIMG + ((size_t)(d * 32 + chain) * 128) * 8192;
        f32x4 H[4];
#pragma unroll
        for (int m = 0; m < 4; ++m) H[m] = (f32x4){0.f, 0.f, 0.f, 0.f};
        bf16x8 qa[4][2], ma[4][2]; u32x2 y0[4], bc[4];
#pragma unroll
        for (int m = 0; m < 4; ++m) {
#pragma unroll
            for (int s = 0; s < 2; ++s) { qa[m][s] = *(const bf16x8*)(ops + ((m * 2 + s) * 64 + F.lane) * 16); ma[m][s] = *(const bf16x8*)(ops + 8192 + ((m * 2 + s) * 64 + F.lane) * 16); }
            y0[m] = *(const u32x2*)(ops + 16384 + ((w4 * 4 + m) * 64 + F.lane) * 8); bc[m] = *(const u32x2*)(ops + 24576 + ((w4 * 4 + m) * 64 + F.lane) * 8); }
#pragma unroll 1
        for (int pc = 0; pc < 132; ++pc) {
            bf16x8 nqa[4][2], nma[4][2]; u32x2 ny0[4], nbc[4];
            const unsigned char* nx = ops + (size_t)(pc + 1 < 132 ? pc + 1 : pc) * 32768;
#pragma unroll
            for (int m = 0; m < 4; ++m) {
#pragma unroll
                for (int s = 0; s < 2; ++s) { nqa[m][s] = *(const bf16x8*)(nx + ((m * 2 + s) * 64 + F.lane) * 16); nma[m][s] = *(const bf16x8*)(nx + 8192 + ((m * 2 + s) * 64 + F.lane) * 16); }
                ny0[m] = *(const u32x2*)(nx + 16384 + ((w4 * 4 + m) * 64 + F.lane) * 8); nbc[m] = *(const u32x2*)(nx + 24576 + ((w4 * 4 + m) * 64 + F.lane) * 8); }
            bf16x8 hb[2];
#pragma unroll
            for (int s = 0; s < 2; ++s) { u32x4 t; t.x = pk2(H[2 * s][0], H[2 * s][1]); t.y = pk2(H[2 * s][2], H[2 * s][3]); t.z = pk2(H[2 * s + 1][0], H[2 * s + 1][1]); t.w = pk2(H[2 * s + 1][2], H[2 * s + 1][3]);
                hb[s] = __builtin_bit_cast(bf16x8, t); }
#pragma unroll
            for (int m = 0; m < 4; ++m) {
                f32x4 y = (f32x4){bflo(y0[m].x), bfhi(y0[m].x), bflo(y0[m].y), bfhi(y0[m].y)};
                f32x4 hn = (f32x4){bflo(bc[m].x), bfhi(bc[m].x), bflo(bc[m].y), bfhi(bc[m].y)};
#pragma unroll
                for (int s = 0; s < 2; ++s) { y = __builtin_amdgcn_mfma_f32_16x16x32_bf16(qa[m][s], hb[s], y, 0, 0, 0); hn = __builtin_amdgcn_mfma_f32_16x16x32_bf16(ma[m][s], hb[s], hn, 0, 0, 0); }
                if (pc >= 4) { u32x2 o; o.x = pk2(y[0], y[1]); o.y = pk2(y[2], y[3]); *(u32x2*)(yim + (size_t)(pc - 4) * 8192 + ((w4 * 4 + m) * 64 + F.lane) * 8) = o; }
                H[m] = hn;
            }
#pragma unroll
            for (int m = 0; m < 4; ++m) {
#pragma unroll
                for (int s = 0; s < 2; ++s) { qa[m][s] = nqa[m][s]; ma[m][s] = nma[m][s]; }
                y0[m] = ny0[m]; bc[m] = nbc[m]; }
        }
    }
}

DI void phase_post2(const Params& p, const Ctx& F) {
    const unsigned char* YIMG = p.ws + WS_YIMG;
    const bf16_t* GATE = (const bf16_t*)((unsigned char*)p.out + DO_GATE); const bf16_t* BV = (const bf16_t*)((unsigned char*)p.out + DO_BV);
    bf16_t* MIXED = (bf16_t*)((unsigned char*)p.out + DO_MIXED);
    LAS float* ys = (LAS float*)F.lds;
    constexpr int LDY = 68;
    const int fr = F.lane & 15, fq = F.lane >> 4;
    for (int unit = F.bid; unit < 4 * 128 * 8; unit += F.G) {
        const int h = unit & 7, j = (unit >> 3) & 127, b = unit >> 10, chain = b * 8 + h;
        __syncthreads();
        const int w4 = F.wave & 3;
        const unsigned char* fi = YIMG + ((size_t)(0 * 32 + chain) * 128 + j) * 8192; const unsigned char* bi = YIMG + ((size_t)(1 * 32 + chain) * 128 + (127 - j)) * 8192;
        u32x2 fv[2], bv2[2];
#pragma unroll
        for (int mm = 0; mm < 2; ++mm) { const int m = 2 * (F.wave >> 2) + mm; fv[mm] = *(const u32x2*)(fi + ((w4 * 4 + m) * 64 + F.lane) * 8); bv2[mm] = *(const u32x2*)(bi + ((w4 * 4 + m) * 64 + F.lane) * 8); }
#pragma unroll
        for (int mm = 0; mm < 2; ++mm) { const int m = 2 * (F.wave >> 2) + mm; const int t0 = 16 * m + 4 * fq, n = 16 * w4 + fr;
            ys[(t0 + 0) * LDY + n] = bflo(fv[mm].x); ys[(t0 + 1) * LDY + n] = bfhi(fv[mm].x); ys[(t0 + 2) * LDY + n] = bflo(fv[mm].y); ys[(t0 + 3) * LDY + n] = bfhi(fv[mm].y); }
        __syncthreads();
#pragma unroll
        for (int mm = 0; mm < 2; ++mm) { const int m = 2 * (F.wave >> 2) + mm; const int t0 = 16 * m + 4 * fq, n = 16 * w4 + fr;
            ys[(63 - t0 - 0) * LDY + n] += bflo(bv2[mm].x); ys[(63 - t0 - 1) * LDY + n] += bfhi(bv2[mm].x); ys[(63 - t0 - 2) * LDY + n] += bflo(bv2[mm].y); ys[(63 - t0 - 3) * LDY + n] += bfhi(bv2[mm].y); }
        __syncthreads();
        { const int tk = F.tid >> 3, cg8 = F.tid & 7; const size_t row = (size_t)b * SEQ + 64 * j + tk;
          const f32x4 ya = *(const LAS f32x4*)(ys + tk * LDY + 8 * cg8), yb = *(const LAS f32x4*)(ys + tk * LDY + 8 * cg8 + 4);
          float y[8] = {ya[0], ya[1], ya[2], ya[3], yb[0], yb[1], yb[2], yb[3]};
          float s1 = 0.f;
#pragma unroll
          for (int i = 0; i < 8; ++i) s1 += y[i];
          s1 += __shfl_xor(s1, 1); s1 += __shfl_xor(s1, 2); s1 += __shfl_xor(s1, 4);
          const float mu = s1 * (1.f / 64.f); float s2 = 0.f;
#pragma unroll
          for (int i = 0; i < 8; ++i) { y[i] -= mu; s2 += y[i] * y[i]; }
          s2 += __shfl_xor(s2, 1); s2 += __shfl_xor(s2, 2); s2 += __shfl_xor(s2, 4);
          const float rstd = 1.f / sqrtf(s2 * (1.f / 64.f) + 64e-5f);
          const size_t o = row * 512 + 64 * h + 8 * cg8;
          const u32x4 gq = *(const u32x4*)(GATE + o), bq = *(const u32x4*)(BV + o);
          float ov[8];
#pragma unroll
          for (int i = 0; i < 8; ++i) { const int ch = 64 * h + 8 * cg8 + i; const float yn = y[i] * rstd * p.in[I_LNXG][ch] + p.in[I_LNXB][ch];
              const float gt = (i & 1) ? bfhi(gq[i >> 1]) : bflo(gq[i >> 1]), bb = (i & 1) ? bfhi(bq[i >> 1]) : bflo(bq[i >> 1]);
              ov[i] = (yn + bb) * gt; }
          u32x4 ow = (u32x4){pk2(ov[0], ov[1]), pk2(ov[2], ov[3]), pk2(ov[4], ov[5]), pk2(ov[6], ov[7])};
          *(u32x4*)(MIXED + row * D + 512 + 64 * h + 8 * cg8) = ow; }
    }
}

DI void phase_post(const Params& p, const Ctx& F) {
    const float* YS = (const float*)(p.ws + WS_YS);
    const bf16_t* GATE = (const bf16_t*)((unsigned char*)p.out + DO_GATE); const bf16_t* BV = (const bf16_t*)((unsigned char*)p.out + DO_BV);
    bf16_t* MIXED = (bf16_t*)((unsigned char*)p.out + DO_MIXED);
    const int t = F.tid; const float lg = p.in[I_LNXG][t], lb = p.in[I_LNXB][t];
    for (int row = F.bid; row < NT; row += F.G) {
        const size_t o = (size_t)row * 512 + t;
        const float y = YS[o] + YS[(size_t)NT * 512 + o];
        const float mu = wave_sum(y) * (1.f / 64.f); const float dd = y - mu; const float var = wave_sum(dd * dd) * (1.f / 64.f);
        const float yn = dd * (1.f / sqrtf(var + 64e-5f)) * lg + lb;
        const float ob = (yn + bf2f(BV[o])) * bf2f(GATE[o]);
        MIXED[(size_t)row * D + 512 + t] = (bf16_t)f2bf(ob);
    }
}

DI void phase_gemm2(const Params& p, const Ctx& F) {
    pg8::StaticOrder S; S.init((unsigned char*)p.out + DO_MIXED, p.ws + WS_WOUTT, NT, 1024, 1024, F.G, F.bid);
    pg8::EpiF32 E{(float*)(p.ws + WS_Y), 1024};
    pg8::gemm_phase<pg8::EpiF32, pg8::StaticOrder, false>(F.lds, 1024, S, E);
}

DI void phase_route(const Params& p, const Ctx& F) {
    LAS float* wr_ = (LAS float*)F.lds;
    for (int i = F.tid; i < 36 * 1024; i += NTHREADS) { const int o = i / 1024, k = i % 1024; wr_[i] = o < 4 ? p.in[I_WRG][k * 4 + o] : p.in[I_WRE][k * 32 + (o - 4)]; }
    __syncthreads();
    const float* mod = (const float*)(p.ws + WS_MOD); const float* Y = (const float*)(p.ws + WS_Y);
    bf16_t* H2 = (bf16_t*)(p.ws + WS_H2); int* cnt = (int*)(p.ws + WS_CTL); int* perm = (int*)(p.ws + WS_PERM); float* ew = (float*)(p.ws + WS_EW);
    const int gw = F.bid * NWAVES + F.wave, NGW = F.G * NWAVES;
    for (int row = gw; row < NT; row += NGW) {
        const int bt = row / SEQ;
        const f32x4* yr = (const f32x4*)(Y + (size_t)row * D) + F.lane; const f32x4* xr = (const f32x4*)(p.in[I_X] + (size_t)row * D) + F.lane;
        f32x4 v[4]; float ss = 0.f;
#pragma unroll
        for (int j = 0; j < 4; ++j) { v[j] = yr[64 * j]; ss += (v[j].x * v[j].x + v[j].y * v[j].y) + (v[j].z * v[j].z + v[j].w * v[j].w); }
        const float rstd = 1.f / sqrtf(wave_sum(ss) * (1.f / D) + 1e-6f);
        float s2 = 0.f;
        f32x4* xo = (f32x4*)(p.out + (size_t)row * D) + F.lane;
#pragma unroll
        for (int j = 0; j < 4; ++j) { const int col = 4 * (F.lane + 64 * j);
            const f32x4 g1 = *(const f32x4*)(mod + bt * 6144 + 2048 + col), gp = *(const f32x4*)(p.in[I_GPOST1] + col);
            v[j] = xr[64 * j] + g1 * (v[j] * rstd * gp);
            xo[64 * j] = v[j];
            s2 += (v[j].x * v[j].x + v[j].y * v[j].y) + (v[j].z * v[j].z + v[j].w * v[j].w); }
        const float rstd2 = 1.f / sqrtf(wave_sum(s2) * (1.f / D) + 1e-6f);
        unsigned long long* o8 = (unsigned long long*)(H2 + (size_t)row * D) + F.lane;
#pragma unroll
        for (int j = 0; j < 4; ++j) { const int col = 4 * (F.lane + 64 * j);
            const f32x4 gg = *(const f32x4*)(p.in[I_GPRE2] + col), sh = *(const f32x4*)(mod + bt * 6144 + 3072 + col), sc = *(const f32x4*)(mod + bt * 6144 + 4096 + col);
            v[j] = v[j] * rstd2 * gg * (sc + 1.f) + sh;
            o8[64 * j] = (unsigned long long)pk2(v[j].x, v[j].y) | ((unsigned long long)pk2(v[j].z, v[j].w) << 32); }
        float mylg = 0.f;
#pragma unroll 2
        for (int o = 0; o < 36; ++o) { float a = 0.f;
#pragma unroll
            for (int j = 0; j < 4; ++j) { const f32x4 w = *(const LAS f32x4*)(wr_ + o * 1024 + 4 * (F.lane + 64 * j)); a += (v[j].x * w.x + v[j].y * w.y) + (v[j].z * w.z + v[j].w * w.w); }
            a = wave_sum(a); mylg = (F.lane == o) ? a : mylg; }
        mylg += (F.lane < 4) ? p.in[I_BRG][F.lane & 3] : p.in[I_BRE][(F.lane - 4) & 31];
        float gl[4];
#pragma unroll
        for (int j = 0; j < 4; ++j) gl[j] = __shfl(mylg, j);
        int gi = 0; float gm = gl[0];
#pragma unroll
        for (int j = 1; j < 4; ++j) if (gl[j] > gm) { gm = gl[j]; gi = j; }
        float gsum = 0.f;
#pragma unroll
        for (int j = 0; j < 4; ++j) gsum += __expf(gl[j] - gm);
        const float gw_ = 1.f / gsum;
        float el[8];
#pragma unroll
        for (int j = 0; j < 8; ++j) el[j] = __shfl(mylg, 4 + gi * 8 + j);
        int i1 = 0; float m1 = el[0];
#pragma unroll
        for (int j = 1; j < 8; ++j) if (el[j] > m1) { m1 = el[j]; i1 = j; }
        int i2 = 0; float m2 = -3.0e38f;
#pragma unroll
        for (int j = 0; j < 8; ++j) if (j != i1 && el[j] > m2) { m2 = el[j]; i2 = j; }
        const float p2 = __expf(m2 - m1);
        const float w1 = gw_ / (1.f + p2), w2 = gw_ * p2 / (1.f + p2);
        if (F.lane == 0) {
            const int e1 = gi * 8 + i1, e2 = gi * 8 + i2;
            const int p1 = atomicAdd(&cnt[e1], 1); perm[(size_t)e1 * NT + p1] = row * 2;
            const int q2 = atomicAdd(&cnt[e2], 1); perm[(size_t)e2 * NT + q2] = row * 2 + 1;
            ew[row * 2] = w1; ew[row * 2 + 1] = w2;
        }
    }
}

DI void moe_tile_prefix(const Params& p, const Ctx& F, LAS int* tp) {
    __syncthreads();
    if (F.tid == 0) { const int* cnt = (const int*)(p.ws + WS_CTL); int acc = 0; for (int e = 0; e < 32; ++e) { tp[e] = acc; acc += (cnt[e] + 255) / 256; } tp[32] = acc; }
    __syncthreads();
}
DI void phase_moe_up(const Params& p, const Ctx& F) {
    LAS int* tp = (LAS int*)(F.lds + pg8::STAGE_BYTES);
    moe_tile_prefix(p, F, tp);
    MoeOrder S{tp, (const int*)(p.ws + WS_CTL), 2, F.G, F.bid, 1024, (const char*)(p.ws + WS_H2), (const char*)(p.ws + WS_WGUT), (size_t)512 * 1024 * 2, (size_t)256 * 1024 * 2, (const int*)(p.ws + WS_PERM), true};
    pg8::EpiMoeUp E{(bf16_t*)(p.ws + WS_HID)};
    pg8::gemm_phase<pg8::EpiMoeUp, MoeOrder, true>(F.lds, 1024, S, E);
}
DI void phase_moe_down(const Params& p, const Ctx& F) {
    LAS int* tp = (LAS int*)(F.lds + pg8::STAGE_BYTES);
    moe_tile_prefix(p, F, tp);
    MoeOrder S{tp, (const int*)(p.ws + WS_CTL), 4, F.G, F.bid, 256, (const char*)(p.ws + WS_HID), (const char*)(p.ws + WS_WDT), (size_t)1024 * 256 * 2, (size_t)256 * 256 * 2, (const int*)(p.ws + WS_PERM), false};
    pg8::EpiMoeDown E{(bf16_t*)(p.ws + WS_YMOE), (const int*)(p.ws + WS_PERM), (const float*)(p.ws + WS_EW)};
    pg8::gemm_phase<pg8::EpiMoeDown, MoeOrder, false>(F.lds, 256, S, E);
}

DI void phase_final(const Params& p, const Ctx& F) {
    const float* mod = (const float*)(p.ws + WS_MOD); const bf16_t* YM = (const bf16_t*)(p.ws + WS_YMOE);
    const int gw = F.bid * NWAVES + F.wave, NGW = F.G * NWAVES;
    for (int row = gw; row < NT; row += NGW) {
        const int bt = row / SEQ;
        const u32x2* y0 = (const u32x2*)(YM + (size_t)row * D) + F.lane; const u32x2* y1 = (const u32x2*)(YM + ((size_t)NT + row) * D) + F.lane;
        f32x4 v[4]; float ss = 0.f;
#pragma unroll
        for (int j = 0; j < 4; ++j) { const u32x2 a = y0[64 * j], b = y1[64 * j];
            v[j] = (f32x4){bflo(a.x) + bflo(b.x), bfhi(a.x) + bfhi(b.x), bflo(a.y) + bflo(b.y), bfhi(a.y) + bfhi(b.y)};
            ss += (v[j].x * v[j].x + v[j].y * v[j].y) + (v[j].z * v[j].z + v[j].w * v[j].w); }
        const float rstd = 1.f / sqrtf(wave_sum(ss) * (1.f / D) + 1e-6f);
        f32x4* xo = (f32x4*)(p.out + (size_t)row * D) + F.lane;
#pragma unroll
        for (int j = 0; j < 4; ++j) { const int col = 4 * (F.lane + 64 * j);
            const f32x4 g2 = *(const f32x4*)(mod + bt * 6144 + 5120 + col), gp = *(const f32x4*)(p.in[I_GPOST2] + col);
            xo[64 * j] = xo[64 * j] + g2 * (v[j] * rstd * gp); }
    }
}

constexpr int NPHASES = 12;
#ifndef SEQ_SCAN
#define SEQ_SCAN 0
#endif
template <int PH> DI void run_phase(const Params& p, const Ctx& F) {
    if constexpr (PH == 0) phase_adaln(p, F);
    if constexpr (PH == 1) phase_convert(p, F);
    if constexpr (PH == 2) phase_hrows(p, F);
    if constexpr (PH == 3) phase_gemm1(p, F);
    if constexpr (PH == 4) { phase_prep(p, F); __syncthreads(); phase_gmlp(p, F); }
    if constexpr (PH == 5) { if (SEQ_SCAN) phase_scan_seq(p, F); else phase_chunkprep(p, F, 0); }
    if constexpr (PH == 12) phase_scan_chunk(p, F, 0);
    if constexpr (PH == 13) phase_chunkprep(p, F, 1);
    if constexpr (PH == 14) phase_scan_chunk(p, F, 1);
    if constexpr (PH == 6) { if (SEQ_SCAN) phase_post(p, F); else phase_post2(p, F); }
    if constexpr (PH == 7) phase_gemm2(p, F);
    if constexpr (PH == 8) phase_route(p, F);
    if constexpr (PH == 9) phase_moe_up(p, F);
    if constexpr (PH == 10) phase_moe_down(p, F);
    if constexpr (PH == 11) phase_final(p, F);
}
DI Ctx make_ctx(unsigned char* lds) {
    Ctx F; F.lds = (LAS unsigned char*)lds; F.tid = threadIdx.x; F.lane = F.tid & 63; F.wave = __builtin_amdgcn_readfirstlane(F.tid >> 6); F.G = gridDim.x; F.bid = blockIdx.x; return F;
}
template <int PH> __global__ void __launch_bounds__(NTHREADS, 2) k_phase(Params p) {
    extern __shared__ __attribute__((aligned(16))) unsigned char lds[];
    const Ctx F = make_ctx(lds);
    run_phase<PH>(p, F);
}
__global__ void __launch_bounds__(NTHREADS, 2) k_mega(Params p) {
    extern __shared__ __attribute__((aligned(16))) unsigned char lds[];
    const Ctx F = make_ctx(lds);
    cg::grid_group grid = cg::this_grid();
    run_phase<0>(p, F); run_phase<1>(p, F); grid.sync();
    run_phase<2>(p, F); grid.sync();
    run_phase<3>(p, F); grid.sync();
    run_phase<4>(p, F); grid.sync();
    run_phase<5>(p, F); grid.sync();
    if (!SEQ_SCAN) { run_phase<12>(p, F); grid.sync(); run_phase<13>(p, F); grid.sync(); run_phase<14>(p, F); grid.sync(); }
    run_phase<6>(p, F); grid.sync();
    run_phase<7>(p, F); grid.sync();
    run_phase<8>(p, F); grid.sync();
    run_phase<9>(p, F); grid.sync();
    run_phase<10>(p, F); grid.sync();
    run_phase<11>(p, F);
}

template <int PH> static void launch_phase(const Params& p, int grid, hipStream_t stream) {
    static bool attr = false;
    if (!attr) { (void)hipFuncSetAttribute((const void*)k_phase<PH>, hipFuncAttributeMaxDynamicSharedMemorySize, LDS_BYTES); attr = true; }
    hipLaunchKernelGGL(k_phase<PH>, dim3(grid), dim3(NTHREADS), LDS_BYTES, stream, p);
}

extern "C" void kernel_launch(void* const* d_in, const int* in_sizes, int n_in, void* d_out, int out_size, void* d_ws, size_t ws_size, hipStream_t stream) {
    static int grid = 0;
    if (grid == 0) {
        int dev = 0, cus = 0, per_cu = 0;
        (void)hipGetDevice(&dev); (void)hipDeviceGetAttribute(&cus, hipDeviceAttributeMultiprocessorCount, dev);
        (void)hipFuncSetAttribute((const void*)k_mega, hipFuncAttributeMaxDynamicSharedMemorySize, LDS_BYTES);
        (void)hipOccupancyMaxActiveBlocksPerMultiprocessor(&per_cu, (const void*)k_mega, NTHREADS, LDS_BYTES);
        (void)hipGetLastError();
        grid = cus > 0 ? cus : 256;
        if (n_in != 34 || ws_size < 512 * MiB) fprintf(stderr, "kernel_launch: unexpected n_in %d / ws_size %zu\n", n_in, ws_size);
    }
    Params p{};
    for (int i = 0; i < 34; ++i) p.in[i] = (const float*)d_in[i];
    p.out = (float*)d_out; p.ws = (unsigned char*)d_ws;
    (void)hipMemsetAsync((char*)d_ws + WS_CTL, 0, CTL_BYTES, stream);
#if ONE_LAUNCH
    void* args[] = {&p};
    hipError_t e = hipLaunchCooperativeKernel((const void*)k_mega, dim3(grid), dim3(NTHREADS), args, LDS_BYTES, stream);
    if (e != hipSuccess) fprintf(stderr, "cooperative launch failed: %s (grid %d)\n", hipGetErrorString(e), grid);
#else
    launch_phase<0>(p, grid, stream); launch_phase<1>(p, grid, stream); launch_phase<2>(p, grid, stream); launch_phase<3>(p, grid, stream);
    launch_phase<4>(p, grid, stream); launch_phase<5>(p, grid, stream);
    if (!SEQ_SCAN) { launch_phase<12>(p, grid, stream); launch_phase<13>(p, grid, stream); launch_phase<14>(p, grid, stream); }
    launch_phase<6>(p, grid, stream); launch_phase<7>(p, grid, stream);
    launch_phase<8>(p, grid, stream); launch_phase<9>(p, grid, stream); launch_phase<10>(p, grid, stream); launch_phase<11>(p, grid, stream);
#endif
}
```

```cpp
#include <hip/hip_runtime.h>
#include <hip/hip_cooperative_groups.h>
#include <cstdio>
#include <cstdint>
namespace cg = cooperative_groups;

#ifndef ONE_LAUNCH
#define ONE_LAUNCH 1
#endif

#define DI __device__ __forceinline__
#define LAS __attribute__((address_space(3)))
typedef unsigned short bf16_t;
typedef short bf16x8 __attribute__((ext_vector_type(8)));
typedef short s16x4 __attribute__((ext_vector_type(4)));
typedef float f32x4 __attribute__((ext_vector_type(4)));
typedef float f32x2 __attribute__((ext_vector_type(2)));
typedef unsigned u32x4 __attribute__((ext_vector_type(4)));
typedef unsigned u32x2 __attribute__((ext_vector_type(2)));

constexpr int D = 1024, BATCH = 4, SEQ = 8192, CTXL = 256;
constexpr int NT = BATCH * SEQ;
constexpr int NCX = BATCH * CTXL;
constexpr int MR = NT + NCX;
constexpr int BW = 512, AW = 512, NH = 8, HD = 64;
constexpr int DIN = 2944, DINP = 3072;
constexpr int OFF_K = 0, OFF_V = 512, OFF_R = 1024, OFF_WD = 1536, OFF_AD = 1664, OFF_GD = 1792, OFF_U = 1920, OFF_VA = 2432;
constexpr int NEXP = 32, DEXP = 256;
constexpr int NWAVES = 8, NTHREADS = 512;
constexpr int LDS_BYTES = 149504, LDS_MISC = 147456;

constexpr size_t MiB = 1u << 20;
constexpr size_t WS_CTL = 0, CTL_BYTES = 64 * 1024;
constexpr size_t WS_MOD = 1 * MiB;
constexpr size_t WS_DUPT = 2 * MiB;
constexpr size_t WS_AUPT = WS_DUPT + 131072;
constexpr size_t WS_GUPT = WS_AUPT + 131072;
constexpr size_t WS_WSP = WS_GUPT + 131072;
constexpr size_t WS_CONVW = WS_WSP + 262144;
constexpr size_t WS_WINT = 3 * MiB;
constexpr size_t WS_WOUTT = 9 * MiB;
constexpr size_t WS_H = 11 * MiB;
constexpr size_t WS_Z = 77 * MiB;
constexpr size_t ROWB = (size_t)MR * 512 * 2;
constexpr size_t WS_KC = 275 * MiB, WS_VC = WS_KC + ROWB, WS_RC = WS_VC + ROWB, WS_A0 = WS_RC + ROWB, WS_A1 = WS_A0 + ROWB, WS_L0 = WS_A1 + ROWB, WS_L1 = WS_L0 + ROWB;
constexpr size_t WS_OPS = 11 * MiB;
constexpr size_t WS_YS = 11 * MiB;
constexpr size_t WS_Y = 11 * MiB;
constexpr size_t WS_H2 = 139 * MiB;
constexpr size_t WS_EW = 203 * MiB;
constexpr size_t WS_PERM = 204 * MiB;
constexpr size_t WS_HID = 210 * MiB;
constexpr size_t WS_YMOE = 246 * MiB;
constexpr size_t WS_WGUT = 374 * MiB;
constexpr size_t WS_WDT = 406 * MiB;
constexpr size_t DO_MIXED = 0, DO_GATE = 64 * MiB, DO_BV = 96 * MiB;

struct Params { const float* in[34]; float* out; unsigned char* ws; };
enum { I_X = 0, I_C, I_CTX, I_CCTX, I_WMOD, I_BMOD, I_GPRE1, I_GPOST1, I_GPRE2, I_GPOST2, I_WIN, I_CONV, I_GMLNG, I_GMLNB, I_WSP, I_BSP,
       I_DW0, I_DUP, I_A0, I_AUP, I_KK, I_KA, I_RK, I_GUP, I_LNXG, I_LNXB, I_WOUT, I_WRG, I_BRG, I_WRE, I_BRE, I_WG, I_WU, I_WD };

typedef __bf16 bf16x2_t __attribute__((ext_vector_type(2)));
DI unsigned pk2(float lo, float hi) { const f32x2 v = {lo, hi}; const bf16x2_t b = __builtin_convertvector(v, bf16x2_t); return __builtin_bit_cast(unsigned, b); }
DI unsigned f2bf(float f) { return pk2(f, f) & 0xffffu; }
DI float bf2f(unsigned b) { return __builtin_bit_cast(float, b << 16); }
DI float bflo(unsigned w) { return __builtin_bit_cast(float, w << 16); }
DI float bfhi(unsigned w) { return __builtin_bit_cast(float, w & 0xffff0000u); }
DI unsigned cvt_pk_bf16(float lo, float hi) { return pk2(lo, hi); }
DI float wave_sum(float v) {
#pragma unroll
    for (int o = 1; o < 64; o <<= 1) v += __shfl_xor(v, o);
    return v;
}
DI float sigmoidf_(float x) { return __builtin_amdgcn_rcpf(1.f + __expf(-x)); }
DI float siluf_(float x) { return x * __builtin_amdgcn_rcpf(1.f + __expf(-x)); }
DI float softplusf_(float x) { return fmaxf(x, 0.f) + __logf(1.f + __expf(-fabsf(x))); }
DI float tanh_fast(float x) { const float e = __expf(-2.f * fabsf(x)); const float t = (1.f - e) * __builtin_amdgcn_rcpf(1.f + e); return x < 0.f ? -t : t; }
DI float gelu_tanh(float x) { const float u = 0.7978845608028654f * (x + 0.044715f * x * x * x); return 0.5f * x * (1.f + tanh_fast(u)); }
#define LDS_WAIT() asm volatile("s_waitcnt lgkmcnt(0)" ::: "memory")

namespace pg8 {
constexpr int BM = 256, BK = 64, HALF = 128, HTB = HALF * BK * 2, STAGE_BYTES = 8 * HTB, NXCD = 8, WGM = 8;
__host__ __device__ __forceinline__ int lds_byte(int r, int c) { const int st = (r >> 4) * 2 + (c >> 5), rr = r & 15, cc = c & 31, ob = rr * 64 + cc * 2; return st * 1024 + (ob ^ (((ob >> 9) & 1) << 5)); }
__host__ __device__ __forceinline__ void stage_rc(int b, int& R, int& C) { const int st = b / 1024, sb = b % 1024, swz = sb ^ (((sb >> 9) & 1) << 5); R = (st >> 1) * 16 + swz / 64; C = (st & 1) * 32 + (swz % 64) / 2; }
__host__ __device__ __forceinline__ int perm32(int rho) { const int n = rho >> 4, i = rho & 15; return 8 * (i >> 2) + 4 * n + (i & 3); }

struct Unit { const char* A; const char* B; const int* ridx; int pm, pn, e, lt, nvalid; };

struct StaticOrder {
    const char* A; const char* Bt; int K; int nM, nN, nwg, G, c;
    __device__ void init(const void* A_, const void* Bt_, int M, int N, int K_, int G_, int c_) { A = (const char*)A_; Bt = (const char*)Bt_; K = K_; nM = M / BM; nN = N / BM; nwg = nM * nN; G = G_; c = c_; }
    __device__ bool next(int i, Unit& u) const {
        const long L = (long)i * G + c; if (L >= nwg) return false;
        int wgid = (int)L; { const int q = nwg / NXCD, r = nwg % NXCD, xcd = wgid % NXCD, off = wgid / NXCD; wgid = (xcd < r ? xcd * (q + 1) : r * (q + 1) + (xcd - r) * q) + off; }
        const int nig = WGM * nN, gid = wgid / nig, fm = gid * WGM, gsz = (nM - fm) < WGM ? (nM - fm) : WGM;
        u.pm = fm + ((wgid % nig) % gsz); u.pn = (wgid % nig) / gsz;
        u.A = A + (size_t)u.pm * BM * K * 2; u.B = Bt + (size_t)u.pn * BM * K * 2; u.ridx = nullptr; u.e = 0; u.lt = 0; u.nvalid = BM; return true;
    }
};

DI int gidx(const Unit& u, int r) { return r < u.nvalid ? (u.ridx[r] >> 1) : 0; }

template <class Epi, class Sched, bool GATHER>
DI void gemm_phase(LAS unsigned char* lds, const int K, const Sched& S, const Epi& E) {
    const int tid = threadIdx.x, wid = __builtin_amdgcn_readfirstlane(tid >> 6), lane = tid & 63, wr = wid >> 2, wc = wid & 3, fr = lane & 15, fq = lane >> 4;
    const int nt = K / BK;
    int Rr[2], Cc[2];
    unsigned voffB[2], vA[2][2], vAn[2][2];
#pragma unroll
    for (int i = 0; i < 2; ++i) { int R, C; stage_rc(tid * 16 + i * 8192, R, C); Rr[i] = R; Cc[i] = C; const int Rb = (R & ~31) + perm32(R & 31);
        voffB[i] = (unsigned)(Rb * K + C) * 2u;
        vA[0][i] = (unsigned)(R * K + C) * 2u; vA[1][i] = (unsigned)((R + HALF) * K + C) * 2u; vAn[0][i] = vA[0][i]; vAn[1][i] = vA[1][i]; }
    const size_t kstep = (size_t)(BK * 2);
    const size_t hstep = (size_t)HALF * K * 2;
    const unsigned ldsw = (unsigned)wid * 1024u;
    const int aoff = lds_byte(wr * 64 + fr, fq * 8), boff = lds_byte(wc * 32 + fr, fq * 8);
#define PG8_SA(b, h) (((b) * 2 + (h)) * HTB)
#define PG8_SB(b, h) ((4 + (b) * 2 + (h)) * HTB)
#define PG8_STAGE(bufoff, gbase, voff) do { _Pragma("unroll") for (int _i = 0; _i < 2; ++_i) \
        __builtin_amdgcn_global_load_lds((const unsigned*)((const char*)(gbase) + (voff)[_i]), (LAS unsigned*)(lds + (bufoff) + ldsw + _i * 8192), 16, 0, 0); } while (0)
#define PG8_LDA(dst, b, h) do { _Pragma("unroll") for (int m = 0; m < 4; ++m) _Pragma("unroll") for (int k = 0; k < 2; ++k) dst[m][k] = *(const LAS bf16x8*)(lds + PG8_SA(b, h) + aoff + m * 2048 + k * 1024); } while (0)
#define PG8_LDB(dst, b, h) do { _Pragma("unroll") for (int n = 0; n < 2; ++n) _Pragma("unroll") for (int k = 0; k < 2; ++k) dst[n][k] = *(const LAS bf16x8*)(lds + PG8_SB(b, h) + boff + n * 2048 + k * 1024); } while (0)
#define PG8_MMA(ai, bj, At, Bt) do { __builtin_amdgcn_s_setprio(1); _Pragma("unroll") for (int m = 0; m < 4; ++m) _Pragma("unroll") for (int n = 0; n < 2; ++n) _Pragma("unroll") for (int k = 0; k < 2; ++k) \
        acc[ai][bj][m][n] = __builtin_amdgcn_mfma_f32_16x16x32_bf16(Bt[n][k], At[m][k], acc[ai][bj][m][n], 0, 0, 0); __builtin_amdgcn_s_setprio(0); } while (0)
#define PG8_WAIT_V(n) asm volatile("s_waitcnt vmcnt(" #n ")" ::: "memory")
#define PG8_WAIT_L(n) asm volatile("s_waitcnt lgkmcnt(" #n ")" ::: "memory")
#define PG8_BAR __builtin_amdgcn_s_barrier()
#define PG8_SCHED __builtin_amdgcn_sched_barrier(0)
    Unit cur, nxt; int ui = 0;
    if (!S.next(0, cur)) return;
    if constexpr (GATHER) {
#pragma unroll
        for (int i = 0; i < 2; ++i) { vA[0][i] = (unsigned)(gidx(cur, Rr[i]) * K + Cc[i]) * 2u; vA[1][i] = (unsigned)(gidx(cur, Rr[i] + HALF) * K + Cc[i]) * 2u; }
    }
    f32x4 acc[2][2][4][2];
#pragma unroll
    for (int a = 0; a < 2; ++a)
#pragma unroll
        for (int b = 0; b < 2; ++b)
#pragma unroll
            for (int m = 0; m < 4; ++m)
#pragma unroll
                for (int n = 0; n < 2; ++n) acc[a][b][m][n] = (f32x4){0.f, 0.f, 0.f, 0.f};
    bf16x8 At[4][2], B0[2][2], B1[2][2];
    const char* cA = cur.A; const char* cB = cur.B;
    PG8_STAGE(PG8_SB(0, 0), cB, voffB); PG8_STAGE(PG8_SB(0, 1), cB + hstep, voffB); PG8_STAGE(PG8_SA(0, 0), cA, vA[0]); PG8_STAGE(PG8_SA(0, 1), cA, vA[1]);
    if (wr == 1) PG8_BAR;
    PG8_WAIT_V(2); PG8_BAR;
    PG8_STAGE(PG8_SB(1, 0), cB + kstep, voffB); PG8_STAGE(PG8_SA(1, 0), cA + kstep, vA[0]); PG8_STAGE(PG8_SB(1, 1), cB + hstep + kstep, voffB);
    PG8_WAIT_V(6); PG8_BAR;
    for (;;) {
        const bool has_next = S.next(ui + 1, nxt);
        const char* nA = has_next ? nxt.A : cA; const char* nB = has_next ? nxt.B : cB;
        if constexpr (GATHER) {
            if (has_next) {
#pragma unroll
                for (int i = 0; i < 2; ++i) { vAn[0][i] = (unsigned)(gidx(nxt, Rr[i]) * K + Cc[i]) * 2u; vAn[1][i] = (unsigned)(gidx(nxt, Rr[i] + HALF) * K + Cc[i]) * 2u; }
            } else {
#pragma unroll
                for (int i = 0; i < 2; ++i) { vAn[0][i] = vA[0][i]; vAn[1][i] = vA[1][i]; }
            }
        }
#pragma unroll 1
        for (int t = 0; t < nt; t += 2) {
            const bool last = (t == nt - 2);
            const char* a1 = cA + (size_t)(t + 1) * kstep;
            const char* a2 = last ? nA : cA + (size_t)(t + 2) * kstep; const char* b2 = last ? nB : cB + (size_t)(t + 2) * kstep;
            const char* a3 = a2 + kstep; const char* b3 = b2 + kstep;
            unsigned w0[2], w1[2];
            if constexpr (GATHER) { w0[0] = last ? vAn[0][0] : vA[0][0]; w0[1] = last ? vAn[0][1] : vA[0][1]; w1[0] = last ? vAn[1][0] : vA[1][0]; w1[1] = last ? vAn[1][1] : vA[1][1]; }
            else { w0[0] = vA[0][0]; w0[1] = vA[0][1]; w1[0] = vA[1][0]; w1[1] = vA[1][1]; }
            PG8_LDB(B0, 0, 0); PG8_LDB(B1, 0, 1); PG8_SCHED; PG8_LDA(At, 0, 0); PG8_STAGE(PG8_SA(1, 1), a1, vA[1]);
            PG8_WAIT_V(8); PG8_WAIT_L(0); PG8_BAR; PG8_MMA(0, 0, At, B0); PG8_MMA(0, 1, At, B1); PG8_BAR; PG8_SCHED;
            PG8_LDA(At, 0, 1); PG8_STAGE(PG8_SB(0, 0), b2, voffB); PG8_STAGE(PG8_SB(0, 1), b2 + hstep, voffB); PG8_STAGE(PG8_SA(0, 0), a2, w0);
            PG8_WAIT_V(8); PG8_WAIT_L(0); PG8_BAR; PG8_MMA(1, 0, At, B0); PG8_MMA(1, 1, At, B1); PG8_BAR; PG8_SCHED;
            PG8_LDB(B0, 1, 0); PG8_LDB(B1, 1, 1); PG8_SCHED; PG8_LDA(At, 1, 0); PG8_STAGE(PG8_SA(0, 1), a2, w1);
            PG8_WAIT_V(8); PG8_WAIT_L(0); PG8_BAR; PG8_MMA(0, 0, At, B0); PG8_MMA(0, 1, At, B1); PG8_BAR; PG8_SCHED;
            PG8_LDA(At, 1, 1); PG8_STAGE(PG8_SB(1, 0), b3, voffB); PG8_STAGE(PG8_SB(1, 1), b3 + hstep, voffB); PG8_STAGE(PG8_SA(1, 0), a3, w0);
            PG8_WAIT_V(8); PG8_WAIT_L(0); PG8_BAR; PG8_MMA(1, 0, At, B0); PG8_MMA(1, 1, At, B1); PG8_BAR; PG8_SCHED;
        }
        if (wr == 0) PG8_BAR;
        E(acc, cur, wr, wc, fr, fq);
        if (!has_next) break;
#pragma unroll
        for (int a = 0; a < 2; ++a)
#pragma unroll
            for (int b = 0; b < 2; ++b)
#pragma unroll
                for (int m = 0; m < 4; ++m)
#pragma unroll
                    for (int n = 0; n < 2; ++n) acc[a][b][m][n] = (f32x4){0.f, 0.f, 0.f, 0.f};
        cur = nxt; cA = nA; cB = nB; ++ui;
        if constexpr (GATHER) {
#pragma unroll
            for (int i = 0; i < 2; ++i) { vA[0][i] = vAn[0][i]; vA[1][i] = vAn[1][i]; }
        }
        if (wr == 1) PG8_BAR;
    }
    PG8_WAIT_V(0);
    PG8_BAR;
#undef PG8_SA
#undef PG8_SB
#undef PG8_STAGE
#undef PG8_LDA
#undef PG8_LDB
#undef PG8_MMA
#undef PG8_WAIT_V
#undef PG8_WAIT_L
#undef PG8_BAR
#undef PG8_SCHED
}

struct EpiBf16 {
    bf16_t* O; int ldc;
    DI void operator()(const f32x4 (&acc)[2][2][4][2], const Unit& u, int wr, int wc, int fr, int fq) const {
        const int row0 = u.pm * BM + wr * 64 + fr, col0 = u.pn * BM + wc * 32 + 8 * fq;
#pragma unroll
        for (int ai = 0; ai < 2; ++ai)
#pragma unroll
            for (int m = 0; m < 4; ++m) { bf16_t* rowp = O + (size_t)(row0 + ai * HALF + m * 16) * ldc + col0;
#pragma unroll
                for (int bj = 0; bj < 2; ++bj) { const f32x4 v0 = acc[ai][bj][m][0], v1 = acc[ai][bj][m][1];
                    u32x4 w; w.x = cvt_pk_bf16(v0[0], v0[1]); w.y = cvt_pk_bf16(v0[2], v0[3]); w.z = cvt_pk_bf16(v1[0], v1[1]); w.w = cvt_pk_bf16(v1[2], v1[3]);
                    *(u32x4*)(rowp + bj * HALF) = w; } }
    }
};
struct EpiF32 {
    float* O; int ldc;
    DI void operator()(const f32x4 (&acc)[2][2][4][2], const Unit& u, int wr, int wc, int fr, int fq) const {
        const int row0 = u.pm * BM + wr * 64 + fr, col0 = u.pn * BM + wc * 32 + 8 * fq;
#pragma unroll
        for (int ai = 0; ai < 2; ++ai)
#pragma unroll
            for (int m = 0; m < 4; ++m) { float* rowp = O + (size_t)(row0 + ai * HALF + m * 16) * ldc + col0;
#pragma unroll
                for (int bj = 0; bj < 2; ++bj) { *(f32x4*)(rowp + bj * HALF) = acc[ai][bj][m][0]; *(f32x4*)(rowp + bj * HALF + 4) = acc[ai][bj][m][1]; } }
    }
};
struct EpiMoeUp {
    bf16_t* HID;
    DI void operator()(const f32x4 (&acc)[2][2][4][2], const Unit& u, int wr, int wc, int fr, int fq) const {
        const int row0 = u.pm * BM + wr * 64 + fr, col0 = u.pn * HALF + wc * 32 + 8 * fq;
#pragma unroll
        for (int ai = 0; ai < 2; ++ai)
#pragma unroll
            for (int m = 0; m < 4; ++m) { bf16_t* rowp = HID + (size_t)(row0 + ai * HALF + m * 16) * DEXP + col0;
                float h[8];
#pragma unroll
                for (int n = 0; n < 2; ++n)
#pragma unroll
                    for (int j = 0; j < 4; ++j) { const float g = acc[ai][0][m][n][j], up = acc[ai][1][m][n][j]; h[n * 4 + j] = siluf_(g) * up; }
                u32x4 w; w.x = cvt_pk_bf16(h[0], h[1]); w.y = cvt_pk_bf16(h[2], h[3]); w.z = cvt_pk_bf16(h[4], h[5]); w.w = cvt_pk_bf16(h[6], h[7]);
                *(u32x4*)rowp = w; }
    }
};
struct EpiMoeDown {
    bf16_t* YM; const int* perm; const float* ew;
    DI void operator()(const f32x4 (&acc)[2][2][4][2], const Unit& u, int wr, int wc, int fr, int fq) const {
        const int col0 = u.pn * BM + wc * 32 + 8 * fq;
#pragma unroll
        for (int ai = 0; ai < 2; ++ai)
#pragma unroll
            for (int m = 0; m < 4; ++m) { const int r = ai * HALF + wr * 64 + m * 16 + fr;
                if (r < u.nvalid) { const int pr = perm[(size_t)u.e * NT + u.lt * BM + r]; const int tok = pr >> 1, slot = pr & 1; const float wgt = ew[pr];
                    bf16_t* rowp = YM + ((size_t)slot * NT + tok) * D + col0;
#pragma unroll
                    for (int bj = 0; bj < 2; ++bj) { const f32x4 v0 = acc[ai][bj][m][0] * wgt, v1 = acc[ai][bj][m][1] * wgt;
                        u32x4 w; w.x = cvt_pk_bf16(v0[0], v0[1]); w.y = cvt_pk_bf16(v0[2], v0[3]); w.z = cvt_pk_bf16(v1[0], v1[1]); w.w = cvt_pk_bf16(v1[2], v1[3]);
                        *(u32x4*)(rowp + bj * HALF) = w; } }
                asm volatile("" ::: "memory"); }
    }
};
}

struct MoeOrder {
    const LAS int* tp; const int* cnt; int npn, G, c, K; const char* A; const char* Bbase; size_t bstride_e, bstride_pn; const int* perm; bool gather;
    __device__ bool next(int i, pg8::Unit& u) const {
        const int TT = __builtin_amdgcn_readfirstlane(tp[32]); const long L = (long)i * G + c; if (L >= (long)TT * npn) return false;
        const int rt = (int)(L / npn), pn = (int)(L % npn);
        int e = 0;
#pragma unroll 1
        for (int j = 1; j < 32; ++j) e += (__builtin_amdgcn_readfirstlane(tp[j]) <= rt) ? 1 : 0;
        const int lt = rt - __builtin_amdgcn_readfirstlane(tp[e]);
        u.pm = rt; u.pn = pn; u.e = e; u.lt = lt; const int rem = cnt[e * 64] - lt * 256; u.nvalid = rem < 256 ? rem : 256;
        u.ridx = perm + (size_t)e * NT + lt * 256;
        u.A = gather ? A : A + (size_t)rt * 256 * K * 2;
        u.B = Bbase + (size_t)e * bstride_e + (size_t)pn * bstride_pn;
        return true;
    }
};

struct Ctx {
    LAS unsigned char* lds; int tid, lane, wave, G, bid;
};

DI void phase_adaln(const Params& p, const Ctx& F) {
    LAS float* s = (LAS float*)F.lds;
    LAS float* red = (LAS float*)(F.lds + 20480);
    const float* c = p.in[I_C]; const float* cc = p.in[I_CCTX]; const float* wm = p.in[I_WMOD]; const float* bm = p.in[I_BMOD];
    float* mod = (float*)(p.ws + WS_MOD);
    for (int i = F.tid; i < 5 * 1024; i += NTHREADS) { const float v = i < 4096 ? c[i] : cc[i - 4096]; s[i] = siluf_(v); }
    __syncthreads();
    for (int grp = F.bid; grp < 256; grp += F.G) {
        const int col0 = grp * 24, q = F.tid % 6, ks = F.tid / 6;
        float acc[5][4];
#pragma unroll
        for (int b = 0; b < 5; ++b)
#pragma unroll
            for (int j = 0; j < 4; ++j) acc[b][j] = 0.f;
        if (F.tid < 510) {
            f32x4 wv[13];
#pragma unroll
            for (int i = 0; i < 13; ++i) { const int k = ks + 85 * i; wv[i] = k < 1024 ? *(const f32x4*)(wm + (size_t)k * 6144 + col0 + 4 * q) : (f32x4){0.f, 0.f, 0.f, 0.f}; }
#pragma unroll
            for (int i = 0; i < 13; ++i) { const int k = ks + 85 * i; const int kc = k < 1024 ? k : 0;
#pragma unroll
                for (int b = 0; b < 5; ++b) { const float sv = s[b * 1024 + kc];
#pragma unroll
                    for (int j = 0; j < 4; ++j) acc[b][j] += sv * wv[i][j]; } }
#pragma unroll
            for (int b = 0; b < 5; ++b)
#pragma unroll
                for (int j = 0; j < 4; ++j) red[ks * 120 + q * 20 + b * 4 + j] = acc[b][j];
        }
        __syncthreads();
        if (F.tid < 120) {
            float sum = 0.f;
            for (int k2 = 0; k2 < 85; ++k2) sum += red[k2 * 120 + F.tid];
            const int qq = F.tid / 20, b = (F.tid % 20) / 4, j = F.tid % 4, col = col0 + 4 * qq + j;
            mod[b * 6144 + col] = sum + bm[col];
        }
        __syncthreads();
    }
}

DI void transpose_item(const float* W, int K, int N, bf16_t* WT, int row_off, LAS float* scr, int item, int lane) {
    const int nblk = N / 32, kb = item / nblk, nb = item % nblk, k0 = 64 * kb, n0 = 32 * nb;
#pragma unroll 8
    for (int i = 0; i < 32; ++i) { const int kk = 2 * i + (lane >> 5); scr[kk * 33 + (lane & 31)] = W[(size_t)(k0 + kk) * N + n0 + (lane & 31)]; }
    LDS_WAIT(); asm volatile("" ::: "memory");
    const int c = lane & 7;
#pragma unroll
    for (int j = 0; j < 4; ++j) { const int n = (lane >> 3) + 8 * j; const LAS float* s = scr + (8 * c) * 33 + n;
        u32x4 o; o.x = pk2(s[0 * 33], s[1 * 33]); o.y = pk2(s[2 * 33], s[3 * 33]); o.z = pk2(s[4 * 33], s[5 * 33]); o.w = pk2(s[6 * 33], s[7 * 33]);
        *(u32x4*)(WT + (size_t)(row_off + n0 + n) * K + k0 + 8 * c) = o; }
    LDS_WAIT(); asm volatile("" ::: "memory");
}
DI void phase_convert(const Params& p, const Ctx& F) {
    __syncthreads();
    LAS float* scr = (LAS float*)(F.lds + F.wave * 16384);
    const int gw = F.bid * NWAVES + F.wave, NGW = F.G * NWAVES;
    bf16_t* WinT = (bf16_t*)(p.ws + WS_WINT); bf16_t* WoutT = (bf16_t*)(p.ws + WS_WOUTT); bf16_t* WguT = (bf16_t*)(p.ws + WS_WGUT); bf16_t* WdT = (bf16_t*)(p.ws + WS_WDT);
    constexpr int I_IN = 16 * 92, I_OUT = 16 * 32;
    constexpr int NITEMS = I_IN + I_OUT;
    for (int it = gw; it < NITEMS; it += NGW) {
        int r = it;
        if (r < I_IN) { transpose_item(p.in[I_WIN], 1024, DIN, WinT, 0, scr, r, F.lane); continue; } r -= I_IN;
        transpose_item(p.in[I_WOUT], 1024, 1024, WoutT, 0, scr, r, F.lane);
    }
    (void)WguT; (void)WdT;
    { const int gt = F.bid * NTHREADS + F.tid, NG = F.G * NTHREADS; u32x4 z = {0u, 0u, 0u, 0u};
      for (int i = gt; i < 128 * 1024 / 8; i += NG) *(u32x4*)(WinT + (size_t)DIN * 1024 + (size_t)i * 8) = z;
      bf16_t* DupT = (bf16_t*)(p.ws + WS_DUPT); bf16_t* AupT = (bf16_t*)(p.ws + WS_AUPT); bf16_t* GupT = (bf16_t*)(p.ws + WS_GUPT); bf16_t* Wsp = (bf16_t*)(p.ws + WS_WSP);
      for (int i = gt; i < 2 * 512 * 64; i += NG) { const int d = i / (512 * 64), ch = (i / 64) % 512, l = i % 64;
          DupT[i] = (bf16_t)f2bf(p.in[I_DUP][(size_t)(d * 64 + l) * 512 + ch]); AupT[i] = (bf16_t)f2bf(p.in[I_AUP][(size_t)(d * 64 + l) * 512 + ch]); }
      for (int i = gt; i < 512 * 128; i += NG) { const int ch = i / 128, l = i % 128; GupT[i] = (bf16_t)f2bf(p.in[I_GUP][(size_t)l * 512 + ch]); }
      for (int i = gt; i < 8 * 128 * 128; i += NG) Wsp[i] = (bf16_t)f2bf(p.in[I_WSP][i]);
      float* cw2 = (float*)(p.ws + WS_CONVW);
      for (int i = gt; i < 128 * 9 * 3 * 4; i += NG) { const int j = i & 3, s3 = (i >> 2) % 3, tap = (i / 12) % 9, qd = i / 108; cw2[i] = p.in[I_CONV][tap * 1536 + s3 * 512 + 4 * qd + j]; } }
}


DI void phase_convert_experts(const Params& p, const Ctx& F) {
    if (F.wave == 0) return;
    LAS float* scr = (LAS float*)(F.lds + F.wave * 16384);
    bf16_t* WguT = (bf16_t*)(p.ws + WS_WGUT); bf16_t* WdT = (bf16_t*)(p.ws + WS_WDT);
    constexpr int I_GU = 16 * 8, I_DN = 4 * 32;
    constexpr int NITEMS = 32 * 2 * I_GU + 32 * I_DN;
    const int gw = F.bid * 7 + (F.wave - 1), NGW = F.G * 7;
    for (int it = gw; it < NITEMS; it += NGW) {
        int r = it;
        if (r < 32 * 2 * I_GU) { const int e = r / (2 * I_GU), r2 = r % (2 * I_GU), up = r2 / I_GU, item = r2 % I_GU;
            const int nb = item % 8, n0 = 32 * nb;
            const int tgt = (n0 / 128) * 256 + (n0 % 128) + (up ? 128 : 0);
            transpose_item((up ? p.in[I_WU] : p.in[I_WG]) + (size_t)e * 1024 * 256, 1024, 256, WguT + (size_t)e * 512 * 1024, tgt - n0, scr, item, F.lane); continue; }
        r -= 32 * 2 * I_GU;
        { const int e = r / I_DN, item = r % I_DN; transpose_item(p.in[I_WD] + (size_t)e * 256 * 1024, 256, 1024, WdT + (size_t)e * 1024 * 256, 0, scr, item, F.lane); }
    }
}

DI void phase_hrows(const Params& p, const Ctx& F) {
    const float* mod = (const float*)(p.ws + WS_MOD); const float* g = p.in[I_GPRE1]; bf16_t* H = (bf16_t*)(p.ws + WS_H);
    const int gw = F.bid * NWAVES + F.wave, NGW = F.G * NWAVES;
    for (int row = gw; row < MR; row += NGW) {
        const float* src = row < NT ? p.in[I_X] + (size_t)row * D : p.in[I_CTX] + (size_t)(row - NT) * D;
        const int bt = row < NT ? row / SEQ : 4;
        const f32x4* xr = (const f32x4*)src + F.lane;
        f32x4 v[4]; float ss = 0.f;
#pragma unroll
        for (int j = 0; j < 4; ++j) { v[j] = xr[64 * j]; ss += (v[j].x * v[j].x + v[j].y * v[j].y) + (v[j].z * v[j].z + v[j].w * v[j].w); }
        const float rstd = 1.f / sqrtf(wave_sum(ss) * (1.f / D) + 1e-6f);
        unsigned long long* o8 = (unsigned long long*)(H + (size_t)row * D) + F.lane;
#pragma unroll
        for (int j = 0; j < 4; ++j) { const int col = 4 * (F.lane + 64 * j);
            const f32x4 gg = *(const f32x4*)(g + col), sh = *(const f32x4*)(mod + bt * 6144 + col), sc = *(const f32x4*)(mod + bt * 6144 + 1024 + col);
            const f32x4 h = v[j] * rstd * gg * (sc + 1.f) + sh;
            o8[64 * j] = (unsigned long long)pk2(h.x, h.y) | ((unsigned long long)pk2(h.z, h.w) << 32); }
    }
}

DI void phase_gemm1(const Params& p, const Ctx& F) {
    pg8::StaticOrder S; S.init(p.ws + WS_H, p.ws + WS_WINT, MR, DINP, 1024, F.G, F.bid);
    pg8::EpiBf16 E{(bf16_t*)(p.ws + WS_Z), DINP};
    pg8::gemm_phase<pg8::EpiBf16, pg8::StaticOrder, false>(F.lds, 1024, S, E);
}

DI void phase_prep(const Params& p, const Ctx& F) {
    const bf16_t* Z = (const bf16_t*)(p.ws + WS_Z);
    bf16_t* Kc = (bf16_t*)(p.ws + WS_KC); bf16_t* Vc = (bf16_t*)(p.ws + WS_VC); bf16_t* Rc = (bf16_t*)(p.ws + WS_RC);
    bf16_t* A0 = (bf16_t*)(p.ws + WS_A0); bf16_t* A1 = (bf16_t*)(p.ws + WS_A1); bf16_t* L0 = (bf16_t*)(p.ws + WS_L0); bf16_t* L1 = (bf16_t*)(p.ws + WS_L1);
    bf16_t* GATE = (bf16_t*)((unsigned char*)p.out + DO_GATE); bf16_t* BV = (bf16_t*)((unsigned char*)p.out + DO_BV);
    const float* conv = p.in[I_CONV];
    LAS float* sl = (LAS float*)F.lds;
    const int t = F.tid;
    for (int it = F.bid; it < MR / 8; it += F.G) {
        const int row0 = it * 8;
        __syncthreads();
        for (int i = t; i < 8 * 384; i += NTHREADS) { const int rr = i / 384, c = i % 384; const float zv = bf2f(Z[(size_t)(row0 + rr) * DINP + OFF_WD + c]);
            sl[i] = c < 128 ? tanhf(zv) : (c < 256 ? zv : sigmoidf_(zv)); }
        __syncthreads();
        float dw0[8], dw1[8], da0[8], da1[8], gt[8];
#pragma unroll
        for (int r = 0; r < 8; ++r) { dw0[r] = dw1[r] = da0[r] = da1[r] = gt[r] = 0.f; }
        for (int l = 0; l < 64; ++l) {
            const float u0 = p.in[I_DUP][(size_t)l * 512 + t], u1 = p.in[I_DUP][(size_t)(64 + l) * 512 + t];
            const float v0 = p.in[I_AUP][(size_t)l * 512 + t], v1 = p.in[I_AUP][(size_t)(64 + l) * 512 + t];
            const float g0 = p.in[I_GUP][(size_t)l * 512 + t], g1 = p.in[I_GUP][(size_t)(64 + l) * 512 + t];
#pragma unroll
            for (int r = 0; r < 8; ++r) { const LAS float* s = sl + r * 384;
                dw0[r] += s[l] * u0; dw1[r] += s[64 + l] * u1; da0[r] += s[128 + l] * v0; da1[r] += s[192 + l] * v1; gt[r] += s[256 + l] * g0 + s[320 + l] * g1; }
        }
        const float w00 = p.in[I_DW0][t], w01 = p.in[I_DW0][512 + t], a00 = p.in[I_A0][t], a01 = p.in[I_A0][512 + t];
        const float ka0 = p.in[I_KA][t], ka1 = p.in[I_KA][512 + t], rk = p.in[I_RK][t];
#pragma unroll 1
        for (int r = 0; r < 8; ++r) {
            const int row = row0 + r;
            float cv[3] = {0.f, 0.f, 0.f};
            if (row < NT) {
                const int tb = row % SEQ, gy = tb / 64, gx = tb % 64;
#pragma unroll
                for (int dy = 0; dy < 3; ++dy) { const int ny = gy + dy - 1; if (ny < 0 || ny >= 128) continue;
#pragma unroll
                    for (int dx = 0; dx < 3; ++dx) { const int nx = gx + dx - 1; if (nx < 0 || nx >= 64) continue;
                        const size_t nrow = (size_t)(row + (dy - 1) * 64 + (dx - 1));
#pragma unroll
                        for (int s3 = 0; s3 < 3; ++s3) cv[s3] += bf2f(Z[nrow * DINP + s3 * 512 + t]) * conv[(dy * 3 + dx) * 1536 + s3 * 512 + t]; } }
            } else {
                const int tb = (row - NT) % CTXL;
#pragma unroll
                for (int dx = 0; dx < 3; ++dx) { const int nx = tb + dx - 1; if (nx < 0 || nx >= CTXL) continue;
                    const size_t nrow = (size_t)(row + dx - 1);
#pragma unroll
                    for (int s3 = 0; s3 < 3; ++s3) cv[s3] += bf2f(Z[nrow * DINP + s3 * 512 + t]) * conv[(3 + dx) * 1536 + s3 * 512 + t]; }
            }
            const float k = cv[0], v = cv[1], rr = cv[2];
            const float wl0 = w00 + dw0[r], wl1 = w01 + dw1[r];
            const float lg0 = -__expf(-softplusf_(-wl0) - 0.5f), lg1 = -__expf(-softplusf_(-wl1) - 0.5f);
            const float a0 = sigmoidf_(a00 + da0[r]), a1 = sigmoidf_(a01 + da1[r]);
            const size_t o = (size_t)row * 512 + t;
            Kc[o] = (bf16_t)f2bf(k); Vc[o] = (bf16_t)f2bf(v); Rc[o] = (bf16_t)f2bf(rr);
            A0[o] = (bf16_t)f2bf(a0); A1[o] = (bf16_t)f2bf(a1); L0[o] = (bf16_t)f2bf(lg0); L1[o] = (bf16_t)f2bf(lg1);
            if (row < NT) {
                const float km0 = k * (1.f + (a0 - 1.f) * ka0), km1 = k * (1.f + (a1 - 1.f) * ka1);
                const float bon = wave_sum(rr * (km0 + km1) * rk);
                GATE[o] = (bf16_t)f2bf(gt[r]); BV[o] = (bf16_t)f2bf(bon * v);
            }
        }
    }
}


constexpr int ZS_TOKB = 400, ZS_ROWB = 66 * ZS_TOKB, ZS_BYTES = 3 * ZS_ROWB;
constexpr int XS_OFF = ZS_BYTES, XS_ARR = 64 * 144, XSG_OFF = XS_OFF + 4 * XS_ARR, XSG_PITCH = 272, BON_OFF = XSG_OFF + 64 * XSG_PITCH;
static_assert(BON_OFF + 64 * 4 * 4 <= LDS_MISC, "prep LDS");
struct PrepLd { u32x4 zv[9]; u32x4 hv; u32x4 xv[6]; };
DI void prep_issue(PrepLd& L, const bf16_t* Z, int item, int tidv) {
    const int h = item & 7, ck = item >> 3; const bool lat = ck < 512;
    const int b = lat ? ck >> 7 : (ck - 512) >> 2, c = lat ? ck & 127 : (ck - 512) & 3;
    const int rowbase = lat ? b * SEQ + c * 64 : NT + b * CTXL + c * 64;
    const int q8 = tidv & 7, tsl = tidv >> 3;
    const bf16_t* zc = Z + (size_t)(rowbase + tsl) * DINP + 64 * h + 8 * q8;
#pragma unroll
    for (int rr = 0; rr < 3; ++rr) {
        const bool ok = lat ? (c + rr - 1 >= 0 && c + rr - 1 < 128) : (rr == 1);
        const bf16_t* zr = ok ? zc + (long)(rr - 1) * 64 * DINP : zc;
#pragma unroll
        for (int sec = 0; sec < 3; ++sec) { const u32x4 v = *(const u32x4*)(zr + sec * 512); L.zv[rr * 3 + sec] = ok ? v : (u32x4){0u, 0u, 0u, 0u}; }
    }
    {
      const int hq8 = tidv & 7, hsec = (tidv >> 3) % 3, hside = (tidv >> 3) / 3 & 1, hrr = (tidv >> 3) / 6;
      const int tx = c * 64 + (hside ? 64 : -1);
      const bool ok = !lat && tidv < 144 && hrr == 1 && tx >= 0 && tx < CTXL;
      const size_t off = ok ? (size_t)(NT + b * CTXL + tx) * DINP + hsec * 512 + 64 * h + 8 * hq8 : 0;
      const u32x4 v = *(const u32x4*)(Z + off); L.hv = ok ? v : (u32x4){0u, 0u, 0u, 0u}; }
    const bf16_t* zx = Z + (size_t)(rowbase + tsl) * DINP + OFF_WD + 8 * q8;
#pragma unroll
    for (int it = 0; it < 6; ++it) L.xv[it] = *(const u32x4*)(zx + 64 * it);
}
DI void phase_prep2(const Params& p, const Ctx& F) {
    const bf16_t* Z = (const bf16_t*)(p.ws + WS_Z);
    bf16_t* Kc = (bf16_t*)(p.ws + WS_KC); bf16_t* Vc = (bf16_t*)(p.ws + WS_VC); bf16_t* Rc = (bf16_t*)(p.ws + WS_RC);
    bf16_t* A0 = (bf16_t*)(p.ws + WS_A0); bf16_t* A1 = (bf16_t*)(p.ws + WS_A1); bf16_t* L0 = (bf16_t*)(p.ws + WS_L0); bf16_t* L1 = (bf16_t*)(p.ws + WS_L1);
    bf16_t* GATE = (bf16_t*)((unsigned char*)p.out + DO_GATE); bf16_t* BV = (bf16_t*)((unsigned char*)p.out + DO_BV);
    const bf16_t* DupT = (const bf16_t*)(p.ws + WS_DUPT); const bf16_t* AupT = (const bf16_t*)(p.ws + WS_AUPT); const bf16_t* GupT = (const bf16_t*)(p.ws + WS_GUPT);
    const float* cw2 = (const float*)(p.ws + WS_CONVW);
    LAS unsigned char* ZS = F.lds; LAS float* BON = (LAS float*)(F.lds + BON_OFF);
    const int w = F.wave, fr0 = F.lane & 15, fq0 = F.lane >> 4, ct = w >> 1, tt0 = 2 * (w & 1);
    constexpr int NITEM = 528 * 8;
    PrepLd L;
    if (F.bid < NITEM) prep_issue(L, Z, F.bid, F.tid);
    for (int item = F.bid; item < NITEM; item += F.G) {
        const int h = item & 7, ck = item >> 3;
        const bool lat = ck < 512;
        const int b = lat ? ck >> 7 : (ck - 512) >> 2, c = lat ? ck & 127 : (ck - 512) & 3;
        const int rowbase = lat ? b * SEQ + c * 64 : NT + b * CTXL + c * 64;
        int tidv = F.tid, fr = fr0, fq = fq0; asm volatile("" : "+v"(tidv), "+v"(fr), "+v"(fq));
        __syncthreads();
        { const int q8 = tidv & 7, tsl = tidv >> 3;
#pragma unroll
          for (int rr = 0; rr < 3; ++rr)
#pragma unroll
              for (int sec = 0; sec < 3; ++sec) *(LAS u32x4*)(ZS + rr * ZS_ROWB + (tsl + 1) * ZS_TOKB + sec * 128 + q8 * 16) = L.zv[rr * 3 + sec];
          if (tidv < 144) { const int hsec = (tidv >> 3) % 3, hside = (tidv >> 3) / 3 & 1, hrr = (tidv >> 3) / 6;
              *(LAS u32x4*)(ZS + hrr * ZS_ROWB + (hside ? 65 : 0) * ZS_TOKB + hsec * 128 + q8 * 16) = L.hv; }
#pragma unroll
          for (int it = 0; it < 6; ++it) {
              float f[8];
#pragma unroll
              for (int j = 0; j < 4; ++j) { f[2 * j] = bflo(L.xv[it][j]); f[2 * j + 1] = bfhi(L.xv[it][j]); }
              if (it < 2) {
#pragma unroll
                  for (int j = 0; j < 8; ++j) f[j] = tanh_fast(f[j]);
              } else if (it >= 4) {
#pragma unroll
                  for (int j = 0; j < 8; ++j) f[j] = sigmoidf_(f[j]);
              }
              const u32x4 o = (u32x4){pk2(f[0], f[1]), pk2(f[2], f[3]), pk2(f[4], f[5]), pk2(f[6], f[7])};
              if (it < 4) *(LAS u32x4*)(F.lds + XS_OFF + it * XS_ARR + tsl * 144 + q8 * 16) = o;
              else *(LAS u32x4*)(F.lds + XSG_OFF + tsl * XSG_PITCH + ((it - 4) * 8 + q8) * 16) = o; } }
        if (item + F.G < NITEM) prep_issue(L, Z, item + F.G, tidv);
        const int chrow = 64 * h + 16 * ct + fr;
        const int gch = 64 * h + 16 * ct + 4 * fq;
        bf16x8 wf[4][2], gf[4];
#pragma unroll
        for (int q = 0; q < 4; ++q) { const bf16_t* WT = (q < 2 ? DupT : AupT) + ((size_t)(q & 1) * 512 + chrow) * 64;
#pragma unroll
            for (int s2 = 0; s2 < 2; ++s2) wf[q][s2] = *(const bf16x8*)(WT + 32 * s2 + 8 * fq); }
#pragma unroll
        for (int s2 = 0; s2 < 4; ++s2) gf[s2] = *(const bf16x8*)(GupT + (size_t)chrow * 128 + 32 * s2 + 8 * fq);
        const f32x4 w00 = *(const f32x4*)(p.in[I_DW0] + gch), w01 = *(const f32x4*)(p.in[I_DW0] + 512 + gch), a00 = *(const f32x4*)(p.in[I_A0] + gch), a01 = *(const f32x4*)(p.in[I_A0] + 512 + gch);
        const f32x4 ka0 = *(const f32x4*)(p.in[I_KA] + gch), ka1 = *(const f32x4*)(p.in[I_KA] + 512 + gch), rk = *(const f32x4*)(p.in[I_RK] + gch);
        const float* cwl = cw2 + (gch >> 2) * 108;
        __syncthreads();
        f32x4 vkeep[2];
#pragma unroll 1
        for (int t2 = 0; t2 < 2; ++t2) {
            const int tok = 16 * (tt0 + t2) + fr;
            f32x4 acc[5];
#pragma unroll
            for (int q = 0; q < 5; ++q) acc[q] = (f32x4){0.f, 0.f, 0.f, 0.f};
#pragma unroll
            for (int q = 0; q < 4; ++q) {
#pragma unroll
                for (int s2 = 0; s2 < 2; ++s2) { const bf16x8 bfr = *(const LAS bf16x8*)(F.lds + XS_OFF + q * XS_ARR + tok * 144 + (32 * s2 + 8 * fq) * 2);
                    acc[q] = __builtin_amdgcn_mfma_f32_16x16x32_bf16(wf[q][s2], bfr, acc[q], 0, 0, 0); }
            }
#pragma unroll
            for (int s2 = 0; s2 < 4; ++s2) { const bf16x8 bfr = *(const LAS bf16x8*)(F.lds + XSG_OFF + tok * XSG_PITCH + (32 * s2 + 8 * fq) * 2);
                acc[4] = __builtin_amdgcn_mfma_f32_16x16x32_bf16(gf[s2], bfr, acc[4], 0, 0, 0); }
            f32x4 cv[3];
#pragma unroll
            for (int s3 = 0; s3 < 3; ++s3) cv[s3] = (f32x4){0.f, 0.f, 0.f, 0.f};
#pragma unroll
            for (int dy = 0; dy < 3; ++dy)
#pragma unroll
                for (int dx = 0; dx < 3; ++dx) {
#pragma unroll
                    for (int s3 = 0; s3 < 3; ++s3) { const f32x4 wv = *(const f32x4*)(cwl + ((dy * 3 + dx) * 3 + s3) * 4);
                        const u32x2 zz = *(const LAS u32x2*)(ZS + dy * ZS_ROWB + (tok + dx) * ZS_TOKB + s3 * 128 + (16 * ct + 4 * fq) * 2);
                        cv[s3] += (f32x4){bflo(zz.x), bfhi(zz.x), bflo(zz.y), bfhi(zz.y)} * wv; }
                }
            const size_t o = (size_t)(rowbase + tok) * 512 + gch;
            float lg0[4], lg1[4], a0[4], a1[4]; float bs = 0.f;
#pragma unroll
            for (int i = 0; i < 4; ++i) { const float wl0 = w00[i] + acc[0][i], wl1 = w01[i] + acc[1][i];
                lg0[i] = -__expf(-softplusf_(-wl0) - 0.5f); lg1[i] = -__expf(-softplusf_(-wl1) - 0.5f);
                a0[i] = sigmoidf_(a00[i] + acc[2][i]); a1[i] = sigmoidf_(a01[i] + acc[3][i]);
                const float k = cv[0][i]; const float km0 = k * (1.f + (a0[i] - 1.f) * ka0[i]), km1 = k * (1.f + (a1[i] - 1.f) * ka1[i]);
                bs += cv[2][i] * (km0 + km1) * rk[i]; }
            bs += __shfl_xor(bs, 16); bs += __shfl_xor(bs, 32);
            u32x2 wv2;
            wv2.x = pk2(cv[0][0], cv[0][1]); wv2.y = pk2(cv[0][2], cv[0][3]); *(u32x2*)(Kc + o) = wv2;
            wv2.x = pk2(cv[1][0], cv[1][1]); wv2.y = pk2(cv[1][2], cv[1][3]); *(u32x2*)(Vc + o) = wv2;
            wv2.x = pk2(cv[2][0], cv[2][1]); wv2.y = pk2(cv[2][2], cv[2][3]); *(u32x2*)(Rc + o) = wv2;
            wv2.x = pk2(a0[0], a0[1]); wv2.y = pk2(a0[2], a0[3]); *(u32x2*)(A0 + o) = wv2;
            wv2.x = pk2(a1[0], a1[1]); wv2.y = pk2(a1[2], a1[3]); *(u32x2*)(A1 + o) = wv2;
            wv2.x = pk2(lg0[0], lg0[1]); wv2.y = pk2(lg0[2], lg0[3]); *(u32x2*)(L0 + o) = wv2;
            wv2.x = pk2(lg1[0], lg1[1]); wv2.y = pk2(lg1[2], lg1[3]); *(u32x2*)(L1 + o) = wv2;
            if (lat) { wv2.x = pk2(acc[4][0], acc[4][1]); wv2.y = pk2(acc[4][2], acc[4][3]); *(u32x2*)(GATE + o) = wv2; }
            if (fq == 0) BON[tok * 4 + ct] = bs;
            if (t2 == 0) vkeep[0] = cv[1]; else vkeep[1] = cv[1];
        }
        __syncthreads();
        if (lat) {
#pragma unroll
            for (int t2 = 0; t2 < 2; ++t2) { const int tok = 16 * (tt0 + t2) + fr; const f32x4 bq = *(const LAS f32x4*)(BON + tok * 4); const float bon = (bq[0] + bq[1]) + (bq[2] + bq[3]);
                const size_t o = (size_t)(rowbase + tok) * 512 + gch;
                u32x2 wv2; wv2.x = pk2(bon * vkeep[t2][0], bon * vkeep[t2][1]); wv2.y = pk2(bon * vkeep[t2][2], bon * vkeep[t2][3]); *(u32x2*)(BV + o) = wv2; }
        }
    }
}

DI void phase_gmlp(const Params& p, const Ctx& F) {
    const bf16_t* Z = (const bf16_t*)(p.ws + WS_Z); const bf16_t* Wsp = (const bf16_t*)(p.ws + WS_WSP);
    bf16_t* MIXED = (bf16_t*)((unsigned char*)p.out + DO_MIXED);
    constexpr int LDV = 136;
    LAS bf16_t* vnT = (LAS bf16_t*)F.lds;
    LAS float* gu = (LAS float*)(F.lds + 17408);
    constexpr int LDG = 68;
    const int fr = F.lane & 15, fq = F.lane >> 4;
    for (int un = F.bid; un < 4 * 64 * 8; un += F.G) {
        const int g = un & 7, cc = (un >> 3) & 63, b = un >> 9;
        const size_t tok0 = (size_t)b * SEQ + cc * 128;
        __syncthreads();
        { const int pq = F.tid >> 2, seg = F.tid & 3;
          const bf16_t* zr = Z + (tok0 + pq) * DINP;
          const u32x4 ua = *(const u32x4*)(zr + OFF_U + 64 * g + 16 * seg), ub = *(const u32x4*)(zr + OFF_U + 64 * g + 16 * seg + 8);
          const u32x4 va = *(const u32x4*)(zr + OFF_VA + 64 * g + 16 * seg), vb = *(const u32x4*)(zr + OFF_VA + 64 * g + 16 * seg + 8);
          float u[16], v[16];
#pragma unroll
          for (int j = 0; j < 4; ++j) { u[2 * j] = bflo(ua[j]); u[2 * j + 1] = bfhi(ua[j]); u[8 + 2 * j] = bflo(ub[j]); u[8 + 2 * j + 1] = bfhi(ub[j]);
              v[2 * j] = bflo(va[j]); v[2 * j + 1] = bfhi(va[j]); v[8 + 2 * j] = bflo(vb[j]); v[8 + 2 * j + 1] = bfhi(vb[j]); }
          float s = 0.f;
#pragma unroll
          for (int j = 0; j < 16; ++j) { u[j] = gelu_tanh(u[j]); v[j] = gelu_tanh(v[j]); s += v[j]; }
          s += __shfl_xor(s, 1); s += __shfl_xor(s, 2);
          const float mu = s * (1.f / 64.f); float q = 0.f;
#pragma unroll
          for (int j = 0; j < 16; ++j) { v[j] -= mu; q += v[j] * v[j]; }
          q += __shfl_xor(q, 1); q += __shfl_xor(q, 2);
          const float rstd = 1.f / sqrtf(q * (1.f / 64.f) + 1e-5f);
#pragma unroll
          for (int j = 0; j < 16; ++j) { const int ch = 16 * seg + j; const float vn = v[j] * rstd * p.in[I_GMLNG][64 * g + ch] + p.in[I_GMLNB][64 * g + ch];
              vnT[ch * LDV + pq] = (bf16_t)f2bf(vn); gu[pq * LDG + ch] = u[j]; }
        }
        __syncthreads();
        f32x4 acc[4];
#pragma unroll
        for (int n = 0; n < 4; ++n) acc[n] = (f32x4){0.f, 0.f, 0.f, 0.f};
        const int pp = 16 * F.wave + fr;
#pragma unroll
        for (int s = 0; s < 4; ++s) {
            const bf16x8 bfrag = *(const bf16x8*)(Wsp + ((size_t)(g * 128 + pp)) * 128 + 32 * s + 8 * fq);
#pragma unroll
            for (int n = 0; n < 4; ++n) { const bf16x8 afrag = *(const LAS bf16x8*)(vnT + (16 * n + fr) * LDV + 32 * s + 8 * fq);
                acc[n] = __builtin_amdgcn_mfma_f32_16x16x32_bf16(afrag, bfrag, acc[n], 0, 0, 0); }
        }
        const float bs = p.in[I_BSP][g * 128 + pp];
#pragma unroll
        for (int n = 0; n < 4; ++n) { const int d0 = 16 * n + 4 * fq; const f32x4 gv = *(const LAS f32x4*)(gu + pp * LDG + d0);
            const f32x4 o = gv * (acc[n] + bs);
            u32x2 w; w.x = pk2(o[0], o[1]); w.y = pk2(o[2], o[3]);
            *(u32x2*)(MIXED + (tok0 + pp) * D + 64 * g + d0) = w; }
    }
}

DI void phase_scan_seq(const Params& p, const Ctx& F) {
    const bf16_t* Kc = (const bf16_t*)(p.ws + WS_KC); const bf16_t* Vc = (const bf16_t*)(p.ws + WS_VC); const bf16_t* Rc = (const bf16_t*)(p.ws + WS_RC);
    float* YS = (float*)(p.ws + WS_YS);
    const int vrow = F.tid >> 3, q = F.tid & 7;
    for (int ch = F.bid; ch < 64; ch += F.G) {
        const int d = ch & 1, h = (ch >> 1) & 7, b = ch >> 4;
        const bf16_t* Ad = (const bf16_t*)(p.ws + (d ? WS_A1 : WS_A0)); const bf16_t* Ld = (const bf16_t*)(p.ws + (d ? WS_L1 : WS_L0));
        float kkw[8], kaw[8];
#pragma unroll
        for (int j = 0; j < 8; ++j) { kkw[j] = p.in[I_KK][64 * h + 8 * q + j]; kaw[j] = p.in[I_KA][d * 512 + 64 * h + 8 * q + j]; }
        float S[8];
#pragma unroll
        for (int j = 0; j < 8; ++j) S[j] = 0.f;
        const int TOT = CTXL + SEQ;
        for (int step = 0; step < TOT; ++step) {
            size_t row;
            if (step < CTXL) { const int tc = d ? (CTXL - 1 - step) : step; row = (size_t)NT + b * CTXL + tc; }
            else { const int tl = d ? (SEQ - 1 - (step - CTXL)) : (step - CTXL); row = (size_t)b * SEQ + tl; }
            const size_t o = row * 512 + 64 * h + 8 * q;
            const u32x4 kq = *(const u32x4*)(Kc + o), rq = *(const u32x4*)(Rc + o), aq = *(const u32x4*)(Ad + o), lq = *(const u32x4*)(Ld + o);
            const float vv = bf2f(Vc[row * 512 + 64 * h + vrow]);
            float k[8], r[8], a[8], l[8];
#pragma unroll
            for (int j = 0; j < 4; ++j) { k[2 * j] = bflo(kq[j]); k[2 * j + 1] = bfhi(kq[j]); r[2 * j] = bflo(rq[j]); r[2 * j + 1] = bfhi(rq[j]);
                a[2 * j] = bflo(aq[j]); a[2 * j + 1] = bfhi(aq[j]); l[2 * j] = bflo(lq[j]); l[2 * j + 1] = bfhi(lq[j]); }
            float kk[8], ss = 0.f;
#pragma unroll
            for (int j = 0; j < 8; ++j) { kk[j] = k[j] * kkw[j]; ss += kk[j] * kk[j]; }
            ss += __shfl_xor(ss, 1); ss += __shfl_xor(ss, 2); ss += __shfl_xor(ss, 4);
            const float rn = 1.f / sqrtf(fmaxf(ss, 1e-24f));
            float dot = 0.f;
#pragma unroll
            for (int j = 0; j < 8; ++j) { kk[j] *= rn; dot += S[j] * kk[j]; }
            dot += __shfl_xor(dot, 1); dot += __shfl_xor(dot, 2); dot += __shfl_xor(dot, 4);
            float y = 0.f;
#pragma unroll
            for (int j = 0; j < 8; ++j) { const float w = __expf(l[j]); const float km = k[j] * (1.f + (a[j] - 1.f) * kaw[j]);
                S[j] = S[j] * w - dot * (kk[j] * a[j]) + vv * km; y += S[j] * r[j]; }
            y += __shfl_xor(y, 1); y += __shfl_xor(y, 2); y += __shfl_xor(y, 4);
            if (step >= CTXL && q == 0) YS[((size_t)d * NT + row) * 512 + 64 * h + vrow] = y;
        }
    }
}


constexpr int LDP = 72;
constexpr int SLOTB = 64 * LDP * 2;
constexpr int CP_CUM = 12 * SLOTB, CP_TOT = CP_CUM + 16384, CP_ADIAG = CP_TOT + 2048, CP_GC = CP_ADIAG + 4096;

DI void mm64(f32x4 (&acc)[2], const LAS bf16_t* P, const LAS bf16_t* Q, int r0, int c0, int fr, int fq) {
#pragma unroll
    for (int s = 0; s < 2; ++s) { const bf16x8 b = *(const LAS bf16x8*)(Q + (c0 + fr) * LDP + 32 * s + 8 * fq);
#pragma unroll
        for (int m = 0; m < 2; ++m) { const bf16x8 a = *(const LAS bf16x8*)(P + (r0 + 16 * m + fr) * LDP + 32 * s + 8 * fq);
            acc[m] = __builtin_amdgcn_mfma_f32_16x16x32_bf16(a, b, acc[m], 0, 0, 0); } }
}
DI void zero2(f32x4 (&a)[2]) { a[0] = (f32x4){0.f, 0.f, 0.f, 0.f}; a[1] = a[0]; }
DI void writeT(LAS bf16_t* dst, const f32x4 (&acc)[2], int r0, int c0, int fr, int fq) {
#pragma unroll
    for (int m = 0; m < 2; ++m) { u32x2 w; w.x = pk2(acc[m][0], acc[m][1]); w.y = pk2(acc[m][2], acc[m][3]); *(LAS u32x2*)(dst + (c0 + fr) * LDP + r0 + 16 * m + 4 * fq) = w; }
}
DI void writeN(LAS bf16_t* dst, const f32x4 (&acc)[2], int r0, int c0, int fr, int fq) {
#pragma unroll
    for (int m = 0; m < 2; ++m)
#pragma unroll
        for (int i = 0; i < 4; ++i) dst[(r0 + 16 * m + 4 * fq + i) * LDP + c0 + fr] = (bf16_t)f2bf(acc[m][i]);
}
DI size_t chunk_row(int d, int b, int pc, int pp) {
    const int base = pc < 4 ? NT + b * CTXL : b * SEQ, len = pc < 4 ? CTXL : SEQ, q = 64 * (pc < 4 ? pc : pc - 4) + pp;
    return (size_t)(d ? base + len - 1 - q : base + q);
}

DI void phase_chunkprep(const Params& p, const Ctx& F) {
    const bf16_t* Kc = (const bf16_t*)(p.ws + WS_KC); const bf16_t* Vc = (const bf16_t*)(p.ws + WS_VC); const bf16_t* Rc = (const bf16_t*)(p.ws + WS_RC);
    unsigned char* OPS = p.ws + WS_OPS;
    LAS bf16_t* SL[12];
#pragma unroll
    for (int i = 0; i < 12; ++i) SL[i] = (LAS bf16_t*)(F.lds + i * SLOTB);
    LAS float* CUM = (LAS float*)(F.lds + CP_CUM); LAS float* TOT = (LAS float*)(F.lds + CP_TOT); LAS float* ADIAG = (LAS float*)(F.lds + CP_ADIAG); LAS float* GC = (LAS float*)(F.lds + CP_GC);
    const int w = F.wave, fr = F.lane & 15, fq = F.lane >> 4, r0 = 32 * (w >> 2), c0 = 16 * (w & 3);
    const int pp = F.tid >> 3, cg8 = F.tid & 7;
    for (int unit = F.bid; unit < 2 * 32 * 132; unit += F.G) {
        const int d = unit / (32 * 132), chain = (unit / 132) & 31, pc = unit % 132, b = chain >> 3, h = chain & 7;
        const bf16_t* Ad = (const bf16_t*)(p.ws + (d ? WS_A1 : WS_A0)); const bf16_t* Ld = (const bf16_t*)(p.ws + (d ? WS_L1 : WS_L0));
        __syncthreads();
        float kk[8], km[8], ka[8], vv[8], rr[8], ll[8];
        { const size_t o = chunk_row(d, b, pc, pp) * 512 + 64 * h + 8 * cg8;
          const u32x4 kq = *(const u32x4*)(Kc + o), vq = *(const u32x4*)(Vc + o), rq = *(const u32x4*)(Rc + o), aq = *(const u32x4*)(Ad + o), lq = *(const u32x4*)(Ld + o);
          float k[8], a[8]; float ss = 0.f;
#pragma unroll
          for (int j = 0; j < 4; ++j) { k[2 * j] = bflo(kq[j]); k[2 * j + 1] = bfhi(kq[j]); vv[2 * j] = bflo(vq[j]); vv[2 * j + 1] = bfhi(vq[j]); rr[2 * j] = bflo(rq[j]); rr[2 * j + 1] = bfhi(rq[j]);
              a[2 * j] = bflo(aq[j]); a[2 * j + 1] = bfhi(aq[j]); ll[2 * j] = bflo(lq[j]); ll[2 * j + 1] = bfhi(lq[j]); }
#pragma unroll
          for (int j = 0; j < 8; ++j) { kk[j] = k[j] * p.in[I_KK][64 * h + 8 * cg8 + j]; ss += kk[j] * kk[j]; }
          ss += __shfl_xor(ss, 1); ss += __shfl_xor(ss, 2); ss += __shfl_xor(ss, 4);
          const float rn = 1.f / sqrtf(fmaxf(ss, 1e-24f));
#pragma unroll
          for (int j = 0; j < 8; ++j) { kk[j] *= rn; km[j] = k[j] * (1.f + (a[j] - 1.f) * p.in[I_KA][d * 512 + 64 * h + 8 * cg8 + j]); ka[j] = kk[j] * a[j]; }
          *(LAS f32x4*)(CUM + pp * 64 + 8 * cg8) = (f32x4){ll[0], ll[1], ll[2], ll[3]}; *(LAS f32x4*)(CUM + pp * 64 + 8 * cg8 + 4) = (f32x4){ll[4], ll[5], ll[6], ll[7]}; }
        for (int i = F.tid; i < 2 * SLOTB / 4; i += NTHREADS) ((LAS unsigned*)(F.lds + 9 * SLOTB))[i] = 0u;
        __syncthreads();
        { const int ch = F.tid & 63, seg = F.tid >> 6; float run = 0.f;
#pragma unroll
          for (int i = 0; i < 8; ++i) { run += CUM[(8 * seg + i) * 64 + ch]; CUM[(8 * seg + i) * 64 + ch] = run; }
          TOT[seg * 64 + ch] = run; }
        __syncthreads();
        { const int ch = F.tid & 63, seg = F.tid >> 6; float off = 0.f;
          for (int s2 = 0; s2 < seg; ++s2) off += TOT[s2 * 64 + ch];
#pragma unroll
          for (int i = 0; i < 8; ++i) CUM[(8 * seg + i) * 64 + ch] += off;
          if (seg == 7) GC[ch] = off + TOT[7 * 64 + ch]; }
        __syncthreads();
        { float g[8], gc[8];
          { const f32x4 g0 = *(const LAS f32x4*)(CUM + pp * 64 + 8 * cg8), g1 = *(const LAS f32x4*)(CUM + pp * 64 + 8 * cg8 + 4);
            const f32x4 c0v = *(const LAS f32x4*)(GC + 8 * cg8), c1v = *(const LAS f32x4*)(GC + 8 * cg8 + 4);
#pragma unroll
            for (int j = 0; j < 4; ++j) { g[j] = g0[j]; g[4 + j] = g1[j]; gc[j] = c0v[j]; gc[4 + j] = c1v[j]; } }
          float kkg[8], rg[8], ki[8], kai[8], kd[8], kad[8];
#pragma unroll
          for (int j = 0; j < 8; ++j) { const float eg = __expf(g[j]), egp = __expf(g[j] - ll[j]), eng = __expf(-g[j]), ecg = __expf(gc[j] - g[j]);
              kkg[j] = kk[j] * egp; rg[j] = rr[j] * eg; ki[j] = km[j] * eng; kai[j] = ka[j] * eng; kd[j] = km[j] * ecg; kad[j] = ka[j] * ecg; }
          u32x4 w4;
          w4 = (u32x4){pk2(kkg[0], kkg[1]), pk2(kkg[2], kkg[3]), pk2(kkg[4], kkg[5]), pk2(kkg[6], kkg[7])}; *(LAS u32x4*)(SL[0] + pp * LDP + 8 * cg8) = w4;
          w4 = (u32x4){pk2(rg[0], rg[1]), pk2(rg[2], rg[3]), pk2(rg[4], rg[5]), pk2(rg[6], rg[7])}; *(LAS u32x4*)(SL[1] + pp * LDP + 8 * cg8) = w4;
          w4 = (u32x4){pk2(ki[0], ki[1]), pk2(ki[2], ki[3]), pk2(ki[4], ki[5]), pk2(ki[6], ki[7])}; *(LAS u32x4*)(SL[2] + pp * LDP + 8 * cg8) = w4;
          w4 = (u32x4){pk2(kai[0], kai[1]), pk2(kai[2], kai[3]), pk2(kai[4], kai[5]), pk2(kai[6], kai[7])}; *(LAS u32x4*)(SL[3] + pp * LDP + 8 * cg8) = w4;
#pragma unroll
          for (int j = 0; j < 8; ++j) { const int ch = 8 * cg8 + j;
              SL[4][ch * LDP + pp] = (bf16_t)f2bf(kkg[j]); SL[5][ch * LDP + pp] = (bf16_t)f2bf(vv[j]); SL[6][ch * LDP + pp] = (bf16_t)f2bf(kd[j]); SL[7][ch * LDP + pp] = (bf16_t)f2bf(kad[j]); } }
        __syncthreads();
        { f32x4 aAk[2], aAa[2], aBk[2], aBa[2]; zero2(aAk); zero2(aAa); zero2(aBk); zero2(aBa);
          mm64(aAk, SL[2], SL[0], r0, c0, fr, fq);
          mm64(aAa, SL[0], SL[3], r0, c0, fr, fq);
          mm64(aBk, SL[2], SL[1], r0, c0, fr, fq);
          mm64(aBa, SL[3], SL[1], r0, c0, fr, fq);
          __syncthreads();
          const int tcol = c0 + fr;
#pragma unroll
          for (int m = 0; m < 2; ++m)
#pragma unroll
              for (int i = 0; i < 4; ++i) { const int jr = r0 + 16 * m + 4 * fq + i;
                  aAk[m][i] = jr < tcol ? aAk[m][i] : 0.f; aBk[m][i] = jr <= tcol ? aBk[m][i] : 0.f; aBa[m][i] = jr <= tcol ? aBa[m][i] : 0.f; }
          writeT(SL[0], aAk, r0, c0, fr, fq); writeT(SL[8], aBk, r0, c0, fr, fq); writeT(SL[2], aBa, r0, c0, fr, fq);
          const int jb = w & 3;
#pragma unroll
          for (int m = 0; m < 2; ++m) { const int tb = 2 * (w >> 2) + m;
              if (tb == jb) {
#pragma unroll
                  for (int i = 0; i < 4; ++i) ADIAG[tb * 256 + (4 * fq + i) * 16 + fr] = (fr < 4 * fq + i) ? aAa[m][i] : 0.f; }
#pragma unroll
              for (int i = 0; i < 4; ++i) aAa[m][i] = tb > jb ? aAa[m][i] : 0.f; }
          writeT(SL[3], aAa, r0, c0, fr, fq);
        }
        __syncthreads();
        if (F.tid < 64) { const int blk = F.tid >> 4, c = F.tid & 15; const LAS float* A = ADIAG + blk * 256; float x[16];
#pragma unroll
            for (int r = 0; r < 16; ++r) { float sa = (r == c) ? 1.f : 0.f;
#pragma unroll
                for (int j = 0; j < r; ++j) sa -= A[r * 16 + j] * x[j];
                x[r] = sa; }
#pragma unroll
            for (int r = 0; r < 16; ++r) SL[9][(16 * blk + r) * LDP + 16 * blk + c] = (bf16_t)f2bf(x[r]);
            u32x4 lo = (u32x4){pk2(x[0], x[1]), pk2(x[2], x[3]), pk2(x[4], x[5]), pk2(x[6], x[7])}, hi = (u32x4){pk2(x[8], x[9]), pk2(x[10], x[11]), pk2(x[12], x[13]), pk2(x[14], x[15])};
            *(LAS u32x4*)(SL[10] + (16 * blk + c) * LDP + 16 * blk) = lo; *(LAS u32x4*)(SL[10] + (16 * blk + c) * LDP + 16 * blk + 8) = hi; }
        __syncthreads();
        f32x4 a1[2], a2[2], a3[2];
        zero2(a1); mm64(a1, SL[3], SL[9], r0, c0, fr, fq);
        __syncthreads();
        writeT(SL[11], a1, r0, c0, fr, fq);
        writeN(SL[3], a1, r0, c0, fr, fq);
        __syncthreads();
        zero2(a2); mm64(a2, SL[11], SL[3], r0, c0, fr, fq);
#pragma unroll
        for (int m = 0; m < 2; ++m)
#pragma unroll
            for (int i = 0; i < 4; ++i) a2[m][i] += (r0 + 16 * m + 4 * fq + i == c0 + fr) ? 1.f : 0.f;
        writeT(SL[9], a2, r0, c0, fr, fq);
        __syncthreads();
        zero2(a3); mm64(a3, SL[11], SL[9], r0, c0, fr, fq);
        a3[0] = a2[0] - a3[0]; a3[1] = a2[1] - a3[1];
        writeN(SL[3], a3, r0, c0, fr, fq);
        __syncthreads();
        zero2(a1); mm64(a1, SL[3], SL[10], r0, c0, fr, fq);
        zero2(a2); mm64(a2, SL[0], SL[5], r0, c0, fr, fq);
        writeN(SL[9], a1, r0, c0, fr, fq); writeT(SL[11], a2, r0, c0, fr, fq);
        __syncthreads();
        zero2(a1); mm64(a1, SL[9], SL[4], r0, c0, fr, fq);
        zero2(a2); mm64(a2, SL[9], SL[11], r0, c0, fr, fq);
        writeT(SL[3], a1, r0, c0, fr, fq); writeT(SL[10], a2, r0, c0, fr, fq);
        __syncthreads();
        unsigned char* ob = OPS + ((size_t)(d * 32 + chain) * 132 + pc) * 32768;
        const int fragoff = (((w & 3) * 2 + (w >> 2)) * 64 + F.lane) * 16;
        {
          zero2(a1); mm64(a1, SL[3], SL[2], r0, c0, fr, fq);
          u32x4 o;
#pragma unroll
          for (int m = 0; m < 2; ++m) { const u32x2 rgv = *(const LAS u32x2*)(SL[1] + (c0 + fr) * LDP + r0 + 16 * m + 4 * fq);
              const float q0 = bflo(rgv.x) - a1[m][0], q1 = bfhi(rgv.x) - a1[m][1], q2 = bflo(rgv.y) - a1[m][2], q3 = bfhi(rgv.y) - a1[m][3];
              o[2 * m] = pk2(q0, q1); o[2 * m + 1] = pk2(q2, q3); }
          *(u32x4*)(ob + fragoff) = o; }
        {
          zero2(a1); mm64(a1, SL[3], SL[7], r0, c0, fr, fq);
          const float gcv = __expf(GC[c0 + fr]); u32x4 o;
#pragma unroll
          for (int m = 0; m < 2; ++m) { float q[4];
#pragma unroll
              for (int i = 0; i < 4; ++i) q[i] = ((r0 + 16 * m + 4 * fq + i == c0 + fr) ? gcv : 0.f) - a1[m][i];
              o[2 * m] = pk2(q[0], q[1]); o[2 * m + 1] = pk2(q[2], q[3]); }
          *(u32x4*)(ob + 8192 + fragoff) = o; }
        {
          zero2(a1); mm64(a1, SL[8], SL[5], r0, c0, fr, fq); zero2(a2); mm64(a2, SL[2], SL[10], r0, c0, fr, fq);
#pragma unroll
          for (int m = 0; m < 2; ++m) { const f32x4 q = a1[m] - a2[m]; u32x2 o; o.x = pk2(q[0], q[1]); o.y = pk2(q[2], q[3]);
              *(u32x2*)(ob + 16384 + (((w & 3) * 4 + 2 * (w >> 2) + m) * 64 + F.lane) * 8) = o; } }
        {
          zero2(a1); mm64(a1, SL[6], SL[5], r0, c0, fr, fq); zero2(a2); mm64(a2, SL[7], SL[10], r0, c0, fr, fq);
#pragma unroll
          for (int m = 0; m < 2; ++m) { const f32x4 q = a1[m] - a2[m]; u32x2 o; o.x = pk2(q[0], q[1]); o.y = pk2(q[2], q[3]);
              *(u32x2*)(ob + 24576 + (((w & 3) * 4 + 2 * (w >> 2) + m) * 64 + F.lane) * 8) = o; } }
    }
}

DI void phase_scan_chunk(const Params& p, const Ctx& F) {
    if (F.wave != 0) return;
    unsigned char* OPS = p.ws + WS_OPS;
    for (int item = F.bid; item < 256; item += F.G) {
        const int d = item >> 7, chain = (item >> 2) & 31, w4 = item & 3;
        unsigned char* ops = OPS + (size_t)(d * 32 + chain) * 132 * 32768;
        f32x4 H[4];
#pragma unroll
        for (int m = 0; m < 4; ++m) H[m] = (f32x4){0.f, 0.f, 0.f, 0.f};
        bf16x8 qa[4][2], ma[4][2]; u32x2 y0[4], bc[4];
#pragma unroll
        for (int m = 0; m < 4; ++m) {
#pragma unroll
            for (int s = 0; s < 2; ++s) { qa[m][s] = *(const bf16x8*)(ops + ((m * 2 + s) * 64 + F.lane) * 16); ma[m][s] = *(const bf16x8*)(ops + 8192 + ((m * 2 + s) * 64 + F.lane) * 16); }
            y0[m] = *(const u32x2*)(ops + 16384 + ((w4 * 4 + m) * 64 + F.lane) * 8); bc[m] = *(const u32x2*)(ops + 24576 + ((w4 * 4 + m) * 64 + F.lane) * 8); }
#pragma unroll 1
        for (int pc = 0; pc < 132; ++pc) {
            bf16x8 nqa[4][2], nma[4][2]; u32x2 ny0[4], nbc[4];
            const unsigned char* nx = ops + (size_t)(pc + 1 < 132 ? pc + 1 : pc) * 32768;
#pragma unroll
            for (int m = 0; m < 4; ++m) {
#pragma unroll
                for (int s = 0; s < 2; ++s) { nqa[m][s] = *(const bf16x8*)(nx + ((m * 2 + s) * 64 + F.lane) * 16); nma[m][s] = *(const bf16x8*)(nx + 8192 + ((m * 2 + s) * 64 + F.lane) * 16); }
                ny0[m] = *(const u32x2*)(nx + 16384 + ((w4 * 4 + m) * 64 + F.lane) * 8); nbc[m] = *(const u32x2*)(nx + 24576 + ((w4 * 4 + m) * 64 + F.lane) * 8); }
            bf16x8 hb[2];
#pragma unroll
            for (int s = 0; s < 2; ++s) { u32x4 t; t.x = pk2(H[2 * s][0], H[2 * s][1]); t.y = pk2(H[2 * s][2], H[2 * s][3]); t.z = pk2(H[2 * s + 1][0], H[2 * s + 1][1]); t.w = pk2(H[2 * s + 1][2], H[2 * s + 1][3]);
                hb[s] = __builtin_bit_cast(bf16x8, t); }
#pragma unroll
            for (int m = 0; m < 4; ++m) {
                f32x4 y = (f32x4){bflo(y0[m].x), bfhi(y0[m].x), bflo(y0[m].y), bfhi(y0[m].y)};
                f32x4 hn = (f32x4){bflo(bc[m].x), bfhi(bc[m].x), bflo(bc[m].y), bfhi(bc[m].y)};
#pragma unroll
                for (int s = 0; s < 2; ++s) { y = __builtin_amdgcn_mfma_f32_16x16x32_bf16(qa[m][s], hb[s], y, 0, 0, 0); hn = __builtin_amdgcn_mfma_f32_16x16x32_bf16(ma[m][s], hb[s], hn, 0, 0, 0); }
                if (pc >= 4) { u32x2 o; o.x = pk2(y[0], y[1]); o.y = pk2(y[2], y[3]); *(u32x2*)(ops + (size_t)pc * 32768 + 16384 + ((w4 * 4 + m) * 64 + F.lane) * 8) = o; }
                H[m] = hn;
            }
#pragma unroll
            for (int m = 0; m < 4; ++m) {
#pragma unroll
                for (int s = 0; s < 2; ++s) { qa[m][s] = nqa[m][s]; ma[m][s] = nma[m][s]; }
                y0[m] = ny0[m]; bc[m] = nbc[m]; }
        }
    }
}

DI void phase_post2(const Params& p, const Ctx& F) {
    const unsigned char* OPS = p.ws + WS_OPS;
    const bf16_t* GATE = (const bf16_t*)((unsigned char*)p.out + DO_GATE); const bf16_t* BV = (const bf16_t*)((unsigned char*)p.out + DO_BV);
    bf16_t* MIXED = (bf16_t*)((unsigned char*)p.out + DO_MIXED);
    LAS float* ys = (LAS float*)F.lds;
    constexpr int LDY = 68;
    const int fr = F.lane & 15, fq = F.lane >> 4;
    for (int unit = F.bid; unit < 4 * 128 * 8; unit += F.G) {
        const int h = unit & 7, j = (unit >> 3) & 127, b = unit >> 10, chain = b * 8 + h;
        __syncthreads();
        const int w4 = F.wave & 3;
        const unsigned char* fi = OPS + ((size_t)(0 * 32 + chain) * 132 + 4 + j) * 32768 + 16384; const unsigned char* bi = OPS + ((size_t)(1 * 32 + chain) * 132 + 4 + (127 - j)) * 32768 + 16384;
        u32x2 fv[2], bv2[2];
#pragma unroll
        for (int mm = 0; mm < 2; ++mm) { const int m = 2 * (F.wave >> 2) + mm; fv[mm] = *(const u32x2*)(fi + ((w4 * 4 + m) * 64 + F.lane) * 8); bv2[mm] = *(const u32x2*)(bi + ((w4 * 4 + m) * 64 + F.lane) * 8); }
#pragma unroll
        for (int mm = 0; mm < 2; ++mm) { const int m = 2 * (F.wave >> 2) + mm; const int t0 = 16 * m + 4 * fq, n = 16 * w4 + fr;
            ys[(t0 + 0) * LDY + n] = bflo(fv[mm].x); ys[(t0 + 1) * LDY + n] = bfhi(fv[mm].x); ys[(t0 + 2) * LDY + n] = bflo(fv[mm].y); ys[(t0 + 3) * LDY + n] = bfhi(fv[mm].y); }
        __syncthreads();
#pragma unroll
        for (int mm = 0; mm < 2; ++mm) { const int m = 2 * (F.wave >> 2) + mm; const int t0 = 16 * m + 4 * fq, n = 16 * w4 + fr;
            ys[(63 - t0 - 0) * LDY + n] += bflo(bv2[mm].x); ys[(63 - t0 - 1) * LDY + n] += bfhi(bv2[mm].x); ys[(63 - t0 - 2) * LDY + n] += bflo(bv2[mm].y); ys[(63 - t0 - 3) * LDY + n] += bfhi(bv2[mm].y); }
        __syncthreads();
        { const int tk = F.tid >> 3, cg8 = F.tid & 7; const size_t row = (size_t)b * SEQ + 64 * j + tk;
          const f32x4 ya = *(const LAS f32x4*)(ys + tk * LDY + 8 * cg8), yb = *(const LAS f32x4*)(ys + tk * LDY + 8 * cg8 + 4);
          float y[8] = {ya[0], ya[1], ya[2], ya[3], yb[0], yb[1], yb[2], yb[3]};
          float s1 = 0.f;
#pragma unroll
          for (int i = 0; i < 8; ++i) s1 += y[i];
          s1 += __shfl_xor(s1, 1); s1 += __shfl_xor(s1, 2); s1 += __shfl_xor(s1, 4);
          const float mu = s1 * (1.f / 64.f); float s2 = 0.f;
#pragma unroll
          for (int i = 0; i < 8; ++i) { y[i] -= mu; s2 += y[i] * y[i]; }
          s2 += __shfl_xor(s2, 1); s2 += __shfl_xor(s2, 2); s2 += __shfl_xor(s2, 4);
          const float rstd = 1.f / sqrtf(s2 * (1.f / 64.f) + 64e-5f);
          const size_t o = row * 512 + 64 * h + 8 * cg8;
          const u32x4 gq = *(const u32x4*)(GATE + o), bq = *(const u32x4*)(BV + o);
          float ov[8];
#pragma unroll
          for (int i = 0; i < 8; ++i) { const int ch = 64 * h + 8 * cg8 + i; const float yn = y[i] * rstd * p.in[I_LNXG][ch] + p.in[I_LNXB][ch];
              const float gt = (i & 1) ? bfhi(gq[i >> 1]) : bflo(gq[i >> 1]), bb = (i & 1) ? bfhi(bq[i >> 1]) : bflo(bq[i >> 1]);
              ov[i] = (yn + bb) * gt; }
          u32x4 ow = (u32x4){pk2(ov[0], ov[1]), pk2(ov[2], ov[3]), pk2(ov[4], ov[5]), pk2(ov[6], ov[7])};
          *(u32x4*)(MIXED + row * D + 512 + 64 * h + 8 * cg8) = ow; }
    }
}

DI void phase_post(const Params& p, const Ctx& F) {
    const float* YS = (const float*)(p.ws + WS_YS);
    const bf16_t* GATE = (const bf16_t*)((unsigned char*)p.out + DO_GATE); const bf16_t* BV = (const bf16_t*)((unsigned char*)p.out + DO_BV);
    bf16_t* MIXED = (bf16_t*)((unsigned char*)p.out + DO_MIXED);
    const int t = F.tid; const float lg = p.in[I_LNXG][t], lb = p.in[I_LNXB][t];
    for (int row = F.bid; row < NT; row += F.G) {
        const size_t o = (size_t)row * 512 + t;
        const float y = YS[o] + YS[(size_t)NT * 512 + o];
        const float mu = wave_sum(y) * (1.f / 64.f); const float dd = y - mu; const float var = wave_sum(dd * dd) * (1.f / 64.f);
        const float yn = dd * (1.f / sqrtf(var + 64e-5f)) * lg + lb;
        const float ob = (yn + bf2f(BV[o])) * bf2f(GATE[o]);
        MIXED[(size_t)row * D + 512 + t] = (bf16_t)f2bf(ob);
    }
}

DI void phase_gemm2(const Params& p, const Ctx& F) {
    pg8::StaticOrder S; S.init((unsigned char*)p.out + DO_MIXED, p.ws + WS_WOUTT, NT, 1024, 1024, F.G, F.bid);
    pg8::EpiF32 E{(float*)(p.ws + WS_Y), 1024};
    pg8::gemm_phase<pg8::EpiF32, pg8::StaticOrder, false>(F.lds, 1024, S, E);
}

DI void phase_route(const Params& p, const Ctx& F, const bool dry = false) {
    LAS float* wr_ = (LAS float*)F.lds;
    for (int i = F.tid; i < 36 * 1024; i += NTHREADS) { const int o = i / 1024, k = i % 1024; wr_[i] = o < 4 ? p.in[I_WRG][k * 4 + o] : p.in[I_WRE][k * 32 + (o - 4)]; }
    __syncthreads();
    const float* mod = (const float*)(p.ws + WS_MOD); const float* Y = (const float*)(p.ws + WS_Y);
    bf16_t* H2 = (bf16_t*)(p.ws + WS_H2); int* cnt = (int*)(p.ws + WS_CTL); int* perm = (int*)(p.ws + WS_PERM); float* ew = (float*)(p.ws + WS_EW);
    const int gw = F.bid * NWAVES + F.wave, NGW = F.G * NWAVES;
    LAS int* hist = (LAS int*)(F.lds + LDS_MISC + 64); LAS int* basel = (LAS int*)(F.lds + LDS_MISC + 192); LAS int* sel = (LAS int*)(F.lds + LDS_MISC + 320);
    if (F.tid < 32) hist[F.tid] = 0;
    __syncthreads();
    int itn = -1;
    for (int row = gw; row < NT; row += NGW) {
        ++itn;
        const int bt = row / SEQ;
        const f32x4* yr = (const f32x4*)(Y + (size_t)row * D) + F.lane; const f32x4* xr = (const f32x4*)(p.in[I_X] + (size_t)row * D) + F.lane;
        f32x4 v[4]; float ss = 0.f;
#pragma unroll
        for (int j = 0; j < 4; ++j) { v[j] = yr[64 * j]; ss += (v[j].x * v[j].x + v[j].y * v[j].y) + (v[j].z * v[j].z + v[j].w * v[j].w); }
        const float rstd = 1.f / sqrtf(wave_sum(ss) * (1.f / D) + 1e-6f);
        float s2 = 0.f;
        f32x4* xo = (f32x4*)(p.out + (size_t)row * D) + F.lane;
#pragma unroll
        for (int j = 0; j < 4; ++j) { const int col = 4 * (F.lane + 64 * j);
            const f32x4 g1 = *(const f32x4*)(mod + bt * 6144 + 2048 + col), gp = *(const f32x4*)(p.in[I_GPOST1] + col);
            v[j] = xr[64 * j] + g1 * (v[j] * rstd * gp);
            xo[64 * j] = v[j];
            s2 += (v[j].x * v[j].x + v[j].y * v[j].y) + (v[j].z * v[j].z + v[j].w * v[j].w); }
        const float rstd2 = 1.f / sqrtf(wave_sum(s2) * (1.f / D) + 1e-6f);
        unsigned long long* o8 = (unsigned long long*)(H2 + (size_t)row * D) + F.lane;
#pragma unroll
        for (int j = 0; j < 4; ++j) { const int col = 4 * (F.lane + 64 * j);
            const f32x4 gg = *(const f32x4*)(p.in[I_GPRE2] + col), sh = *(const f32x4*)(mod + bt * 6144 + 3072 + col), sc = *(const f32x4*)(mod + bt * 6144 + 4096 + col);
            v[j] = v[j] * rstd2 * gg * (sc + 1.f) + sh;
            o8[64 * j] = (unsigned long long)pk2(v[j].x, v[j].y) | ((unsigned long long)pk2(v[j].z, v[j].w) << 32); }
        float part[36];
#pragma unroll
        for (int o = 0; o < 36; ++o) { float a = 0.f;
#pragma unroll
            for (int j = 0; j < 4; ++j) { const f32x4 w = *(const LAS f32x4*)(wr_ + o * 1024 + 4 * (F.lane + 64 * j)); a += (v[j].x * w.x + v[j].y * w.y) + (v[j].z * w.z + v[j].w * w.w); }
            part[o] = a; if ((o & 3) == 3) __builtin_amdgcn_sched_barrier(0); }
        float v32[32], v16[16], v8[8], v4[4], v2[2], mylg;
        { const bool b5 = (F.lane & 32) != 0, b4 = (F.lane & 16) != 0, b3 = (F.lane & 8) != 0, b2 = (F.lane & 4) != 0, b1 = (F.lane & 2) != 0, b0 = (F.lane & 1) != 0;
#pragma unroll
          for (int i = 0; i < 32; ++i) { const float lo = part[i], hi = (i < 4) ? part[32 + (i & 3)] : 0.f; const float mine = b5 ? hi : lo, th = b5 ? lo : hi; v32[i] = mine + __shfl_xor(th, 32); }
#pragma unroll
          for (int i = 0; i < 16; ++i) { const float mine = b4 ? v32[16 + i] : v32[i], th = b4 ? v32[i] : v32[16 + i]; v16[i] = mine + __shfl_xor(th, 16); }
#pragma unroll
          for (int i = 0; i < 8; ++i) { const float mine = b3 ? v16[8 + i] : v16[i], th = b3 ? v16[i] : v16[8 + i]; v8[i] = mine + __shfl_xor(th, 8); }
#pragma unroll
          for (int i = 0; i < 4; ++i) { const float mine = b2 ? v8[4 + i] : v8[i], th = b2 ? v8[i] : v8[4 + i]; v4[i] = mine + __shfl_xor(th, 4); }
#pragma unroll
          for (int i = 0; i < 2; ++i) { const float mine = b1 ? v4[2 + i] : v4[i], th = b1 ? v4[i] : v4[2 + i]; v2[i] = mine + __shfl_xor(th, 2); }
          { const float mine = b0 ? v2[1] : v2[0], th = b0 ? v2[0] : v2[1]; mylg = mine + __shfl_xor(th, 1); } }
        mylg += (F.lane < 4) ? p.in[I_BRG][F.lane & 3] : p.in[I_BRE][(F.lane - 4) & 31];
        float gl[4];
#pragma unroll
        for (int j = 0; j < 4; ++j) gl[j] = __shfl(mylg, j);
        int gi = 0; float gm = gl[0];
#pragma unroll
        for (int j = 1; j < 4; ++j) if (gl[j] > gm) { gm = gl[j]; gi = j; }
        float gsum = 0.f;
#pragma unroll
        for (int j = 0; j < 4; ++j) gsum += __expf(gl[j] - gm);
        const float gw_ = 1.f / gsum;
        float el[8];
#pragma unroll
        for (int j = 0; j < 8; ++j) el[j] = __shfl(mylg, 4 + gi * 8 + j);
        int i1 = 0; float m1 = el[0];
#pragma unroll
        for (int j = 1; j < 8; ++j) if (el[j] > m1) { m1 = el[j]; i1 = j; }
        int i2 = 0; float m2 = -3.0e38f;
#pragma unroll
        for (int j = 0; j < 8; ++j) if (j != i1 && el[j] > m2) { m2 = el[j]; i2 = j; }
        const float p2 = __expf(m2 - m1);
        const float w1 = gw_ / (1.f + p2), w2 = gw_ * p2 / (1.f + p2);
        if (F.lane == 0 && !dry) {
            const int e1 = gi * 8 + i1, e2 = gi * 8 + i2;
            const int s1 = atomicAdd((int*)(hist + e1), 1), s2 = atomicAdd((int*)(hist + e2), 1);
            sel[(F.wave * 16 + itn) * 2] = (e1 << 16) | s1; sel[(F.wave * 16 + itn) * 2 + 1] = (e2 << 16) | s2;
            ew[row * 2] = w1; ew[row * 2 + 1] = w2;
        }
    }
    if (!dry) {
        __syncthreads();
        if (F.tid < 32) basel[F.tid] = atomicAdd(&cnt[F.tid * 64], (int)hist[F.tid]);
        __syncthreads();
        if (F.tid < 256) { const int wv = F.tid >> 5, it2 = (F.tid >> 1) & 15, sl = F.tid & 1; const int row = F.bid * NWAVES + wv + it2 * NGW;
            if (row < NT) { const int sv = sel[F.tid]; const int e = sv >> 16, ps = sv & 0xffff; perm[(size_t)e * NT + basel[e] + ps] = row * 2 + sl; } }
    }
}

DI void moe_tile_prefix(const Params& p, const Ctx& F, LAS int* tp) {
    __syncthreads();
    if (F.tid == 0) { const int* cnt = (const int*)(p.ws + WS_CTL); int acc = 0; for (int e = 0; e < 32; ++e) { tp[e] = acc; acc += (cnt[e * 64] + 255) / 256; } tp[32] = acc; }
    __syncthreads();
}
DI void phase_moe_up(const Params& p, const Ctx& F) {
    LAS int* tp = (LAS int*)(F.lds + pg8::STAGE_BYTES);
    moe_tile_prefix(p, F, tp);
    MoeOrder S{tp, (const int*)(p.ws + WS_CTL), 2, F.G, F.bid, 1024, (const char*)(p.ws + WS_H2), (const char*)(p.ws + WS_WGUT), (size_t)512 * 1024 * 2, (size_t)256 * 1024 * 2, (const int*)(p.ws + WS_PERM), true};
    pg8::EpiMoeUp E{(bf16_t*)(p.ws + WS_HID)};
    pg8::gemm_phase<pg8::EpiMoeUp, MoeOrder, true>(F.lds, 1024, S, E);
}
DI void phase_moe_down(const Params& p, const Ctx& F) {
    LAS int* tp = (LAS int*)(F.lds + pg8::STAGE_BYTES);
    moe_tile_prefix(p, F, tp);
    MoeOrder S{tp, (const int*)(p.ws + WS_CTL), 4, F.G, F.bid, 256, (const char*)(p.ws + WS_HID), (const char*)(p.ws + WS_WDT), (size_t)1024 * 256 * 2, (size_t)256 * 256 * 2, (const int*)(p.ws + WS_PERM), false};
    pg8::EpiMoeDown E{(bf16_t*)(p.ws + WS_YMOE), (const int*)(p.ws + WS_PERM), (const float*)(p.ws + WS_EW)};
    pg8::gemm_phase<pg8::EpiMoeDown, MoeOrder, false>(F.lds, 256, S, E);
}

DI void phase_final(const Params& p, const Ctx& F, const float fsc = 1.f) {
    const float* mod = (const float*)(p.ws + WS_MOD); const bf16_t* YM = (const bf16_t*)(p.ws + WS_YMOE);
    const int gw = F.bid * NWAVES + F.wave, NGW = F.G * NWAVES;
    for (int row = gw; row < NT; row += NGW) {
        const int bt = row / SEQ;
        const u32x2* y0 = (const u32x2*)(YM + (size_t)row * D) + F.lane; const u32x2* y1 = (const u32x2*)(YM + ((size_t)NT + row) * D) + F.lane;
        f32x4 v[4]; float ss = 0.f;
#pragma unroll
        for (int j = 0; j < 4; ++j) { const u32x2 a = y0[64 * j], b = y1[64 * j];
            v[j] = (f32x4){bflo(a.x) + bflo(b.x), bfhi(a.x) + bfhi(b.x), bflo(a.y) + bflo(b.y), bfhi(a.y) + bfhi(b.y)};
            ss += (v[j].x * v[j].x + v[j].y * v[j].y) + (v[j].z * v[j].z + v[j].w * v[j].w); }
        const float rstd = 1.f / sqrtf(wave_sum(ss) * (1.f / D) + 1e-6f);
        f32x4* xo = (f32x4*)(p.out + (size_t)row * D) + F.lane;
#pragma unroll
        for (int j = 0; j < 4; ++j) { const int col = 4 * (F.lane + 64 * j);
            const f32x4 g2 = *(const f32x4*)(mod + bt * 6144 + 5120 + col), gp = *(const f32x4*)(p.in[I_GPOST2] + col);
            xo[64 * j] = xo[64 * j] + g2 * (v[j] * (rstd * fsc) * gp); }
    }
}


#define XB_TMO      128
#define XB_XCNT(j)  (256  + 64 * (j))
#define XB_XSUB(j)  (1280 + 64 * (j))
#define XB_XGEN(j)  (2304 + 64 * (j))
#define XB_TOP      3328
#define XB_TOPGEN   3392
#define XCD_BAR_WORDS 3456
#define XB_SPIN_CAP (1u << 20)
constexpr int CW_BAR = 4096;
DI unsigned xb_ld(unsigned* p)              { return __hip_atomic_load(p, __ATOMIC_RELAXED, __HIP_MEMORY_SCOPE_AGENT); }
DI unsigned xb_add(unsigned* p, unsigned v) { return __hip_atomic_fetch_add(p, v, __ATOMIC_RELAXED, __HIP_MEMORY_SCOPE_AGENT); }
DI unsigned xb_xcc_id() { return (unsigned)__builtin_amdgcn_s_getreg((3 << 11) | 20) & 0xFu; }
#define XB_SPIN(cond, bar) do { unsigned _sp = 0; while (cond) { __builtin_amdgcn_s_sleep(1); \
    if ((++_sp & 255u) == 0u) { if (xb_ld(&(bar)[XB_TMO])) break; if (_sp > XB_SPIN_CAP) { atomicAdd(&(bar)[XB_TMO], 1u); break; } } } } while (0)
struct XcdBarrier { unsigned* bar; unsigned x; volatile LAS unsigned* st; };
DI XcdBarrier xcd_barrier_post(unsigned* bar, volatile LAS unsigned* st) {
    XcdBarrier b; b.bar = bar; b.x = xb_xcc_id(); b.st = st;
    if (threadIdx.x == 0) (void)xb_add(&bar[XB_XCNT(b.x)], 1u);
    return b;
}
DI void xcd_barrier_complete(unsigned* bar, unsigned x, unsigned& nloc, unsigned& nx) {
    const unsigned G = gridDim.x * gridDim.y * gridDim.z;
    unsigned sum, cnt, mine, sp = 0u;
    for (;;) {
        sum = 0u; cnt = 0u; mine = 0u;
#pragma unroll
        for (unsigned j = 0; j < 16; ++j) { const unsigned c = xb_ld(&bar[XB_XCNT(j)]); sum += c; cnt += (c > 0u) ? 1u : 0u; mine = (j == x) ? c : mine; }
        if (sum == G) break;
        __builtin_amdgcn_s_sleep(1);
        if ((++sp & 255u) == 0u) { if (xb_ld(&bar[XB_TMO])) break; if (sp > XB_SPIN_CAP) { atomicAdd(&bar[XB_TMO], 1u); break; } }
    }
    nloc = mine > 0u ? mine : 1u; nx = cnt > 0u ? cnt : 1u;
}
DI void xcd_barrier(const XcdBarrier& b) {
    asm volatile("s_waitcnt vmcnt(0)" ::: "memory");
    __syncthreads();
    if (threadIdx.x == 0) {
        unsigned* bar = b.bar;
        __builtin_amdgcn_s_waitcnt(0);
        unsigned nloc = b.st[0], nx = b.st[1];
        if (nloc == 0u) { xcd_barrier_complete(bar, b.x, nloc, nx); b.st[0] = nloc; b.st[1] = nx; }
        const unsigned old = xb_add(&bar[XB_XSUB(b.x)], 1u);
        const unsigned gen = old / nloc;
        if (old + 1u == (gen + 1u) * nloc) {
            __builtin_amdgcn_fence(__ATOMIC_RELEASE, "agent");
            asm volatile("s_waitcnt vmcnt(0)" ::: "memory");
            const unsigned og = xb_add(&bar[XB_TOP], 1u);
            const unsigned tg = og / nx;
            if (og + 1u == (tg + 1u) * nx) xb_add(&bar[XB_TOPGEN], 1u);
            else XB_SPIN(xb_ld(&bar[XB_TOPGEN]) == tg, bar);
            __builtin_amdgcn_fence(__ATOMIC_ACQUIRE, "agent");
            xb_add(&bar[XB_XGEN(b.x)], 1u);
            asm volatile("s_waitcnt vmcnt(0)" ::: "memory");
        } else {
            XB_SPIN(xb_ld(&bar[XB_XGEN(b.x)]) == gen, bar);
            __builtin_amdgcn_fence(__ATOMIC_ACQUIRE, "agent");
            asm volatile("s_waitcnt vmcnt(0)" ::: "memory");
        }
    }
    __syncthreads();
}

constexpr int NPHASES = 12;
#ifndef SEQ_SCAN
#define SEQ_SCAN 0
#endif
#ifndef DUP_PHASE
#define DUP_PHASE -1
#endif
#ifndef PROBE_T
#define PROBE_T -1
#endif
template <int PH> DI void run_phase(const Params& p, const Ctx& F) {
    if constexpr (PH == 0) phase_adaln(p, F);
    if constexpr (PH == 1) phase_convert(p, F);
    if constexpr (PH == 2) phase_hrows(p, F);
    if constexpr (PH == 3) phase_gemm1(p, F);
#ifndef OLD_PREP
#define OLD_PREP 0
#endif
    if constexpr (PH == 4) { if (OLD_PREP) phase_prep(p, F); else phase_prep2(p, F); __syncthreads(); phase_gmlp(p, F); }
    if constexpr (PH == 5) phase_chunkprep(p, F);
    if constexpr (PH == 12) { phase_scan_chunk(p, F); phase_convert_experts(p, F); }
    if constexpr (PH == 6) phase_post2(p, F);
    if constexpr (PH == 7) phase_gemm2(p, F);
    if constexpr (PH == 8) phase_route(p, F);
    if constexpr (PH == 28) phase_route(p, F, true);
    if constexpr (PH == 9) phase_moe_up(p, F);
    if constexpr (PH == 10) phase_moe_down(p, F);
    if constexpr (PH == 11) phase_final(p, F, DUP_PHASE == 11 ? 0.5f : 1.f);
}
DI Ctx make_ctx(unsigned char* lds) {
    Ctx F; F.lds = (LAS unsigned char*)lds; F.tid = threadIdx.x; F.lane = F.tid & 63; F.wave = __builtin_amdgcn_readfirstlane(F.tid >> 6); F.G = gridDim.x; F.bid = blockIdx.x; return F;
}
template <int PH> __global__ void __launch_bounds__(NTHREADS, 2) k_phase(Params p) {
    extern __shared__ __attribute__((aligned(16))) unsigned char lds[];
    const Ctx F = make_ctx(lds);
    run_phase<PH>(p, F);
}
#ifndef USE_CG_SYNC
#define USE_CG_SYNC 0
#endif
__global__ void __launch_bounds__(NTHREADS, 2) k_mega(Params p) {
    extern __shared__ __attribute__((aligned(16))) unsigned char lds[];
    const Ctx F = make_ctx(lds);
#if USE_CG_SYNC
    cg::grid_group grid = cg::this_grid();
#define GSYNC() grid.sync()
#else
    volatile LAS unsigned* misc = (volatile LAS unsigned*)(F.lds + LDS_MISC);
    if (F.tid < 4) misc[F.tid] = 0u;
    __syncthreads();
    const XcdBarrier bar = xcd_barrier_post((unsigned*)(p.ws + WS_CTL) + CW_BAR, misc);
#define GSYNC() xcd_barrier(bar)
#endif
#define DUP(X) if (DUP_PHASE == X) { run_phase<X>(p, F); GSYNC(); }
    unsigned long long ts_a = 0, ts_b = 0; int nst = 0;
#define STAMP() do { if (PROBE_T >= 0) { const unsigned long long t_ = __builtin_amdgcn_s_memrealtime(); if (nst == PROBE_T) ts_a = t_; if (nst == PROBE_T + 1) ts_b = t_; ++nst; } } while (0)
    STAMP();
    DUP(0) DUP(1)
    run_phase<0>(p, F); run_phase<1>(p, F); GSYNC(); STAMP();
    DUP(2) run_phase<2>(p, F); GSYNC(); STAMP();
    DUP(3) run_phase<3>(p, F); GSYNC(); STAMP();
    DUP(4) run_phase<4>(p, F); GSYNC(); STAMP();
    DUP(5) run_phase<5>(p, F); GSYNC(); STAMP();
    DUP(12)
    run_phase<12>(p, F); GSYNC(); STAMP();
    DUP(6) run_phase<6>(p, F); GSYNC(); STAMP();
    DUP(7) run_phase<7>(p, F); GSYNC(); STAMP();
    if (DUP_PHASE == 8) { run_phase<28>(p, F); GSYNC(); STAMP(); }
    run_phase<8>(p, F); GSYNC(); STAMP();
    DUP(9) run_phase<9>(p, F); GSYNC(); STAMP();
    DUP(10) run_phase<10>(p, F); GSYNC(); STAMP();
    if (DUP_PHASE == 11) { run_phase<11>(p, F); GSYNC(); STAMP(); }
    run_phase<11>(p, F);
    if (PROBE_T >= 0 && F.bid == 0 && F.tid == 0) { const unsigned long long t0 = __builtin_amdgcn_s_memrealtime(); const unsigned long long w_ = ts_b - ts_a; while (__builtin_amdgcn_s_memrealtime() - t0 < w_) __builtin_amdgcn_s_sleep(8); }
}

template <int PH> static void launch_phase(const Params& p, int grid, hipStream_t stream) {
    static bool attr = false;
    if (!attr) { (void)hipFuncSetAttribute((const void*)k_phase<PH>, hipFuncAttributeMaxDynamicSharedMemorySize, LDS_BYTES); attr = true; }
    hipLaunchKernelGGL(k_phase<PH>, dim3(grid), dim3(NTHREADS), LDS_BYTES, stream, p);
}

extern "C" void kernel_launch(void* const* d_in, const int* in_sizes, int n_in, void* d_out, int out_size, void* d_ws, size_t ws_size, hipStream_t stream) {
    static int grid = 0;
    if (grid == 0) {
        int dev = 0, cus = 0, per_cu = 0;
        (void)hipGetDevice(&dev); (void)hipDeviceGetAttribute(&cus, hipDeviceAttributeMultiprocessorCount, dev);
        (void)hipFuncSetAttribute((const void*)k_mega, hipFuncAttributeMaxDynamicSharedMemorySize, LDS_BYTES);
        (void)hipOccupancyMaxActiveBlocksPerMultiprocessor(&per_cu, (const void*)k_mega, NTHREADS, LDS_BYTES);
        (void)hipGetLastError();
        grid = cus > 0 ? cus : 256;
        if (n_in != 34 || ws_size < 512 * MiB) fprintf(stderr, "kernel_launch: unexpected n_in %d / ws_size %zu\n", n_in, ws_size);
    }
    Params p{};
    for (int i = 0; i < 34; ++i) p.in[i] = (const float*)d_in[i];
    p.out = (float*)d_out; p.ws = (unsigned char*)d_ws;
    (void)hipMemsetAsync((char*)d_ws + WS_CTL, 0, CTL_BYTES, stream);
#if ONE_LAUNCH
    void* args[] = {&p};
    hipError_t e = hipLaunchCooperativeKernel((const void*)k_mega, dim3(grid), dim3(NTHREADS), args, LDS_BYTES, stream);
    if (e != hipSuccess) fprintf(stderr, "cooperative launch failed: %s (grid %d)\n", hipGetErrorString(e), grid);
#else
    launch_phase<0>(p, grid, stream); launch_phase<1>(p, grid, stream); launch_phase<2>(p, grid, stream); launch_phase<3>(p, grid, stream);
    launch_phase<4>(p, grid, stream); launch_phase<5>(p, grid, stream);
    launch_phase<12>(p, grid, stream);
    launch_phase<6>(p, grid, stream); launch_phase<7>(p, grid, stream);
    launch_phase<8>(p, grid, stream); launch_phase<9>(p, grid, stream); launch_phase<10>(p, grid, stream); launch_phase<11>(p, grid, stream);
#endif
}
```

```cpp
#include <hip/hip_runtime.h>
#include <hip/hip_cooperative_groups.h>
#include <cstdio>
#include <cstdint>
namespace cg = cooperative_groups;

#ifndef ONE_LAUNCH
#define ONE_LAUNCH 1
#endif

#define DI __device__ __forceinline__
#define LAS __attribute__((address_space(3)))
typedef unsigned short bf16_t;
typedef short bf16x8 __attribute__((ext_vector_type(8)));
typedef short s16x4 __attribute__((ext_vector_type(4)));
typedef float f32x4 __attribute__((ext_vector_type(4)));
typedef float f32x2 __attribute__((ext_vector_type(2)));
typedef unsigned u32x4 __attribute__((ext_vector_type(4)));
typedef unsigned u32x2 __attribute__((ext_vector_type(2)));

constexpr int D = 1024, BATCH = 4, SEQ = 8192, CTXL = 256;
constexpr int NT = BATCH * SEQ;
constexpr int NCX = BATCH * CTXL;
constexpr int MR = NT + NCX;
constexpr int BW = 512, AW = 512, NH = 8, HD = 64;
constexpr int DIN = 2944, DINP = 3072;
constexpr int OFF_K = 0, OFF_V = 512, OFF_R = 1024, OFF_WD = 1536, OFF_AD = 1664, OFF_GD = 1792, OFF_U = 1920, OFF_VA = 2432;
constexpr int NEXP = 32, DEXP = 256;
constexpr int NWAVES = 8, NTHREADS = 512;
constexpr int LDS_BYTES = 149504, LDS_MISC = 147456;

constexpr size_t MiB = 1u << 20;
constexpr size_t WS_CTL = 0, CTL_BYTES = 64 * 1024;
constexpr size_t WS_MOD = 1 * MiB;
constexpr size_t WS_DUPT = 2 * MiB;
constexpr size_t WS_AUPT = WS_DUPT + 131072;
constexpr size_t WS_GUPT = WS_AUPT + 131072;
constexpr size_t WS_WSP = WS_GUPT + 131072;
constexpr size_t WS_CONVW = WS_WSP + 262144;
constexpr size_t WS_WINT = 3 * MiB;
constexpr size_t WS_WOUTT = 9 * MiB;
constexpr size_t WS_H = 11 * MiB;
constexpr size_t WS_Z = 77 * MiB;
constexpr size_t ROWB = (size_t)MR * 512 * 2;
constexpr size_t WS_KC = 275 * MiB, WS_VC = WS_KC + ROWB, WS_RC = WS_VC + ROWB, WS_A0 = WS_RC + ROWB, WS_A1 = WS_A0 + ROWB, WS_L0 = WS_A1 + ROWB, WS_L1 = WS_L0 + ROWB;
constexpr size_t WS_OPS = 11 * MiB;
constexpr size_t WS_YS = 11 * MiB;
constexpr size_t WS_Y = 11 * MiB;
constexpr size_t WS_H2 = 139 * MiB;
constexpr size_t WS_EW = 203 * MiB;
constexpr size_t WS_PERM = 204 * MiB;
constexpr size_t WS_HID = 210 * MiB;
constexpr size_t WS_YMOE = 246 * MiB;
constexpr size_t WS_WGUT = 374 * MiB;
constexpr size_t WS_WDT = 406 * MiB;
constexpr size_t DO_MIXED = 0, DO_GATE = 64 * MiB, DO_BV = 96 * MiB;

struct Params { const float* in[34]; float* out; unsigned char* ws; };
enum { I_X = 0, I_C, I_CTX, I_CCTX, I_WMOD, I_BMOD, I_GPRE1, I_GPOST1, I_GPRE2, I_GPOST2, I_WIN, I_CONV, I_GMLNG, I_GMLNB, I_WSP, I_BSP,
       I_DW0, I_DUP, I_A0, I_AUP, I_KK, I_KA, I_RK, I_GUP, I_LNXG, I_LNXB, I_WOUT, I_WRG, I_BRG, I_WRE, I_BRE, I_WG, I_WU, I_WD };

typedef __bf16 bf16x2_t __attribute__((ext_vector_type(2)));
DI unsigned pk2(float lo, float hi) { const f32x2 v = {lo, hi}; const bf16x2_t b = __builtin_convertvector(v, bf16x2_t); return __builtin_bit_cast(unsigned, b); }
DI unsigned f2bf(float f) { return pk2(f, f) & 0xffffu; }
DI float bf2f(unsigned b) { return __builtin_bit_cast(float, b << 16); }
DI float bflo(unsigned w) { return __builtin_bit_cast(float, w << 16); }
DI float bfhi(unsigned w) { return __builtin_bit_cast(float, w & 0xffff0000u); }
DI unsigned cvt_pk_bf16(float lo, float hi) { return pk2(lo, hi); }
DI float wave_sum(float v) {
#pragma unroll
    for (int o = 1; o < 64; o <<= 1) v += __shfl_xor(v, o);
    return v;
}
DI float sigmoidf_(float x) { return __builtin_amdgcn_rcpf(1.f + __expf(-x)); }
DI float siluf_(float x) { return x * __builtin_amdgcn_rcpf(1.f + __expf(-x)); }
DI float softplusf_(float x) { return fmaxf(x, 0.f) + __logf(1.f + __expf(-fabsf(x))); }
DI float tanh_fast(float x) { const float e = __expf(-2.f * fabsf(x)); const float t = (1.f - e) * __builtin_amdgcn_rcpf(1.f + e); return x < 0.f ? -t : t; }
DI float gelu_tanh(float x) { const float u = 0.7978845608028654f * (x + 0.044715f * x * x * x); return 0.5f * x * (1.f + tanh_fast(u)); }
#define LDS_WAIT() asm volatile("s_waitcnt lgkmcnt(0)" ::: "memory")

namespace pg8 {
constexpr int BM = 256, BK = 64, HALF = 128, HTB = HALF * BK * 2, STAGE_BYTES = 8 * HTB, NXCD = 8, WGM = 8;
__host__ __device__ __forceinline__ int lds_byte(int r, int c) { const int st = (r >> 4) * 2 + (c >> 5), rr = r & 15, cc = c & 31, ob = rr * 64 + cc * 2; return st * 1024 + (ob ^ (((ob >> 9) & 1) << 5)); }
__host__ __device__ __forceinline__ void stage_rc(int b, int& R, int& C) { const int st = b / 1024, sb = b % 1024, swz = sb ^ (((sb >> 9) & 1) << 5); R = (st >> 1) * 16 + swz / 64; C = (st & 1) * 32 + (swz % 64) / 2; }
__host__ __device__ __forceinline__ int perm32(int rho) { const int n = rho >> 4, i = rho & 15; return 8 * (i >> 2) + 4 * n + (i & 3); }

struct Unit { const char* A; const char* B; const int* ridx; int pm, pn, e, lt, nvalid; };

struct StaticOrder {
    const char* A; const char* Bt; int K; int nM, nN, nwg, G, c;
    __device__ void init(const void* A_, const void* Bt_, int M, int N, int K_, int G_, int c_) { A = (const char*)A_; Bt = (const char*)Bt_; K = K_; nM = M / BM; nN = N / BM; nwg = nM * nN; G = G_; c = c_; }
    __device__ bool next(int i, Unit& u) const {
        const long L = (long)i * G + c; if (L >= nwg) return false;
        int wgid = (int)L; { const int q = nwg / NXCD, r = nwg % NXCD, xcd = wgid % NXCD, off = wgid / NXCD; wgid = (xcd < r ? xcd * (q + 1) : r * (q + 1) + (xcd - r) * q) + off; }
        const int nig = WGM * nN, gid = wgid / nig, fm = gid * WGM, gsz = (nM - fm) < WGM ? (nM - fm) : WGM;
        u.pm = fm + ((wgid % nig) % gsz); u.pn = (wgid % nig) / gsz;
        u.A = A + (size_t)u.pm * BM * K * 2; u.B = Bt + (size_t)u.pn * BM * K * 2; u.ridx = nullptr; u.e = 0; u.lt = 0; u.nvalid = BM; return true;
    }
};

DI int gidx(const Unit& u, int r) { return r < u.nvalid ? (u.ridx[r] >> 1) : 0; }

template <class Epi, class Sched, bool GATHER>
DI void gemm_phase(LAS unsigned char* lds, const int K, const Sched& S, const Epi& E) {
    const int tid = threadIdx.x, wid = __builtin_amdgcn_readfirstlane(tid >> 6), lane = tid & 63, wr = wid >> 2, wc = wid & 3, fr = lane & 15, fq = lane >> 4;
    const int nt = K / BK;
    int Rr[2], Cc[2];
    unsigned voffB[2], vA[2][2], vAn[2][2];
#pragma unroll
    for (int i = 0; i < 2; ++i) { int R, C; stage_rc(tid * 16 + i * 8192, R, C); Rr[i] = R; Cc[i] = C; const int Rb = (R & ~31) + perm32(R & 31);
        voffB[i] = (unsigned)(Rb * K + C) * 2u;
        vA[0][i] = (unsigned)(R * K + C) * 2u; vA[1][i] = (unsigned)((R + HALF) * K + C) * 2u; vAn[0][i] = vA[0][i]; vAn[1][i] = vA[1][i]; }
    const size_t kstep = (size_t)(BK * 2);
    const size_t hstep = (size_t)HALF * K * 2;
    const unsigned ldsw = (unsigned)wid * 1024u;
    const int aoff = lds_byte(wr * 64 + fr, fq * 8), boff = lds_byte(wc * 32 + fr, fq * 8);
#define PG8_SA(b, h) (((b) * 2 + (h)) * HTB)
#define PG8_SB(b, h) ((4 + (b) * 2 + (h)) * HTB)
#define PG8_STAGE(bufoff, gbase, voff) do { _Pragma("unroll") for (int _i = 0; _i < 2; ++_i) \
        __builtin_amdgcn_global_load_lds((const unsigned*)((const char*)(gbase) + (voff)[_i]), (LAS unsigned*)(lds + (bufoff) + ldsw + _i * 8192), 16, 0, 0); } while (0)
#define PG8_LDA(dst, b, h) do { _Pragma("unroll") for (int m = 0; m < 4; ++m) _Pragma("unroll") for (int k = 0; k < 2; ++k) dst[m][k] = *(const LAS bf16x8*)(lds + PG8_SA(b, h) + aoff + m * 2048 + k * 1024); } while (0)
#define PG8_LDB(dst, b, h) do { _Pragma("unroll") for (int n = 0; n < 2; ++n) _Pragma("unroll") for (int k = 0; k < 2; ++k) dst[n][k] = *(const LAS bf16x8*)(lds + PG8_SB(b, h) + boff + n * 2048 + k * 1024); } while (0)
#define PG8_MMA(ai, bj, At, Bt) do { __builtin_amdgcn_s_setprio(1); _Pragma("unroll") for (int m = 0; m < 4; ++m) _Pragma("unroll") for (int n = 0; n < 2; ++n) _Pragma("unroll") for (int k = 0; k < 2; ++k) \
        acc[ai][bj][m][n] = __builtin_amdgcn_mfma_f32_16x16x32_bf16(Bt[n][k], At[m][k], acc[ai][bj][m][n], 0, 0, 0); __builtin_amdgcn_s_setprio(0); } while (0)
#define PG8_WAIT_V(n) asm volatile("s_waitcnt vmcnt(" #n ")" ::: "memory")
#define PG8_WAIT_L(n) asm volatile("s_waitcnt lgkmcnt(" #n ")" ::: "memory")
#define PG8_BAR __builtin_amdgcn_s_barrier()
#define PG8_SCHED __builtin_amdgcn_sched_barrier(0)
    Unit cur, nxt; int ui = 0;
    if (!S.next(0, cur)) return;
    if constexpr (GATHER) {
#pragma unroll
        for (int i = 0; i < 2; ++i) { vA[0][i] = (unsigned)(gidx(cur, Rr[i]) * K + Cc[i]) * 2u; vA[1][i] = (unsigned)(gidx(cur, Rr[i] + HALF) * K + Cc[i]) * 2u; }
    }
    f32x4 acc[2][2][4][2];
#pragma unroll
    for (int a = 0; a < 2; ++a)
#pragma unroll
        for (int b = 0; b < 2; ++b)
#pragma unroll
            for (int m = 0; m < 4; ++m)
#pragma unroll
                for (int n = 0; n < 2; ++n) acc[a][b][m][n] = (f32x4){0.f, 0.f, 0.f, 0.f};
    bf16x8 At[4][2], B0[2][2], B1[2][2];
    const char* cA = cur.A; const char* cB = cur.B;
    PG8_STAGE(PG8_SB(0, 0), cB, voffB); PG8_STAGE(PG8_SB(0, 1), cB + hstep, voffB); PG8_STAGE(PG8_SA(0, 0), cA, vA[0]); PG8_STAGE(PG8_SA(0, 1), cA, vA[1]);
    if (wr == 1) PG8_BAR;
    PG8_WAIT_V(2); PG8_BAR;
    PG8_STAGE(PG8_SB(1, 0), cB + kstep, voffB); PG8_STAGE(PG8_SA(1, 0), cA + kstep, vA[0]); PG8_STAGE(PG8_SB(1, 1), cB + hstep + kstep, voffB);
    PG8_WAIT_V(6); PG8_BAR;
    for (;;) {
        const bool has_next = S.next(ui + 1, nxt);
        const char* nA = has_next ? nxt.A : cA; const char* nB = has_next ? nxt.B : cB;
        if constexpr (GATHER) {
            if (has_next) {
#pragma unroll
                for (int i = 0; i < 2; ++i) { vAn[0][i] = (unsigned)(gidx(nxt, Rr[i]) * K + Cc[i]) * 2u; vAn[1][i] = (unsigned)(gidx(nxt, Rr[i] + HALF) * K + Cc[i]) * 2u; }
            } else {
#pragma unroll
                for (int i = 0; i < 2; ++i) { vAn[0][i] = vA[0][i]; vAn[1][i] = vA[1][i]; }
            }
        }
#pragma unroll 1
        for (int t = 0; t < nt; t += 2) {
            const bool last = (t == nt - 2);
            const char* a1 = cA + (size_t)(t + 1) * kstep;
            const char* a2 = last ? nA : cA + (size_t)(t + 2) * kstep; const char* b2 = last ? nB : cB + (size_t)(t + 2) * kstep;
            const char* a3 = a2 + kstep; const char* b3 = b2 + kstep;
            unsigned w0[2], w1[2];
            if constexpr (GATHER) { w0[0] = last ? vAn[0][0] : vA[0][0]; w0[1] = last ? vAn[0][1] : vA[0][1]; w1[0] = last ? vAn[1][0] : vA[1][0]; w1[1] = last ? vAn[1][1] : vA[1][1]; }
            else { w0[0] = vA[0][0]; w0[1] = vA[0][1]; w1[0] = vA[1][0]; w1[1] = vA[1][1]; }
            PG8_LDB(B0, 0, 0); PG8_LDB(B1, 0, 1); PG8_SCHED; PG8_LDA(At, 0, 0); PG8_STAGE(PG8_SA(1, 1), a1, vA[1]);
            PG8_WAIT_V(8); PG8_WAIT_L(0); PG8_BAR; PG8_MMA(0, 0, At, B0); PG8_MMA(0, 1, At, B1); PG8_BAR; PG8_SCHED;
            PG8_LDA(At, 0, 1); PG8_STAGE(PG8_SB(0, 0), b2, voffB); PG8_STAGE(PG8_SB(0, 1), b2 + hstep, voffB); PG8_STAGE(PG8_SA(0, 0), a2, w0);
            PG8_WAIT_V(8); PG8_WAIT_L(0); PG8_BAR; PG8_MMA(1, 0, At, B0); PG8_MMA(1, 1, At, B1); PG8_BAR; PG8_SCHED;
            PG8_LDB(B0, 1, 0); PG8_LDB(B1, 1, 1); PG8_SCHED; PG8_LDA(At, 1, 0); PG8_STAGE(PG8_SA(0, 1), a2, w1);
            PG8_WAIT_V(8); PG8_WAIT_L(0); PG8_BAR; PG8_MMA(0, 0, At, B0); PG8_MMA(0, 1, At, B1); PG8_BAR; PG8_SCHED;
            PG8_LDA(At, 1, 1); PG8_STAGE(PG8_SB(1, 0), b3, voffB); PG8_STAGE(PG8_SB(1, 1), b3 + hstep, voffB); PG8_STAGE(PG8_SA(1, 0), a3, w0);
            PG8_WAIT_V(8); PG8_WAIT_L(0); PG8_BAR; PG8_MMA(1, 0, At, B0); PG8_MMA(1, 1, At, B1); PG8_BAR; PG8_SCHED;
        }
        if (wr == 0) PG8_BAR;
        E(acc, cur, wr, wc, fr, fq);
        if (!has_next) break;
#pragma unroll
        for (int a = 0; a < 2; ++a)
#pragma unroll
            for (int b = 0; b < 2; ++b)
#pragma unroll
                for (int m = 0; m < 4; ++m)
#pragma unroll
                    for (int n = 0; n < 2; ++n) acc[a][b][m][n] = (f32x4){0.f, 0.f, 0.f, 0.f};
        cur = nxt; cA = nA; cB = nB; ++ui;
        if constexpr (GATHER) {
#pragma unroll
            for (int i = 0; i < 2; ++i) { vA[0][i] = vAn[0][i]; vA[1][i] = vAn[1][i]; }
        }
        if (wr == 1) PG8_BAR;
    }
    PG8_WAIT_V(0);
    PG8_BAR;
#undef PG8_SA
#undef PG8_SB
#undef PG8_STAGE
#undef PG8_LDA
#undef PG8_LDB
#undef PG8_MMA
#undef PG8_WAIT_V
#undef PG8_WAIT_L
#undef PG8_BAR
#undef PG8_SCHED
}

struct EpiBf16 {
    bf16_t* O; int ldc;
    DI void operator()(const f32x4 (&acc)[2][2][4][2], const Unit& u, int wr, int wc, int fr, int fq) const {
        const int row0 = u.pm * BM + wr * 64 + fr, col0 = u.pn * BM + wc * 32 + 8 * fq;
#pragma unroll
        for (int ai = 0; ai < 2; ++ai)
#pragma unroll
            for (int m = 0; m < 4; ++m) { bf16_t* rowp = O + (size_t)(row0 + ai * HALF + m * 16) * ldc + col0;
#pragma unroll
                for (int bj = 0; bj < 2; ++bj) { const f32x4 v0 = acc[ai][bj][m][0], v1 = acc[ai][bj][m][1];
                    u32x4 w; w.x = cvt_pk_bf16(v0[0], v0[1]); w.y = cvt_pk_bf16(v0[2], v0[3]); w.z = cvt_pk_bf16(v1[0], v1[1]); w.w = cvt_pk_bf16(v1[2], v1[3]);
                    *(u32x4*)(rowp + bj * HALF) = w; } }
    }
};
struct EpiF32 {
    float* O; int ldc;
    DI void operator()(const f32x4 (&acc)[2][2][4][2], const Unit& u, int wr, int wc, int fr, int fq) const {
        const int row0 = u.pm * BM + wr * 64 + fr, col0 = u.pn * BM + wc * 32 + 8 * fq;
#pragma unroll
        for (int ai = 0; ai < 2; ++ai)
#pragma unroll
            for (int m = 0; m < 4; ++m) { float* rowp = O + (size_t)(row0 + ai * HALF + m * 16) * ldc + col0;
#pragma unroll
                for (int bj = 0; bj < 2; ++bj) { *(f32x4*)(rowp + bj * HALF) = acc[ai][bj][m][0]; *(f32x4*)(rowp + bj * HALF + 4) = acc[ai][bj][m][1]; } }
    }
};
struct EpiMoeUp {
    bf16_t* HID;
    DI void operator()(const f32x4 (&acc)[2][2][4][2], const Unit& u, int wr, int wc, int fr, int fq) const {
        const int row0 = u.pm * BM + wr * 64 + fr, col0 = u.pn * HALF + wc * 32 + 8 * fq;
#pragma unroll
        for (int ai = 0; ai < 2; ++ai)
#pragma unroll
            for (int m = 0; m < 4; ++m) { bf16_t* rowp = HID + (size_t)(row0 + ai * HALF + m * 16) * DEXP + col0;
                float h[8];
#pragma unroll
                for (int n = 0; n < 2; ++n)
#pragma unroll
                    for (int j = 0; j < 4; ++j) { const float g = acc[ai][0][m][n][j], up = acc[ai][1][m][n][j]; h[n * 4 + j] = siluf_(g) * up; }
                u32x4 w; w.x = cvt_pk_bf16(h[0], h[1]); w.y = cvt_pk_bf16(h[2], h[3]); w.z = cvt_pk_bf16(h[4], h[5]); w.w = cvt_pk_bf16(h[6], h[7]);
                *(u32x4*)rowp = w; }
    }
};
struct EpiMoeDown {
    bf16_t* YM; const int* perm; const float* ew;
    DI void operator()(const f32x4 (&acc)[2][2][4][2], const Unit& u, int wr, int wc, int fr, int fq) const {
        const int col0 = u.pn * BM + wc * 32 + 8 * fq;
#pragma unroll
        for (int ai = 0; ai < 2; ++ai)
#pragma unroll
            for (int m = 0; m < 4; ++m) { const int r = ai * HALF + wr * 64 + m * 16 + fr;
                if (r < u.nvalid) { const int pr = perm[(size_t)u.e * NT + u.lt * BM + r]; const int tok = pr >> 1, slot = pr & 1; const float wgt = ew[pr];
                    bf16_t* rowp = YM + ((size_t)slot * NT + tok) * D + col0;
#pragma unroll
                    for (int bj = 0; bj < 2; ++bj) { const f32x4 v0 = acc[ai][bj][m][0] * wgt, v1 = acc[ai][bj][m][1] * wgt;
                        u32x4 w; w.x = cvt_pk_bf16(v0[0], v0[1]); w.y = cvt_pk_bf16(v0[2], v0[3]); w.z = cvt_pk_bf16(v1[0], v1[1]); w.w = cvt_pk_bf16(v1[2], v1[3]);
                        *(u32x4*)(rowp + bj * HALF) = w; } }
                asm volatile("" ::: "memory"); }
    }
};
}

struct MoeOrder {
    const LAS int* tp; const int* cnt; int npn, G, c, K; const char* A; const char* Bbase; size_t bstride_e, bstride_pn; const int* perm; bool gather;
    __device__ bool next(int i, pg8::Unit& u) const {
        const int TT = __builtin_amdgcn_readfirstlane(tp[32]); const long L = (long)i * G + c; if (L >= (long)TT * npn) return false;
        const int rt = (int)(L / npn), pn = (int)(L % npn);
        int e = 0;
#pragma unroll 1
        for (int j = 1; j < 32; ++j) e += (__builtin_amdgcn_readfirstlane(tp[j]) <= rt) ? 1 : 0;
        const int lt = rt - __builtin_amdgcn_readfirstlane(tp[e]);
        u.pm = rt; u.pn = pn; u.e = e; u.lt = lt; const int rem = cnt[e * 64] - lt * 256; u.nvalid = rem < 256 ? rem : 256;
        u.ridx = perm + (size_t)e * NT + lt * 256;
        u.A = gather ? A : A + (size_t)rt * 256 * K * 2;
        u.B = Bbase + (size_t)e * bstride_e + (size_t)pn * bstride_pn;
        return true;
    }
};

struct Ctx {
    LAS unsigned char* lds; int tid, lane, wave, G, bid;
};

DI void phase_adaln(const Params& p, const Ctx& F) {
    LAS float* s = (LAS float*)F.lds;
    LAS float* red = (LAS float*)(F.lds + 20480);
    const float* c = p.in[I_C]; const float* cc = p.in[I_CCTX]; const float* wm = p.in[I_WMOD]; const float* bm = p.in[I_BMOD];
    float* mod = (float*)(p.ws + WS_MOD);
    for (int i = F.tid; i < 5 * 1024; i += NTHREADS) { const float v = i < 4096 ? c[i] : cc[i - 4096]; s[i] = siluf_(v); }
    __syncthreads();
    for (int grp = F.bid; grp < 256; grp += F.G) {
        const int col0 = grp * 24, q = F.tid % 6, ks = F.tid / 6;
        float acc[5][4];
#pragma unroll
        for (int b = 0; b < 5; ++b)
#pragma unroll
            for (int j = 0; j < 4; ++j) acc[b][j] = 0.f;
        if (F.tid < 510) {
            f32x4 wv[13];
#pragma unroll
            for (int i = 0; i < 13; ++i) { const int k = ks + 85 * i; wv[i] = k < 1024 ? *(const f32x4*)(wm + (size_t)k * 6144 + col0 + 4 * q) : (f32x4){0.f, 0.f, 0.f, 0.f}; }
#pragma unroll
            for (int i = 0; i < 13; ++i) { const int k = ks + 85 * i; const int kc = k < 1024 ? k : 0;
#pragma unroll
                for (int b = 0; b < 5; ++b) { const float sv = s[b * 1024 + kc];
#pragma unroll
                    for (int j = 0; j < 4; ++j) acc[b][j] += sv * wv[i][j]; } }
#pragma unroll
            for (int b = 0; b < 5; ++b)
#pragma unroll
                for (int j = 0; j < 4; ++j) red[ks * 120 + q * 20 + b * 4 + j] = acc[b][j];
        }
        __syncthreads();
        if (F.tid < 120) {
            float sum = 0.f;
            for (int k2 = 0; k2 < 85; ++k2) sum += red[k2 * 120 + F.tid];
            const int qq = F.tid / 20, b = (F.tid % 20) / 4, j = F.tid % 4, col = col0 + 4 * qq + j;
            mod[b * 6144 + col] = sum + bm[col];
        }
        __syncthreads();
    }
}

DI void transpose_item(const float* W, int K, int N, bf16_t* WT, int row_off, LAS float* scr, int item, int lane) {
    const int nblk = N / 32, kb = item / nblk, nb = item % nblk, k0 = 64 * kb, n0 = 32 * nb;
#pragma unroll 8
    for (int i = 0; i < 32; ++i) { const int kk = 2 * i + (lane >> 5); scr[kk * 33 + (lane & 31)] = W[(size_t)(k0 + kk) * N + n0 + (lane & 31)]; }
    LDS_WAIT(); asm volatile("" ::: "memory");
    const int c = lane & 7;
#pragma unroll
    for (int j = 0; j < 4; ++j) { const int n = (lane >> 3) + 8 * j; const LAS float* s = scr + (8 * c) * 33 + n;
        u32x4 o; o.x = pk2(s[0 * 33], s[1 * 33]); o.y = pk2(s[2 * 33], s[3 * 33]); o.z = pk2(s[4 * 33], s[5 * 33]); o.w = pk2(s[6 * 33], s[7 * 33]);
        *(u32x4*)(WT + (size_t)(row_off + n0 + n) * K + k0 + 8 * c) = o; }
    LDS_WAIT(); asm volatile("" ::: "memory");
}
DI void phase_convert(const Params& p, const Ctx& F) {
    __syncthreads();
    LAS float* scr = (LAS float*)(F.lds + F.wave * 16384);
    const int gw = F.bid * NWAVES + F.wave, NGW = F.G * NWAVES;
    bf16_t* WinT = (bf16_t*)(p.ws + WS_WINT); bf16_t* WoutT = (bf16_t*)(p.ws + WS_WOUTT); bf16_t* WguT = (bf16_t*)(p.ws + WS_WGUT); bf16_t* WdT = (bf16_t*)(p.ws + WS_WDT);
    constexpr int I_IN = 16 * 92, I_OUT = 16 * 32;
    constexpr int NITEMS = I_IN + I_OUT;
    for (int it = gw; it < NITEMS; it += NGW) {
        int r = it;
        if (r < I_IN) { transpose_item(p.in[I_WIN], 1024, DIN, WinT, 0, scr, r, F.lane); continue; } r -= I_IN;
        transpose_item(p.in[I_WOUT], 1024, 1024, WoutT, 0, scr, r, F.lane);
    }
    (void)WguT; (void)WdT;
    { const int gt = F.bid * NTHREADS + F.tid, NG = F.G * NTHREADS; u32x4 z = {0u, 0u, 0u, 0u};
      for (int i = gt; i < 128 * 1024 / 8; i += NG) *(u32x4*)(WinT + (size_t)DIN * 1024 + (size_t)i * 8) = z;
      bf16_t* DupT = (bf16_t*)(p.ws + WS_DUPT); bf16_t* AupT = (bf16_t*)(p.ws + WS_AUPT); bf16_t* GupT = (bf16_t*)(p.ws + WS_GUPT); bf16_t* Wsp = (bf16_t*)(p.ws + WS_WSP);
      for (int i = gt; i < 2 * 512 * 64; i += NG) { const int d = i / (512 * 64), ch = (i / 64) % 512, l = i % 64;
          DupT[i] = (bf16_t)f2bf(p.in[I_DUP][(size_t)(d * 64 + l) * 512 + ch]); AupT[i] = (bf16_t)f2bf(p.in[I_AUP][(size_t)(d * 64 + l) * 512 + ch]); }
      for (int i = gt; i < 512 * 128; i += NG) { const int ch = i / 128, l = i % 128; GupT[i] = (bf16_t)f2bf(p.in[I_GUP][(size_t)l * 512 + ch]); }
      for (int i = gt; i < 8 * 128 * 128; i += NG) Wsp[i] = (bf16_t)f2bf(p.in[I_WSP][i]);
      float* cw2 = (float*)(p.ws + WS_CONVW);
      for (int i = gt; i < 128 * 9 * 3 * 4; i += NG) { const int j = i & 3, s3 = (i >> 2) % 3, tap = (i / 12) % 9, qd = i / 108; cw2[i] = p.in[I_CONV][tap * 1536 + s3 * 512 + 4 * qd + j]; } }
}


DI void phase_convert_experts(const Params& p, const Ctx& F) {
    constexpr int TP = 264;
    LAS bf16_t* tile = (LAS bf16_t*)F.lds;
    bf16_t* WguT = (bf16_t*)(p.ws + WS_WGUT); bf16_t* WdT = (bf16_t*)(p.ws + WS_WDT);
    constexpr int NIT = 32 * 2 * 16 + 32 * 16;
    const int b0 = F.bid, nb = F.G;
    for (int it = b0; it < NIT; it += nb) {
        const float* src; int ldn; bf16_t* dst; int ldk, k0; int rowmap;
        int n0 = 0;
        if (it < 1024) { const int e = it >> 5, up = (it >> 4) & 1, kt = it & 15; src = (up ? p.in[I_WU] : p.in[I_WG]) + (size_t)e * 1024 * 256 + (size_t)kt * 64 * 256; ldn = 256;
            dst = WguT + (size_t)e * 512 * 1024; ldk = 1024; k0 = kt * 64; rowmap = 1 + up; }
        else { const int r = it - 1024, e = r >> 4, kt = (r >> 2) & 3, ntl = r & 3; src = p.in[I_WD] + (size_t)e * 256 * 1024 + (size_t)kt * 64 * 1024 + ntl * 256; ldn = 1024;
            dst = WdT + (size_t)e * 1024 * 256; ldk = 256; k0 = kt * 64; rowmap = 0; n0 = ntl * 256; }
        __syncthreads();
#pragma unroll
        for (int i = 0; i < 8; ++i) { const int k = 8 * F.wave + i; const f32x4 v = *(const f32x4*)(src + (size_t)k * ldn + 4 * F.lane);
            u32x2 o; o.x = pk2(v[0], v[1]); o.y = pk2(v[2], v[3]); *(LAS u32x2*)(tile + k * TP + 4 * F.lane) = o; }
        __syncthreads();
        { const int n = F.tid >> 1, kh = F.tid & 1;
          u32x4 o[4];
#pragma unroll
          for (int q = 0; q < 4; ++q) { unsigned wds[4];
#pragma unroll
              for (int j = 0; j < 4; ++j) { const int k = 32 * kh + 8 * q + 2 * j; wds[j] = (unsigned)tile[k * TP + n] | ((unsigned)tile[(k + 1) * TP + n] << 16); }
              o[q] = (u32x4){wds[0], wds[1], wds[2], wds[3]}; }
          const int drow = rowmap == 0 ? n0 + n : ((n >> 7) * 256 + (n & 127) + (rowmap == 2 ? 128 : 0));
          bf16_t* dp = dst + (size_t)drow * ldk + k0 + 32 * kh;
#pragma unroll
          for (int q = 0; q < 4; ++q) *(u32x4*)(dp + 8 * q) = o[q]; }
    }
}

DI void phase_hrows(const Params& p, const Ctx& F) {
    const float* mod = (const float*)(p.ws + WS_MOD); const float* g = p.in[I_GPRE1]; bf16_t* H = (bf16_t*)(p.ws + WS_H);
    const int gw = F.bid * NWAVES + F.wave, NGW = F.G * NWAVES;
    for (int row = gw; row < MR; row += NGW) {
        const float* src = row < NT ? p.in[I_X] + (size_t)row * D : p.in[I_CTX] + (size_t)(row - NT) * D;
        const int bt = row < NT ? row / SEQ : 4;
        const f32x4* xr = (const f32x4*)src + F.lane;
        f32x4 v[4]; float ss = 0.f;
#pragma unroll
        for (int j = 0; j < 4; ++j) { v[j] = xr[64 * j]; ss += (v[j].x * v[j].x + v[j].y * v[j].y) + (v[j].z * v[j].z + v[j].w * v[j].w); }
        const float rstd = 1.f / sqrtf(wave_sum(ss) * (1.f / D) + 1e-6f);
        unsigned long long* o8 = (unsigned long long*)(H + (size_t)row * D) + F.lane;
#pragma unroll
        for (int j = 0; j < 4; ++j) { const int col = 4 * (F.lane + 64 * j);
            const f32x4 gg = *(const f32x4*)(g + col), sh = *(const f32x4*)(mod + bt * 6144 + col), sc = *(const f32x4*)(mod + bt * 6144 + 1024 + col);
            const f32x4 h = v[j] * rstd * gg * (sc + 1.f) + sh;
            o8[64 * j] = (unsigned long long)pk2(h.x, h.y) | ((unsigned long long)pk2(h.z, h.w) << 32); }
    }
}

DI void phase_gemm1(const Params& p, const Ctx& F) {
    pg8::StaticOrder S; S.init(p.ws + WS_H, p.ws + WS_WINT, MR, DINP, 1024, F.G, F.bid);
    pg8::EpiBf16 E{(bf16_t*)(p.ws + WS_Z), DINP};
    pg8::gemm_phase<pg8::EpiBf16, pg8::StaticOrder, false>(F.lds, 1024, S, E);
}

DI void phase_prep(const Params& p, const Ctx& F) {
    const bf16_t* Z = (const bf16_t*)(p.ws + WS_Z);
    bf16_t* Kc = (bf16_t*)(p.ws + WS_KC); bf16_t* Vc = (bf16_t*)(p.ws + WS_VC); bf16_t* Rc = (bf16_t*)(p.ws + WS_RC);
    bf16_t* A0 = (bf16_t*)(p.ws + WS_A0); bf16_t* A1 = (bf16_t*)(p.ws + WS_A1); bf16_t* L0 = (bf16_t*)(p.ws + WS_L0); bf16_t* L1 = (bf16_t*)(p.ws + WS_L1);
    bf16_t* GATE = (bf16_t*)((unsigned char*)p.out + DO_GATE); bf16_t* BV = (bf16_t*)((unsigned char*)p.out + DO_BV);
    const float* conv = p.in[I_CONV];
    LAS float* sl = (LAS float*)F.lds;
    const int t = F.tid;
    for (int it = F.bid; it < MR / 8; it += F.G) {
        const int row0 = it * 8;
        __syncthreads();
        for (int i = t; i < 8 * 384; i += NTHREADS) { const int rr = i / 384, c = i % 384; const float zv = bf2f(Z[(size_t)(row0 + rr) * DINP + OFF_WD + c]);
            sl[i] = c < 128 ? tanhf(zv) : (c < 256 ? zv : sigmoidf_(zv)); }
        __syncthreads();
        float dw0[8], dw1[8], da0[8], da1[8], gt[8];
#pragma unroll
        for (int r = 0; r < 8; ++r) { dw0[r] = dw1[r] = da0[r] = da1[r] = gt[r] = 0.f; }
        for (int l = 0; l < 64; ++l) {
            const float u0 = p.in[I_DUP][(size_t)l * 512 + t], u1 = p.in[I_DUP][(size_t)(64 + l) * 512 + t];
            const float v0 = p.in[I_AUP][(size_t)l * 512 + t], v1 = p.in[I_AUP][(size_t)(64 + l) * 512 + t];
            const float g0 = p.in[I_GUP][(size_t)l * 512 + t], g1 = p.in[I_GUP][(size_t)(64 + l) * 512 + t];
#pragma unroll
            for (int r = 0; r < 8; ++r) { const LAS float* s = sl + r * 384;
                dw0[r] += s[l] * u0; dw1[r] += s[64 + l] * u1; da0[r] += s[128 + l] * v0; da1[r] += s[192 + l] * v1; gt[r] += s[256 + l] * g0 + s[320 + l] * g1; }
        }
        const float w00 = p.in[I_DW0][t], w01 = p.in[I_DW0][512 + t], a00 = p.in[I_A0][t], a01 = p.in[I_A0][512 + t];
        const float ka0 = p.in[I_KA][t], ka1 = p.in[I_KA][512 + t], rk = p.in[I_RK][t];
#pragma unroll 1
        for (int r = 0; r < 8; ++r) {
            const int row = row0 + r;
            float cv[3] = {0.f, 0.f, 0.f};
            if (row < NT) {
                const int tb = row % SEQ, gy = tb / 64, gx = tb % 64;
#pragma unroll
                for (int dy = 0; dy < 3; ++dy) { const int ny = gy + dy - 1; if (ny < 0 || ny >= 128) continue;
#pragma unroll
                    for (int dx = 0; dx < 3; ++dx) { const int nx = gx + dx - 1; if (nx < 0 || nx >= 64) continue;
                        const size_t nrow = (size_t)(row + (dy - 1) * 64 + (dx - 1));
#pragma unroll
                        for (int s3 = 0; s3 < 3; ++s3) cv[s3] += bf2f(Z[nrow * DINP + s3 * 512 + t]) * conv[(dy * 3 + dx) * 1536 + s3 * 512 + t]; } }
            } else {
                const int tb = (row - NT) % CTXL;
#pragma unroll
                for (int dx = 0; dx < 3; ++dx) { const int nx = tb + dx - 1; if (nx < 0 || nx >= CTXL) continue;
                    const size_t nrow = (size_t)(row + dx - 1);
#pragma unroll
                    for (int s3 = 0; s3 < 3; ++s3) cv[s3] += bf2f(Z[nrow * DINP + s3 * 512 + t]) * conv[(3 + dx) * 1536 + s3 * 512 + t]; }
            }
            const float k = cv[0], v = cv[1], rr = cv[2];
            const float wl0 = w00 + dw0[r], wl1 = w01 + dw1[r];
            const float lg0 = -__expf(-softplusf_(-wl0) - 0.5f), lg1 = -__expf(-softplusf_(-wl1) - 0.5f);
            const float a0 = sigmoidf_(a00 + da0[r]), a1 = sigmoidf_(a01 + da1[r]);
            const size_t o = (size_t)row * 512 + t;
            Kc[o] = (bf16_t)f2bf(k); Vc[o] = (bf16_t)f2bf(v); Rc[o] = (bf16_t)f2bf(rr);
            A0[o] = (bf16_t)f2bf(a0); A1[o] = (bf16_t)f2bf(a1); L0[o] = (bf16_t)f2bf(lg0); L1[o] = (bf16_t)f2bf(lg1);
            if (row < NT) {
                const float km0 = k * (1.f + (a0 - 1.f) * ka0), km1 = k * (1.f + (a1 - 1.f) * ka1);
                const float bon = wave_sum(rr * (km0 + km1) * rk);
                GATE[o] = (bf16_t)f2bf(gt[r]); BV[o] = (bf16_t)f2bf(bon * v);
            }
        }
    }
}


constexpr int ZS_TOKB = 400, ZS_ROWB = 66 * ZS_TOKB, ZS_BYTES = 3 * ZS_ROWB;
constexpr int XS_OFF = ZS_BYTES, XS_ARR = 64 * 144, XSG_OFF = XS_OFF + 4 * XS_ARR, XSG_PITCH = 272, BON_OFF = XSG_OFF + 64 * XSG_PITCH;
constexpr int CWL_OFF = BON_OFF + 1024;
static_assert(CWL_OFF + 6912 <= LDS_MISC, "prep LDS");
struct PrepLd { u32x4 zv[9]; u32x4 hv; u32x4 xv[6]; };
DI void prep_issue(PrepLd& L, const bf16_t* Z, int item, int tidv) {
    const int h = item & 7, ck = item >> 3; const bool lat = ck < 512;
    const int b = lat ? ck >> 7 : (ck - 512) >> 2, c = lat ? ck & 127 : (ck - 512) & 3;
    const int rowbase = lat ? b * SEQ + c * 64 : NT + b * CTXL + c * 64;
    const int q8 = tidv & 7, tsl = tidv >> 3;
    const bf16_t* zc = Z + (size_t)(rowbase + tsl) * DINP + 64 * h + 8 * q8;
#pragma unroll
    for (int rr = 0; rr < 3; ++rr) {
        const bool ok = lat ? (c + rr - 1 >= 0 && c + rr - 1 < 128) : (rr == 1);
        const bf16_t* zr = ok ? zc + (long)(rr - 1) * 64 * DINP : zc;
#pragma unroll
        for (int sec = 0; sec < 3; ++sec) { const u32x4 v = *(const u32x4*)(zr + sec * 512); L.zv[rr * 3 + sec] = ok ? v : (u32x4){0u, 0u, 0u, 0u}; }
    }
    {
      const int hq8 = tidv & 7, hsec = (tidv >> 3) % 3, hside = (tidv >> 3) / 3 & 1, hrr = (tidv >> 3) / 6;
      const int tx = c * 64 + (hside ? 64 : -1);
      const bool ok = !lat && tidv < 144 && hrr == 1 && tx >= 0 && tx < CTXL;
      const size_t off = ok ? (size_t)(NT + b * CTXL + tx) * DINP + hsec * 512 + 64 * h + 8 * hq8 : 0;
      const u32x4 v = *(const u32x4*)(Z + off); L.hv = ok ? v : (u32x4){0u, 0u, 0u, 0u}; }
    const bf16_t* zx = Z + (size_t)(rowbase + tsl) * DINP + OFF_WD + 8 * q8;
#pragma unroll
    for (int it = 0; it < 6; ++it) L.xv[it] = *(const u32x4*)(zx + 64 * it);
}
DI void phase_prep2(const Params& p, const Ctx& F) {
    const bf16_t* Z = (const bf16_t*)(p.ws + WS_Z);
    bf16_t* Kc = (bf16_t*)(p.ws + WS_KC); bf16_t* Vc = (bf16_t*)(p.ws + WS_VC); bf16_t* Rc = (bf16_t*)(p.ws + WS_RC);
    bf16_t* A0 = (bf16_t*)(p.ws + WS_A0); bf16_t* A1 = (bf16_t*)(p.ws + WS_A1); bf16_t* L0 = (bf16_t*)(p.ws + WS_L0); bf16_t* L1 = (bf16_t*)(p.ws + WS_L1);
    bf16_t* GATE = (bf16_t*)((unsigned char*)p.out + DO_GATE); bf16_t* BV = (bf16_t*)((unsigned char*)p.out + DO_BV);
    const bf16_t* DupT = (const bf16_t*)(p.ws + WS_DUPT); const bf16_t* AupT = (const bf16_t*)(p.ws + WS_AUPT); const bf16_t* GupT = (const bf16_t*)(p.ws + WS_GUPT);
    const float* cw2 = (const float*)(p.ws + WS_CONVW);
    LAS unsigned char* ZS = F.lds; LAS float* BON = (LAS float*)(F.lds + BON_OFF);
    const int w = F.wave, fr0 = F.lane & 15, fq0 = F.lane >> 4, ct = w >> 1, tt0 = 2 * (w & 1);
    constexpr int NITEM = 528 * 8;
    const bool xmap = (F.G == 256);
    auto item_of = [&](int i) -> int { if (!xmap) { const int it = F.bid + i * F.G; return it < NITEM ? it : -1; }
        const int x = F.bid & 7, y = F.bid >> 3, j = y + 32 * i; return j < 528 ? (x * 66 + (j >> 3)) * 8 + (j & 7) : -1; };
    PrepLd L;
    bf16x8 wf[4][2], gf[4]; f32x4 w00, w01, a00, a01, ka0, ka1, rk; int hcur = -1;
    int itx = 0, item = item_of(0);
    if (item >= 0) prep_issue(L, Z, item, F.tid);
    for (; item >= 0; ) {
        const int item_next = item_of(++itx);
        const int h = item & 7, ck = item >> 3;
        const bool lat = ck < 512;
        const int b = lat ? ck >> 7 : (ck - 512) >> 2, c = lat ? ck & 127 : (ck - 512) & 3;
        const int rowbase = lat ? b * SEQ + c * 64 : NT + b * CTXL + c * 64;
        int tidv = F.tid, fr = fr0, fq = fq0; asm volatile("" : "+v"(tidv), "+v"(fr), "+v"(fq));
        __syncthreads();
        { const int q8 = tidv & 7, tsl = tidv >> 3;
#pragma unroll
          for (int rr = 0; rr < 3; ++rr)
#pragma unroll
              for (int sec = 0; sec < 3; ++sec) *(LAS u32x4*)(ZS + rr * ZS_ROWB + (tsl + 1) * ZS_TOKB + sec * 128 + q8 * 16) = L.zv[rr * 3 + sec];
          if (tidv < 144) { const int hsec = (tidv >> 3) % 3, hside = (tidv >> 3) / 3 & 1, hrr = (tidv >> 3) / 6;
              *(LAS u32x4*)(ZS + hrr * ZS_ROWB + (hside ? 65 : 0) * ZS_TOKB + hsec * 128 + q8 * 16) = L.hv; }
#pragma unroll
          for (int it = 0; it < 6; ++it) {
              float f[8];
#pragma unroll
              for (int j = 0; j < 4; ++j) { f[2 * j] = bflo(L.xv[it][j]); f[2 * j + 1] = bfhi(L.xv[it][j]); }
              if (it < 2) {
#pragma unroll
                  for (int j = 0; j < 8; ++j) f[j] = tanh_fast(f[j]);
              } else if (it >= 4) {
#pragma unroll
                  for (int j = 0; j < 8; ++j) f[j] = sigmoidf_(f[j]);
              }
              const u32x4 o = (u32x4){pk2(f[0], f[1]), pk2(f[2], f[3]), pk2(f[4], f[5]), pk2(f[6], f[7])};
              if (it < 4) *(LAS u32x4*)(F.lds + XS_OFF + it * XS_ARR + tsl * 144 + q8 * 16) = o;
              else *(LAS u32x4*)(F.lds + XSG_OFF + tsl * XSG_PITCH + ((it - 4) * 8 + q8) * 16) = o; } }
        if (h != hcur) {
            hcur = h;
            const int chrow = 64 * h + 16 * ct + fr, gch0 = 64 * h + 16 * ct + 4 * fq;
#pragma unroll
            for (int q = 0; q < 4; ++q) { const bf16_t* WT = (q < 2 ? DupT : AupT) + ((size_t)(q & 1) * 512 + chrow) * 64;
#pragma unroll
                for (int s2 = 0; s2 < 2; ++s2) wf[q][s2] = *(const bf16x8*)(WT + 32 * s2 + 8 * fq); }
#pragma unroll
            for (int s2 = 0; s2 < 4; ++s2) gf[s2] = *(const bf16x8*)(GupT + (size_t)chrow * 128 + 32 * s2 + 8 * fq);
            w00 = *(const f32x4*)(p.in[I_DW0] + gch0); w01 = *(const f32x4*)(p.in[I_DW0] + 512 + gch0); a00 = *(const f32x4*)(p.in[I_A0] + gch0); a01 = *(const f32x4*)(p.in[I_A0] + 512 + gch0);
            ka0 = *(const f32x4*)(p.in[I_KA] + gch0); ka1 = *(const f32x4*)(p.in[I_KA] + 512 + gch0); rk = *(const f32x4*)(p.in[I_RK] + gch0);
            if (tidv < 432) *(LAS f32x4*)(F.lds + CWL_OFF + tidv * 16) = *(const f32x4*)(cw2 + (size_t)h * 16 * 108 + tidv * 4);
        }
        if (item_next >= 0) prep_issue(L, Z, item_next, tidv);
        const int gch = 64 * h + 16 * ct + 4 * fq;
        const LAS float* cwl = (const LAS float*)(F.lds + CWL_OFF) + (4 * ct + fq) * 108;
        __syncthreads();
        f32x4 vkeep[2];
#pragma unroll 1
        for (int t2 = 0; t2 < 2; ++t2) {
            const int tok = 16 * (tt0 + t2) + fr;
            f32x4 acc[5];
#pragma unroll
            for (int q = 0; q < 5; ++q) acc[q] = (f32x4){0.f, 0.f, 0.f, 0.f};
#pragma unroll
            for (int q = 0; q < 4; ++q) {
#pragma unroll
                for (int s2 = 0; s2 < 2; ++s2) { const bf16x8 bfr = *(const LAS bf16x8*)(F.lds + XS_OFF + q * XS_ARR + tok * 144 + (32 * s2 + 8 * fq) * 2);
                    acc[q] = __builtin_amdgcn_mfma_f32_16x16x32_bf16(wf[q][s2], bfr, acc[q], 0, 0, 0); }
            }
#pragma unroll
            for (int s2 = 0; s2 < 4; ++s2) { const bf16x8 bfr = *(const LAS bf16x8*)(F.lds + XSG_OFF + tok * XSG_PITCH + (32 * s2 + 8 * fq) * 2);
                acc[4] = __builtin_amdgcn_mfma_f32_16x16x32_bf16(gf[s2], bfr, acc[4], 0, 0, 0); }
            f32x4 cv[3];
#pragma unroll
            for (int s3 = 0; s3 < 3; ++s3) cv[s3] = (f32x4){0.f, 0.f, 0.f, 0.f};
#pragma unroll
            for (int dy = 0; dy < 3; ++dy)
#pragma unroll
                for (int dx = 0; dx < 3; ++dx) {
#pragma unroll
                    for (int s3 = 0; s3 < 3; ++s3) { const f32x4 wv = *(const LAS f32x4*)(cwl + ((dy * 3 + dx) * 3 + s3) * 4);
                        const u32x2 zz = *(const LAS u32x2*)(ZS + dy * ZS_ROWB + (tok + dx) * ZS_TOKB + s3 * 128 + (16 * ct + 4 * fq) * 2);
                        cv[s3] += (f32x4){bflo(zz.x), bfhi(zz.x), bflo(zz.y), bfhi(zz.y)} * wv; }
                }
            const size_t o = (size_t)(rowbase + tok) * 512 + gch;
            float lg0[4], lg1[4], a0[4], a1[4]; float bs = 0.f;
#pragma unroll
            for (int i = 0; i < 4; ++i) { const float wl0 = w00[i] + acc[0][i], wl1 = w01[i] + acc[1][i];
                lg0[i] = -__expf(-softplusf_(-wl0) - 0.5f); lg1[i] = -__expf(-softplusf_(-wl1) - 0.5f);
                a0[i] = sigmoidf_(a00[i] + acc[2][i]); a1[i] = sigmoidf_(a01[i] + acc[3][i]);
                const float k = cv[0][i]; const float km0 = k * (1.f + (a0[i] - 1.f) * ka0[i]), km1 = k * (1.f + (a1[i] - 1.f) * ka1[i]);
                bs += cv[2][i] * (km0 + km1) * rk[i]; }
            bs += __shfl_xor(bs, 16); bs += __shfl_xor(bs, 32);
            u32x2 wv2;
            wv2.x = pk2(cv[0][0], cv[0][1]); wv2.y = pk2(cv[0][2], cv[0][3]); *(u32x2*)(Kc + o) = wv2;
            wv2.x = pk2(cv[1][0], cv[1][1]); wv2.y = pk2(cv[1][2], cv[1][3]); *(u32x2*)(Vc + o) = wv2;
            wv2.x = pk2(cv[2][0], cv[2][1]); wv2.y = pk2(cv[2][2], cv[2][3]); *(u32x2*)(Rc + o) = wv2;
            wv2.x = pk2(a0[0], a0[1]); wv2.y = pk2(a0[2], a0[3]); *(u32x2*)(A0 + o) = wv2;
            wv2.x = pk2(a1[0], a1[1]); wv2.y = pk2(a1[2], a1[3]); *(u32x2*)(A1 + o) = wv2;
            wv2.x = pk2(lg0[0], lg0[1]); wv2.y = pk2(lg0[2], lg0[3]); *(u32x2*)(L0 + o) = wv2;
            wv2.x = pk2(lg1[0], lg1[1]); wv2.y = pk2(lg1[2], lg1[3]); *(u32x2*)(L1 + o) = wv2;
            if (lat) { wv2.x = pk2(acc[4][0], acc[4][1]); wv2.y = pk2(acc[4][2], acc[4][3]); *(u32x2*)(GATE + o) = wv2; }
            if (fq == 0) BON[tok * 4 + ct] = bs;
            if (t2 == 0) vkeep[0] = cv[1]; else vkeep[1] = cv[1];
        }
        __syncthreads();
        if (lat) {
#pragma unroll
            for (int t2 = 0; t2 < 2; ++t2) { const int tok = 16 * (tt0 + t2) + fr; const f32x4 bq = *(const LAS f32x4*)(BON + tok * 4); const float bon = (bq[0] + bq[1]) + (bq[2] + bq[3]);
                const size_t o = (size_t)(rowbase + tok) * 512 + gch;
                u32x2 wv2; wv2.x = pk2(bon * vkeep[t2][0], bon * vkeep[t2][1]); wv2.y = pk2(bon * vkeep[t2][2], bon * vkeep[t2][3]); *(u32x2*)(BV + o) = wv2; }
        }
        item = item_next;
    }
}

DI void phase_gmlp(const Params& p, const Ctx& F) {
    const bf16_t* Z = (const bf16_t*)(p.ws + WS_Z); const bf16_t* Wsp = (const bf16_t*)(p.ws + WS_WSP);
    bf16_t* MIXED = (bf16_t*)((unsigned char*)p.out + DO_MIXED);
    constexpr int LDV = 136;
    LAS bf16_t* vnT = (LAS bf16_t*)F.lds;
    LAS float* gu = (LAS float*)(F.lds + 17408);
    constexpr int LDG = 68;
    const int fr = F.lane & 15, fq = F.lane >> 4;
    for (int un = F.bid; un < 4 * 64 * 8; un += F.G) {
        const int g = un & 7, cc = (un >> 3) & 63, b = un >> 9;
        const size_t tok0 = (size_t)b * SEQ + cc * 128;
        __syncthreads();
        { const int pq = F.tid >> 2, seg = F.tid & 3;
          const bf16_t* zr = Z + (tok0 + pq) * DINP;
          const u32x4 ua = *(const u32x4*)(zr + OFF_U + 64 * g + 16 * seg), ub = *(const u32x4*)(zr + OFF_U + 64 * g + 16 * seg + 8);
          const u32x4 va = *(const u32x4*)(zr + OFF_VA + 64 * g + 16 * seg), vb = *(const u32x4*)(zr + OFF_VA + 64 * g + 16 * seg + 8);
          float u[16], v[16];
#pragma unroll
          for (int j = 0; j < 4; ++j) { u[2 * j] = bflo(ua[j]); u[2 * j + 1] = bfhi(ua[j]); u[8 + 2 * j] = bflo(ub[j]); u[8 + 2 * j + 1] = bfhi(ub[j]);
              v[2 * j] = bflo(va[j]); v[2 * j + 1] = bfhi(va[j]); v[8 + 2 * j] = bflo(vb[j]); v[8 + 2 * j + 1] = bfhi(vb[j]); }
          float s = 0.f;
#pragma unroll
          for (int j = 0; j < 16; ++j) { u[j] = gelu_tanh(u[j]); v[j] = gelu_tanh(v[j]); s += v[j]; }
          s += __shfl_xor(s, 1); s += __shfl_xor(s, 2);
          const float mu = s * (1.f / 64.f); float q = 0.f;
#pragma unroll
          for (int j = 0; j < 16; ++j) { v[j] -= mu; q += v[j] * v[j]; }
          q += __shfl_xor(q, 1); q += __shfl_xor(q, 2);
          const float rstd = 1.f / sqrtf(q * (1.f / 64.f) + 1e-5f);
#pragma unroll
          for (int j = 0; j < 16; ++j) { const int ch = 16 * seg + j; const float vn = v[j] * rstd * p.in[I_GMLNG][64 * g + ch] + p.in[I_GMLNB][64 * g + ch];
              vnT[ch * LDV + pq] = (bf16_t)f2bf(vn); gu[pq * LDG + ch] = u[j]; }
        }
        __syncthreads();
        f32x4 acc[4];
#pragma unroll
        for (int n = 0; n < 4; ++n) acc[n] = (f32x4){0.f, 0.f, 0.f, 0.f};
        const int pp = 16 * F.wave + fr;
#pragma unroll
        for (int s = 0; s < 4; ++s) {
            const bf16x8 bfrag = *(const bf16x8*)(Wsp + ((size_t)(g * 128 + pp)) * 128 + 32 * s + 8 * fq);
#pragma unroll
            for (int n = 0; n < 4; ++n) { const bf16x8 afrag = *(const LAS bf16x8*)(vnT + (16 * n + fr) * LDV + 32 * s + 8 * fq);
                acc[n] = __builtin_amdgcn_mfma_f32_16x16x32_bf16(afrag, bfrag, acc[n], 0, 0, 0); }
        }
        const float bs = p.in[I_BSP][g * 128 + pp];
#pragma unroll
        for (int n = 0; n < 4; ++n) { const int d0 = 16 * n + 4 * fq; const f32x4 gv = *(const LAS f32x4*)(gu + pp * LDG + d0);
            const f32x4 o = gv * (acc[n] + bs);
            u32x2 w; w.x = pk2(o[0], o[1]); w.y = pk2(o[2], o[3]);
            *(u32x2*)(MIXED + (tok0 + pp) * D + 64 * g + d0) = w; }
    }
}

DI void phase_scan_seq(const Params& p, const Ctx& F) {
    const bf16_t* Kc = (const bf16_t*)(p.ws + WS_KC); const bf16_t* Vc = (const bf16_t*)(p.ws + WS_VC); const bf16_t* Rc = (const bf16_t*)(p.ws + WS_RC);
    float* YS = (float*)(p.ws + WS_YS);
    const int vrow = F.tid >> 3, q = F.tid & 7;
    for (int ch = F.bid; ch < 64; ch += F.G) {
        const int d = ch & 1, h = (ch >> 1) & 7, b = ch >> 4;
        const bf16_t* Ad = (const bf16_t*)(p.ws + (d ? WS_A1 : WS_A0)); const bf16_t* Ld = (const bf16_t*)(p.ws + (d ? WS_L1 : WS_L0));
        float kkw[8], kaw[8];
#pragma unroll
        for (int j = 0; j < 8; ++j) { kkw[j] = p.in[I_KK][64 * h + 8 * q + j]; kaw[j] = p.in[I_KA][d * 512 + 64 * h + 8 * q + j]; }
        float S[8];
#pragma unroll
        for (int j = 0; j < 8; ++j) S[j] = 0.f;
        const int TOT = CTXL + SEQ;
        for (int step = 0; step < TOT; ++step) {
            size_t row;
            if (step < CTXL) { const int tc = d ? (CTXL - 1 - step) : step; row = (size_t)NT + b * CTXL + tc; }
            else { const int tl = d ? (SEQ - 1 - (step - CTXL)) : (step - CTXL); row = (size_t)b * SEQ + tl; }
            const size_t o = row * 512 + 64 * h + 8 * q;
            const u32x4 kq = *(const u32x4*)(Kc + o), rq = *(const u32x4*)(Rc + o), aq = *(const u32x4*)(Ad + o), lq = *(const u32x4*)(Ld + o);
            const float vv = bf2f(Vc[row * 512 + 64 * h + vrow]);
            float k[8], r[8], a[8], l[8];
#pragma unroll
            for (int j = 0; j < 4; ++j) { k[2 * j] = bflo(kq[j]); k[2 * j + 1] = bfhi(kq[j]); r[2 * j] = bflo(rq[j]); r[2 * j + 1] = bfhi(rq[j]);
                a[2 * j] = bflo(aq[j]); a[2 * j + 1] = bfhi(aq[j]); l[2 * j] = bflo(lq[j]); l[2 * j + 1] = bfhi(lq[j]); }
            float kk[8], ss = 0.f;
#pragma unroll
            for (int j = 0; j < 8; ++j) { kk[j] = k[j] * kkw[j]; ss += kk[j] * kk[j]; }
            ss += __shfl_xor(ss, 1); ss += __shfl_xor(ss, 2); ss += __shfl_xor(ss, 4);
            const float rn = 1.f / sqrtf(fmaxf(ss, 1e-24f));
            float dot = 0.f;
#pragma unroll
            for (int j = 0; j < 8; ++j) { kk[j] *= rn; dot += S[j] * kk[j]; }
            dot += __shfl_xor(dot, 1); dot += __shfl_xor(dot, 2); dot += __shfl_xor(dot, 4);
            float y = 0.f;
#pragma unroll
            for (int j = 0; j < 8; ++j) { const float w = __expf(l[j]); const float km = k[j] * (1.f + (a[j] - 1.f) * kaw[j]);
                S[j] = S[j] * w - dot * (kk[j] * a[j]) + vv * km; y += S[j] * r[j]; }
            y += __shfl_xor(y, 1); y += __shfl_xor(y, 2); y += __shfl_xor(y, 4);
            if (step >= CTXL && q == 0) YS[((size_t)d * NT + row) * 512 + 64 * h + vrow] = y;
        }
    }
}


constexpr int LDP = 72;
constexpr int SLOTB = 64 * LDP * 2;
constexpr int CP_CUM = 12 * SLOTB, CP_TOT = CP_CUM + 16384, CP_ADIAG = CP_TOT + 2048, CP_GC = CP_ADIAG + 4096;

DI void mm64(f32x4 (&acc)[2], const LAS bf16_t* P, const LAS bf16_t* Q, int r0, int c0, int fr, int fq) {
#pragma unroll
    for (int s = 0; s < 2; ++s) { const bf16x8 b = *(const LAS bf16x8*)(Q + (c0 + fr) * LDP + 32 * s + 8 * fq);
#pragma unroll
        for (int m = 0; m < 2; ++m) { const bf16x8 a = *(const LAS bf16x8*)(P + (r0 + 16 * m + fr) * LDP + 32 * s + 8 * fq);
            acc[m] = __builtin_amdgcn_mfma_f32_16x16x32_bf16(a, b, acc[m], 0, 0, 0); } }
}
DI void zero2(f32x4 (&a)[2]) { a[0] = (f32x4){0.f, 0.f, 0.f, 0.f}; a[1] = a[0]; }
DI void writeT(LAS bf16_t* dst, const f32x4 (&acc)[2], int r0, int c0, int fr, int fq) {
#pragma unroll
    for (int m = 0; m < 2; ++m) { u32x2 w; w.x = pk2(acc[m][0], acc[m][1]); w.y = pk2(acc[m][2], acc[m][3]); *(LAS u32x2*)(dst + (c0 + fr) * LDP + r0 + 16 * m + 4 * fq) = w; }
}
DI void writeN(LAS bf16_t* dst, const f32x4 (&acc)[2], int r0, int c0, int fr, int fq) {
#pragma unroll
    for (int m = 0; m < 2; ++m)
#pragma unroll
        for (int i = 0; i < 4; ++i) dst[(r0 + 16 * m + 4 * fq + i) * LDP + c0 + fr] = (bf16_t)f2bf(acc[m][i]);
}
DI size_t chunk_row(int d, int b, int pc, int pp) {
    const int base = pc < 4 ? NT + b * CTXL : b * SEQ, len = pc < 4 ? CTXL : SEQ, q = 64 * (pc < 4 ? pc : pc - 4) + pp;
    return (size_t)(d ? base + len - 1 - q : base + q);
}

DI void phase_chunkprep(const Params& p, const Ctx& F) {
    const bf16_t* Kc = (const bf16_t*)(p.ws + WS_KC); const bf16_t* Vc = (const bf16_t*)(p.ws + WS_VC); const bf16_t* Rc = (const bf16_t*)(p.ws + WS_RC);
    unsigned char* OPS = p.ws + WS_OPS;
    LAS bf16_t* SL[12];
#pragma unroll
    for (int i = 0; i < 12; ++i) SL[i] = (LAS bf16_t*)(F.lds + i * SLOTB);
    LAS float* CUM = (LAS float*)(F.lds + CP_CUM); LAS float* TOT = (LAS float*)(F.lds + CP_TOT); LAS float* ADIAG = (LAS float*)(F.lds + CP_ADIAG); LAS float* GC = (LAS float*)(F.lds + CP_GC);
    const int w = F.wave, fr = F.lane & 15, fq = F.lane >> 4, r0 = 32 * (w >> 2), c0 = 16 * (w & 3);
    const int pp = F.tid >> 3, cg8 = F.tid & 7;
    const bool fixedmap = (F.G == 256);
    auto unit_of = [&](int i) -> int { if (fixedmap) return i < 33 ? (F.bid >> 2) * 132 + (F.bid & 3) * 33 + i : -1; const int u = F.bid + i * F.G; return u < 2 * 32 * 132 ? u : -1; };
    struct RawLd { u32x4 kq, vq, rq, aq, lq; };
    auto raw_issue = [&](RawLd& R, int unit) { const int d = unit / (32 * 132), chain = (unit / 132) & 31, pc = unit % 132, b = chain >> 3, h = chain & 7;
        const size_t o = chunk_row(d, b, pc, pp) * 512 + 64 * h + 8 * cg8;
        R.kq = *(const u32x4*)(Kc + o); R.vq = *(const u32x4*)(Vc + o); R.rq = *(const u32x4*)(Rc + o);
        R.aq = *(const u32x4*)((const bf16_t*)(p.ws + (d ? WS_A1 : WS_A0)) + o); R.lq = *(const u32x4*)((const bf16_t*)(p.ws + (d ? WS_L1 : WS_L0)) + o); };
    RawLd R;
    float kkw[8], kaw[8]; int hdcur = -1;
    int uix = 0, unit = unit_of(0);
    if (unit >= 0) raw_issue(R, unit);
    for (; unit >= 0; ) {
        const int unit_next = unit_of(++uix);
        const int d = unit / (32 * 132), chain = (unit / 132) & 31, pc = unit % 132, b = chain >> 3, h = chain & 7;
        if (d * 8 + h != hdcur) { hdcur = d * 8 + h;
#pragma unroll
            for (int j = 0; j < 8; ++j) { kkw[j] = p.in[I_KK][64 * h + 8 * cg8 + j]; kaw[j] = p.in[I_KA][d * 512 + 64 * h + 8 * cg8 + j]; } }
        __syncthreads();
        float kk[8], km[8], ka[8], vv[8], rr[8], ll[8];
        { float k[8], a[8]; float ss = 0.f;
#pragma unroll
          for (int j = 0; j < 4; ++j) { k[2 * j] = bflo(R.kq[j]); k[2 * j + 1] = bfhi(R.kq[j]); vv[2 * j] = bflo(R.vq[j]); vv[2 * j + 1] = bfhi(R.vq[j]); rr[2 * j] = bflo(R.rq[j]); rr[2 * j + 1] = bfhi(R.rq[j]);
              a[2 * j] = bflo(R.aq[j]); a[2 * j + 1] = bfhi(R.aq[j]); ll[2 * j] = bflo(R.lq[j]); ll[2 * j + 1] = bfhi(R.lq[j]); }
          if (unit_next >= 0) raw_issue(R, unit_next);
#pragma unroll
          for (int j = 0; j < 8; ++j) { kk[j] = k[j] * kkw[j]; ss += kk[j] * kk[j]; }
          ss += __shfl_xor(ss, 1); ss += __shfl_xor(ss, 2); ss += __shfl_xor(ss, 4);
          const float rn = 1.f / sqrtf(fmaxf(ss, 1e-24f));
#pragma unroll
          for (int j = 0; j < 8; ++j) { kk[j] *= rn; km[j] = k[j] * (1.f + (a[j] - 1.f) * kaw[j]); ka[j] = kk[j] * a[j]; }
          *(LAS f32x4*)(CUM + pp * 64 + 8 * cg8) = (f32x4){ll[0], ll[1], ll[2], ll[3]}; *(LAS f32x4*)(CUM + pp * 64 + 8 * cg8 + 4) = (f32x4){ll[4], ll[5], ll[6], ll[7]}; }
        for (int i = F.tid; i < 2 * SLOTB / 4; i += NTHREADS) ((LAS unsigned*)(F.lds + 9 * SLOTB))[i] = 0u;
        __syncthreads();
        { const int ch = F.tid & 63, seg = F.tid >> 6; float run = 0.f;
#pragma unroll
          for (int i = 0; i < 8; ++i) { run += CUM[(8 * seg + i) * 64 + ch]; CUM[(8 * seg + i) * 64 + ch] = run; }
          TOT[seg * 64 + ch] = run; }
        __syncthreads();
        { const int ch = F.tid & 63, seg = F.tid >> 6; float off = 0.f;
          for (int s2 = 0; s2 < seg; ++s2) off += TOT[s2 * 64 + ch];
#pragma unroll
          for (int i = 0; i < 8; ++i) CUM[(8 * seg + i) * 64 + ch] += off;
          if (seg == 7) GC[ch] = off + TOT[7 * 64 + ch]; }
        __syncthreads();
        { float g[8], gc[8];
          { const f32x4 g0 = *(const LAS f32x4*)(CUM + pp * 64 + 8 * cg8), g1 = *(const LAS f32x4*)(CUM + pp * 64 + 8 * cg8 + 4);
            const f32x4 c0v = *(const LAS f32x4*)(GC + 8 * cg8), c1v = *(const LAS f32x4*)(GC + 8 * cg8 + 4);
#pragma unroll
            for (int j = 0; j < 4; ++j) { g[j] = g0[j]; g[4 + j] = g1[j]; gc[j] = c0v[j]; gc[4 + j] = c1v[j]; } }
          float kkg[8], rg[8], ki[8], kai[8], kd[8], kad[8];
#pragma unroll
          for (int j = 0; j < 8; ++j) { const float eg = __expf(g[j]), egp = __expf(g[j] - ll[j]), eng = __expf(-g[j]), ecg = __expf(gc[j] - g[j]);
              kkg[j] = kk[j] * egp; rg[j] = rr[j] * eg; ki[j] = km[j] * eng; kai[j] = ka[j] * eng; kd[j] = km[j] * ecg; kad[j] = ka[j] * ecg; }
          u32x4 w4;
          w4 = (u32x4){pk2(kkg[0], kkg[1]), pk2(kkg[2], kkg[3]), pk2(kkg[4], kkg[5]), pk2(kkg[6], kkg[7])}; *(LAS u32x4*)(SL[0] + pp * LDP + 8 * cg8) = w4;
          w4 = (u32x4){pk2(rg[0], rg[1]), pk2(rg[2], rg[3]), pk2(rg[4], rg[5]), pk2(rg[6], rg[7])}; *(LAS u32x4*)(SL[1] + pp * LDP + 8 * cg8) = w4;
          w4 = (u32x4){pk2(ki[0], ki[1]), pk2(ki[2], ki[3]), pk2(ki[4], ki[5]), pk2(ki[6], ki[7])}; *(LAS u32x4*)(SL[2] + pp * LDP + 8 * cg8) = w4;
          w4 = (u32x4){pk2(kai[0], kai[1]), pk2(kai[2], kai[3]), pk2(kai[4], kai[5]), pk2(kai[6], kai[7])}; *(LAS u32x4*)(SL[3] + pp * LDP + 8 * cg8) = w4;
#pragma unroll
          for (int j = 0; j < 8; ++j) { const int ch = 8 * cg8 + j;
              SL[4][ch * LDP + pp] = (bf16_t)f2bf(kkg[j]); SL[5][ch * LDP + pp] = (bf16_t)f2bf(vv[j]); SL[6][ch * LDP + pp] = (bf16_t)f2bf(kd[j]); SL[7][ch * LDP + pp] = (bf16_t)f2bf(kad[j]); } }
        __syncthreads();
        { f32x4 aAk[2], aAa[2], aBk[2], aBa[2]; zero2(aAk); zero2(aAa); zero2(aBk); zero2(aBa);
          mm64(aAk, SL[2], SL[0], r0, c0, fr, fq);
          mm64(aAa, SL[0], SL[3], r0, c0, fr, fq);
          mm64(aBk, SL[2], SL[1], r0, c0, fr, fq);
          mm64(aBa, SL[3], SL[1], r0, c0, fr, fq);
          __syncthreads();
          const int tcol = c0 + fr;
#pragma unroll
          for (int m = 0; m < 2; ++m)
#pragma unroll
              for (int i = 0; i < 4; ++i) { const int jr = r0 + 16 * m + 4 * fq + i;
                  aAk[m][i] = jr < tcol ? aAk[m][i] : 0.f; aBk[m][i] = jr <= tcol ? aBk[m][i] : 0.f; aBa[m][i] = jr <= tcol ? aBa[m][i] : 0.f; }
          writeT(SL[0], aAk, r0, c0, fr, fq); writeT(SL[8], aBk, r0, c0, fr, fq); writeT(SL[2], aBa, r0, c0, fr, fq);
          const int jb = w & 3;
#pragma unroll
          for (int m = 0; m < 2; ++m) { const int tb = 2 * (w >> 2) + m;
              if (tb == jb) {
#pragma unroll
                  for (int i = 0; i < 4; ++i) ADIAG[tb * 256 + (4 * fq + i) * 16 + fr] = (fr < 4 * fq + i) ? aAa[m][i] : 0.f; }
#pragma unroll
              for (int i = 0; i < 4; ++i) aAa[m][i] = tb > jb ? aAa[m][i] : 0.f; }
          writeT(SL[3], aAa, r0, c0, fr, fq);
        }
        __syncthreads();
        if (F.tid < 64) { const int blk = F.tid >> 4, c = F.tid & 15; const LAS float* A = ADIAG + blk * 256; float x[16];
#pragma unroll
            for (int r = 0; r < 16; ++r) { float sa = (r == c) ? 1.f : 0.f;
#pragma unroll
                for (int j = 0; j < r; ++j) sa -= A[r * 16 + j] * x[j];
                x[r] = sa; }
#pragma unroll
            for (int r = 0; r < 16; ++r) SL[9][(16 * blk + r) * LDP + 16 * blk + c] = (bf16_t)f2bf(x[r]);
            u32x4 lo = (u32x4){pk2(x[0], x[1]), pk2(x[2], x[3]), pk2(x[4], x[5]), pk2(x[6], x[7])}, hi = (u32x4){pk2(x[8], x[9]), pk2(x[10], x[11]), pk2(x[12], x[13]), pk2(x[14], x[15])};
            *(LAS u32x4*)(SL[10] + (16 * blk + c) * LDP + 16 * blk) = lo; *(LAS u32x4*)(SL[10] + (16 * blk + c) * LDP + 16 * blk + 8) = hi; }
        __syncthreads();
        f32x4 a1[2], a2[2], a3[2];
        zero2(a1); mm64(a1, SL[3], SL[9], r0, c0, fr, fq);
        __syncthreads();
        writeT(SL[11], a1, r0, c0, fr, fq);
        writeN(SL[3], a1, r0, c0, fr, fq);
        __syncthreads();
        zero2(a2); mm64(a2, SL[11], SL[3], r0, c0, fr, fq);
#pragma unroll
        for (int m = 0; m < 2; ++m)
#pragma unroll
            for (int i = 0; i < 4; ++i) a2[m][i] += (r0 + 16 * m + 4 * fq + i == c0 + fr) ? 1.f : 0.f;
        writeT(SL[9], a2, r0, c0, fr, fq);
        __syncthreads();
        zero2(a3); mm64(a3, SL[11], SL[9], r0, c0, fr, fq);
        a3[0] = a2[0] - a3[0]; a3[1] = a2[1] - a3[1];
        writeN(SL[3], a3, r0, c0, fr, fq);
        __syncthreads();
        zero2(a1); mm64(a1, SL[3], SL[10], r0, c0, fr, fq);
        zero2(a2); mm64(a2, SL[0], SL[5], r0, c0, fr, fq);
        writeN(SL[9], a1, r0, c0, fr, fq); writeT(SL[11], a2, r0, c0, fr, fq);
        __syncthreads();
        zero2(a1); mm64(a1, SL[9], SL[4], r0, c0, fr, fq);
        zero2(a2); mm64(a2, SL[9], SL[11], r0, c0, fr, fq);
        writeT(SL[3], a1, r0, c0, fr, fq); writeT(SL[10], a2, r0, c0, fr, fq);
        __syncthreads();
        unsigned char* ob = OPS + ((size_t)(d * 32 + chain) * 132 + pc) * 32768;
        const int fragoff = (((w & 3) * 2 + (w >> 2)) * 64 + F.lane) * 16;
        {
          zero2(a1); mm64(a1, SL[3], SL[2], r0, c0, fr, fq);
          u32x4 o;
#pragma unroll
          for (int m = 0; m < 2; ++m) { const u32x2 rgv = *(const LAS u32x2*)(SL[1] + (c0 + fr) * LDP + r0 + 16 * m + 4 * fq);
              const float q0 = bflo(rgv.x) - a1[m][0], q1 = bfhi(rgv.x) - a1[m][1], q2 = bflo(rgv.y) - a1[m][2], q3 = bfhi(rgv.y) - a1[m][3];
              o[2 * m] = pk2(q0, q1); o[2 * m + 1] = pk2(q2, q3); }
          *(u32x4*)(ob + fragoff) = o; }
        {
          zero2(a1); mm64(a1, SL[3], SL[7], r0, c0, fr, fq);
          const float gcv = __expf(GC[c0 + fr]); u32x4 o;
#pragma unroll
          for (int m = 0; m < 2; ++m) { float q[4];
#pragma unroll
              for (int i = 0; i < 4; ++i) q[i] = ((r0 + 16 * m + 4 * fq + i == c0 + fr) ? gcv : 0.f) - a1[m][i];
              o[2 * m] = pk2(q[0], q[1]); o[2 * m + 1] = pk2(q[2], q[3]); }
          *(u32x4*)(ob + 8192 + fragoff) = o; }
        {
          zero2(a1); mm64(a1, SL[8], SL[5], r0, c0, fr, fq); zero2(a2); mm64(a2, SL[2], SL[10], r0, c0, fr, fq);
#pragma unroll
          for (int m = 0; m < 2; ++m) { const f32x4 q = a1[m] - a2[m]; u32x2 o; o.x = pk2(q[0], q[1]); o.y = pk2(q[2], q[3]);
              *(u32x2*)(ob + 16384 + (((w & 3) * 4 + 2 * (w >> 2) + m) * 64 + F.lane) * 8) = o; } }
        {
          zero2(a1); mm64(a1, SL[6], SL[5], r0, c0, fr, fq); zero2(a2); mm64(a2, SL[7], SL[10], r0, c0, fr, fq);
#pragma unroll
          for (int m = 0; m < 2; ++m) { const f32x4 q = a1[m] - a2[m]; u32x2 o; o.x = pk2(q[0], q[1]); o.y = pk2(q[2], q[3]);
              *(u32x2*)(ob + 24576 + (((w & 3) * 4 + 2 * (w >> 2) + m) * 64 + F.lane) * 8) = o; } }
        unit = unit_next;
    }
}


typedef short s16x4v __attribute__((ext_vector_type(4)));
DI f32x4 mfma16(s16x4v a, s16x4v b, f32x4 c) { return __builtin_amdgcn_mfma_f32_16x16x16bf16_1k(a, b, c, 0, 0, 0); }
DI s16x4v pack4(const f32x4& v) { u32x2 t; t.x = pk2(v[0], v[1]); t.y = pk2(v[2], v[3]); return __builtin_bit_cast(s16x4v, t); }
DI void slab64(f32x4 (&acc)[4], const LAS bf16_t* P, const LAS bf16_t* Q, int s4, int fr, int fq) {
#pragma unroll
    for (int s2 = 0; s2 < 2; ++s2) { const bf16x8 b = *(const LAS bf16x8*)(Q + (16 * s4 + fr) * LDP + 32 * s2 + 8 * fq);
#pragma unroll
        for (int m = 0; m < 4; ++m) { const bf16x8 a = *(const LAS bf16x8*)(P + (16 * m + fr) * LDP + 32 * s2 + 8 * fq);
            acc[m] = __builtin_amdgcn_mfma_f32_16x16x32_bf16(a, b, acc[m], 0, 0, 0); } }
}
constexpr int C2_NORM = 9 * SLOTB, C2_GC = C2_NORM + 2048, C2_ADIAG = C2_GC + 256, C2_DINV = C2_ADIAG + 4096;
static_assert(C2_DINV + 2048 <= LDS_MISC, "chunkprep2 LDS");
DI void phase_chunkprep2(const Params& p, const Ctx& F) {
    const bf16_t* Kc = (const bf16_t*)(p.ws + WS_KC); const bf16_t* Vc = (const bf16_t*)(p.ws + WS_VC); const bf16_t* Rc = (const bf16_t*)(p.ws + WS_RC);
    unsigned char* OPS = p.ws + WS_OPS;
    LAS bf16_t* SL[9];
#pragma unroll
    for (int i = 0; i < 9; ++i) SL[i] = (LAS bf16_t*)(F.lds + i * SLOTB);
    LAS float* NORM = (LAS float*)(F.lds + C2_NORM); LAS float* GC = (LAS float*)(F.lds + C2_GC); LAS float* ADIAG = (LAS float*)(F.lds + C2_ADIAG); LAS bf16_t* DINV = (LAS bf16_t*)(F.lds + C2_DINV);
    const int w = F.wave, s4 = w & 3, g2 = w >> 2;
    const bool fixedmap = (F.G == 256);
    auto unit_of = [&](int i) -> int { if (fixedmap) return i < 33 ? (F.bid >> 2) * 132 + (F.bid & 3) * 33 + i : -1; const int u = F.bid + i * F.G; return u < 2 * 32 * 132 ? u : -1; };
    struct RawLd { u32x4 kq, vq, rq, aq, lq; };
    auto raw_issue = [&](RawLd& R, int unit, int lane) { const int d = unit / (32 * 132), chain = (unit / 132) & 31, pc = unit % 132, b = chain >> 3, h = chain & 7;
        const size_t o = chunk_row(d, b, pc, lane) * 512 + 64 * h + 8 * w;
        R.kq = *(const u32x4*)(Kc + o); R.vq = *(const u32x4*)(Vc + o); R.rq = *(const u32x4*)(Rc + o);
        R.aq = *(const u32x4*)((const bf16_t*)(p.ws + (d ? WS_A1 : WS_A0)) + o); R.lq = *(const u32x4*)((const bf16_t*)(p.ws + (d ? WS_L1 : WS_L0)) + o); };
    RawLd R;
    float kkw[8], kaw[8]; int hdcur = -1;
    int uix = 0, unit = unit_of(0);
    if (unit >= 0) raw_issue(R, unit, F.lane);
    for (; unit >= 0; ) {
        const int unit_next = unit_of(++uix);
        const int d = unit / (32 * 132), chain = (unit / 132) & 31, pc = unit % 132, h = chain & 7;
        if (d * 8 + h != hdcur) { hdcur = d * 8 + h;
#pragma unroll
            for (int j = 0; j < 8; ++j) { kkw[j] = p.in[I_KK][64 * h + 8 * w + j]; kaw[j] = p.in[I_KA][d * 512 + 64 * h + 8 * w + j]; } }
        int lane = F.lane; asm volatile("" : "+v"(lane));
        const int fr = lane & 15, fq = lane >> 4, pp = lane;
        __syncthreads();
        float k[8], a[8], vv[8], rr[8], ll[8], kk[8];
        { float ss = 0.f;
#pragma unroll
          for (int j = 0; j < 4; ++j) { k[2 * j] = bflo(R.kq[j]); k[2 * j + 1] = bfhi(R.kq[j]); vv[2 * j] = bflo(R.vq[j]); vv[2 * j + 1] = bfhi(R.vq[j]); rr[2 * j] = bflo(R.rq[j]); rr[2 * j + 1] = bfhi(R.rq[j]);
              a[2 * j] = bflo(R.aq[j]); a[2 * j + 1] = bfhi(R.aq[j]); ll[2 * j] = bflo(R.lq[j]); ll[2 * j + 1] = bfhi(R.lq[j]); }
          if (unit_next >= 0) raw_issue(R, unit_next, lane);
#pragma unroll
          for (int j = 0; j < 8; ++j) { kk[j] = k[j] * kkw[j]; ss += kk[j] * kk[j]; }
          NORM[w * 64 + pp] = ss; }
        float g[8];
#pragma unroll
        for (int j = 0; j < 8; ++j) g[j] = ll[j];
#pragma unroll
        for (int off = 1; off < 64; off <<= 1) {
#pragma unroll
            for (int j = 0; j < 8; ++j) { const float t = __shfl_up(g[j], off); g[j] += (lane >= off) ? t : 0.f; } }
        float gc[8];
#pragma unroll
        for (int j = 0; j < 8; ++j) gc[j] = __shfl(g[j], 63);
        if (lane == 0) { *(LAS f32x4*)(GC + 8 * w) = (f32x4){gc[0], gc[1], gc[2], gc[3]}; *(LAS f32x4*)(GC + 8 * w + 4) = (f32x4){gc[4], gc[5], gc[6], gc[7]}; }
        __syncthreads();
        { float ss = 0.f;
#pragma unroll
          for (int q = 0; q < 8; ++q) ss += NORM[q * 64 + pp];
          const float rn = 1.f / sqrtf(fmaxf(ss, 1e-24f));
          float kkg[8], rg[8], ki[8], kai[8];
#pragma unroll
          for (int j = 0; j < 8; ++j) { const float kkn = kk[j] * rn, km = k[j] * (1.f + (a[j] - 1.f) * kaw[j]), kan = kkn * a[j];
              const float eg = __expf(g[j]), egp = __expf(g[j] - ll[j]), eng = __expf(-g[j]);
              kkg[j] = kkn * egp; rg[j] = rr[j] * eg; ki[j] = km * eng; kai[j] = kan * eng; }
          *(LAS u32x4*)(SL[0] + pp * LDP + 8 * w) = (u32x4){pk2(kkg[0], kkg[1]), pk2(kkg[2], kkg[3]), pk2(kkg[4], kkg[5]), pk2(kkg[6], kkg[7])};
          *(LAS u32x4*)(SL[1] + pp * LDP + 8 * w) = (u32x4){pk2(rg[0], rg[1]), pk2(rg[2], rg[3]), pk2(rg[4], rg[5]), pk2(rg[6], rg[7])};
          *(LAS u32x4*)(SL[2] + pp * LDP + 8 * w) = (u32x4){pk2(ki[0], ki[1]), pk2(ki[2], ki[3]), pk2(ki[4], ki[5]), pk2(ki[6], ki[7])};
          *(LAS u32x4*)(SL[3] + pp * LDP + 8 * w) = (u32x4){pk2(kai[0], kai[1]), pk2(kai[2], kai[3]), pk2(kai[4], kai[5]), pk2(kai[6], kai[7])};
#pragma unroll
          for (int j = 0; j < 8; ++j) { const int ch = 8 * w + j;
              SL[4][ch * LDP + pp] = (bf16_t)f2bf(kkg[j]); SL[5][ch * LDP + pp] = (bf16_t)f2bf(vv[j]); SL[6][ch * LDP + pp] = (bf16_t)f2bf(ki[j]); SL[7][ch * LDP + pp] = (bf16_t)f2bf(kai[j]); } }
        __syncthreads();
        { f32x4 accA[4], accK[4];
#pragma unroll
          for (int m = 0; m < 4; ++m) { accA[m] = (f32x4){0.f, 0.f, 0.f, 0.f}; accK[m] = accA[m]; }
          const LAS bf16_t* Qop = g2 == 0 ? SL[0] : SL[1];
          slab64(accA, SL[3], Qop, s4, fr, fq);
          slab64(accK, SL[2], Qop, s4, fr, fq);
          __syncthreads();
          const int tcol = 16 * s4 + fr;
#pragma unroll
          for (int m = 0; m < 4; ++m) {
#pragma unroll
              for (int i = 0; i < 4; ++i) { const int jr = 16 * m + 4 * fq + i; const bool keep = g2 == 0 ? jr < tcol : jr <= tcol; accA[m][i] = keep ? accA[m][i] : 0.f; accK[m][i] = keep ? accK[m][i] : 0.f; }
              u32x2 wa, wk; wa.x = pk2(accA[m][0], accA[m][1]); wa.y = pk2(accA[m][2], accA[m][3]); wk.x = pk2(accK[m][0], accK[m][1]); wk.y = pk2(accK[m][2], accK[m][3]);
              *(LAS u32x2*)((g2 == 0 ? SL[0] : SL[8]) + tcol * LDP + 16 * m + 4 * fq) = wa;
              *(LAS u32x2*)((g2 == 0 ? SL[2] : SL[3]) + tcol * LDP + 16 * m + 4 * fq) = wk;
              if (g2 == 0 && m == s4) {
#pragma unroll
                  for (int i = 0; i < 4; ++i) ADIAG[s4 * 256 + fr * 16 + 4 * fq + i] = accA[m][i]; } } }
        __syncthreads();
        if (F.tid < 64) { const int blk = F.tid >> 4, c = F.tid & 15; const LAS float* A = ADIAG + blk * 256; float x[16];
            f32x4 Ar[16][4];
#pragma unroll
            for (int r = 1; r < 16; ++r)
#pragma unroll
                for (int q = 0; q < 4; ++q) if (4 * q < r) Ar[r][q] = *(const LAS f32x4*)(A + r * 16 + 4 * q);
#pragma unroll
            for (int r = 0; r < 16; ++r) { float sa = (r == c) ? 1.f : 0.f;
#pragma unroll
                for (int j = 0; j < r; ++j) sa -= Ar[r][j >> 2][j & 3] * x[j];
                x[r] = sa; }
#pragma unroll
            for (int r = 0; r < 16; ++r) DINV[(blk * 16 + r) * 16 + c] = (bf16_t)f2bf(x[r]); }
        f32x4 X[4];
        if (g2 == 0) {
#pragma unroll
            for (int m = 0; m < 4; ++m) { const u32x2 v2 = *(const LAS u32x2*)(SL[4] + (16 * s4 + fr) * LDP + 16 * m + 4 * fq); X[m] = (f32x4){bflo(v2.x), bfhi(v2.x), bflo(v2.y), bfhi(v2.y)}; }
        } else {
#pragma unroll
            for (int m = 0; m < 4; ++m) X[m] = (f32x4){0.f, 0.f, 0.f, 0.f};
            slab64(X, SL[2], SL[5], s4, fr, fq);
        }
        __syncthreads();
        s16x4v xb[4];
#pragma unroll
        for (int bi = 0; bi < 4; ++bi) {
            f32x4 sacc = (f32x4){0.f, 0.f, 0.f, 0.f};
#pragma unroll
            for (int bj = 0; bj < bi; ++bj) { const s16x4v af = *(const LAS s16x4v*)(SL[0] + (16 * bi + fr) * LDP + 16 * bj + 4 * fq); sacc = mfma16(af, xb[bj], sacc); }
            const f32x4 rhs = X[bi] - sacc;
            const s16x4v df = *(const LAS s16x4v*)(DINV + (bi * 16 + fr) * 16 + 4 * fq);
            X[bi] = mfma16(df, pack4(rhs), (f32x4){0.f, 0.f, 0.f, 0.f});
            xb[bi] = pack4(X[bi]);
        }
        unsigned char* ob = OPS + (size_t)unit * 32768;
        if (g2 == 0) {
#pragma unroll
            for (int mt = 0; mt < 4; ++mt) {
                f32x4 aq = (f32x4){0.f, 0.f, 0.f, 0.f}, am = aq;
#pragma unroll
                for (int kb = 0; kb < 4; ++kb) { const s16x4v bq = *(const LAS s16x4v*)(SL[8] + (16 * mt + fr) * LDP + 16 * kb + 4 * fq);
                    const s16x4v bm = *(const LAS s16x4v*)(SL[7] + (16 * mt + fr) * LDP + 16 * kb + 4 * fq);
                    aq = mfma16(xb[kb], bq, aq); am = mfma16(xb[kb], bm, am); }
                const u32x2 rgv = *(const LAS u32x2*)(SL[1] + (16 * mt + fr) * LDP + 16 * s4 + 4 * fq);
                u32x2 oq; oq.x = pk2(bflo(rgv.x) - aq[0], bfhi(rgv.x) - aq[1]); oq.y = pk2(bflo(rgv.y) - aq[2], bfhi(rgv.y) - aq[3]);
                *(u32x2*)(ob + ((mt * 2 + (s4 >> 1)) * 64 + lane) * 16 + (s4 & 1) * 8) = oq;
                const float egc = __expf(GC[16 * mt + fr]); float mv[4];
#pragma unroll
                for (int i = 0; i < 4; ++i) mv[i] = egc * (((16 * s4 + 4 * fq + i) == (16 * mt + fr) ? 1.f : 0.f) - am[i]);
                u32x2 om; om.x = pk2(mv[0], mv[1]); om.y = pk2(mv[2], mv[3]);
                *(u32x2*)(ob + 8192 + ((mt * 2 + (s4 >> 1)) * 64 + lane) * 16 + (s4 & 1) * 8) = om;
            }
        } else {
            f32x4 y1[4], b1[4];
#pragma unroll
            for (int m = 0; m < 4; ++m) { y1[m] = (f32x4){0.f, 0.f, 0.f, 0.f}; b1[m] = y1[m]; }
            slab64(y1, SL[3], SL[5], s4, fr, fq);
            slab64(b1, SL[6], SL[5], s4, fr, fq);
#pragma unroll
            for (int m = 0; m < 4; ++m) {
                f32x4 y2 = (f32x4){0.f, 0.f, 0.f, 0.f}, b2 = y2;
#pragma unroll
                for (int kb = 0; kb < 4; ++kb) { const s16x4v ay = *(const LAS s16x4v*)(SL[8] + (16 * m + fr) * LDP + 16 * kb + 4 * fq);
                    const s16x4v ab = *(const LAS s16x4v*)(SL[7] + (16 * m + fr) * LDP + 16 * kb + 4 * fq);
                    y2 = mfma16(ay, xb[kb], y2); b2 = mfma16(ab, xb[kb], b2); }
                const f32x4 yv = y1[m] - y2; u32x2 oy; oy.x = pk2(yv[0], yv[1]); oy.y = pk2(yv[2], yv[3]);
                *(u32x2*)(ob + 16384 + ((s4 * 4 + m) * 64 + lane) * 8) = oy;
                const f32x4 gcv = *(const LAS f32x4*)(GC + 16 * m + 4 * fq);
                const f32x4 bv = b1[m] - b2; u32x2 obc; obc.x = pk2(__expf(gcv[0]) * bv[0], __expf(gcv[1]) * bv[1]); obc.y = pk2(__expf(gcv[2]) * bv[2], __expf(gcv[3]) * bv[3]);
                *(u32x2*)(ob + 24576 + ((s4 * 4 + m) * 64 + lane) * 8) = obc;
            }
        }
        unit = unit_next;
    }
}

constexpr int SC_SLOT = 20480, SC_NSLOT = 5, SC_TILE = SC_NSLOT * SC_SLOT, CV_TP = 264;
static_assert(SC_TILE + 64 * CV_TP * 2 <= LDS_MISC, "scan ring + conversion tile");
DI void scan_issue(const unsigned char* st, LAS unsigned char* slot, int w4, int wave, int lane) {
    if (wave == 0 || wave > 3) return;
#pragma unroll
    for (int i = 0; i < 7; ++i) { const int f = wave - 1 + 3 * i;
        if (f < 20) { const unsigned char* src = f < 16 ? st + f * 1024 : (f < 18 ? st + 16384 + w4 * 2048 + (f - 16) * 1024 : st + 24576 + w4 * 2048 + (f - 18) * 1024);
            __builtin_amdgcn_global_load_lds((const unsigned*)(src + lane * 16), (LAS unsigned*)(slot + f * 1024), 16, 0, 0); } }
}
struct CvTile { const float* src; bf16_t* dst; int ldn, ldk, k0, n0, rowmap; bool ok; };
DI CvTile cv_tile(const Params& p, int it) {
    CvTile t; t.ok = it < 32 * 2 * 16 + 32 * 16; t.n0 = 0;
    if (it < 1024) { const int e = it >> 5, up = (it >> 4) & 1, kt = it & 15; t.src = (up ? p.in[I_WU] : p.in[I_WG]) + (size_t)e * 1024 * 256 + (size_t)kt * 64 * 256; t.ldn = 256;
        t.dst = (bf16_t*)(p.ws + WS_WGUT) + (size_t)e * 512 * 1024; t.ldk = 1024; t.k0 = kt * 64; t.rowmap = 1 + up; }
    else { const int r = (it - 1024) & 511, e = r >> 4, kt = (r >> 2) & 3, ntl = r & 3; t.src = p.in[I_WD] + (size_t)e * 256 * 1024 + (size_t)kt * 64 * 1024 + ntl * 256; t.ldn = 1024;
        t.dst = (bf16_t*)(p.ws + WS_WDT) + (size_t)e * 1024 * 256; t.ldk = 256; t.k0 = kt * 64; t.rowmap = 0; t.n0 = ntl * 256; }
    return t;
}
DI void phase_scan_chunk(const Params& p, const Ctx& F) {
    unsigned char* OPS = p.ws + WS_OPS;
    LAS unsigned char* ring = F.lds; LAS bf16_t* tile = (LAS bf16_t*)(F.lds + SC_TILE);
    const bool fused_cv = (F.G == 256);
    for (int item = F.bid; item < 256; item += F.G) {
        const int xq = item & 7, yq = item >> 3, w4 = yq & 3, chainid = xq + 8 * (yq >> 2);
        unsigned char* ops = OPS + (size_t)chainid * 132 * 32768;
        f32x4 H[4];
#pragma unroll
        for (int m = 0; m < 4; ++m) H[m] = (f32x4){0.f, 0.f, 0.f, 0.f};
        f32x4 cvr[8];
#pragma unroll
        for (int i = 0; i < 8; ++i) cvr[i] = (f32x4){0.f, 0.f, 0.f, 0.f};
        __syncthreads();
#pragma unroll
        for (int i = 0; i < SC_NSLOT - 1; ++i) scan_issue(ops + (size_t)i * 32768, ring + i * SC_SLOT, w4, F.wave, F.lane);
        auto scan_step = [&](int pc) {
            if (F.wave == 3) asm volatile("s_waitcnt vmcnt(18)" ::: "memory"); else if (F.wave == 1 || F.wave == 2) asm volatile("s_waitcnt vmcnt(21)" ::: "memory");
            __builtin_amdgcn_s_barrier();
            const LAS unsigned char* slot = ring + (pc % SC_NSLOT) * SC_SLOT;
            { const int nx = pc + SC_NSLOT - 1 < 132 ? pc + SC_NSLOT - 1 : 131;
              scan_issue(ops + (size_t)nx * 32768, ring + ((pc + SC_NSLOT - 1) % SC_NSLOT) * SC_SLOT, w4, F.wave, F.lane); }
            if (F.wave == 0) {
                bf16x8 qa[4][2], ma[4][2]; u32x2 y0[4], bc[4];
#pragma unroll
                for (int m = 0; m < 4; ++m) {
#pragma unroll
                    for (int s2 = 0; s2 < 2; ++s2) { qa[m][s2] = *(const LAS bf16x8*)(slot + ((m * 2 + s2) * 64 + F.lane) * 16); ma[m][s2] = *(const LAS bf16x8*)(slot + 8192 + ((m * 2 + s2) * 64 + F.lane) * 16); }
                    y0[m] = *(const LAS u32x2*)(slot + 16384 + (m * 64 + F.lane) * 8); bc[m] = *(const LAS u32x2*)(slot + 18432 + (m * 64 + F.lane) * 8); }
                asm volatile("s_waitcnt lgkmcnt(0)" ::: "memory");
                bf16x8 hb[2];
#pragma unroll
                for (int s2 = 0; s2 < 2; ++s2) { u32x4 t; t.x = pk2(H[2 * s2][0], H[2 * s2][1]); t.y = pk2(H[2 * s2][2], H[2 * s2][3]); t.z = pk2(H[2 * s2 + 1][0], H[2 * s2 + 1][1]); t.w = pk2(H[2 * s2 + 1][2], H[2 * s2 + 1][3]);
                    hb[s2] = __builtin_bit_cast(bf16x8, t); }
#pragma unroll
                for (int m = 0; m < 4; ++m) {
                    f32x4 y = (f32x4){bflo(y0[m].x), bfhi(y0[m].x), bflo(y0[m].y), bfhi(y0[m].y)};
                    f32x4 hn = (f32x4){bflo(bc[m].x), bfhi(bc[m].x), bflo(bc[m].y), bfhi(bc[m].y)};
#pragma unroll
                    for (int s2 = 0; s2 < 2; ++s2) { y = __builtin_amdgcn_mfma_f32_16x16x32_bf16(qa[m][s2], hb[s2], y, 0, 0, 0); hn = __builtin_amdgcn_mfma_f32_16x16x32_bf16(ma[m][s2], hb[s2], hn, 0, 0, 0); }
                    if (pc >= 4) { u32x2 o; o.x = pk2(y[0], y[1]); o.y = pk2(y[2], y[3]); *(u32x2*)(ops + (size_t)pc * 32768 + 16384 + ((w4 * 4 + m) * 64 + F.lane) * 8) = o; }
                    H[m] = hn;
                }
            }
        };
#pragma unroll 1
        for (int pc4 = 0; pc4 < 132; pc4 += 4) {
            const CvTile T = cv_tile(p, item + 256 * (pc4 / 4));
            const bool cvon = fused_cv && F.wave >= 4 && T.ok;
            const int r0 = 16 * (F.wave - 4);
            scan_step(pc4);
            if (cvon) {
#pragma unroll
                for (int i = 0; i < 8; ++i) cvr[i] = *(const f32x4*)(T.src + (size_t)(r0 + i) * T.ldn + 4 * F.lane); }
            scan_step(pc4 + 1);
            if (cvon) {
#pragma unroll
                for (int i = 0; i < 8; ++i) { u32x2 o; o.x = pk2(cvr[i][0], cvr[i][1]); o.y = pk2(cvr[i][2], cvr[i][3]); *(LAS u32x2*)(tile + (r0 + i) * CV_TP + 4 * F.lane) = o; }
#pragma unroll
                for (int i = 0; i < 8; ++i) cvr[i] = *(const f32x4*)(T.src + (size_t)(r0 + 8 + i) * T.ldn + 4 * F.lane); }
            scan_step(pc4 + 2);
            if (cvon) {
#pragma unroll
                for (int i = 0; i < 8; ++i) { u32x2 o; o.x = pk2(cvr[i][0], cvr[i][1]); o.y = pk2(cvr[i][2], cvr[i][3]); *(LAS u32x2*)(tile + (r0 + 8 + i) * CV_TP + 4 * F.lane) = o; } }
            scan_step(pc4 + 3);
            if (cvon) {
                const int n = F.tid - 256;
                const int drow = T.rowmap == 0 ? T.n0 + n : ((n >> 7) * 256 + (n & 127) + (T.rowmap == 2 ? 128 : 0));
                bf16_t* dp = T.dst + (size_t)drow * T.ldk + T.k0;
#pragma unroll
                for (int q = 0; q < 8; ++q) { unsigned wds[4];
#pragma unroll
                    for (int jj = 0; jj < 4; ++jj) { const int k = 8 * q + 2 * jj; wds[jj] = (unsigned)tile[k * CV_TP + n] | ((unsigned)tile[(k + 1) * CV_TP + n] << 16); }
                    *(u32x4*)(dp + 8 * q) = (u32x4){wds[0], wds[1], wds[2], wds[3]}; } }
        }
        asm volatile("s_waitcnt vmcnt(0)" ::: "memory");
    }
}

DI void phase_post2(const Params& p, const Ctx& F) {
    const unsigned char* OPS = p.ws + WS_OPS;
    const bf16_t* GATE = (const bf16_t*)((unsigned char*)p.out + DO_GATE); const bf16_t* BV = (const bf16_t*)((unsigned char*)p.out + DO_BV);
    bf16_t* MIXED = (bf16_t*)((unsigned char*)p.out + DO_MIXED);
    constexpr int LDY = 68;
    const int fr = F.lane & 15, fq = F.lane >> 4, w4 = F.wave & 3, tk = F.tid >> 3, cg8 = F.tid & 7;
    constexpr int NU = 4 * 128 * 8;
    struct PLd { u32x2 fv[2], bv2[2]; u32x4 gq, bq; };
    auto issue = [&](PLd& L, int unit) { const int h = unit & 7, j = (unit >> 3) & 127, b = unit >> 10, chain = b * 8 + h;
        const unsigned char* fi = OPS + ((size_t)(0 * 32 + chain) * 132 + 4 + j) * 32768 + 16384; const unsigned char* bi = OPS + ((size_t)(1 * 32 + chain) * 132 + 4 + (127 - j)) * 32768 + 16384;
#pragma unroll
        for (int mm = 0; mm < 2; ++mm) { const int m = 2 * (F.wave >> 2) + mm; L.fv[mm] = *(const u32x2*)(fi + ((w4 * 4 + m) * 64 + F.lane) * 8); L.bv2[mm] = *(const u32x2*)(bi + ((w4 * 4 + m) * 64 + F.lane) * 8); }
        const size_t o = ((size_t)b * SEQ + 64 * j + tk) * 512 + 64 * h + 8 * cg8;
        L.gq = *(const u32x4*)(GATE + o); L.bq = *(const u32x4*)(BV + o); };
    PLd L;
    if (F.bid < NU) issue(L, F.bid);
    int par = 0;
    for (int unit = F.bid; unit < NU; unit += F.G, par ^= 1) {
        const int h = unit & 7, j = (unit >> 3) & 127, b = unit >> 10;
        LAS float* ys = (LAS float*)F.lds + par * 64 * LDY;
        const PLd C = L;
        if (unit + F.G < NU) issue(L, unit + F.G);
#pragma unroll
        for (int mm = 0; mm < 2; ++mm) { const int m = 2 * (F.wave >> 2) + mm; const int t0 = 16 * m + 4 * fq, n = 16 * w4 + fr;
            ys[(t0 + 0) * LDY + n] = bflo(C.fv[mm].x); ys[(t0 + 1) * LDY + n] = bfhi(C.fv[mm].x); ys[(t0 + 2) * LDY + n] = bflo(C.fv[mm].y); ys[(t0 + 3) * LDY + n] = bfhi(C.fv[mm].y); }
        __syncthreads();
#pragma unroll
        for (int mm = 0; mm < 2; ++mm) { const int m = 2 * (F.wave >> 2) + mm; const int t0 = 16 * m + 4 * fq, n = 16 * w4 + fr;
            ys[(63 - t0 - 0) * LDY + n] += bflo(C.bv2[mm].x); ys[(63 - t0 - 1) * LDY + n] += bfhi(C.bv2[mm].x); ys[(63 - t0 - 2) * LDY + n] += bflo(C.bv2[mm].y); ys[(63 - t0 - 3) * LDY + n] += bfhi(C.bv2[mm].y); }
        __syncthreads();
        { const size_t row = (size_t)b * SEQ + 64 * j + tk;
          const f32x4 ya = *(const LAS f32x4*)(ys + tk * LDY + 8 * cg8), yb = *(const LAS f32x4*)(ys + tk * LDY + 8 * cg8 + 4);
          float y[8] = {ya[0], ya[1], ya[2], ya[3], yb[0], yb[1], yb[2], yb[3]};
          float s1 = 0.f;
#pragma unroll
          for (int i = 0; i < 8; ++i) s1 += y[i];
          s1 += __shfl_xor(s1, 1); s1 += __shfl_xor(s1, 2); s1 += __shfl_xor(s1, 4);
          const float mu = s1 * (1.f / 64.f); float s2 = 0.f;
#pragma unroll
          for (int i = 0; i < 8; ++i) { y[i] -= mu; s2 += y[i] * y[i]; }
          s2 += __shfl_xor(s2, 1); s2 += __shfl_xor(s2, 2); s2 += __shfl_xor(s2, 4);
          const float rstd = 1.f / sqrtf(s2 * (1.f / 64.f) + 64e-5f);
          const f32x4 lg0 = *(const f32x4*)(p.in[I_LNXG] + 64 * h + 8 * cg8), lg1 = *(const f32x4*)(p.in[I_LNXG] + 64 * h + 8 * cg8 + 4), lb0 = *(const f32x4*)(p.in[I_LNXB] + 64 * h + 8 * cg8), lb1 = *(const f32x4*)(p.in[I_LNXB] + 64 * h + 8 * cg8 + 4);
          float ov[8];
#pragma unroll
          for (int i = 0; i < 8; ++i) { const float yn = y[i] * rstd * (i < 4 ? lg0[i & 3] : lg1[i & 3]) + (i < 4 ? lb0[i & 3] : lb1[i & 3]);
              const float gt = (i & 1) ? bfhi(C.gq[i >> 1]) : bflo(C.gq[i >> 1]), bb = (i & 1) ? bfhi(C.bq[i >> 1]) : bflo(C.bq[i >> 1]);
              ov[i] = (yn + bb) * gt; }
          u32x4 ow = (u32x4){pk2(ov[0], ov[1]), pk2(ov[2], ov[3]), pk2(ov[4], ov[5]), pk2(ov[6], ov[7])};
          *(u32x4*)(MIXED + row * D + 512 + 64 * h + 8 * cg8) = ow; }
    }
}

DI void phase_post(const Params& p, const Ctx& F) {
    const float* YS = (const float*)(p.ws + WS_YS);
    const bf16_t* GATE = (const bf16_t*)((unsigned char*)p.out + DO_GATE); const bf16_t* BV = (const bf16_t*)((unsigned char*)p.out + DO_BV);
    bf16_t* MIXED = (bf16_t*)((unsigned char*)p.out + DO_MIXED);
    const int t = F.tid; const float lg = p.in[I_LNXG][t], lb = p.in[I_LNXB][t];
    for (int row = F.bid; row < NT; row += F.G) {
        const size_t o = (size_t)row * 512 + t;
        const float y = YS[o] + YS[(size_t)NT * 512 + o];
        const float mu = wave_sum(y) * (1.f / 64.f); const float dd = y - mu; const float var = wave_sum(dd * dd) * (1.f / 64.f);
        const float yn = dd * (1.f / sqrtf(var + 64e-5f)) * lg + lb;
        const float ob = (yn + bf2f(BV[o])) * bf2f(GATE[o]);
        MIXED[(size_t)row * D + 512 + t] = (bf16_t)f2bf(ob);
    }
}

DI void phase_gemm2(const Params& p, const Ctx& F) {
    pg8::StaticOrder S; S.init((unsigned char*)p.out + DO_MIXED, p.ws + WS_WOUTT, NT, 1024, 1024, F.G, F.bid);
    pg8::EpiBf16 E{(bf16_t*)(p.ws + WS_Y), 1024};
    pg8::gemm_phase<pg8::EpiBf16, pg8::StaticOrder, false>(F.lds, 1024, S, E);
}

DI void phase_route(const Params& p, const Ctx& F, const bool dry = false) {
    LAS float* wr_ = (LAS float*)F.lds;
    for (int i = F.tid; i < 4 * 1024; i += NTHREADS) wr_[(i & 3) * 1024 + (i >> 2)] = p.in[I_WRG][i];
    for (int i = F.tid; i < 32 * 1024; i += NTHREADS) wr_[(4 + (i & 31)) * 1024 + (i >> 5)] = p.in[I_WRE][i];
    __syncthreads();
    const float* mod = (const float*)(p.ws + WS_MOD); const bf16_t* Y = (const bf16_t*)(p.ws + WS_Y);
    bf16_t* H2 = (bf16_t*)(p.ws + WS_H2); int* cnt = (int*)(p.ws + WS_CTL); int* perm = (int*)(p.ws + WS_PERM); float* ew = (float*)(p.ws + WS_EW);
    const int gw = F.bid * NWAVES + F.wave, NGW = F.G * NWAVES;
    LAS int* hist = (LAS int*)(F.lds + LDS_MISC + 64); LAS int* basel = (LAS int*)(F.lds + LDS_MISC + 192); LAS int* sel = (LAS int*)(F.lds + LDS_MISC + 320);
    if (F.tid < 32) hist[F.tid] = 0;
    __syncthreads();
    int itn = -1;
    for (int row = gw; row < NT; row += NGW) {
        ++itn;
        const int bt = row / SEQ;
        const u32x2* yr = (const u32x2*)(Y + (size_t)row * D) + F.lane; const f32x4* xr = (const f32x4*)(p.in[I_X] + (size_t)row * D) + F.lane;
        f32x4 v[4]; float ss = 0.f;
#pragma unroll
        for (int j = 0; j < 4; ++j) { const u32x2 yy = yr[64 * j]; v[j] = (f32x4){bflo(yy.x), bfhi(yy.x), bflo(yy.y), bfhi(yy.y)}; ss += (v[j].x * v[j].x + v[j].y * v[j].y) + (v[j].z * v[j].z + v[j].w * v[j].w); }
        const float rstd = 1.f / sqrtf(wave_sum(ss) * (1.f / D) + 1e-6f);
        float s2 = 0.f;
        f32x4* xo = (f32x4*)(p.out + (size_t)row * D) + F.lane;
#pragma unroll
        for (int j = 0; j < 4; ++j) { const int col = 4 * (F.lane + 64 * j);
            const f32x4 g1 = *(const f32x4*)(mod + bt * 6144 + 2048 + col), gp = *(const f32x4*)(p.in[I_GPOST1] + col);
            v[j] = xr[64 * j] + g1 * (v[j] * rstd * gp);
            xo[64 * j] = v[j];
            s2 += (v[j].x * v[j].x + v[j].y * v[j].y) + (v[j].z * v[j].z + v[j].w * v[j].w); }
        const float rstd2 = 1.f / sqrtf(wave_sum(s2) * (1.f / D) + 1e-6f);
        unsigned long long* o8 = (unsigned long long*)(H2 + (size_t)row * D) + F.lane;
#pragma unroll
        for (int j = 0; j < 4; ++j) { const int col = 4 * (F.lane + 64 * j);
            const f32x4 gg = *(const f32x4*)(p.in[I_GPRE2] + col), sh = *(const f32x4*)(mod + bt * 6144 + 3072 + col), sc = *(const f32x4*)(mod + bt * 6144 + 4096 + col);
            v[j] = v[j] * rstd2 * gg * (sc + 1.f) + sh;
            o8[64 * j] = (unsigned long long)pk2(v[j].x, v[j].y) | ((unsigned long long)pk2(v[j].z, v[j].w) << 32); }
        float part[36];
#pragma unroll
        for (int o = 0; o < 36; ++o) { float a = 0.f;
#pragma unroll
            for (int j = 0; j < 4; ++j) { const f32x4 w = *(const LAS f32x4*)(wr_ + o * 1024 + 4 * (F.lane + 64 * j)); a += (v[j].x * w.x + v[j].y * w.y) + (v[j].z * w.z + v[j].w * w.w); }
            part[o] = a; if ((o & 3) == 3) __builtin_amdgcn_sched_barrier(0); }
        float v32[32], v16[16], v8[8], v4[4], v2[2], mylg;
        { const bool b5 = (F.lane & 32) != 0, b4 = (F.lane & 16) != 0, b3 = (F.lane & 8) != 0, b2 = (F.lane & 4) != 0, b1 = (F.lane & 2) != 0, b0 = (F.lane & 1) != 0;
#pragma unroll
          for (int i = 0; i < 32; ++i) { const float lo = part[i], hi = (i < 4) ? part[32 + (i & 3)] : 0.f; const float mine = b5 ? hi : lo, th = b5 ? lo : hi; v32[i] = mine + __shfl_xor(th, 32); }
#pragma unroll
          for (int i = 0; i < 16; ++i) { const float mine = b4 ? v32[16 + i] : v32[i], th = b4 ? v32[i] : v32[16 + i]; v16[i] = mine + __shfl_xor(th, 16); }
#pragma unroll
          for (int i = 0; i < 8; ++i) { const float mine = b3 ? v16[8 + i] : v16[i], th = b3 ? v16[i] : v16[8 + i]; v8[i] = mine + __shfl_xor(th, 8); }
#pragma unroll
          for (int i = 0; i < 4; ++i) { const float mine = b2 ? v8[4 + i] : v8[i], th = b2 ? v8[i] : v8[4 + i]; v4[i] = mine + __shfl_xor(th, 4); }
#pragma unroll
          for (int i = 0; i < 2; ++i) { const float mine = b1 ? v4[2 + i] : v4[i], th = b1 ? v4[i] : v4[2 + i]; v2[i] = mine + __shfl_xor(th, 2); }
          { const float mine = b0 ? v2[1] : v2[0], th = b0 ? v2[0] : v2[1]; mylg = mine + __shfl_xor(th, 1); } }
        mylg += (F.lane < 4) ? p.in[I_BRG][F.lane & 3] : p.in[I_BRE][(F.lane - 4) & 31];
        float gl[4];
#pragma unroll
        for (int j = 0; j < 4; ++j) gl[j] = __shfl(mylg, j);
        int gi = 0; float gm = gl[0];
#pragma unroll
        for (int j = 1; j < 4; ++j) if (gl[j] > gm) { gm = gl[j]; gi = j; }
        float gsum = 0.f;
#pragma unroll
        for (int j = 0; j < 4; ++j) gsum += __expf(gl[j] - gm);
        const float gw_ = 1.f / gsum;
        float el[8];
#pragma unroll
        for (int j = 0; j < 8; ++j) el[j] = __shfl(mylg, 4 + gi * 8 + j);
        int i1 = 0; float m1 = el[0];
#pragma unroll
        for (int j = 1; j < 8; ++j) if (el[j] > m1) { m1 = el[j]; i1 = j; }
        int i2 = 0; float m2 = -3.0e38f;
#pragma unroll
        for (int j = 0; j < 8; ++j) if (j != i1 && el[j] > m2) { m2 = el[j]; i2 = j; }
        const float p2 = __expf(m2 - m1);
        const float w1 = gw_ / (1.f + p2), w2 = gw_ * p2 / (1.f + p2);
        if (F.lane == 0 && !dry) {
            const int e1 = gi * 8 + i1, e2 = gi * 8 + i2;
            const int s1 = atomicAdd((int*)(hist + e1), 1), s2 = atomicAdd((int*)(hist + e2), 1);
            sel[(F.wave * 16 + itn) * 2] = (e1 << 16) | s1; sel[(F.wave * 16 + itn) * 2 + 1] = (e2 << 16) | s2;
            ew[row * 2] = w1; ew[row * 2 + 1] = w2;
        }
    }
    if (!dry) {
        __syncthreads();
        if (F.tid < 32) basel[F.tid] = atomicAdd(&cnt[F.tid * 64], (int)hist[F.tid]);
        __syncthreads();
        if (F.tid < 256) { const int wv = F.tid >> 5, it2 = (F.tid >> 1) & 15, sl = F.tid & 1; const int row = F.bid * NWAVES + wv + it2 * NGW;
            if (row < NT) { const int sv = sel[F.tid]; const int e = sv >> 16, ps = sv & 0xffff; perm[(size_t)e * NT + basel[e] + ps] = row * 2 + sl; } }
    }
}

DI void moe_tile_prefix(const Params& p, const Ctx& F, LAS int* tp) {
    __syncthreads();
    if (F.tid == 0) { const int* cnt = (const int*)(p.ws + WS_CTL); int acc = 0; for (int e = 0; e < 32; ++e) { tp[e] = acc; acc += (cnt[e * 64] + 255) / 256; } tp[32] = acc; }
    __syncthreads();
}
DI void phase_moe_up(const Params& p, const Ctx& F) {
    LAS int* tp = (LAS int*)(F.lds + pg8::STAGE_BYTES);
    moe_tile_prefix(p, F, tp);
    MoeOrder S{tp, (const int*)(p.ws + WS_CTL), 2, F.G, F.bid, 1024, (const char*)(p.ws + WS_H2), (const char*)(p.ws + WS_WGUT), (size_t)512 * 1024 * 2, (size_t)256 * 1024 * 2, (const int*)(p.ws + WS_PERM), true};
    pg8::EpiMoeUp E{(bf16_t*)(p.ws + WS_HID)};
    pg8::gemm_phase<pg8::EpiMoeUp, MoeOrder, true>(F.lds, 1024, S, E);
}
DI void phase_moe_down(const Params& p, const Ctx& F) {
    LAS int* tp = (LAS int*)(F.lds + pg8::STAGE_BYTES);
    moe_tile_prefix(p, F, tp);
    MoeOrder S{tp, (const int*)(p.ws + WS_CTL), 4, F.G, F.bid, 256, (const char*)(p.ws + WS_HID), (const char*)(p.ws + WS_WDT), (size_t)1024 * 256 * 2, (size_t)256 * 256 * 2, (const int*)(p.ws + WS_PERM), false};
    pg8::EpiMoeDown E{(bf16_t*)(p.ws + WS_YMOE), (const int*)(p.ws + WS_PERM), (const float*)(p.ws + WS_EW)};
    pg8::gemm_phase<pg8::EpiMoeDown, MoeOrder, false>(F.lds, 256, S, E);
}

DI void phase_final(const Params& p, const Ctx& F, const float fsc = 1.f) {
    const float* mod = (const float*)(p.ws + WS_MOD); const bf16_t* YM = (const bf16_t*)(p.ws + WS_YMOE);
    const int gw = F.bid * NWAVES + F.wave, NGW = F.G * NWAVES;
    for (int row = gw; row < NT; row += NGW) {
        const int bt = row / SEQ;
        const u32x2* y0 = (const u32x2*)(YM + (size_t)row * D) + F.lane; const u32x2* y1 = (const u32x2*)(YM + ((size_t)NT + row) * D) + F.lane;
        f32x4 v[4]; float ss = 0.f;
#pragma unroll
        for (int j = 0; j < 4; ++j) { const u32x2 a = y0[64 * j], b = y1[64 * j];
            v[j] = (f32x4){bflo(a.x) + bflo(b.x), bfhi(a.x) + bfhi(b.x), bflo(a.y) + bflo(b.y), bfhi(a.y) + bfhi(b.y)};
            ss += (v[j].x * v[j].x + v[j].y * v[j].y) + (v[j].z * v[j].z + v[j].w * v[j].w); }
        const float rstd = 1.f / sqrtf(wave_sum(ss) * (1.f / D) + 1e-6f);
        f32x4* xo = (f32x4*)(p.out + (size_t)row * D) + F.lane;
#pragma unroll
        for (int j = 0; j < 4; ++j) { const int col = 4 * (F.lane + 64 * j);
            const f32x4 g2 = *(const f32x4*)(mod + bt * 6144 + 5120 + col), gp = *(const f32x4*)(p.in[I_GPOST2] + col);
            xo[64 * j] = xo[64 * j] + g2 * (v[j] * (rstd * fsc) * gp); }
    }
}


#define XB_TMO      128
#define XB_XCNT(j)  (256  + 64 * (j))
#define XB_XSUB(j)  (1280 + 64 * (j))
#define XB_XGEN(j)  (2304 + 64 * (j))
#define XB_TOP      3328
#define XB_TOPGEN   3392
#define XCD_BAR_WORDS 3456
#define XB_SPIN_CAP (1u << 20)
constexpr int CW_BAR = 4096;
DI unsigned xb_ld(unsigned* p)              { return __hip_atomic_load(p, __ATOMIC_RELAXED, __HIP_MEMORY_SCOPE_AGENT); }
DI unsigned xb_add(unsigned* p, unsigned v) { return __hip_atomic_fetch_add(p, v, __ATOMIC_RELAXED, __HIP_MEMORY_SCOPE_AGENT); }
DI unsigned xb_xcc_id() { return (unsigned)__builtin_amdgcn_s_getreg((3 << 11) | 20) & 0xFu; }
#define XB_SPIN(cond, bar) do { unsigned _sp = 0; while (cond) { __builtin_amdgcn_s_sleep(1); \
    if ((++_sp & 255u) == 0u) { if (xb_ld(&(bar)[XB_TMO])) break; if (_sp > XB_SPIN_CAP) { atomicAdd(&(bar)[XB_TMO], 1u); break; } } } } while (0)
struct XcdBarrier { unsigned* bar; unsigned x; volatile LAS unsigned* st; };
DI XcdBarrier xcd_barrier_post(unsigned* bar, volatile LAS unsigned* st) {
    XcdBarrier b; b.bar = bar; b.x = xb_xcc_id(); b.st = st;
    if (threadIdx.x == 0) (void)xb_add(&bar[XB_XCNT(b.x)], 1u);
    return b;
}
DI void xcd_barrier_complete(unsigned* bar, unsigned x, unsigned& nloc, unsigned& nx) {
    const unsigned G = gridDim.x * gridDim.y * gridDim.z;
    unsigned sum, cnt, mine, sp = 0u;
    for (;;) {
        sum = 0u; cnt = 0u; mine = 0u;
#pragma unroll
        for (unsigned j = 0; j < 16; ++j) { const unsigned c = xb_ld(&bar[XB_XCNT(j)]); sum += c; cnt += (c > 0u) ? 1u : 0u; mine = (j == x) ? c : mine; }
        if (sum == G) break;
        __builtin_amdgcn_s_sleep(1);
        if ((++sp & 255u) == 0u) { if (xb_ld(&bar[XB_TMO])) break; if (sp > XB_SPIN_CAP) { atomicAdd(&bar[XB_TMO], 1u); break; } }
    }
    nloc = mine > 0u ? mine : 1u; nx = cnt > 0u ? cnt : 1u;
}
DI void xcd_barrier(const XcdBarrier& b) {
    asm volatile("s_waitcnt vmcnt(0)" ::: "memory");
    __syncthreads();
    if (threadIdx.x == 0) {
        unsigned* bar = b.bar;
        __builtin_amdgcn_s_waitcnt(0);
        unsigned nloc = b.st[0], nx = b.st[1];
        if (nloc == 0u) { xcd_barrier_complete(bar, b.x, nloc, nx); b.st[0] = nloc; b.st[1] = nx; }
        const unsigned old = xb_add(&bar[XB_XSUB(b.x)], 1u);
        const unsigned gen = old / nloc;
        if (old + 1u == (gen + 1u) * nloc) {
            __builtin_amdgcn_fence(__ATOMIC_RELEASE, "agent");
            asm volatile("s_waitcnt vmcnt(0)" ::: "memory");
            const unsigned og = xb_add(&bar[XB_TOP], 1u);
            const unsigned tg = og / nx;
            if (og + 1u == (tg + 1u) * nx) xb_add(&bar[XB_TOPGEN], 1u);
            else XB_SPIN(xb_ld(&bar[XB_TOPGEN]) == tg, bar);
            __builtin_amdgcn_fence(__ATOMIC_ACQUIRE, "agent");
            xb_add(&bar[XB_XGEN(b.x)], 1u);
            asm volatile("s_waitcnt vmcnt(0)" ::: "memory");
        } else {
            XB_SPIN(xb_ld(&bar[XB_XGEN(b.x)]) == gen, bar);
            __builtin_amdgcn_fence(__ATOMIC_ACQUIRE, "agent");
            asm volatile("s_waitcnt vmcnt(0)" ::: "memory");
        }
    }
    __syncthreads();
}

constexpr int NPHASES = 12;
#ifndef SEQ_SCAN
#define SEQ_SCAN 0
#endif
#ifndef DUP_PHASE
#define DUP_PHASE -1
#endif
#ifndef PROBE_T
#define PROBE_T -1
#endif
template <int PH> DI void run_phase(const Params& p, const Ctx& F) {
    if constexpr (PH == 0) phase_adaln(p, F);
    if constexpr (PH == 1) phase_convert(p, F);
    if constexpr (PH == 2) phase_hrows(p, F);
    if constexpr (PH == 3) phase_gemm1(p, F);
#ifndef OLD_PREP
#define OLD_PREP 0
#endif
    if constexpr (PH == 4) { if (OLD_PREP) phase_prep(p, F); else phase_prep2(p, F); __syncthreads(); phase_gmlp(p, F); }
#ifndef OLD_CHUNKPREP
#define OLD_CHUNKPREP 0
#endif
    if constexpr (PH == 5) { if (OLD_CHUNKPREP) phase_chunkprep(p, F); else phase_chunkprep2(p, F); }
    if constexpr (PH == 12) { phase_scan_chunk(p, F); if (F.G != 256) phase_convert_experts(p, F); }
    if constexpr (PH == 6) phase_post2(p, F);
    if constexpr (PH == 7) phase_gemm2(p, F);
    if constexpr (PH == 8) phase_route(p, F);
    if constexpr (PH == 28) phase_route(p, F, true);
    if constexpr (PH == 9) phase_moe_up(p, F);
    if constexpr (PH == 10) phase_moe_down(p, F);
    if constexpr (PH == 11) phase_final(p, F, DUP_PHASE == 11 ? 0.5f : 1.f);
}
DI Ctx make_ctx(unsigned char* lds) {
    Ctx F; F.lds = (LAS unsigned char*)lds; F.tid = threadIdx.x; F.lane = F.tid & 63; F.wave = __builtin_amdgcn_readfirstlane(F.tid >> 6); F.G = gridDim.x; F.bid = blockIdx.x; return F;
}
template <int PH> __global__ void __launch_bounds__(NTHREADS, 2) k_phase(Params p) {
    extern __shared__ __attribute__((aligned(16))) unsigned char lds[];
    const Ctx F = make_ctx(lds);
    run_phase<PH>(p, F);
}
#ifndef USE_CG_SYNC
#define USE_CG_SYNC 0
#endif
__global__ void __launch_bounds__(NTHREADS, 2) k_mega(Params p) {
    extern __shared__ __attribute__((aligned(16))) unsigned char lds[];
    const Ctx F = make_ctx(lds);
#if USE_CG_SYNC
    cg::grid_group grid = cg::this_grid();
#define GSYNC() grid.sync()
#else
    volatile LAS unsigned* misc = (volatile LAS unsigned*)(F.lds + LDS_MISC);
    if (F.tid < 4) misc[F.tid] = 0u;
    __syncthreads();
    const XcdBarrier bar = xcd_barrier_post((unsigned*)(p.ws + WS_CTL) + CW_BAR, misc);
#define GSYNC() xcd_barrier(bar)
#endif
#define DUP(X) if (DUP_PHASE == X) { run_phase<X>(p, F); GSYNC(); }
    unsigned long long ts_a = 0, ts_b = 0; int nst = 0;
#define STAMP() do { if (PROBE_T >= 0) { const unsigned long long t_ = __builtin_amdgcn_s_memrealtime(); if (nst == PROBE_T) ts_a = t_; if (nst == PROBE_T + 1) ts_b = t_; ++nst; } } while (0)
    STAMP();
    DUP(0) DUP(1)
    run_phase<0>(p, F); run_phase<1>(p, F); GSYNC(); STAMP();
    DUP(2) run_phase<2>(p, F); GSYNC(); STAMP();
    DUP(3) run_phase<3>(p, F); GSYNC(); STAMP();
    DUP(4) run_phase<4>(p, F); GSYNC(); STAMP();
    DUP(5) run_phase<5>(p, F); GSYNC(); STAMP();
    DUP(12)
    run_phase<12>(p, F); GSYNC(); STAMP();
    DUP(6) run_phase<6>(p, F); GSYNC(); STAMP();
    DUP(7) run_phase<7>(p, F); GSYNC(); STAMP();
    if (DUP_PHASE == 8) { run_phase<28>(p, F); GSYNC(); STAMP(); }
    run_phase<8>(p, F); GSYNC(); STAMP();
    DUP(9) run_phase<9>(p, F); GSYNC(); STAMP();
    DUP(10) run_phase<10>(p, F); GSYNC(); STAMP();
    if (DUP_PHASE == 11) { run_phase<11>(p, F); GSYNC(); STAMP(); }
    run_phase<11>(p, F); STAMP();
    if (PROBE_T >= 0 && F.bid == 0 && F.tid == 0) { const unsigned long long t0 = __builtin_amdgcn_s_memrealtime(); const unsigned long long w_ = ts_b - ts_a; while (__builtin_amdgcn_s_memrealtime() - t0 < w_) __builtin_amdgcn_s_sleep(8); }
}

template <int PH> static void launch_phase(const Params& p, int grid, hipStream_t stream) {
    static bool attr = false;
    if (!attr) { (void)hipFuncSetAttribute((const void*)k_phase<PH>, hipFuncAttributeMaxDynamicSharedMemorySize, LDS_BYTES); attr = true; }
    hipLaunchKernelGGL(k_phase<PH>, dim3(grid), dim3(NTHREADS), LDS_BYTES, stream, p);
}

extern "C" void kernel_launch(void* const* d_in, const int* in_sizes, int n_in, void* d_out, int out_size, void* d_ws, size_t ws_size, hipStream_t stream) {
    static int grid = 0;
    if (grid == 0) {
        int dev = 0, cus = 0, per_cu = 0;
        (void)hipGetDevice(&dev); (void)hipDeviceGetAttribute(&cus, hipDeviceAttributeMultiprocessorCount, dev);
        (void)hipFuncSetAttribute((const void*)k_mega, hipFuncAttributeMaxDynamicSharedMemorySize, LDS_BYTES);
        (void)hipOccupancyMaxActiveBlocksPerMultiprocessor(&per_cu, (const void*)k_mega, NTHREADS, LDS_BYTES);
        (void)hipGetLastError();
        grid = cus > 0 ? cus : 256;
        if (n_in != 34 || ws_size < 512 * MiB) fprintf(stderr, "kernel_launch: unexpected n_in %d / ws_size %zu\n", n_in, ws_size);
    }
    Params p{};
    for (int i = 0; i < 34; ++i) p.in[i] = (const float*)d_in[i];
    p.out = (float*)d_out; p.ws = (unsigned char*)d_ws;
    (void)hipMemsetAsync((char*)d_ws + WS_CTL, 0, CTL_BYTES, stream);
#if ONE_LAUNCH
    void* args[] = {&p};
    hipError_t e = hipLaunchCooperativeKernel((const void*)k_mega, dim3(grid), dim3(NTHREADS), args, LDS_BYTES, stream);
    if (e != hipSuccess) fprintf(stderr, "cooperative launch failed: %s (grid %d)\n", hipGetErrorString(e), grid);
#else
    launch_phase<0>(p, grid, stream); launch_phase<1>(p, grid, stream); launch_phase<2>(p, grid, stream); launch_phase<3>(p, grid, stream);
    launch_phase<4>(p, grid, stream); launch_phase<5>(p, grid, stream);
    launch_phase<12>(p, grid, stream);
    launch_phase<6>(p, grid, stream); launch_phase<7>(p, grid, stream);
    launch_phase<8>(p, grid, stream); launch_phase<9>(p, grid, stream); launch_phase<10>(p, grid, stream); launch_phase<11>(p, grid, stream);
#endif
}
```

```cpp
#include <hip/hip_runtime.h>
#include <hip/hip_cooperative_groups.h>
#include <cstdio>
#include <cstdint>
namespace cg = cooperative_groups;

#ifndef ONE_LAUNCH
#define ONE_LAUNCH 1
#endif

#define DI __device__ __forceinline__
#define LAS __attribute__((address_space(3)))
typedef unsigned short bf16_t;
typedef short bf16x8 __attribute__((ext_vector_type(8)));
typedef short s16x4 __attribute__((ext_vector_type(4)));
typedef float f32x4 __attribute__((ext_vector_type(4)));
typedef float f32x2 __attribute__((ext_vector_type(2)));
typedef unsigned u32x4 __attribute__((ext_vector_type(4)));
typedef unsigned u32x2 __attribute__((ext_vector_type(2)));

constexpr int D = 1024, BATCH = 4, SEQ = 8192, CTXL = 256;
constexpr int NT = BATCH * SEQ;
constexpr int NCX = BATCH * CTXL;
constexpr int MR = NT + NCX;
constexpr int BW = 512, AW = 512, NH = 8, HD = 64;
constexpr int DIN = 2944, DINP = 3072;
constexpr int OFF_K = 0, OFF_V = 512, OFF_R = 1024, OFF_WD = 1536, OFF_AD = 1664, OFF_GD = 1792, OFF_U = 1920, OFF_VA = 2432;
constexpr int NEXP = 32, DEXP = 256;
constexpr int NWAVES = 8, NTHREADS = 512;
constexpr int LDS_BYTES = 149504, LDS_MISC = 147456;

constexpr size_t MiB = 1u << 20;
constexpr size_t WS_CTL = 0, CTL_BYTES = 64 * 1024;
constexpr size_t WS_MOD = 1 * MiB;
constexpr size_t WS_DUPT = 2 * MiB;
constexpr size_t WS_AUPT = WS_DUPT + 131072;
constexpr size_t WS_GUPT = WS_AUPT + 131072;
constexpr size_t WS_WSP = WS_GUPT + 131072;
constexpr size_t WS_CONVW = WS_WSP + 262144;
constexpr size_t WS_WINT = 3 * MiB;
constexpr size_t WS_WOUTT = 9 * MiB;
constexpr size_t WS_H = 11 * MiB;
constexpr size_t WS_Z = 77 * MiB;
constexpr size_t ROWB = (size_t)MR * 512 * 2;
constexpr size_t WS_KC = 275 * MiB, WS_VC = WS_KC + ROWB, WS_RC = WS_VC + ROWB, WS_A0 = WS_RC + ROWB, WS_A1 = WS_A0 + ROWB, WS_L0 = WS_A1 + ROWB, WS_L1 = WS_L0 + ROWB;
constexpr size_t WS_OPS = 11 * MiB;
constexpr size_t WS_YS = 11 * MiB;
constexpr size_t WS_Y = 11 * MiB;
constexpr size_t WS_H2 = 139 * MiB;
constexpr size_t WS_EW = 203 * MiB;
constexpr size_t WS_PERM = 204 * MiB;
constexpr size_t WS_HID = 210 * MiB;
constexpr size_t WS_YMOE = 246 * MiB;
constexpr size_t WS_WGUT = 374 * MiB;
constexpr size_t WS_WDT = 406 * MiB;
constexpr size_t DO_MIXED = 0, DO_GATE = 64 * MiB, DO_BV = 96 * MiB;

struct Params { const float* in[34]; float* out; unsigned char* ws; };
enum { I_X = 0, I_C, I_CTX, I_CCTX, I_WMOD, I_BMOD, I_GPRE1, I_GPOST1, I_GPRE2, I_GPOST2, I_WIN, I_CONV, I_GMLNG, I_GMLNB, I_WSP, I_BSP,
       I_DW0, I_DUP, I_A0, I_AUP, I_KK, I_KA, I_RK, I_GUP, I_LNXG, I_LNXB, I_WOUT, I_WRG, I_BRG, I_WRE, I_BRE, I_WG, I_WU, I_WD };

typedef __bf16 bf16x2_t __attribute__((ext_vector_type(2)));
typedef _Float16 h2_t __attribute__((ext_vector_type(2)));
typedef _Float16 h4_t __attribute__((ext_vector_type(4)));
DI unsigned pkh2(float lo, float hi) { const f32x2 v = {lo, hi}; const h2_t h = __builtin_convertvector(v, h2_t); return __builtin_bit_cast(unsigned, h); }
DI unsigned pk2(float lo, float hi) { const f32x2 v = {lo, hi}; const bf16x2_t b = __builtin_convertvector(v, bf16x2_t); return __builtin_bit_cast(unsigned, b); }
DI unsigned f2bf(float f) { return pk2(f, f) & 0xffffu; }
DI float bf2f(unsigned b) { return __builtin_bit_cast(float, b << 16); }
DI float bflo(unsigned w) { return __builtin_bit_cast(float, w << 16); }
DI float bfhi(unsigned w) { return __builtin_bit_cast(float, w & 0xffff0000u); }
DI unsigned cvt_pk_bf16(float lo, float hi) { return pk2(lo, hi); }

template <int CTRL, int ROWMASK> DI float dppf(float v) { return __builtin_bit_cast(float, __builtin_amdgcn_update_dpp(0, __builtin_bit_cast(int, v), CTRL, ROWMASK, 0xf, false)); }
DI float wave_scan_incl(float v) {
    v += dppf<0x111, 0xf>(v); v += dppf<0x112, 0xf>(v); v += dppf<0x114, 0xf>(v); v += dppf<0x118, 0xf>(v);
    v += dppf<0x142, 0xa>(v); v += dppf<0x143, 0xc>(v); return v;
}
DI float lane63(float v) { return __builtin_bit_cast(float, __builtin_amdgcn_readlane(__builtin_bit_cast(int, v), 63)); }
DI float wave_sum(float v) { return lane63(wave_scan_incl(v)); }
DI float sigmoidf_(float x) { return __builtin_amdgcn_rcpf(1.f + __expf(-x)); }
DI float siluf_(float x) { return x * __builtin_amdgcn_rcpf(1.f + __expf(-x)); }
DI float softplusf_(float x) { return fmaxf(x, 0.f) + __logf(1.f + __expf(-fabsf(x))); }
DI float tanh_fast(float x) { const float e = __expf(-2.f * fabsf(x)); const float t = (1.f - e) * __builtin_amdgcn_rcpf(1.f + e); return x < 0.f ? -t : t; }
DI float gelu_tanh(float x) { const float u = 0.7978845608028654f * (x + 0.044715f * x * x * x); return 0.5f * x * (1.f + tanh_fast(u)); }
#define LDS_WAIT() asm volatile("s_waitcnt lgkmcnt(0)" ::: "memory")

namespace pg8 {
constexpr int BM = 256, BK = 64, HALF = 128, HTB = HALF * BK * 2, STAGE_BYTES = 8 * HTB, NXCD = 8, WGM = 8;
__host__ __device__ __forceinline__ int lds_byte(int r, int c) { const int st = (r >> 4) * 2 + (c >> 5), rr = r & 15, cc = c & 31, ob = rr * 64 + cc * 2; return st * 1024 + (ob ^ (((ob >> 9) & 1) << 5)); }
__host__ __device__ __forceinline__ void stage_rc(int b, int& R, int& C) { const int st = b / 1024, sb = b % 1024, swz = sb ^ (((sb >> 9) & 1) << 5); R = (st >> 1) * 16 + swz / 64; C = (st & 1) * 32 + (swz % 64) / 2; }
__host__ __device__ __forceinline__ int perm32(int rho) { const int n = rho >> 4, i = rho & 15; return 8 * (i >> 2) + 4 * n + (i & 3); }

struct Unit { const char* A; const char* B; const int* ridx; int pm, pn, e, lt, nvalid; };

struct StaticOrder {
    const char* A; const char* Bt; int K; int nM, nN, nwg, G, c;
    __device__ void init(const void* A_, const void* Bt_, int M, int N, int K_, int G_, int c_) { A = (const char*)A_; Bt = (const char*)Bt_; K = K_; nM = M / BM; nN = N / BM; nwg = nM * nN; G = G_; c = c_; }
    __device__ bool next(int i, Unit& u) const {
        const long L = (long)i * G + c; if (L >= nwg) return false;
        int wgid = (int)L; { const int q = nwg / NXCD, r = nwg % NXCD, xcd = wgid % NXCD, off = wgid / NXCD; wgid = (xcd < r ? xcd * (q + 1) : r * (q + 1) + (xcd - r) * q) + off; }
        const int nig = WGM * nN, gid = wgid / nig, fm = gid * WGM, gsz = (nM - fm) < WGM ? (nM - fm) : WGM;
        u.pm = fm + ((wgid % nig) % gsz); u.pn = (wgid % nig) / gsz;
        u.A = A + (size_t)u.pm * BM * K * 2; u.B = Bt + (size_t)u.pn * BM * K * 2; u.ridx = nullptr; u.e = 0; u.lt = 0; u.nvalid = BM; return true;
    }
};

DI int gidx(const Unit& u, int r) { return r < u.nvalid ? (u.ridx[r] >> 1) : 0; }

template <class Epi, class Sched, bool GATHER>
DI void gemm_phase(LAS unsigned char* lds, const int K, const Sched& S, const Epi& E) {
    const int tid = threadIdx.x, wid = __builtin_amdgcn_readfirstlane(tid >> 6), lane = tid & 63, wr = wid >> 2, wc = wid & 3, fr = lane & 15, fq = lane >> 4;
    const int nt = K / BK;
    int Rr[2], Cc[2];
    unsigned voffB[2], vA[2][2], vAn[2][2];
#pragma unroll
    for (int i = 0; i < 2; ++i) { int R, C; stage_rc(tid * 16 + i * 8192, R, C); Rr[i] = R; Cc[i] = C; const int Rb = (R & ~31) + perm32(R & 31);
        voffB[i] = (unsigned)(Rb * K + C) * 2u;
        vA[0][i] = (unsigned)(R * K + C) * 2u; vA[1][i] = (unsigned)((R + HALF) * K + C) * 2u; vAn[0][i] = vA[0][i]; vAn[1][i] = vA[1][i]; }
    const size_t kstep = (size_t)(BK * 2);
    const size_t hstep = (size_t)HALF * K * 2;
    const unsigned ldsw = (unsigned)wid * 1024u;
    const int aoff = lds_byte(wr * 64 + fr, fq * 8), boff = lds_byte(wc * 32 + fr, fq * 8);
#define PG8_SA(b, h) (((b) * 2 + (h)) * HTB)
#define PG8_SB(b, h) ((4 + (b) * 2 + (h)) * HTB)
#define PG8_STAGE(bufoff, gbase, voff) do { _Pragma("unroll") for (int _i = 0; _i < 2; ++_i) \
        __builtin_amdgcn_global_load_lds((const unsigned*)((const char*)(gbase) + (voff)[_i]), (LAS unsigned*)(lds + (bufoff) + ldsw + _i * 8192), 16, 0, 0); } while (0)
#define PG8_LDA(dst, b, h) do { _Pragma("unroll") for (int m = 0; m < 4; ++m) _Pragma("unroll") for (int k = 0; k < 2; ++k) dst[m][k] = *(const LAS bf16x8*)(lds + PG8_SA(b, h) + aoff + m * 2048 + k * 1024); } while (0)
#define PG8_LDB(dst, b, h) do { _Pragma("unroll") for (int n = 0; n < 2; ++n) _Pragma("unroll") for (int k = 0; k < 2; ++k) dst[n][k] = *(const LAS bf16x8*)(lds + PG8_SB(b, h) + boff + n * 2048 + k * 1024); } while (0)
#define PG8_MMA(ai, bj, At, Bt) do { __builtin_amdgcn_s_setprio(1); _Pragma("unroll") for (int m = 0; m < 4; ++m) _Pragma("unroll") for (int n = 0; n < 2; ++n) _Pragma("unroll") for (int k = 0; k < 2; ++k) \
        acc[ai][bj][m][n] = __builtin_amdgcn_mfma_f32_16x16x32_bf16(Bt[n][k], At[m][k], acc[ai][bj][m][n], 0, 0, 0); __builtin_amdgcn_s_setprio(0); } while (0)
#define PG8_WAIT_V(n) asm volatile("s_waitcnt vmcnt(" #n ")" ::: "memory")
#define PG8_WAIT_L(n) asm volatile("s_waitcnt lgkmcnt(" #n ")" ::: "memory")
#define PG8_BAR __builtin_amdgcn_s_barrier()
#define PG8_SCHED __builtin_amdgcn_sched_barrier(0)
    Unit cur, nxt; int ui = 0;
    if (!S.next(0, cur)) return;
    if constexpr (GATHER) {
#pragma unroll
        for (int i = 0; i < 2; ++i) { vA[0][i] = (unsigned)(gidx(cur, Rr[i]) * K + Cc[i]) * 2u; vA[1][i] = (unsigned)(gidx(cur, Rr[i] + HALF) * K + Cc[i]) * 2u; }
    }
    f32x4 acc[2][2][4][2];
#pragma unroll
    for (int a = 0; a < 2; ++a)
#pragma unroll
        for (int b = 0; b < 2; ++b)
#pragma unroll
            for (int m = 0; m < 4; ++m)
#pragma unroll
                for (int n = 0; n < 2; ++n) acc[a][b][m][n] = (f32x4){0.f, 0.f, 0.f, 0.f};
    bf16x8 At[4][2], B0[2][2], B1[2][2];
    const char* cA = cur.A; const char* cB = cur.B;
    PG8_STAGE(PG8_SB(0, 0), cB, voffB); PG8_STAGE(PG8_SB(0, 1), cB + hstep, voffB); PG8_STAGE(PG8_SA(0, 0), cA, vA[0]); PG8_STAGE(PG8_SA(0, 1), cA, vA[1]);
    if (wr == 1) PG8_BAR;
    PG8_WAIT_V(2); PG8_BAR;
    PG8_STAGE(PG8_SB(1, 0), cB + kstep, voffB); PG8_STAGE(PG8_SA(1, 0), cA + kstep, vA[0]); PG8_STAGE(PG8_SB(1, 1), cB + hstep + kstep, voffB);
    PG8_WAIT_V(6); PG8_BAR;
    for (;;) {
        const bool has_next = S.next(ui + 1, nxt);
        const char* nA = has_next ? nxt.A : cA; const char* nB = has_next ? nxt.B : cB;
        if constexpr (GATHER) {
            if (has_next) {
#pragma unroll
                for (int i = 0; i < 2; ++i) { vAn[0][i] = (unsigned)(gidx(nxt, Rr[i]) * K + Cc[i]) * 2u; vAn[1][i] = (unsigned)(gidx(nxt, Rr[i] + HALF) * K + Cc[i]) * 2u; }
            } else {
#pragma unroll
                for (int i = 0; i < 2; ++i) { vAn[0][i] = vA[0][i]; vAn[1][i] = vA[1][i]; }
            }
        }
#pragma unroll 1
        for (int t = 0; t < nt; t += 2) {
            const bool last = (t == nt - 2);
            const char* a1 = cA + (size_t)(t + 1) * kstep;
            const char* a2 = last ? nA : cA + (size_t)(t + 2) * kstep; const char* b2 = last ? nB : cB + (size_t)(t + 2) * kstep;
            const char* a3 = a2 + kstep; const char* b3 = b2 + kstep;
            unsigned w0[2], w1[2];
            if constexpr (GATHER) { w0[0] = last ? vAn[0][0] : vA[0][0]; w0[1] = last ? vAn[0][1] : vA[0][1]; w1[0] = last ? vAn[1][0] : vA[1][0]; w1[1] = last ? vAn[1][1] : vA[1][1]; }
            else { w0[0] = vA[0][0]; w0[1] = vA[0][1]; w1[0] = vA[1][0]; w1[1] = vA[1][1]; }
            PG8_LDB(B0, 0, 0); PG8_LDB(B1, 0, 1); PG8_SCHED; PG8_LDA(At, 0, 0); PG8_STAGE(PG8_SA(1, 1), a1, vA[1]);
            PG8_WAIT_V(8); PG8_WAIT_L(0); PG8_BAR; PG8_MMA(0, 0, At, B0); PG8_MMA(0, 1, At, B1); PG8_BAR; PG8_SCHED;
            PG8_LDA(At, 0, 1); PG8_STAGE(PG8_SB(0, 0), b2, voffB); PG8_STAGE(PG8_SB(0, 1), b2 + hstep, voffB); PG8_STAGE(PG8_SA(0, 0), a2, w0);
            PG8_WAIT_V(8); PG8_WAIT_L(0); PG8_BAR; PG8_MMA(1, 0, At, B0); PG8_MMA(1, 1, At, B1); PG8_BAR; PG8_SCHED;
            PG8_LDB(B0, 1, 0); PG8_LDB(B1, 1, 1); PG8_SCHED; PG8_LDA(At, 1, 0); PG8_STAGE(PG8_SA(0, 1), a2, w1);
            PG8_WAIT_V(8); PG8_WAIT_L(0); PG8_BAR; PG8_MMA(0, 0, At, B0); PG8_MMA(0, 1, At, B1); PG8_BAR; PG8_SCHED;
            PG8_LDA(At, 1, 1); PG8_STAGE(PG8_SB(1, 0), b3, voffB); PG8_STAGE(PG8_SB(1, 1), b3 + hstep, voffB); PG8_STAGE(PG8_SA(1, 0), a3, w0);
            PG8_WAIT_V(8); PG8_WAIT_L(0); PG8_BAR; PG8_MMA(1, 0, At, B0); PG8_MMA(1, 1, At, B1); PG8_BAR; PG8_SCHED;
        }
        if (wr == 0) PG8_BAR;
        E(acc, cur, wr, wc, fr, fq);
        if (!has_next) break;
#pragma unroll
        for (int a = 0; a < 2; ++a)
#pragma unroll
            for (int b = 0; b < 2; ++b)
#pragma unroll
                for (int m = 0; m < 4; ++m)
#pragma unroll
                    for (int n = 0; n < 2; ++n) acc[a][b][m][n] = (f32x4){0.f, 0.f, 0.f, 0.f};
        cur = nxt; cA = nA; cB = nB; ++ui;
        if constexpr (GATHER) {
#pragma unroll
            for (int i = 0; i < 2; ++i) { vA[0][i] = vAn[0][i]; vA[1][i] = vAn[1][i]; }
        }
        if (wr == 1) PG8_BAR;
    }
    PG8_WAIT_V(0);
    PG8_BAR;
#undef PG8_SA
#undef PG8_SB
#undef PG8_STAGE
#undef PG8_LDA
#undef PG8_LDB
#undef PG8_MMA
#undef PG8_WAIT_V
#undef PG8_WAIT_L
#undef PG8_BAR
#undef PG8_SCHED
}

struct EpiBf16 {
    bf16_t* O; int ldc; bool zact;
    DI void operator()(const f32x4 (&acc)[2][2][4][2], const Unit& u, int wr, int wc, int fr, int fq) const {
        const int row0 = u.pm * BM + wr * 64 + fr, col0 = u.pn * BM + wc * 32 + 8 * fq;
#pragma unroll
        for (int bj = 0; bj < 2; ++bj) { const int hc = 2 * u.pn + bj; const int act = !zact ? 0 : (hc < 12 ? 4 : (hc == 12 ? 1 : (hc == 14 ? 2 : (hc >= 15 ? 3 : 0))));
#pragma unroll
            for (int ai = 0; ai < 2; ++ai)
#pragma unroll
                for (int m = 0; m < 4; ++m) { bf16_t* rowp = O + (size_t)(row0 + ai * HALF + m * 16) * ldc + col0;
                    f32x4 v0 = acc[ai][bj][m][0], v1 = acc[ai][bj][m][1];
                    if (act == 1) {
#pragma unroll
                        for (int j = 0; j < 4; ++j) { v0[j] = tanh_fast(v0[j]); v1[j] = tanh_fast(v1[j]); }
                    } else if (act == 2) {
#pragma unroll
                        for (int j = 0; j < 4; ++j) { v0[j] = sigmoidf_(v0[j]); v1[j] = sigmoidf_(v1[j]); }
                    } else if (act == 3) {
#pragma unroll
                        for (int j = 0; j < 4; ++j) { v0[j] = gelu_tanh(v0[j]); v1[j] = gelu_tanh(v1[j]); }
                    }
                    u32x4 w;
                    if (act == 4) { w.x = pkh2(v0[0], v0[1]); w.y = pkh2(v0[2], v0[3]); w.z = pkh2(v1[0], v1[1]); w.w = pkh2(v1[2], v1[3]); }
                    else { w.x = cvt_pk_bf16(v0[0], v0[1]); w.y = cvt_pk_bf16(v0[2], v0[3]); w.z = cvt_pk_bf16(v1[0], v1[1]); w.w = cvt_pk_bf16(v1[2], v1[3]); }
                    *(u32x4*)(rowp + bj * HALF) = w; } }
    }
};
struct EpiF32 {
    float* O; int ldc;
    DI void operator()(const f32x4 (&acc)[2][2][4][2], const Unit& u, int wr, int wc, int fr, int fq) const {
        const int row0 = u.pm * BM + wr * 64 + fr, col0 = u.pn * BM + wc * 32 + 8 * fq;
#pragma unroll
        for (int ai = 0; ai < 2; ++ai)
#pragma unroll
            for (int m = 0; m < 4; ++m) { float* rowp = O + (size_t)(row0 + ai * HALF + m * 16) * ldc + col0;
#pragma unroll
                for (int bj = 0; bj < 2; ++bj) { *(f32x4*)(rowp + bj * HALF) = acc[ai][bj][m][0]; *(f32x4*)(rowp + bj * HALF + 4) = acc[ai][bj][m][1]; } }
    }
};
struct EpiMoeUp {
    bf16_t* HID;
    DI void operator()(const f32x4 (&acc)[2][2][4][2], const Unit& u, int wr, int wc, int fr, int fq) const {
        const int row0 = u.pm * BM + wr * 64 + fr, col0 = u.pn * HALF + wc * 32 + 8 * fq;
#pragma unroll
        for (int ai = 0; ai < 2; ++ai)
#pragma unroll
            for (int m = 0; m < 4; ++m) { bf16_t* rowp = HID + (size_t)(row0 + ai * HALF + m * 16) * DEXP + col0;
                float h[8];
#pragma unroll
                for (int n = 0; n < 2; ++n)
#pragma unroll
                    for (int j = 0; j < 4; ++j) { const float g = acc[ai][0][m][n][j], up = acc[ai][1][m][n][j]; h[n * 4 + j] = siluf_(g) * up; }
                u32x4 w; w.x = cvt_pk_bf16(h[0], h[1]); w.y = cvt_pk_bf16(h[2], h[3]); w.z = cvt_pk_bf16(h[4], h[5]); w.w = cvt_pk_bf16(h[6], h[7]);
                *(u32x4*)rowp = w; }
    }
};
struct EpiMoeDown {
    bf16_t* YM; const int* perm; const float* ew;
    DI void operator()(const f32x4 (&acc)[2][2][4][2], const Unit& u, int wr, int wc, int fr, int fq) const {
        const int col0 = u.pn * BM + wc * 32 + 8 * fq;
#pragma unroll
        for (int ai = 0; ai < 2; ++ai)
#pragma unroll
            for (int m = 0; m < 4; ++m) { const int r = ai * HALF + wr * 64 + m * 16 + fr;
                if (r < u.nvalid) { const int pr = perm[(size_t)u.e * NT + u.lt * BM + r]; const int tok = pr >> 1, slot = pr & 1; const float wgt = ew[pr];
                    bf16_t* rowp = YM + ((size_t)slot * NT + tok) * D + col0;
#pragma unroll
                    for (int bj = 0; bj < 2; ++bj) { const f32x4 v0 = acc[ai][bj][m][0] * wgt, v1 = acc[ai][bj][m][1] * wgt;
                        u32x4 w; w.x = cvt_pk_bf16(v0[0], v0[1]); w.y = cvt_pk_bf16(v0[2], v0[3]); w.z = cvt_pk_bf16(v1[0], v1[1]); w.w = cvt_pk_bf16(v1[2], v1[3]);
                        *(u32x4*)(rowp + bj * HALF) = w; } }
                asm volatile("" ::: "memory"); }
    }
};
}

struct MoeOrder {
    const LAS int* tp; const int* cnt; int npn, G, c, K; const char* A; const char* Bbase; size_t bstride_e, bstride_pn; const int* perm; bool gather;
    __device__ bool next(int i, pg8::Unit& u) const {
        const int TT = __builtin_amdgcn_readfirstlane(tp[32]); const long L = (long)i * G + c; if (L >= (long)TT * npn) return false;
        const int rt = (int)(L / npn), pn = (int)(L % npn);
        int e = 0;
#pragma unroll 1
        for (int j = 1; j < 32; ++j) e += (__builtin_amdgcn_readfirstlane(tp[j]) <= rt) ? 1 : 0;
        const int lt = rt - __builtin_amdgcn_readfirstlane(tp[e]);
        u.pm = rt; u.pn = pn; u.e = e; u.lt = lt; const int rem = cnt[e * 64] - lt * 256; u.nvalid = rem < 256 ? rem : 256;
        u.ridx = perm + (size_t)e * NT + lt * 256;
        u.A = gather ? A : A + (size_t)rt * 256 * K * 2;
        u.B = Bbase + (size_t)e * bstride_e + (size_t)pn * bstride_pn;
        return true;
    }
};

struct Ctx {
    LAS unsigned char* lds; int tid, lane, wave, G, bid;
};

DI void phase_adaln(const Params& p, const Ctx& F) {
    LAS float* s = (LAS float*)F.lds;
    LAS float* red = (LAS float*)(F.lds + 20480);
    const float* c = p.in[I_C]; const float* cc = p.in[I_CCTX]; const float* wm = p.in[I_WMOD]; const float* bm = p.in[I_BMOD];
    float* mod = (float*)(p.ws + WS_MOD);
    for (int i = F.tid; i < 5 * 1024; i += NTHREADS) { const float v = i < 4096 ? c[i] : cc[i - 4096]; s[i] = siluf_(v); }
    __syncthreads();
    for (int grp = F.bid; grp < 256; grp += F.G) {
        const int col0 = grp * 24, q = F.tid % 6, ks = F.tid / 6;
        float acc[5][4];
#pragma unroll
        for (int b = 0; b < 5; ++b)
#pragma unroll
            for (int j = 0; j < 4; ++j) acc[b][j] = 0.f;
        if (F.tid < 510) {
            f32x4 wv[13];
#pragma unroll
            for (int i = 0; i < 13; ++i) { const int k = ks + 85 * i; wv[i] = k < 1024 ? *(const f32x4*)(wm + (size_t)k * 6144 + col0 + 4 * q) : (f32x4){0.f, 0.f, 0.f, 0.f}; }
#pragma unroll
            for (int i = 0; i < 13; ++i) { const int k = ks + 85 * i; const int kc = k < 1024 ? k : 0;
#pragma unroll
                for (int b = 0; b < 5; ++b) { const float sv = s[b * 1024 + kc];
#pragma unroll
                    for (int j = 0; j < 4; ++j) acc[b][j] += sv * wv[i][j]; } }
#pragma unroll
            for (int b = 0; b < 5; ++b)
#pragma unroll
                for (int j = 0; j < 4; ++j) red[ks * 120 + q * 20 + b * 4 + j] = acc[b][j];
        }
        __syncthreads();
        if (F.tid < 120) {
            float sum = 0.f;
            for (int k2 = 0; k2 < 85; ++k2) sum += red[k2 * 120 + F.tid];
            const int qq = F.tid / 20, b = (F.tid % 20) / 4, j = F.tid % 4, col = col0 + 4 * qq + j;
            mod[b * 6144 + col] = sum + bm[col];
        }
        __syncthreads();
    }
}

DI void transpose_item(const float* W, int K, int N, bf16_t* WT, int row_off, LAS float* scr, int item, int lane) {
    const int nblk = N / 32, kb = item / nblk, nb = item % nblk, k0 = 64 * kb, n0 = 32 * nb;
#pragma unroll 8
    for (int i = 0; i < 32; ++i) { const int kk = 2 * i + (lane >> 5); scr[kk * 33 + (lane & 31)] = W[(size_t)(k0 + kk) * N + n0 + (lane & 31)]; }
    LDS_WAIT(); asm volatile("" ::: "memory");
    const int c = lane & 7;
#pragma unroll
    for (int j = 0; j < 4; ++j) { const int n = (lane >> 3) + 8 * j; const LAS float* s = scr + (8 * c) * 33 + n;
        u32x4 o; o.x = pk2(s[0 * 33], s[1 * 33]); o.y = pk2(s[2 * 33], s[3 * 33]); o.z = pk2(s[4 * 33], s[5 * 33]); o.w = pk2(s[6 * 33], s[7 * 33]);
        *(u32x4*)(WT + (size_t)(row_off + n0 + n) * K + k0 + 8 * c) = o; }
    LDS_WAIT(); asm volatile("" ::: "memory");
}
DI void phase_convert(const Params& p, const Ctx& F) {
    __syncthreads();
    LAS float* scr = (LAS float*)(F.lds + F.wave * 16384);
    const int gw = F.bid * NWAVES + F.wave, NGW = F.G * NWAVES;
    bf16_t* WinT = (bf16_t*)(p.ws + WS_WINT); bf16_t* WoutT = (bf16_t*)(p.ws + WS_WOUTT); bf16_t* WguT = (bf16_t*)(p.ws + WS_WGUT); bf16_t* WdT = (bf16_t*)(p.ws + WS_WDT);
    constexpr int I_IN = 16 * 92, I_OUT = 16 * 32;
    constexpr int NITEMS = I_IN + I_OUT;
    for (int it = gw; it < NITEMS; it += NGW) {
        int r = it;
        if (r < I_IN) { transpose_item(p.in[I_WIN], 1024, DIN, WinT, 0, scr, r, F.lane); continue; } r -= I_IN;
        transpose_item(p.in[I_WOUT], 1024, 1024, WoutT, 0, scr, r, F.lane);
    }
    (void)WguT; (void)WdT;
    { const int gt = F.bid * NTHREADS + F.tid, NG = F.G * NTHREADS; u32x4 z = {0u, 0u, 0u, 0u};
      for (int i = gt; i < 128 * 1024 / 8; i += NG) *(u32x4*)(WinT + (size_t)DIN * 1024 + (size_t)i * 8) = z;
      bf16_t* DupT = (bf16_t*)(p.ws + WS_DUPT); bf16_t* AupT = (bf16_t*)(p.ws + WS_AUPT); bf16_t* GupT = (bf16_t*)(p.ws + WS_GUPT); bf16_t* Wsp = (bf16_t*)(p.ws + WS_WSP);
      for (int i = gt; i < 2 * 512 * 64; i += NG) { const int d = i / (512 * 64), ch = (i / 64) % 512, l = i % 64;
          DupT[i] = (bf16_t)f2bf(p.in[I_DUP][(size_t)(d * 64 + l) * 512 + ch]); AupT[i] = (bf16_t)f2bf(p.in[I_AUP][(size_t)(d * 64 + l) * 512 + ch]); }
      for (int i = gt; i < 512 * 128; i += NG) { const int ch = i / 128, l = i % 128; GupT[i] = (bf16_t)f2bf(p.in[I_GUP][(size_t)l * 512 + ch]); }
      for (int i = gt; i < 8 * 128 * 128; i += NG) Wsp[i] = (bf16_t)f2bf(p.in[I_WSP][i]);
      float* cw2 = (float*)(p.ws + WS_CONVW);
      for (int i = gt; i < 128 * 9 * 3 * 4; i += NG) { const int j = i & 3, s3 = (i >> 2) % 3, tap = (i / 12) % 9, qd = i / 108; cw2[i] = p.in[I_CONV][tap * 1536 + s3 * 512 + 4 * qd + j]; } }
}


DI void phase_convert_experts(const Params& p, const Ctx& F) {
    constexpr int TP = 264;
    LAS bf16_t* tile = (LAS bf16_t*)F.lds;
    bf16_t* WguT = (bf16_t*)(p.ws + WS_WGUT); bf16_t* WdT = (bf16_t*)(p.ws + WS_WDT);
    constexpr int NIT = 32 * 2 * 16 + 32 * 16;
    const int b0 = F.bid, nb = F.G;
    for (int it = b0; it < NIT; it += nb) {
        const float* src; int ldn; bf16_t* dst; int ldk, k0; int rowmap;
        int n0 = 0;
        if (it < 1024) { const int e = it >> 5, up = (it >> 4) & 1, kt = it & 15; src = (up ? p.in[I_WU] : p.in[I_WG]) + (size_t)e * 1024 * 256 + (size_t)kt * 64 * 256; ldn = 256;
            dst = WguT + (size_t)e * 512 * 1024; ldk = 1024; k0 = kt * 64; rowmap = 1 + up; }
        else { const int r = it - 1024, e = r >> 4, kt = (r >> 2) & 3, ntl = r & 3; src = p.in[I_WD] + (size_t)e * 256 * 1024 + (size_t)kt * 64 * 1024 + ntl * 256; ldn = 1024;
            dst = WdT + (size_t)e * 1024 * 256; ldk = 256; k0 = kt * 64; rowmap = 0; n0 = ntl * 256; }
        __syncthreads();
#pragma unroll
        for (int i = 0; i < 8; ++i) { const int k = 8 * F.wave + i; const f32x4 v = *(const f32x4*)(src + (size_t)k * ldn + 4 * F.lane);
            u32x2 o; o.x = pk2(v[0], v[1]); o.y = pk2(v[2], v[3]); *(LAS u32x2*)(tile + k * TP + 4 * F.lane) = o; }
        __syncthreads();
        { const int n = F.tid >> 1, kh = F.tid & 1;
          u32x4 o[4];
#pragma unroll
          for (int q = 0; q < 4; ++q) { unsigned wds[4];
#pragma unroll
              for (int j = 0; j < 4; ++j) { const int k = 32 * kh + 8 * q + 2 * j; wds[j] = (unsigned)tile[k * TP + n] | ((unsigned)tile[(k + 1) * TP + n] << 16); }
              o[q] = (u32x4){wds[0], wds[1], wds[2], wds[3]}; }
          const int drow = rowmap == 0 ? n0 + n : ((n >> 7) * 256 + (n & 127) + (rowmap == 2 ? 128 : 0));
          bf16_t* dp = dst + (size_t)drow * ldk + k0 + 32 * kh;
#pragma unroll
          for (int q = 0; q < 4; ++q) *(u32x4*)(dp + 8 * q) = o[q]; }
    }
}

DI void phase_hrows(const Params& p, const Ctx& F) {
    const float* mod = (const float*)(p.ws + WS_MOD); const float* g = p.in[I_GPRE1]; bf16_t* H = (bf16_t*)(p.ws + WS_H);
    const int gw = F.bid * NWAVES + F.wave, NGW = F.G * NWAVES;
    auto rowsrc = [&](int row) -> const f32x4* { return (const f32x4*)(row < NT ? p.in[I_X] + (size_t)row * D : p.in[I_CTX] + (size_t)(row - NT) * D) + F.lane; };
    f32x4 nv[4];
    if (gw < MR) { const f32x4* xr = rowsrc(gw);
#pragma unroll
        for (int j = 0; j < 4; ++j) nv[j] = xr[64 * j]; }
    for (int row = gw; row < MR; row += NGW) {
        const int bt = row < NT ? row / SEQ : 4;
        f32x4 v[4]; float ss = 0.f;
#pragma unroll
        for (int j = 0; j < 4; ++j) { v[j] = nv[j]; ss += (v[j].x * v[j].x + v[j].y * v[j].y) + (v[j].z * v[j].z + v[j].w * v[j].w); }
        if (row + NGW < MR) { const f32x4* xr = rowsrc(row + NGW);
#pragma unroll
            for (int j = 0; j < 4; ++j) nv[j] = xr[64 * j]; }
        const float rstd = __builtin_amdgcn_rsqf(wave_sum(ss) * (1.f / D) + 1e-6f);
        unsigned long long* o8 = (unsigned long long*)(H + (size_t)row * D) + F.lane;
#pragma unroll
        for (int j = 0; j < 4; ++j) { const int col = 4 * (F.lane + 64 * j);
            const f32x4 gg = *(const f32x4*)(g + col), sh = *(const f32x4*)(mod + bt * 6144 + col), sc = *(const f32x4*)(mod + bt * 6144 + 1024 + col);
            const f32x4 h = v[j] * rstd * gg * (sc + 1.f) + sh;
            o8[64 * j] = (unsigned long long)pk2(h.x, h.y) | ((unsigned long long)pk2(h.z, h.w) << 32); }
    }
}

DI void phase_gemm1(const Params& p, const Ctx& F) {
    pg8::StaticOrder S; S.init(p.ws + WS_H, p.ws + WS_WINT, MR, DINP, 1024, F.G, F.bid);
    pg8::EpiBf16 E{(bf16_t*)(p.ws + WS_Z), DINP, true};
    pg8::gemm_phase<pg8::EpiBf16, pg8::StaticOrder, false>(F.lds, 1024, S, E);
}

DI void phase_prep(const Params& p, const Ctx& F) {
    const bf16_t* Z = (const bf16_t*)(p.ws + WS_Z);
    bf16_t* Kc = (bf16_t*)(p.ws + WS_KC); bf16_t* Vc = (bf16_t*)(p.ws + WS_VC); bf16_t* Rc = (bf16_t*)(p.ws + WS_RC);
    bf16_t* A0 = (bf16_t*)(p.ws + WS_A0); bf16_t* A1 = (bf16_t*)(p.ws + WS_A1); bf16_t* L0 = (bf16_t*)(p.ws + WS_L0); bf16_t* L1 = (bf16_t*)(p.ws + WS_L1);
    bf16_t* GATE = (bf16_t*)((unsigned char*)p.out + DO_GATE); bf16_t* BV = (bf16_t*)((unsigned char*)p.out + DO_BV);
    const float* conv = p.in[I_CONV];
    LAS float* sl = (LAS float*)F.lds;
    const int t = F.tid;
    for (int it = F.bid; it < MR / 8; it += F.G) {
        const int row0 = it * 8;
        __syncthreads();
        for (int i = t; i < 8 * 384; i += NTHREADS) { const int rr = i / 384, c = i % 384; const float zv = bf2f(Z[(size_t)(row0 + rr) * DINP + OFF_WD + c]);
            sl[i] = c < 128 ? tanhf(zv) : (c < 256 ? zv : sigmoidf_(zv)); }
        __syncthreads();
        float dw0[8], dw1[8], da0[8], da1[8], gt[8];
#pragma unroll
        for (int r = 0; r < 8; ++r) { dw0[r] = dw1[r] = da0[r] = da1[r] = gt[r] = 0.f; }
        for (int l = 0; l < 64; ++l) {
            const float u0 = p.in[I_DUP][(size_t)l * 512 + t], u1 = p.in[I_DUP][(size_t)(64 + l) * 512 + t];
            const float v0 = p.in[I_AUP][(size_t)l * 512 + t], v1 = p.in[I_AUP][(size_t)(64 + l) * 512 + t];
            const float g0 = p.in[I_GUP][(size_t)l * 512 + t], g1 = p.in[I_GUP][(size_t)(64 + l) * 512 + t];
#pragma unroll
            for (int r = 0; r < 8; ++r) { const LAS float* s = sl + r * 384;
                dw0[r] += s[l] * u0; dw1[r] += s[64 + l] * u1; da0[r] += s[128 + l] * v0; da1[r] += s[192 + l] * v1; gt[r] += s[256 + l] * g0 + s[320 + l] * g1; }
        }
        const float w00 = p.in[I_DW0][t], w01 = p.in[I_DW0][512 + t], a00 = p.in[I_A0][t], a01 = p.in[I_A0][512 + t];
        const float ka0 = p.in[I_KA][t], ka1 = p.in[I_KA][512 + t], rk = p.in[I_RK][t];
#pragma unroll 1
        for (int r = 0; r < 8; ++r) {
            const int row = row0 + r;
            float cv[3] = {0.f, 0.f, 0.f};
            if (row < NT) {
                const int tb = row % SEQ, gy = tb / 64, gx = tb % 64;
#pragma unroll
                for (int dy = 0; dy < 3; ++dy) { const int ny = gy + dy - 1; if (ny < 0 || ny >= 128) continue;
#pragma unroll
                    for (int dx = 0; dx < 3; ++dx) { const int nx = gx + dx - 1; if (nx < 0 || nx >= 64) continue;
                        const size_t nrow = (size_t)(row + (dy - 1) * 64 + (dx - 1));
#pragma unroll
                        for (int s3 = 0; s3 < 3; ++s3) cv[s3] += bf2f(Z[nrow * DINP + s3 * 512 + t]) * conv[(dy * 3 + dx) * 1536 + s3 * 512 + t]; } }
            } else {
                const int tb = (row - NT) % CTXL;
#pragma unroll
                for (int dx = 0; dx < 3; ++dx) { const int nx = tb + dx - 1; if (nx < 0 || nx >= CTXL) continue;
                    const size_t nrow = (size_t)(row + dx - 1);
#pragma unroll
                    for (int s3 = 0; s3 < 3; ++s3) cv[s3] += bf2f(Z[nrow * DINP + s3 * 512 + t]) * conv[(3 + dx) * 1536 + s3 * 512 + t]; }
            }
            const float k = cv[0], v = cv[1], rr = cv[2];
            const float wl0 = w00 + dw0[r], wl1 = w01 + dw1[r];
            const float lg0 = -__expf(-softplusf_(-wl0) - 0.5f), lg1 = -__expf(-softplusf_(-wl1) - 0.5f);
            const float a0 = sigmoidf_(a00 + da0[r]), a1 = sigmoidf_(a01 + da1[r]);
            const size_t o = (size_t)row * 512 + t;
            Kc[o] = (bf16_t)f2bf(k); Vc[o] = (bf16_t)f2bf(v); Rc[o] = (bf16_t)f2bf(rr);
            A0[o] = (bf16_t)f2bf(a0); A1[o] = (bf16_t)f2bf(a1); L0[o] = (bf16_t)f2bf(lg0); L1[o] = (bf16_t)f2bf(lg1);
            if (row < NT) {
                const float km0 = k * (1.f + (a0 - 1.f) * ka0), km1 = k * (1.f + (a1 - 1.f) * ka1);
                const float bon = wave_sum(rr * (km0 + km1) * rk);
                GATE[o] = (bf16_t)f2bf(gt[r]); BV[o] = (bf16_t)f2bf(bon * v);
            }
        }
    }
}


constexpr int ZS_TOKB = 400, ZS_ROWB = 66 * ZS_TOKB, ZS_BYTES = 3 * ZS_ROWB;
constexpr int XS_OFF = ZS_BYTES, XS_ARR = 64 * 144, XSG_OFF = XS_OFF + 4 * XS_ARR, XSG_PITCH = 272, BON_OFF = XSG_OFF + 64 * XSG_PITCH;
constexpr int CWL_OFF = BON_OFF + 1024;
static_assert(CWL_OFF + 6912 <= LDS_MISC, "prep LDS");
struct PrepLd { u32x4 zv[9]; u32x4 hv; u32x4 xv[6]; };
DI void prep_issue(PrepLd& L, const bf16_t* Z, int item, int tidv) {
    const int h = item & 7, ck = item >> 3; const bool lat = ck < 512;
    const int b = lat ? ck >> 7 : (ck - 512) >> 2, c = lat ? ck & 127 : (ck - 512) & 3;
    const int rowbase = lat ? b * SEQ + c * 64 : NT + b * CTXL + c * 64;
    const int q8 = tidv & 7, tsl = tidv >> 3;
    const bf16_t* zc = Z + (size_t)(rowbase + tsl) * DINP + 64 * h + 8 * q8;
#pragma unroll
    for (int rr = 0; rr < 3; ++rr) {
        const bool ok = lat ? (c + rr - 1 >= 0 && c + rr - 1 < 128) : (rr == 1);
        const bf16_t* zr = ok ? zc + (long)(rr - 1) * 64 * DINP : zc;
#pragma unroll
        for (int sec = 0; sec < 3; ++sec) { const u32x4 v = *(const u32x4*)(zr + sec * 512); L.zv[rr * 3 + sec] = ok ? v : (u32x4){0u, 0u, 0u, 0u}; }
    }
    {
      const int hq8 = tidv & 7, hsec = (tidv >> 3) % 3, hside = (tidv >> 3) / 3 & 1, hrr = (tidv >> 3) / 6;
      const int tx = c * 64 + (hside ? 64 : -1);
      const bool ok = !lat && tidv < 144 && hrr == 1 && tx >= 0 && tx < CTXL;
      const size_t off = ok ? (size_t)(NT + b * CTXL + tx) * DINP + hsec * 512 + 64 * h + 8 * hq8 : 0;
      const u32x4 v = *(const u32x4*)(Z + off); L.hv = ok ? v : (u32x4){0u, 0u, 0u, 0u}; }
    const bf16_t* zx = Z + (size_t)(rowbase + tsl) * DINP + OFF_WD + 8 * q8;
#pragma unroll
    for (int it = 0; it < 6; ++it) L.xv[it] = *(const u32x4*)(zx + 64 * it);
}
DI void phase_prep2(const Params& p, const Ctx& F) {
    const bf16_t* Z = (const bf16_t*)(p.ws + WS_Z);
    bf16_t* Kc = (bf16_t*)(p.ws + WS_KC); bf16_t* Vc = (bf16_t*)(p.ws + WS_VC); bf16_t* Rc = (bf16_t*)(p.ws + WS_RC);
    bf16_t* A0 = (bf16_t*)(p.ws + WS_A0); bf16_t* A1 = (bf16_t*)(p.ws + WS_A1); bf16_t* L0 = (bf16_t*)(p.ws + WS_L0); bf16_t* L1 = (bf16_t*)(p.ws + WS_L1);
    bf16_t* GATE = (bf16_t*)((unsigned char*)p.out + DO_GATE); bf16_t* BV = (bf16_t*)((unsigned char*)p.out + DO_BV);
    const bf16_t* DupT = (const bf16_t*)(p.ws + WS_DUPT); const bf16_t* AupT = (const bf16_t*)(p.ws + WS_AUPT); const bf16_t* GupT = (const bf16_t*)(p.ws + WS_GUPT);
    const float* cw2 = (const float*)(p.ws + WS_CONVW);
    LAS unsigned char* ZS = F.lds; LAS float* BON = (LAS float*)(F.lds + BON_OFF);
    const int w = F.wave, fr0 = F.lane & 15, fq0 = F.lane >> 4, ct = w >> 1, tt0 = 2 * (w & 1);
    constexpr int NITEM = 528 * 8;
    const bool xmap = (F.G == 256);
    auto item_of = [&](int i) -> int { if (!xmap) { const int it = F.bid + i * F.G; return it < NITEM ? it : -1; }
        const int x = F.bid & 7, y = F.bid >> 3, j = y + 32 * i; return j < 528 ? (x * 66 + (j >> 3)) * 8 + (j & 7) : -1; };
    PrepLd L;
    bf16x8 wf[4][2], gf[4]; f32x4 w00, w01, a00, a01, ka0, ka1, rk; int hcur = -1;
    int itx = 0, item = item_of(0);
    if (item >= 0) prep_issue(L, Z, item, F.tid);
    for (; item >= 0; ) {
        const int item_next = item_of(++itx);
        const int h = item & 7, ck = item >> 3;
        const bool lat = ck < 512;
        const int b = lat ? ck >> 7 : (ck - 512) >> 2, c = lat ? ck & 127 : (ck - 512) & 3;
        const int rowbase = lat ? b * SEQ + c * 64 : NT + b * CTXL + c * 64;
        int tidv = F.tid, fr = fr0, fq = fq0; asm volatile("" : "+v"(tidv), "+v"(fr), "+v"(fq));
        __syncthreads();
        { const int q8 = tidv & 7, tsl = tidv >> 3;
#pragma unroll
          for (int rr = 0; rr < 3; ++rr)
#pragma unroll
              for (int sec = 0; sec < 3; ++sec) *(LAS u32x4*)(ZS + rr * ZS_ROWB + (tsl + 1) * ZS_TOKB + sec * 128 + q8 * 16) = L.zv[rr * 3 + sec];
          if (tidv < 144) { const int hsec = (tidv >> 3) % 3, hside = (tidv >> 3) / 3 & 1, hrr = (tidv >> 3) / 6;
              *(LAS u32x4*)(ZS + hrr * ZS_ROWB + (hside ? 65 : 0) * ZS_TOKB + hsec * 128 + q8 * 16) = L.hv; }
#pragma unroll
          for (int it = 0; it < 6; ++it) {
              const u32x4 o = L.xv[it];
              if (it < 4) *(LAS u32x4*)(F.lds + XS_OFF + it * XS_ARR + tsl * 144 + q8 * 16) = o;
              else *(LAS u32x4*)(F.lds + XSG_OFF + tsl * XSG_PITCH + ((it - 4) * 8 + q8) * 16) = o; } }
        if (h != hcur) {
            hcur = h;
            const int chrow = 64 * h + 16 * ct + fr, gch0 = 64 * h + 16 * ct + 4 * fq;
#pragma unroll
            for (int q = 0; q < 4; ++q) { const bf16_t* WT = (q < 2 ? DupT : AupT) + ((size_t)(q & 1) * 512 + chrow) * 64;
#pragma unroll
                for (int s2 = 0; s2 < 2; ++s2) wf[q][s2] = *(const bf16x8*)(WT + 32 * s2 + 8 * fq); }
#pragma unroll
            for (int s2 = 0; s2 < 4; ++s2) gf[s2] = *(const bf16x8*)(GupT + (size_t)chrow * 128 + 32 * s2 + 8 * fq);
            w00 = *(const f32x4*)(p.in[I_DW0] + gch0); w01 = *(const f32x4*)(p.in[I_DW0] + 512 + gch0); a00 = *(const f32x4*)(p.in[I_A0] + gch0); a01 = *(const f32x4*)(p.in[I_A0] + 512 + gch0);
            ka0 = *(const f32x4*)(p.in[I_KA] + gch0); ka1 = *(const f32x4*)(p.in[I_KA] + 512 + gch0); rk = *(const f32x4*)(p.in[I_RK] + gch0);
            if (tidv < 432) { const f32x4 wv4 = *(const f32x4*)(cw2 + (size_t)h * 16 * 108 + tidv * 4); u32x2 hw; hw.x = pkh2(wv4[0], wv4[1]); hw.y = pkh2(wv4[2], wv4[3]); *(LAS u32x2*)(F.lds + CWL_OFF + tidv * 8) = hw; }
        }
        if (item_next >= 0) prep_issue(L, Z, item_next, tidv);
        const int gch = 64 * h + 16 * ct + 4 * fq;
        const LAS h4_t* cwl = (const LAS h4_t*)(F.lds + CWL_OFF) + (4 * ct + fq) * 27;
        __syncthreads();
        f32x4 vkeep[2];
#pragma unroll 1
        for (int t2 = 0; t2 < 2; ++t2) {
            const int tok = 16 * (tt0 + t2) + fr;
            f32x4 acc[5];
#pragma unroll
            for (int q = 0; q < 5; ++q) acc[q] = (f32x4){0.f, 0.f, 0.f, 0.f};
#pragma unroll
            for (int q = 0; q < 4; ++q) {
#pragma unroll
                for (int s2 = 0; s2 < 2; ++s2) { const bf16x8 bfr = *(const LAS bf16x8*)(F.lds + XS_OFF + q * XS_ARR + tok * 144 + (32 * s2 + 8 * fq) * 2);
                    acc[q] = __builtin_amdgcn_mfma_f32_16x16x32_bf16(wf[q][s2], bfr, acc[q], 0, 0, 0); }
            }
#pragma unroll
            for (int s2 = 0; s2 < 4; ++s2) { const bf16x8 bfr = *(const LAS bf16x8*)(F.lds + XSG_OFF + tok * XSG_PITCH + (32 * s2 + 8 * fq) * 2);
                acc[4] = __builtin_amdgcn_mfma_f32_16x16x32_bf16(gf[s2], bfr, acc[4], 0, 0, 0); }
            f32x4 cv[3];
            { h4_t hc[3];
#pragma unroll
              for (int s3 = 0; s3 < 3; ++s3) hc[s3] = (h4_t){(_Float16)0.f, (_Float16)0.f, (_Float16)0.f, (_Float16)0.f};
#pragma unroll
              for (int dy = 0; dy < 3; ++dy)
#pragma unroll
                  for (int dx = 0; dx < 3; ++dx) {
#pragma unroll
                      for (int s3 = 0; s3 < 3; ++s3) { const h4_t wv = cwl[(dy * 3 + dx) * 3 + s3];
                          const h4_t zz = *(const LAS h4_t*)(ZS + dy * ZS_ROWB + (tok + dx) * ZS_TOKB + s3 * 128 + (16 * ct + 4 * fq) * 2);
                          hc[s3] += zz * wv; }
                  }
#pragma unroll
              for (int s3 = 0; s3 < 3; ++s3) cv[s3] = (f32x4){(float)hc[s3][0], (float)hc[s3][1], (float)hc[s3][2], (float)hc[s3][3]}; }
            const size_t o = (size_t)(rowbase + tok) * 512 + gch;
            float lg0[4], lg1[4], a0[4], a1[4]; float bs = 0.f;
#pragma unroll
            for (int i = 0; i < 4; ++i) { const float wl0 = w00[i] + acc[0][i], wl1 = w01[i] + acc[1][i];
                lg0[i] = -__expf(-softplusf_(-wl0) - 0.5f); lg1[i] = -__expf(-softplusf_(-wl1) - 0.5f);
                a0[i] = sigmoidf_(a00[i] + acc[2][i]); a1[i] = sigmoidf_(a01[i] + acc[3][i]);
                const float k = cv[0][i]; const float km0 = k * (1.f + (a0[i] - 1.f) * ka0[i]), km1 = k * (1.f + (a1[i] - 1.f) * ka1[i]);
                bs += cv[2][i] * (km0 + km1) * rk[i]; }
            bs += __shfl_xor(bs, 16); bs += __shfl_xor(bs, 32);
            u32x2 wv2;
            wv2.x = pk2(cv[0][0], cv[0][1]); wv2.y = pk2(cv[0][2], cv[0][3]); *(u32x2*)(Kc + o) = wv2;
            wv2.x = pk2(cv[1][0], cv[1][1]); wv2.y = pk2(cv[1][2], cv[1][3]); *(u32x2*)(Vc + o) = wv2;
            wv2.x = pk2(cv[2][0], cv[2][1]); wv2.y = pk2(cv[2][2], cv[2][3]); *(u32x2*)(Rc + o) = wv2;
            wv2.x = pk2(a0[0], a0[1]); wv2.y = pk2(a0[2], a0[3]); *(u32x2*)(A0 + o) = wv2;
            wv2.x = pk2(a1[0], a1[1]); wv2.y = pk2(a1[2], a1[3]); *(u32x2*)(A1 + o) = wv2;
            wv2.x = pk2(lg0[0], lg0[1]); wv2.y = pk2(lg0[2], lg0[3]); *(u32x2*)(L0 + o) = wv2;
            wv2.x = pk2(lg1[0], lg1[1]); wv2.y = pk2(lg1[2], lg1[3]); *(u32x2*)(L1 + o) = wv2;
            if (lat) { wv2.x = pk2(acc[4][0], acc[4][1]); wv2.y = pk2(acc[4][2], acc[4][3]); *(u32x2*)(GATE + o) = wv2; }
            if (fq == 0) BON[tok * 4 + ct] = bs;
            if (t2 == 0) vkeep[0] = cv[1]; else vkeep[1] = cv[1];
        }
        __syncthreads();
        if (lat) {
#pragma unroll
            for (int t2 = 0; t2 < 2; ++t2) { const int tok = 16 * (tt0 + t2) + fr; const f32x4 bq = *(const LAS f32x4*)(BON + tok * 4); const float bon = (bq[0] + bq[1]) + (bq[2] + bq[3]);
                const size_t o = (size_t)(rowbase + tok) * 512 + gch;
                u32x2 wv2; wv2.x = pk2(bon * vkeep[t2][0], bon * vkeep[t2][1]); wv2.y = pk2(bon * vkeep[t2][2], bon * vkeep[t2][3]); *(u32x2*)(BV + o) = wv2; }
        }
        item = item_next;
    }
}

DI void phase_gmlp(const Params& p, const Ctx& F) {
    const bf16_t* Z = (const bf16_t*)(p.ws + WS_Z); const bf16_t* Wsp = (const bf16_t*)(p.ws + WS_WSP);
    bf16_t* MIXED = (bf16_t*)((unsigned char*)p.out + DO_MIXED);
    constexpr int LDV = 136;
    LAS bf16_t* vnT = (LAS bf16_t*)F.lds;
    LAS float* gu = (LAS float*)(F.lds + 17408);
    constexpr int LDG = 68;
    const int fr = F.lane & 15, fq = F.lane >> 4;
    for (int un = F.bid; un < 4 * 64 * 8; un += F.G) {
        const int g = un & 7, cc = (un >> 3) & 63, b = un >> 9;
        const size_t tok0 = (size_t)b * SEQ + cc * 128;
        __syncthreads();
        { const int pq = F.tid >> 2, seg = F.tid & 3;
          const bf16_t* zr = Z + (tok0 + pq) * DINP;
          const u32x4 ua = *(const u32x4*)(zr + OFF_U + 64 * g + 16 * seg), ub = *(const u32x4*)(zr + OFF_U + 64 * g + 16 * seg + 8);
          const u32x4 va = *(const u32x4*)(zr + OFF_VA + 64 * g + 16 * seg), vb = *(const u32x4*)(zr + OFF_VA + 64 * g + 16 * seg + 8);
          float u[16], v[16];
#pragma unroll
          for (int j = 0; j < 4; ++j) { u[2 * j] = bflo(ua[j]); u[2 * j + 1] = bfhi(ua[j]); u[8 + 2 * j] = bflo(ub[j]); u[8 + 2 * j + 1] = bfhi(ub[j]);
              v[2 * j] = bflo(va[j]); v[2 * j + 1] = bfhi(va[j]); v[8 + 2 * j] = bflo(vb[j]); v[8 + 2 * j + 1] = bfhi(vb[j]); }
          float s = 0.f;
#pragma unroll
          for (int j = 0; j < 16; ++j) s += v[j];
          s += __shfl_xor(s, 1); s += __shfl_xor(s, 2);
          const float mu = s * (1.f / 64.f); float q = 0.f;
#pragma unroll
          for (int j = 0; j < 16; ++j) { v[j] -= mu; q += v[j] * v[j]; }
          q += __shfl_xor(q, 1); q += __shfl_xor(q, 2);
          const float rstd = 1.f / sqrtf(q * (1.f / 64.f) + 1e-5f);
#pragma unroll
          for (int j = 0; j < 16; ++j) { const int ch = 16 * seg + j; const float vn = v[j] * rstd * p.in[I_GMLNG][64 * g + ch] + p.in[I_GMLNB][64 * g + ch];
              vnT[ch * LDV + pq] = (bf16_t)f2bf(vn); gu[pq * LDG + ch] = u[j]; }
        }
        __syncthreads();
        f32x4 acc[4];
#pragma unroll
        for (int n = 0; n < 4; ++n) acc[n] = (f32x4){0.f, 0.f, 0.f, 0.f};
        const int pp = 16 * F.wave + fr;
#pragma unroll
        for (int s = 0; s < 4; ++s) {
            const bf16x8 bfrag = *(const bf16x8*)(Wsp + ((size_t)(g * 128 + pp)) * 128 + 32 * s + 8 * fq);
#pragma unroll
            for (int n = 0; n < 4; ++n) { const bf16x8 afrag = *(const LAS bf16x8*)(vnT + (16 * n + fr) * LDV + 32 * s + 8 * fq);
                acc[n] = __builtin_amdgcn_mfma_f32_16x16x32_bf16(afrag, bfrag, acc[n], 0, 0, 0); }
        }
        const float bs = p.in[I_BSP][g * 128 + pp];
#pragma unroll
        for (int n = 0; n < 4; ++n) { const int d0 = 16 * n + 4 * fq; const f32x4 gv = *(const LAS f32x4*)(gu + pp * LDG + d0);
            const f32x4 o = gv * (acc[n] + bs);
            u32x2 w; w.x = pk2(o[0], o[1]); w.y = pk2(o[2], o[3]);
            *(u32x2*)(MIXED + (tok0 + pp) * D + 64 * g + d0) = w; }
    }
}

DI void phase_scan_seq(const Params& p, const Ctx& F) {
    const bf16_t* Kc = (const bf16_t*)(p.ws + WS_KC); const bf16_t* Vc = (const bf16_t*)(p.ws + WS_VC); const bf16_t* Rc = (const bf16_t*)(p.ws + WS_RC);
    float* YS = (float*)(p.ws + WS_YS);
    const int vrow = F.tid >> 3, q = F.tid & 7;
    for (int ch = F.bid; ch < 64; ch += F.G) {
        const int d = ch & 1, h = (ch >> 1) & 7, b = ch >> 4;
        const bf16_t* Ad = (const bf16_t*)(p.ws + (d ? WS_A1 : WS_A0)); const bf16_t* Ld = (const bf16_t*)(p.ws + (d ? WS_L1 : WS_L0));
        float kkw[8], kaw[8];
#pragma unroll
        for (int j = 0; j < 8; ++j) { kkw[j] = p.in[I_KK][64 * h + 8 * q + j]; kaw[j] = p.in[I_KA][d * 512 + 64 * h + 8 * q + j]; }
        float S[8];
#pragma unroll
        for (int j = 0; j < 8; ++j) S[j] = 0.f;
        const int TOT = CTXL + SEQ;
        for (int step = 0; step < TOT; ++step) {
            size_t row;
            if (step < CTXL) { const int tc = d ? (CTXL - 1 - step) : step; row = (size_t)NT + b * CTXL + tc; }
            else { const int tl = d ? (SEQ - 1 - (step - CTXL)) : (step - CTXL); row = (size_t)b * SEQ + tl; }
            const size_t o = row * 512 + 64 * h + 8 * q;
            const u32x4 kq = *(const u32x4*)(Kc + o), rq = *(const u32x4*)(Rc + o), aq = *(const u32x4*)(Ad + o), lq = *(const u32x4*)(Ld + o);
            const float vv = bf2f(Vc[row * 512 + 64 * h + vrow]);
            float k[8], r[8], a[8], l[8];
#pragma unroll
            for (int j = 0; j < 4; ++j) { k[2 * j] = bflo(kq[j]); k[2 * j + 1] = bfhi(kq[j]); r[2 * j] = bflo(rq[j]); r[2 * j + 1] = bfhi(rq[j]);
                a[2 * j] = bflo(aq[j]); a[2 * j + 1] = bfhi(aq[j]); l[2 * j] = bflo(lq[j]); l[2 * j + 1] = bfhi(lq[j]); }
            float kk[8], ss = 0.f;
#pragma unroll
            for (int j = 0; j < 8; ++j) { kk[j] = k[j] * kkw[j]; ss += kk[j] * kk[j]; }
            ss += __shfl_xor(ss, 1); ss += __shfl_xor(ss, 2); ss += __shfl_xor(ss, 4);
            const float rn = 1.f / sqrtf(fmaxf(ss, 1e-24f));
            float dot = 0.f;
#pragma unroll
            for (int j = 0; j < 8; ++j) { kk[j] *= rn; dot += S[j] * kk[j]; }
            dot += __shfl_xor(dot, 1); dot += __shfl_xor(dot, 2); dot += __shfl_xor(dot, 4);
            float y = 0.f;
#pragma unroll
            for (int j = 0; j < 8; ++j) { const float w = __expf(l[j]); const float km = k[j] * (1.f + (a[j] - 1.f) * kaw[j]);
                S[j] = S[j] * w - dot * (kk[j] * a[j]) + vv * km; y += S[j] * r[j]; }
            y += __shfl_xor(y, 1); y += __shfl_xor(y, 2); y += __shfl_xor(y, 4);
            if (step >= CTXL && q == 0) YS[((size_t)d * NT + row) * 512 + 64 * h + vrow] = y;
        }
    }
}


constexpr int LDP = 72;
constexpr int SLOTB = 64 * LDP * 2;
constexpr int CP_CUM = 12 * SLOTB, CP_TOT = CP_CUM + 16384, CP_ADIAG = CP_TOT + 2048, CP_GC = CP_ADIAG + 4096;

DI void mm64(f32x4 (&acc)[2], const LAS bf16_t* P, const LAS bf16_t* Q, int r0, int c0, int fr, int fq) {
#pragma unroll
    for (int s = 0; s < 2; ++s) { const bf16x8 b = *(const LAS bf16x8*)(Q + (c0 + fr) * LDP + 32 * s + 8 * fq);
#pragma unroll
        for (int m = 0; m < 2; ++m) { const bf16x8 a = *(const LAS bf16x8*)(P + (r0 + 16 * m + fr) * LDP + 32 * s + 8 * fq);
            acc[m] = __builtin_amdgcn_mfma_f32_16x16x32_bf16(a, b, acc[m], 0, 0, 0); } }
}
DI void zero2(f32x4 (&a)[2]) { a[0] = (f32x4){0.f, 0.f, 0.f, 0.f}; a[1] = a[0]; }
DI void writeT(LAS bf16_t* dst, const f32x4 (&acc)[2], int r0, int c0, int fr, int fq) {
#pragma unroll
    for (int m = 0; m < 2; ++m) { u32x2 w; w.x = pk2(acc[m][0], acc[m][1]); w.y = pk2(acc[m][2], acc[m][3]); *(LAS u32x2*)(dst + (c0 + fr) * LDP + r0 + 16 * m + 4 * fq) = w; }
}
DI void writeN(LAS bf16_t* dst, const f32x4 (&acc)[2], int r0, int c0, int fr, int fq) {
#pragma unroll
    for (int m = 0; m < 2; ++m)
#pragma unroll
        for (int i = 0; i < 4; ++i) dst[(r0 + 16 * m + 4 * fq + i) * LDP + c0 + fr] = (bf16_t)f2bf(acc[m][i]);
}
DI size_t chunk_row(int d, int b, int pc, int pp) {
    const int base = pc < 4 ? NT + b * CTXL : b * SEQ, len = pc < 4 ? CTXL : SEQ, q = 64 * (pc < 4 ? pc : pc - 4) + pp;
    return (size_t)(d ? base + len - 1 - q : base + q);
}

DI void phase_chunkprep(const Params& p, const Ctx& F) {
    const bf16_t* Kc = (const bf16_t*)(p.ws + WS_KC); const bf16_t* Vc = (const bf16_t*)(p.ws + WS_VC); const bf16_t* Rc = (const bf16_t*)(p.ws + WS_RC);
    unsigned char* OPS = p.ws + WS_OPS;
    LAS bf16_t* SL[12];
#pragma unroll
    for (int i = 0; i < 12; ++i) SL[i] = (LAS bf16_t*)(F.lds + i * SLOTB);
    LAS float* CUM = (LAS float*)(F.lds + CP_CUM); LAS float* TOT = (LAS float*)(F.lds + CP_TOT); LAS float* ADIAG = (LAS float*)(F.lds + CP_ADIAG); LAS float* GC = (LAS float*)(F.lds + CP_GC);
    const int w = F.wave, fr = F.lane & 15, fq = F.lane >> 4, r0 = 32 * (w >> 2), c0 = 16 * (w & 3);
    const int pp = F.tid >> 3, cg8 = F.tid & 7;
    const bool fixedmap = (F.G == 256);
    auto unit_of = [&](int i) -> int { if (fixedmap) return i < 33 ? (F.bid >> 2) * 132 + (F.bid & 3) * 33 + i : -1; const int u = F.bid + i * F.G; return u < 2 * 32 * 132 ? u : -1; };
    struct RawLd { u32x4 kq, vq, rq, aq, lq; };
    auto raw_issue = [&](RawLd& R, int unit) { const int d = unit / (32 * 132), chain = (unit / 132) & 31, pc = unit % 132, b = chain >> 3, h = chain & 7;
        const size_t o = chunk_row(d, b, pc, pp) * 512 + 64 * h + 8 * cg8;
        R.kq = *(const u32x4*)(Kc + o); R.vq = *(const u32x4*)(Vc + o); R.rq = *(const u32x4*)(Rc + o);
        R.aq = *(const u32x4*)((const bf16_t*)(p.ws + (d ? WS_A1 : WS_A0)) + o); R.lq = *(const u32x4*)((const bf16_t*)(p.ws + (d ? WS_L1 : WS_L0)) + o); };
    RawLd R;
    float kkw[8], kaw[8]; int hdcur = -1;
    int uix = 0, unit = unit_of(0);
    if (unit >= 0) raw_issue(R, unit);
    for (; unit >= 0; ) {
        const int unit_next = unit_of(++uix);
        const int d = unit / (32 * 132), chain = (unit / 132) & 31, pc = unit % 132, b = chain >> 3, h = chain & 7;
        if (d * 8 + h != hdcur) { hdcur = d * 8 + h;
#pragma unroll
            for (int j = 0; j < 8; ++j) { kkw[j] = p.in[I_KK][64 * h + 8 * cg8 + j]; kaw[j] = p.in[I_KA][d * 512 + 64 * h + 8 * cg8 + j]; } }
        __syncthreads();
        float kk[8], km[8], ka[8], vv[8], rr[8], ll[8];
        { float k[8], a[8]; float ss = 0.f;
#pragma unroll
          for (int j = 0; j < 4; ++j) { k[2 * j] = bflo(R.kq[j]); k[2 * j + 1] = bfhi(R.kq[j]); vv[2 * j] = bflo(R.vq[j]); vv[2 * j + 1] = bfhi(R.vq[j]); rr[2 * j] = bflo(R.rq[j]); rr[2 * j + 1] = bfhi(R.rq[j]);
              a[2 * j] = bflo(R.aq[j]); a[2 * j + 1] = bfhi(R.aq[j]); ll[2 * j] = bflo(R.lq[j]); ll[2 * j + 1] = bfhi(R.lq[j]); }
          if (unit_next >= 0) raw_issue(R, unit_next);
#pragma unroll
          for (int j = 0; j < 8; ++j) { kk[j] = k[j] * kkw[j]; ss += kk[j] * kk[j]; }
          ss += __shfl_xor(ss, 1); ss += __shfl_xor(ss, 2); ss += __shfl_xor(ss, 4);
          const float rn = 1.f / sqrtf(fmaxf(ss, 1e-24f));
#pragma unroll
          for (int j = 0; j < 8; ++j) { kk[j] *= rn; km[j] = k[j] * (1.f + (a[j] - 1.f) * kaw[j]); ka[j] = kk[j] * a[j]; }
          *(LAS f32x4*)(CUM + pp * 64 + 8 * cg8) = (f32x4){ll[0], ll[1], ll[2], ll[3]}; *(LAS f32x4*)(CUM + pp * 64 + 8 * cg8 + 4) = (f32x4){ll[4], ll[5], ll[6], ll[7]}; }
        for (int i = F.tid; i < 2 * SLOTB / 4; i += NTHREADS) ((LAS unsigned*)(F.lds + 9 * SLOTB))[i] = 0u;
        __syncthreads();
        { const int ch = F.tid & 63, seg = F.tid >> 6; float run = 0.f;
#pragma unroll
          for (int i = 0; i < 8; ++i) { run += CUM[(8 * seg + i) * 64 + ch]; CUM[(8 * seg + i) * 64 + ch] = run; }
          TOT[seg * 64 + ch] = run; }
        __syncthreads();
        { const int ch = F.tid & 63, seg = F.tid >> 6; float off = 0.f;
          for (int s2 = 0; s2 < seg; ++s2) off += TOT[s2 * 64 + ch];
#pragma unroll
          for (int i = 0; i < 8; ++i) CUM[(8 * seg + i) * 64 + ch] += off;
          if (seg == 7) GC[ch] = off + TOT[7 * 64 + ch]; }
        __syncthreads();
        { float g[8], gc[8];
          { const f32x4 g0 = *(const LAS f32x4*)(CUM + pp * 64 + 8 * cg8), g1 = *(const LAS f32x4*)(CUM + pp * 64 + 8 * cg8 + 4);
            const f32x4 c0v = *(const LAS f32x4*)(GC + 8 * cg8), c1v = *(const LAS f32x4*)(GC + 8 * cg8 + 4);
#pragma unroll
            for (int j = 0; j < 4; ++j) { g[j] = g0[j]; g[4 + j] = g1[j]; gc[j] = c0v[j]; gc[4 + j] = c1v[j]; } }
          float kkg[8], rg[8], ki[8], kai[8], kd[8], kad[8];
#pragma unroll
          for (int j = 0; j < 8; ++j) { const float eg = __expf(g[j]), egp = __expf(g[j] - ll[j]), eng = __expf(-g[j]), ecg = __expf(gc[j] - g[j]);
              kkg[j] = kk[j] * egp; rg[j] = rr[j] * eg; ki[j] = km[j] * eng; kai[j] = ka[j] * eng; kd[j] = km[j] * ecg; kad[j] = ka[j] * ecg; }
          u32x4 w4;
          w4 = (u32x4){pk2(kkg[0], kkg[1]), pk2(kkg[2], kkg[3]), pk2(kkg[4], kkg[5]), pk2(kkg[6], kkg[7])}; *(LAS u32x4*)(SL[0] + pp * LDP + 8 * cg8) = w4;
          w4 = (u32x4){pk2(rg[0], rg[1]), pk2(rg[2], rg[3]), pk2(rg[4], rg[5]), pk2(rg[6], rg[7])}; *(LAS u32x4*)(SL[1] + pp * LDP + 8 * cg8) = w4;
          w4 = (u32x4){pk2(ki[0], ki[1]), pk2(ki[2], ki[3]), pk2(ki[4], ki[5]), pk2(ki[6], ki[7])}; *(LAS u32x4*)(SL[2] + pp * LDP + 8 * cg8) = w4;
          w4 = (u32x4){pk2(kai[0], kai[1]), pk2(kai[2], kai[3]), pk2(kai[4], kai[5]), pk2(kai[6], kai[7])}; *(LAS u32x4*)(SL[3] + pp * LDP + 8 * cg8) = w4;
#pragma unroll
          for (int j = 0; j < 8; ++j) { const int ch = 8 * cg8 + j;
              SL[4][ch * LDP + pp] = (bf16_t)f2bf(kkg[j]); SL[5][ch * LDP + pp] = (bf16_t)f2bf(vv[j]); SL[6][ch * LDP + pp] = (bf16_t)f2bf(kd[j]); SL[7][ch * LDP + pp] = (bf16_t)f2bf(kad[j]); } }
        __syncthreads();
        { f32x4 aAk[2], aAa[2], aBk[2], aBa[2]; zero2(aAk); zero2(aAa); zero2(aBk); zero2(aBa);
          mm64(aAk, SL[2], SL[0], r0, c0, fr, fq);
          mm64(aAa, SL[0], SL[3], r0, c0, fr, fq);
          mm64(aBk, SL[2], SL[1], r0, c0, fr, fq);
          mm64(aBa, SL[3], SL[1], r0, c0, fr, fq);
          __syncthreads();
          const int tcol = c0 + fr;
#pragma unroll
          for (int m = 0; m < 2; ++m)
#pragma unroll
              for (int i = 0; i < 4; ++i) { const int jr = r0 + 16 * m + 4 * fq + i;
                  aAk[m][i] = jr < tcol ? aAk[m][i] : 0.f; aBk[m][i] = jr <= tcol ? aBk[m][i] : 0.f; aBa[m][i] = jr <= tcol ? aBa[m][i] : 0.f; }
          writeT(SL[0], aAk, r0, c0, fr, fq); writeT(SL[8], aBk, r0, c0, fr, fq); writeT(SL[2], aBa, r0, c0, fr, fq);
          const int jb = w & 3;
#pragma unroll
          for (int m = 0; m < 2; ++m) { const int tb = 2 * (w >> 2) + m;
              if (tb == jb) {
#pragma unroll
                  for (int i = 0; i < 4; ++i) ADIAG[tb * 256 + (4 * fq + i) * 16 + fr] = (fr < 4 * fq + i) ? aAa[m][i] : 0.f; }
#pragma unroll
              for (int i = 0; i < 4; ++i) aAa[m][i] = tb > jb ? aAa[m][i] : 0.f; }
          writeT(SL[3], aAa, r0, c0, fr, fq);
        }
        __syncthreads();
        if (F.tid < 64) { const int blk = F.tid >> 4, c = F.tid & 15; const LAS float* A = ADIAG + blk * 256; float x[16];
#pragma unroll
            for (int r = 0; r < 16; ++r) { float sa = (r == c) ? 1.f : 0.f;
#pragma unroll
                for (int j = 0; j < r; ++j) sa -= A[r * 16 + j] * x[j];
                x[r] = sa; }
#pragma unroll
            for (int r = 0; r < 16; ++r) SL[9][(16 * blk + r) * LDP + 16 * blk + c] = (bf16_t)f2bf(x[r]);
            u32x4 lo = (u32x4){pk2(x[0], x[1]), pk2(x[2], x[3]), pk2(x[4], x[5]), pk2(x[6], x[7])}, hi = (u32x4){pk2(x[8], x[9]), pk2(x[10], x[11]), pk2(x[12], x[13]), pk2(x[14], x[15])};
            *(LAS u32x4*)(SL[10] + (16 * blk + c) * LDP + 16 * blk) = lo; *(LAS u32x4*)(SL[10] + (16 * blk + c) * LDP + 16 * blk + 8) = hi; }
        __syncthreads();
        f32x4 a1[2], a2[2], a3[2];
        zero2(a1); mm64(a1, SL[3], SL[9], r0, c0, fr, fq);
        __syncthreads();
        writeT(SL[11], a1, r0, c0, fr, fq);
        writeN(SL[3], a1, r0, c0, fr, fq);
        __syncthreads();
        zero2(a2); mm64(a2, SL[11], SL[3], r0, c0, fr, fq);
#pragma unroll
        for (int m = 0; m < 2; ++m)
#pragma unroll
            for (int i = 0; i < 4; ++i) a2[m][i] += (r0 + 16 * m + 4 * fq + i == c0 + fr) ? 1.f : 0.f;
        writeT(SL[9], a2, r0, c0, fr, fq);
        __syncthreads();
        zero2(a3); mm64(a3, SL[11], SL[9], r0, c0, fr, fq);
        a3[0] = a2[0] - a3[0]; a3[1] = a2[1] - a3[1];
        writeN(SL[3], a3, r0, c0, fr, fq);
        __syncthreads();
        zero2(a1); mm64(a1, SL[3], SL[10], r0, c0, fr, fq);
        zero2(a2); mm64(a2, SL[0], SL[5], r0, c0, fr, fq);
        writeN(SL[9], a1, r0, c0, fr, fq); writeT(SL[11], a2, r0, c0, fr, fq);
        __syncthreads();
        zero2(a1); mm64(a1, SL[9], SL[4], r0, c0, fr, fq);
        zero2(a2); mm64(a2, SL[9], SL[11], r0, c0, fr, fq);
        writeT(SL[3], a1, r0, c0, fr, fq); writeT(SL[10], a2, r0, c0, fr, fq);
        __syncthreads();
        unsigned char* ob = OPS + ((size_t)(d * 32 + chain) * 132 + pc) * 32768;
        const int fragoff = (((w & 3) * 2 + (w >> 2)) * 64 + F.lane) * 16;
        {
          zero2(a1); mm64(a1, SL[3], SL[2], r0, c0, fr, fq);
          u32x4 o;
#pragma unroll
          for (int m = 0; m < 2; ++m) { const u32x2 rgv = *(const LAS u32x2*)(SL[1] + (c0 + fr) * LDP + r0 + 16 * m + 4 * fq);
              const float q0 = bflo(rgv.x) - a1[m][0], q1 = bfhi(rgv.x) - a1[m][1], q2 = bflo(rgv.y) - a1[m][2], q3 = bfhi(rgv.y) - a1[m][3];
              o[2 * m] = pk2(q0, q1); o[2 * m + 1] = pk2(q2, q3); }
          *(u32x4*)(ob + fragoff) = o; }
        {
          zero2(a1); mm64(a1, SL[3], SL[7], r0, c0, fr, fq);
          const float gcv = __expf(GC[c0 + fr]); u32x4 o;
#pragma unroll
          for (int m = 0; m < 2; ++m) { float q[4];
#pragma unroll
              for (int i = 0; i < 4; ++i) q[i] = ((r0 + 16 * m + 4 * fq + i == c0 + fr) ? gcv : 0.f) - a1[m][i];
              o[2 * m] = pk2(q[0], q[1]); o[2 * m + 1] = pk2(q[2], q[3]); }
          *(u32x4*)(ob + 8192 + fragoff) = o; }
        {
          zero2(a1); mm64(a1, SL[8], SL[5], r0, c0, fr, fq); zero2(a2); mm64(a2, SL[2], SL[10], r0, c0, fr, fq);
#pragma unroll
          for (int m = 0; m < 2; ++m) { const f32x4 q = a1[m] - a2[m]; u32x2 o; o.x = pk2(q[0], q[1]); o.y = pk2(q[2], q[3]);
              *(u32x2*)(ob + 16384 + (((w & 3) * 4 + 2 * (w >> 2) + m) * 64 + F.lane) * 8) = o; } }
        {
          zero2(a1); mm64(a1, SL[6], SL[5], r0, c0, fr, fq); zero2(a2); mm64(a2, SL[7], SL[10], r0, c0, fr, fq);
#pragma unroll
          for (int m = 0; m < 2; ++m) { const f32x4 q = a1[m] - a2[m]; u32x2 o; o.x = pk2(q[0], q[1]); o.y = pk2(q[2], q[3]);
              *(u32x2*)(ob + 24576 + (((w & 3) * 4 + 2 * (w >> 2) + m) * 64 + F.lane) * 8) = o; } }
        unit = unit_next;
    }
}


typedef short s16x4v __attribute__((ext_vector_type(4)));
DI f32x4 mfma16(s16x4v a, s16x4v b, f32x4 c) { return __builtin_amdgcn_mfma_f32_16x16x16bf16_1k(a, b, c, 0, 0, 0); }
DI s16x4v pack4(const f32x4& v) { u32x2 t; t.x = pk2(v[0], v[1]); t.y = pk2(v[2], v[3]); return __builtin_bit_cast(s16x4v, t); }
DI void slab64(f32x4 (&acc)[4], const LAS bf16_t* P, const LAS bf16_t* Q, int s4, int fr, int fq) {
#pragma unroll
    for (int s2 = 0; s2 < 2; ++s2) { const bf16x8 b = *(const LAS bf16x8*)(Q + (16 * s4 + fr) * LDP + 32 * s2 + 8 * fq);
#pragma unroll
        for (int m = 0; m < 4; ++m) { const bf16x8 a = *(const LAS bf16x8*)(P + (16 * m + fr) * LDP + 32 * s2 + 8 * fq);
            acc[m] = __builtin_amdgcn_mfma_f32_16x16x32_bf16(a, b, acc[m], 0, 0, 0); } }
}
constexpr int C2_NORM = 12 * SLOTB, C2_GC = C2_NORM + 4096, C2_ADIAG = C2_GC + 512, C2_DINV = C2_ADIAG + 4096;
static_assert(C2_DINV + 2048 <= LDS_MISC, "chunkprep2 LDS");
DI void phase_chunkprep2(const Params& p, const Ctx& F) {
    const bf16_t* Kc = (const bf16_t*)(p.ws + WS_KC); const bf16_t* Vc = (const bf16_t*)(p.ws + WS_VC); const bf16_t* Rc = (const bf16_t*)(p.ws + WS_RC);
    unsigned char* OPS = p.ws + WS_OPS;
    LAS bf16_t* SL[12];
#pragma unroll
    for (int i = 0; i < 12; ++i) SL[i] = (LAS bf16_t*)(F.lds + i * SLOTB);
    LAS float* ADIAG = (LAS float*)(F.lds + C2_ADIAG); LAS bf16_t* DINV = (LAS bf16_t*)(F.lds + C2_DINV);
    const int w = F.wave, s4 = w & 3, g2 = w >> 2;
    const bool fixedmap = (F.G == 256);
    auto unit_of = [&](int i) -> int { if (fixedmap) return i < 33 ? (F.bid >> 2) * 132 + (F.bid & 3) * 33 + i : -1; const int u = F.bid + i * F.G; return u < 2 * 32 * 132 ? u : -1; };
    struct RawLd { u32x4 kq, vq, rq, aq, lq; };
    auto raw_issue = [&](RawLd& R, int unit, int lane) { const int d = unit / (32 * 132), chain = (unit / 132) & 31, pc = unit % 132, b = chain >> 3, h = chain & 7;
        const size_t o = chunk_row(d, b, pc, lane) * 512 + 64 * h + 8 * w;
        R.kq = *(const u32x4*)(Kc + o); R.vq = *(const u32x4*)(Vc + o); R.rq = *(const u32x4*)(Rc + o);
        R.aq = *(const u32x4*)((const bf16_t*)(p.ws + (d ? WS_A1 : WS_A0)) + o); R.lq = *(const u32x4*)((const bf16_t*)(p.ws + (d ? WS_L1 : WS_L0)) + o); };
    RawLd R;
    float kkw[8], kaw[8]; int hdcur = -1;
    int uix = 0, unit = unit_of(0);
    if (unit >= 0) raw_issue(R, unit, F.lane);
    for (; unit >= 0; ) {
        const int unit_next = unit_of(++uix);
        const int d = unit / (32 * 132), chain = (unit / 132) & 31, pc = unit % 132, h = chain & 7;
        if (d * 8 + h != hdcur) { hdcur = d * 8 + h;
#pragma unroll
            for (int j = 0; j < 8; ++j) { kkw[j] = p.in[I_KK][64 * h + 8 * w + j]; kaw[j] = p.in[I_KA][d * 512 + 64 * h + 8 * w + j]; } }
        int lane = F.lane; asm volatile("" : "+v"(lane));
        const int fr = lane & 15, fq = lane >> 4, pp = lane;
        LAS float* NORM = (LAS float*)(F.lds + C2_NORM) + (uix & 1) * 512; LAS float* GC = (LAS float*)(F.lds + C2_GC) + (uix & 1) * 64;
        float k[8], a[8], rr[8], ll[8], kk[8]; const u32x4 R0v = R.vq;
        { float ss = 0.f;
#pragma unroll
          for (int j = 0; j < 4; ++j) { k[2 * j] = bflo(R.kq[j]); k[2 * j + 1] = bfhi(R.kq[j]); rr[2 * j] = bflo(R.rq[j]); rr[2 * j + 1] = bfhi(R.rq[j]);
              a[2 * j] = bflo(R.aq[j]); a[2 * j + 1] = bfhi(R.aq[j]); ll[2 * j] = bflo(R.lq[j]); ll[2 * j + 1] = bfhi(R.lq[j]); }
          if (unit_next >= 0) raw_issue(R, unit_next, lane);
#pragma unroll
          for (int j = 0; j < 8; ++j) { kk[j] = k[j] * kkw[j]; ss += kk[j] * kk[j]; }
          NORM[w * 64 + pp] = ss; }
        float g[8], gc[8];
#pragma unroll
        for (int j = 0; j < 8; ++j) { g[j] = wave_scan_incl(ll[j]); gc[j] = lane63(g[j]); }
        if (lane == 0) { *(LAS f32x4*)(GC + 8 * w) = (f32x4){__expf(gc[0]), __expf(gc[1]), __expf(gc[2]), __expf(gc[3])}; *(LAS f32x4*)(GC + 8 * w + 4) = (f32x4){__expf(gc[4]), __expf(gc[5]), __expf(gc[6]), __expf(gc[7])}; }
        __syncthreads();
        { float ss = 0.f;
#pragma unroll
          for (int q = 0; q < 8; ++q) ss += NORM[q * 64 + pp];
          const float rn = __builtin_amdgcn_rsqf(fmaxf(ss, 1e-24f));
          float kkg[8], rg[8], ki[8], kai[8];
#pragma unroll
          for (int j = 0; j < 8; ++j) { const float kkn = kk[j] * rn, km = k[j] * (1.f + (a[j] - 1.f) * kaw[j]), kan = kkn * a[j];
              const float eg = __expf(g[j]), egp = __expf(g[j] - ll[j]), eng = __expf(-g[j]);
              kkg[j] = kkn * egp; rg[j] = rr[j] * eg; ki[j] = km * eng; kai[j] = kan * eng; }
          const u32x4 wkkg = (u32x4){pk2(kkg[0], kkg[1]), pk2(kkg[2], kkg[3]), pk2(kkg[4], kkg[5]), pk2(kkg[6], kkg[7])};
          const u32x4 wki = (u32x4){pk2(ki[0], ki[1]), pk2(ki[2], ki[3]), pk2(ki[4], ki[5]), pk2(ki[6], ki[7])};
          const u32x4 wkai = (u32x4){pk2(kai[0], kai[1]), pk2(kai[2], kai[3]), pk2(kai[4], kai[5]), pk2(kai[6], kai[7])};
          *(LAS u32x4*)(SL[0] + pp * LDP + 8 * w) = wkkg;
          *(LAS u32x4*)(SL[1] + pp * LDP + 8 * w) = (u32x4){pk2(rg[0], rg[1]), pk2(rg[2], rg[3]), pk2(rg[4], rg[5]), pk2(rg[6], rg[7])};
          *(LAS u32x4*)(SL[2] + pp * LDP + 8 * w) = wki;
          *(LAS u32x4*)(SL[3] + pp * LDP + 8 * w) = wkai;
#pragma unroll
          for (int j = 0; j < 8; ++j) { const int ch = 8 * w + j;
              SL[4][ch * LDP + pp] = (bf16_t)((j & 1) ? wkkg[j >> 1] >> 16 : wkkg[j >> 1]); SL[5][ch * LDP + pp] = (bf16_t)((j & 1) ? R0v[j >> 1] >> 16 : R0v[j >> 1]);
              SL[6][ch * LDP + pp] = (bf16_t)((j & 1) ? wki[j >> 1] >> 16 : wki[j >> 1]); SL[7][ch * LDP + pp] = (bf16_t)((j & 1) ? wkai[j >> 1] >> 16 : wkai[j >> 1]); } }
        __syncthreads();
        { f32x4 accA[4], accK[4];
#pragma unroll
          for (int m = 0; m < 4; ++m) { accA[m] = (f32x4){0.f, 0.f, 0.f, 0.f}; accK[m] = accA[m]; }
          const LAS bf16_t* Qop = g2 == 0 ? SL[0] : SL[1];
          slab64(accA, SL[3], Qop, s4, fr, fq);
          slab64(accK, SL[2], Qop, s4, fr, fq);
          const int tcol = 16 * s4 + fr;
#pragma unroll
          for (int m = 0; m < 4; ++m) {
              if (m > s4) { accA[m] = (f32x4){0.f, 0.f, 0.f, 0.f}; accK[m] = accA[m]; }
              else if (m == s4) {
#pragma unroll
                  for (int i = 0; i < 4; ++i) { const int jl = 4 * fq + i; const bool keep = g2 == 0 ? jl < fr : jl <= fr; accA[m][i] = keep ? accA[m][i] : 0.f; accK[m][i] = keep ? accK[m][i] : 0.f; } }
              u32x2 wa, wk; wa.x = pk2(accA[m][0], accA[m][1]); wa.y = pk2(accA[m][2], accA[m][3]); wk.x = pk2(accK[m][0], accK[m][1]); wk.y = pk2(accK[m][2], accK[m][3]);
              *(LAS u32x2*)((g2 == 0 ? SL[9] : SL[8]) + tcol * LDP + 16 * m + 4 * fq) = wa;
              *(LAS u32x2*)((g2 == 0 ? SL[10] : SL[11]) + tcol * LDP + 16 * m + 4 * fq) = wk;
              if (g2 == 0 && m == s4) {
#pragma unroll
                  for (int i = 0; i < 4; ++i) ADIAG[s4 * 256 + fr * 16 + 4 * fq + i] = accA[m][i]; } } }
        __syncthreads();
        if (F.tid < 64) { const int blk = F.tid >> 4, c = F.tid & 15; const LAS float* A = ADIAG + blk * 256; float x[16];
            f32x4 Ar[16][4];
#pragma unroll
            for (int r = 1; r < 16; ++r)
#pragma unroll
                for (int q = 0; q < 4; ++q) if (4 * q < r) Ar[r][q] = *(const LAS f32x4*)(A + r * 16 + 4 * q);
#pragma unroll
            for (int r = 0; r < 16; ++r) { float sa = (r == c) ? 1.f : 0.f;
#pragma unroll
                for (int j = 0; j < r; ++j) sa -= Ar[r][j >> 2][j & 3] * x[j];
                x[r] = sa; }
#pragma unroll
            for (int r = 0; r < 16; ++r) DINV[(blk * 16 + r) * 16 + c] = (bf16_t)f2bf(x[r]); }
        f32x4 X[4];
        if (g2 == 0) {
#pragma unroll
            for (int m = 0; m < 4; ++m) { const u32x2 v2 = *(const LAS u32x2*)(SL[4] + (16 * s4 + fr) * LDP + 16 * m + 4 * fq); X[m] = (f32x4){bflo(v2.x), bfhi(v2.x), bflo(v2.y), bfhi(v2.y)}; }
        } else {
#pragma unroll
            for (int m = 0; m < 4; ++m) X[m] = (f32x4){0.f, 0.f, 0.f, 0.f};
            slab64(X, SL[10], SL[5], s4, fr, fq);
        }
        __syncthreads();
        s16x4v xb[4];
#pragma unroll
        for (int bi = 0; bi < 4; ++bi) {
            f32x4 sacc = (f32x4){0.f, 0.f, 0.f, 0.f};
#pragma unroll
            for (int bj = 0; bj < bi; ++bj) { const s16x4v af = *(const LAS s16x4v*)(SL[9] + (16 * bi + fr) * LDP + 16 * bj + 4 * fq); sacc = mfma16(af, xb[bj], sacc); }
            const f32x4 rhs = X[bi] - sacc;
            const s16x4v df = *(const LAS s16x4v*)(DINV + (bi * 16 + fr) * 16 + 4 * fq);
            X[bi] = mfma16(df, pack4(rhs), (f32x4){0.f, 0.f, 0.f, 0.f});
            xb[bi] = pack4(X[bi]);
        }
        unsigned char* ob = OPS + (size_t)unit * 32768;
        if (g2 == 0) {
#pragma unroll
            for (int mt = 0; mt < 4; ++mt) {
                f32x4 aq = (f32x4){0.f, 0.f, 0.f, 0.f}, am = aq;
#pragma unroll
                for (int kb = 0; kb < 4; ++kb) { const s16x4v bq = *(const LAS s16x4v*)(SL[8] + (16 * mt + fr) * LDP + 16 * kb + 4 * fq);
                    const s16x4v bm = *(const LAS s16x4v*)(SL[7] + (16 * mt + fr) * LDP + 16 * kb + 4 * fq);
                    aq = mfma16(xb[kb], bq, aq); am = mfma16(xb[kb], bm, am); }
                const u32x2 rgv = *(const LAS u32x2*)(SL[1] + (16 * mt + fr) * LDP + 16 * s4 + 4 * fq);
                u32x2 oq; oq.x = pk2(bflo(rgv.x) - aq[0], bfhi(rgv.x) - aq[1]); oq.y = pk2(bflo(rgv.y) - aq[2], bfhi(rgv.y) - aq[3]);
                *(u32x2*)(ob + ((mt * 2 + (s4 >> 1)) * 64 + lane) * 16 + (s4 & 1) * 8) = oq;
                const float egc = GC[16 * mt + fr]; float mv[4];
#pragma unroll
                for (int i = 0; i < 4; ++i) mv[i] = egc * (((16 * s4 + 4 * fq + i) == (16 * mt + fr) ? 1.f : 0.f) - am[i]);
                u32x2 om; om.x = pk2(mv[0], mv[1]); om.y = pk2(mv[2], mv[3]);
                *(u32x2*)(ob + 8192 + ((mt * 2 + (s4 >> 1)) * 64 + lane) * 16 + (s4 & 1) * 8) = om;
            }
        } else {
            f32x4 y1[4], b1[4];
#pragma unroll
            for (int m = 0; m < 4; ++m) { y1[m] = (f32x4){0.f, 0.f, 0.f, 0.f}; b1[m] = y1[m]; }
            slab64(y1, SL[11], SL[5], s4, fr, fq);
            slab64(b1, SL[6], SL[5], s4, fr, fq);
#pragma unroll
            for (int m = 0; m < 4; ++m) {
                f32x4 y2 = (f32x4){0.f, 0.f, 0.f, 0.f}, b2 = y2;
#pragma unroll
                for (int kb = 0; kb < 4; ++kb) { const s16x4v ay = *(const LAS s16x4v*)(SL[8] + (16 * m + fr) * LDP + 16 * kb + 4 * fq);
                    const s16x4v ab = *(const LAS s16x4v*)(SL[7] + (16 * m + fr) * LDP + 16 * kb + 4 * fq);
                    y2 = mfma16(ay, xb[kb], y2); b2 = mfma16(ab, xb[kb], b2); }
                const f32x4 yv = y1[m] - y2; u32x2 oy; oy.x = pk2(yv[0], yv[1]); oy.y = pk2(yv[2], yv[3]);
                *(u32x2*)(ob + 16384 + ((s4 * 4 + m) * 64 + lane) * 8) = oy;
                const f32x4 gcv = *(const LAS f32x4*)(GC + 16 * m + 4 * fq);
                const f32x4 bv = (b1[m] - b2) * gcv; u32x2 obc; obc.x = pk2(bv[0], bv[1]); obc.y = pk2(bv[2], bv[3]);
                *(u32x2*)(ob + 24576 + ((s4 * 4 + m) * 64 + lane) * 8) = obc;
            }
        }
        unit = unit_next;
    }
}

constexpr int SC_SLOT = 20480, SC_NSLOT = 5, SC_TILE = SC_NSLOT * SC_SLOT, CV_TP = 264;
static_assert(SC_TILE + 64 * CV_TP * 2 <= LDS_MISC, "scan ring + conversion tile");
DI void scan_issue(const unsigned char* st, LAS unsigned char* slot, int w4, int wave, int lane) {
    if (wave == 0 || wave > 3) return;
#pragma unroll
    for (int i = 0; i < 7; ++i) { const int f = wave - 1 + 3 * i;
        if (f < 20) { const unsigned char* src = f < 16 ? st + f * 1024 : (f < 18 ? st + 16384 + w4 * 2048 + (f - 16) * 1024 : st + 24576 + w4 * 2048 + (f - 18) * 1024);
            __builtin_amdgcn_global_load_lds((const unsigned*)(src + lane * 16), (LAS unsigned*)(slot + f * 1024), 16, 0, 0); } }
}
struct CvTile { const float* src; bf16_t* dst; int ldn, ldk, k0, n0, rowmap; bool ok; };
DI CvTile cv_tile(const Params& p, int it) {
    CvTile t; t.ok = it < 32 * 2 * 16 + 32 * 16; t.n0 = 0;
    if (it < 1024) { const int e = it >> 5, up = (it >> 4) & 1, kt = it & 15; t.src = (up ? p.in[I_WU] : p.in[I_WG]) + (size_t)e * 1024 * 256 + (size_t)kt * 64 * 256; t.ldn = 256;
        t.dst = (bf16_t*)(p.ws + WS_WGUT) + (size_t)e * 512 * 1024; t.ldk = 1024; t.k0 = kt * 64; t.rowmap = 1 + up; }
    else { const int r = (it - 1024) & 511, e = r >> 4, kt = (r >> 2) & 3, ntl = r & 3; t.src = p.in[I_WD] + (size_t)e * 256 * 1024 + (size_t)kt * 64 * 1024 + ntl * 256; t.ldn = 1024;
        t.dst = (bf16_t*)(p.ws + WS_WDT) + (size_t)e * 1024 * 256; t.ldk = 256; t.k0 = kt * 64; t.rowmap = 0; t.n0 = ntl * 256; }
    return t;
}
DI void phase_scan_chunk(const Params& p, const Ctx& F) {
    unsigned char* OPS = p.ws + WS_OPS;
    LAS unsigned char* ring = F.lds; LAS bf16_t* tile = (LAS bf16_t*)(F.lds + SC_TILE);
    const bool fused_cv = (F.G == 256);
    for (int item = F.bid; item < 256; item += F.G) {
        const int xq = item & 7, yq = item >> 3, w4 = yq & 3, chainid = xq + 8 * (yq >> 2);
        unsigned char* ops = OPS + (size_t)chainid * 132 * 32768;
        f32x4 H[4];
#pragma unroll
        for (int m = 0; m < 4; ++m) H[m] = (f32x4){0.f, 0.f, 0.f, 0.f};
        f32x4 cvr[8];
#pragma unroll
        for (int i = 0; i < 8; ++i) cvr[i] = (f32x4){0.f, 0.f, 0.f, 0.f};
        __syncthreads();
#pragma unroll
        for (int i = 0; i < SC_NSLOT - 1; ++i) scan_issue(ops + (size_t)i * 32768, ring + i * SC_SLOT, w4, F.wave, F.lane);
        auto scan_step = [&](int pc) {
            if (F.wave == 3) asm volatile("s_waitcnt vmcnt(18)" ::: "memory"); else if (F.wave == 1 || F.wave == 2) asm volatile("s_waitcnt vmcnt(21)" ::: "memory");
            __builtin_amdgcn_s_barrier();
            const LAS unsigned char* slot = ring + (pc % SC_NSLOT) * SC_SLOT;
            { const int nx = pc + SC_NSLOT - 1 < 132 ? pc + SC_NSLOT - 1 : 131;
              scan_issue(ops + (size_t)nx * 32768, ring + ((pc + SC_NSLOT - 1) % SC_NSLOT) * SC_SLOT, w4, F.wave, F.lane); }
            if (F.wave == 0) {
                bf16x8 qa[4][2], ma[4][2]; u32x2 y0[4], bc[4];
#pragma unroll
                for (int m = 0; m < 4; ++m) {
#pragma unroll
                    for (int s2 = 0; s2 < 2; ++s2) { qa[m][s2] = *(const LAS bf16x8*)(slot + ((m * 2 + s2) * 64 + F.lane) * 16); ma[m][s2] = *(const LAS bf16x8*)(slot + 8192 + ((m * 2 + s2) * 64 + F.lane) * 16); }
                    y0[m] = *(const LAS u32x2*)(slot + 16384 + (m * 64 + F.lane) * 8); bc[m] = *(const LAS u32x2*)(slot + 18432 + (m * 64 + F.lane) * 8); }
                asm volatile("s_waitcnt lgkmcnt(0)" ::: "memory");
                bf16x8 hb[2];
#pragma unroll
                for (int s2 = 0; s2 < 2; ++s2) { u32x4 t; t.x = pk2(H[2 * s2][0], H[2 * s2][1]); t.y = pk2(H[2 * s2][2], H[2 * s2][3]); t.z = pk2(H[2 * s2 + 1][0], H[2 * s2 + 1][1]); t.w = pk2(H[2 * s2 + 1][2], H[2 * s2 + 1][3]);
                    hb[s2] = __builtin_bit_cast(bf16x8, t); }
#pragma unroll
                for (int m = 0; m < 4; ++m) {
                    f32x4 y = (f32x4){bflo(y0[m].x), bfhi(y0[m].x), bflo(y0[m].y), bfhi(y0[m].y)};
                    f32x4 hn = (f32x4){bflo(bc[m].x), bfhi(bc[m].x), bflo(bc[m].y), bfhi(bc[m].y)};
#pragma unroll
                    for (int s2 = 0; s2 < 2; ++s2) { y = __builtin_amdgcn_mfma_f32_16x16x32_bf16(qa[m][s2], hb[s2], y, 0, 0, 0); hn = __builtin_amdgcn_mfma_f32_16x16x32_bf16(ma[m][s2], hb[s2], hn, 0, 0, 0); }
                    if (pc >= 4) { u32x2 o; o.x = pk2(y[0], y[1]); o.y = pk2(y[2], y[3]); *(u32x2*)(ops + (size_t)pc * 32768 + 16384 + ((w4 * 4 + m) * 64 + F.lane) * 8) = o; }
                    H[m] = hn;
                }
            }
        };
#pragma unroll 1
        for (int pc4 = 0; pc4 < 132; pc4 += 4) {
            const CvTile T = cv_tile(p, item + 256 * (pc4 / 4));
            const bool cvon = fused_cv && F.wave >= 4 && T.ok;
            const int r0 = 16 * (F.wave - 4);
            scan_step(pc4);
            if (cvon) {
#pragma unroll
                for (int i = 0; i < 8; ++i) cvr[i] = *(const f32x4*)(T.src + (size_t)(r0 + i) * T.ldn + 4 * F.lane); }
            scan_step(pc4 + 1);
            if (cvon) {
#pragma unroll
                for (int i = 0; i < 8; ++i) { u32x2 o; o.x = pk2(cvr[i][0], cvr[i][1]); o.y = pk2(cvr[i][2], cvr[i][3]); *(LAS u32x2*)(tile + (r0 + i) * CV_TP + 4 * F.lane) = o; }
#pragma unroll
                for (int i = 0; i < 8; ++i) cvr[i] = *(const f32x4*)(T.src + (size_t)(r0 + 8 + i) * T.ldn + 4 * F.lane); }
            scan_step(pc4 + 2);
            if (cvon) {
#pragma unroll
                for (int i = 0; i < 8; ++i) { u32x2 o; o.x = pk2(cvr[i][0], cvr[i][1]); o.y = pk2(cvr[i][2], cvr[i][3]); *(LAS u32x2*)(tile + (r0 + 8 + i) * CV_TP + 4 * F.lane) = o; } }
            scan_step(pc4 + 3);
            if (cvon) {
                const int n = F.tid - 256;
                const int drow = T.rowmap == 0 ? T.n0 + n : ((n >> 7) * 256 + (n & 127) + (T.rowmap == 2 ? 128 : 0));
                bf16_t* dp = T.dst + (size_t)drow * T.ldk + T.k0;
#pragma unroll
                for (int q = 0; q < 8; ++q) { unsigned wds[4];
#pragma unroll
                    for (int jj = 0; jj < 4; ++jj) { const int k = 8 * q + 2 * jj; wds[jj] = (unsigned)tile[k * CV_TP + n] | ((unsigned)tile[(k + 1) * CV_TP + n] << 16); }
                    *(u32x4*)(dp + 8 * q) = (u32x4){wds[0], wds[1], wds[2], wds[3]}; } }
        }
        asm volatile("s_waitcnt vmcnt(0)" ::: "memory");
    }
}

DI void phase_post2(const Params& p, const Ctx& F) {
    const unsigned char* OPS = p.ws + WS_OPS;
    const bf16_t* GATE = (const bf16_t*)((unsigned char*)p.out + DO_GATE); const bf16_t* BV = (const bf16_t*)((unsigned char*)p.out + DO_BV);
    bf16_t* MIXED = (bf16_t*)((unsigned char*)p.out + DO_MIXED);
    constexpr int LDY = 68;
    const int fr = F.lane & 15, fq = F.lane >> 4, w4 = F.wave & 3, tk = F.tid >> 3, cg8 = F.tid & 7;
    constexpr int NU = 4 * 128 * 8;
    struct PLd { u32x2 fv[2], bv2[2]; u32x4 gq, bq; };
    auto issue = [&](PLd& L, int unit) { const int h = unit & 7, j = (unit >> 3) & 127, b = unit >> 10, chain = b * 8 + h;
        const unsigned char* fi = OPS + ((size_t)(0 * 32 + chain) * 132 + 4 + j) * 32768 + 16384; const unsigned char* bi = OPS + ((size_t)(1 * 32 + chain) * 132 + 4 + (127 - j)) * 32768 + 16384;
#pragma unroll
        for (int mm = 0; mm < 2; ++mm) { const int m = 2 * (F.wave >> 2) + mm; L.fv[mm] = *(const u32x2*)(fi + ((w4 * 4 + m) * 64 + F.lane) * 8); L.bv2[mm] = *(const u32x2*)(bi + ((w4 * 4 + m) * 64 + F.lane) * 8); }
        const size_t o = ((size_t)b * SEQ + 64 * j + tk) * 512 + 64 * h + 8 * cg8;
        L.gq = *(const u32x4*)(GATE + o); L.bq = *(const u32x4*)(BV + o); };
    PLd L;
    if (F.bid < NU) issue(L, F.bid);
    int par = 0;
    for (int unit = F.bid; unit < NU; unit += F.G, par ^= 1) {
        const int h = unit & 7, j = (unit >> 3) & 127, b = unit >> 10;
        LAS float* ys = (LAS float*)F.lds + par * 64 * LDY;
        const PLd C = L;
        if (unit + F.G < NU) issue(L, unit + F.G);
#pragma unroll
        for (int mm = 0; mm < 2; ++mm) { const int m = 2 * (F.wave >> 2) + mm; const int t0 = 16 * m + 4 * fq, n = 16 * w4 + fr;
            ys[(t0 + 0) * LDY + n] = bflo(C.fv[mm].x); ys[(t0 + 1) * LDY + n] = bfhi(C.fv[mm].x); ys[(t0 + 2) * LDY + n] = bflo(C.fv[mm].y); ys[(t0 + 3) * LDY + n] = bfhi(C.fv[mm].y); }
        __syncthreads();
#pragma unroll
        for (int mm = 0; mm < 2; ++mm) { const int m = 2 * (F.wave >> 2) + mm; const int t0 = 16 * m + 4 * fq, n = 16 * w4 + fr;
            ys[(63 - t0 - 0) * LDY + n] += bflo(C.bv2[mm].x); ys[(63 - t0 - 1) * LDY + n] += bfhi(C.bv2[mm].x); ys[(63 - t0 - 2) * LDY + n] += bflo(C.bv2[mm].y); ys[(63 - t0 - 3) * LDY + n] += bfhi(C.bv2[mm].y); }
        __syncthreads();
        { const size_t row = (size_t)b * SEQ + 64 * j + tk;
          const f32x4 ya = *(const LAS f32x4*)(ys + tk * LDY + 8 * cg8), yb = *(const LAS f32x4*)(ys + tk * LDY + 8 * cg8 + 4);
          float y[8] = {ya[0], ya[1], ya[2], ya[3], yb[0], yb[1], yb[2], yb[3]};
          float s1 = 0.f;
#pragma unroll
          for (int i = 0; i < 8; ++i) s1 += y[i];
          s1 += __shfl_xor(s1, 1); s1 += __shfl_xor(s1, 2); s1 += __shfl_xor(s1, 4);
          const float mu = s1 * (1.f / 64.f); float s2 = 0.f;
#pragma unroll
          for (int i = 0; i < 8; ++i) { y[i] -= mu; s2 += y[i] * y[i]; }
          s2 += __shfl_xor(s2, 1); s2 += __shfl_xor(s2, 2); s2 += __shfl_xor(s2, 4);
          const float rstd = 1.f / sqrtf(s2 * (1.f / 64.f) + 64e-5f);
          const f32x4 lg0 = *(const f32x4*)(p.in[I_LNXG] + 64 * h + 8 * cg8), lg1 = *(const f32x4*)(p.in[I_LNXG] + 64 * h + 8 * cg8 + 4), lb0 = *(const f32x4*)(p.in[I_LNXB] + 64 * h + 8 * cg8), lb1 = *(const f32x4*)(p.in[I_LNXB] + 64 * h + 8 * cg8 + 4);
          float ov[8];
#pragma unroll
          for (int i = 0; i < 8; ++i) { const float yn = y[i] * rstd * (i < 4 ? lg0[i & 3] : lg1[i & 3]) + (i < 4 ? lb0[i & 3] : lb1[i & 3]);
              const float gt = (i & 1) ? bfhi(C.gq[i >> 1]) : bflo(C.gq[i >> 1]), bb = (i & 1) ? bfhi(C.bq[i >> 1]) : bflo(C.bq[i >> 1]);
              ov[i] = (yn + bb) * gt; }
          u32x4 ow = (u32x4){pk2(ov[0], ov[1]), pk2(ov[2], ov[3]), pk2(ov[4], ov[5]), pk2(ov[6], ov[7])};
          *(u32x4*)(MIXED + row * D + 512 + 64 * h + 8 * cg8) = ow; }
    }
}

DI void phase_post(const Params& p, const Ctx& F) {
    const float* YS = (const float*)(p.ws + WS_YS);
    const bf16_t* GATE = (const bf16_t*)((unsigned char*)p.out + DO_GATE); const bf16_t* BV = (const bf16_t*)((unsigned char*)p.out + DO_BV);
    bf16_t* MIXED = (bf16_t*)((unsigned char*)p.out + DO_MIXED);
    const int t = F.tid; const float lg = p.in[I_LNXG][t], lb = p.in[I_LNXB][t];
    for (int row = F.bid; row < NT; row += F.G) {
        const size_t o = (size_t)row * 512 + t;
        const float y = YS[o] + YS[(size_t)NT * 512 + o];
        const float mu = wave_sum(y) * (1.f / 64.f); const float dd = y - mu; const float var = wave_sum(dd * dd) * (1.f / 64.f);
        const float yn = dd * (1.f / sqrtf(var + 64e-5f)) * lg + lb;
        const float ob = (yn + bf2f(BV[o])) * bf2f(GATE[o]);
        MIXED[(size_t)row * D + 512 + t] = (bf16_t)f2bf(ob);
    }
}

DI void phase_gemm2(const Params& p, const Ctx& F) {
    pg8::StaticOrder S; S.init((unsigned char*)p.out + DO_MIXED, p.ws + WS_WOUTT, NT, 1024, 1024, F.G, F.bid);
    pg8::EpiBf16 E{(bf16_t*)(p.ws + WS_Y), 1024, false};
    pg8::gemm_phase<pg8::EpiBf16, pg8::StaticOrder, false>(F.lds, 1024, S, E);
}

DI void phase_route(const Params& p, const Ctx& F, const bool dry = false) {
    LAS float* wr_ = (LAS float*)F.lds;
    for (int i = F.tid; i < 4 * 1024; i += NTHREADS) wr_[(i & 3) * 1024 + (i >> 2)] = p.in[I_WRG][i];
    for (int i = F.tid; i < 32 * 1024; i += NTHREADS) wr_[(4 + (i & 31)) * 1024 + (i >> 5)] = p.in[I_WRE][i];
    __syncthreads();
    const float* mod = (const float*)(p.ws + WS_MOD); const bf16_t* Y = (const bf16_t*)(p.ws + WS_Y);
    bf16_t* H2 = (bf16_t*)(p.ws + WS_H2); int* cnt = (int*)(p.ws + WS_CTL); int* perm = (int*)(p.ws + WS_PERM); float* ew = (float*)(p.ws + WS_EW);
    const int gw = F.bid * NWAVES + F.wave, NGW = F.G * NWAVES;
    LAS int* hist = (LAS int*)(F.lds + LDS_MISC + 64); LAS int* basel = (LAS int*)(F.lds + LDS_MISC + 192); LAS int* sel = (LAS int*)(F.lds + LDS_MISC + 320);
    if (F.tid < 32) hist[F.tid] = 0;
    __syncthreads();
    int itn = -1;
    u32x2 nyy[4]; f32x4 nxx[4];
    auto rissue = [&](int row) { const u32x2* yr = (const u32x2*)(Y + (size_t)row * D) + F.lane; const f32x4* xr = (const f32x4*)(p.in[I_X] + (size_t)row * D) + F.lane;
#pragma unroll
        for (int j = 0; j < 4; ++j) { nyy[j] = yr[64 * j]; nxx[j] = xr[64 * j]; } };
    if (gw < NT) rissue(gw);
    for (int row = gw; row < NT; row += NGW) {
        ++itn;
        const int bt = row / SEQ;
        f32x4 v[4], xv[4]; float ss = 0.f;
#pragma unroll
        for (int j = 0; j < 4; ++j) xv[j] = nxx[j];
#pragma unroll
        for (int j = 0; j < 4; ++j) { const u32x2 yy = nyy[j]; v[j] = (f32x4){bflo(yy.x), bfhi(yy.x), bflo(yy.y), bfhi(yy.y)}; ss += (v[j].x * v[j].x + v[j].y * v[j].y) + (v[j].z * v[j].z + v[j].w * v[j].w); }
        if (row + NGW < NT) rissue(row + NGW);
        const float rstd = __builtin_amdgcn_rsqf(wave_sum(ss) * (1.f / D) + 1e-6f);
        float s2 = 0.f;
        f32x4* xo = (f32x4*)(p.out + (size_t)row * D) + F.lane;
#pragma unroll
        for (int j = 0; j < 4; ++j) { const int col = 4 * (F.lane + 64 * j);
            const f32x4 g1 = *(const f32x4*)(mod + bt * 6144 + 2048 + col), gp = *(const f32x4*)(p.in[I_GPOST1] + col);
            v[j] = xv[j] + g1 * (v[j] * rstd * gp);
            xo[64 * j] = v[j];
            s2 += (v[j].x * v[j].x + v[j].y * v[j].y) + (v[j].z * v[j].z + v[j].w * v[j].w); }
        const float rstd2 = __builtin_amdgcn_rsqf(wave_sum(s2) * (1.f / D) + 1e-6f);
        unsigned long long* o8 = (unsigned long long*)(H2 + (size_t)row * D) + F.lane;
#pragma unroll
        for (int j = 0; j < 4; ++j) { const int col = 4 * (F.lane + 64 * j);
            const f32x4 gg = *(const f32x4*)(p.in[I_GPRE2] + col), sh = *(const f32x4*)(mod + bt * 6144 + 3072 + col), sc = *(const f32x4*)(mod + bt * 6144 + 4096 + col);
            v[j] = v[j] * rstd2 * gg * (sc + 1.f) + sh;
            o8[64 * j] = (unsigned long long)pk2(v[j].x, v[j].y) | ((unsigned long long)pk2(v[j].z, v[j].w) << 32); }
        float part[36];
#pragma unroll
        for (int o = 0; o < 36; ++o) { float a = 0.f;
#pragma unroll
            for (int j = 0; j < 4; ++j) { const f32x4 w = *(const LAS f32x4*)(wr_ + o * 1024 + 4 * (F.lane + 64 * j)); a += (v[j].x * w.x + v[j].y * w.y) + (v[j].z * w.z + v[j].w * w.w); }
            part[o] = a; if ((o & 3) == 3) __builtin_amdgcn_sched_barrier(0); }
        float v32[32], v16[16], v8[8], v4[4], v2[2], mylg;
        { const bool b5 = (F.lane & 32) != 0, b4 = (F.lane & 16) != 0, b3 = (F.lane & 8) != 0, b2 = (F.lane & 4) != 0, b1 = (F.lane & 2) != 0, b0 = (F.lane & 1) != 0;
#pragma unroll
          for (int i = 0; i < 32; ++i) { const float lo = part[i], hi = (i < 4) ? part[32 + (i & 3)] : 0.f; const float mine = b5 ? hi : lo, th = b5 ? lo : hi; v32[i] = mine + __shfl_xor(th, 32); }
#pragma unroll
          for (int i = 0; i < 16; ++i) { const float mine = b4 ? v32[16 + i] : v32[i], th = b4 ? v32[i] : v32[16 + i]; v16[i] = mine + __shfl_xor(th, 16); }
#pragma unroll
          for (int i = 0; i < 8; ++i) { const float mine = b3 ? v16[8 + i] : v16[i], th = b3 ? v16[i] : v16[8 + i]; v8[i] = mine + __shfl_xor(th, 8); }
#pragma unroll
          for (int i = 0; i < 4; ++i) { const float mine = b2 ? v8[4 + i] : v8[i], th = b2 ? v8[i] : v8[4 + i]; v4[i] = mine + __shfl_xor(th, 4); }
#pragma unroll
          for (int i = 0; i < 2; ++i) { const float mine = b1 ? v4[2 + i] : v4[i], th = b1 ? v4[i] : v4[2 + i]; v2[i] = mine + __shfl_xor(th, 2); }
          { const float mine = b0 ? v2[1] : v2[0], th = b0 ? v2[0] : v2[1]; mylg = mine + __shfl_xor(th, 1); } }
        mylg += (F.lane < 4) ? p.in[I_BRG][F.lane & 3] : p.in[I_BRE][(F.lane - 4) & 31];
        float gl[4];
#pragma unroll
        for (int j = 0; j < 4; ++j) gl[j] = __shfl(mylg, j);
        int gi = 0; float gm = gl[0];
#pragma unroll
        for (int j = 1; j < 4; ++j) if (gl[j] > gm) { gm = gl[j]; gi = j; }
        float gsum = 0.f;
#pragma unroll
        for (int j = 0; j < 4; ++j) gsum += __expf(gl[j] - gm);
        const float gw_ = 1.f / gsum;
        float el[8];
#pragma unroll
        for (int j = 0; j < 8; ++j) el[j] = __shfl(mylg, 4 + gi * 8 + j);
        int i1 = 0; float m1 = el[0];
#pragma unroll
        for (int j = 1; j < 8; ++j) if (el[j] > m1) { m1 = el[j]; i1 = j; }
        int i2 = 0; float m2 = -3.0e38f;
#pragma unroll
        for (int j = 0; j < 8; ++j) if (j != i1 && el[j] > m2) { m2 = el[j]; i2 = j; }
        const float p2 = __expf(m2 - m1);
        const float w1 = gw_ / (1.f + p2), w2 = gw_ * p2 / (1.f + p2);
        if (F.lane == 0 && !dry) {
            const int e1 = gi * 8 + i1, e2 = gi * 8 + i2;
            if (itn < 16) {
                const int s1 = atomicAdd((int*)(hist + e1), 1), s2 = atomicAdd((int*)(hist + e2), 1);
                sel[(F.wave * 16 + itn) * 2] = (e1 << 16) | s1; sel[(F.wave * 16 + itn) * 2 + 1] = (e2 << 16) | s2;
            } else {
                const int p1 = atomicAdd(&cnt[e1 * 64], 1); perm[(size_t)e1 * NT + p1] = row * 2;
                const int q2 = atomicAdd(&cnt[e2 * 64], 1); perm[(size_t)e2 * NT + q2] = row * 2 + 1;
            }
            ew[row * 2] = w1; ew[row * 2 + 1] = w2;
        }
    }
    if (!dry) {
        __syncthreads();
        if (F.tid < 32) basel[F.tid] = atomicAdd(&cnt[F.tid * 64], (int)hist[F.tid]);
        __syncthreads();
        if (F.tid < 256) { const int wv = F.tid >> 5, it2 = (F.tid >> 1) & 15, sl = F.tid & 1; const int row = F.bid * NWAVES + wv + it2 * NGW;
            if (row < NT) { const int sv = sel[F.tid]; const int e = sv >> 16, ps = sv & 0xffff; perm[(size_t)e * NT + basel[e] + ps] = row * 2 + sl; } }
    }
}

DI void moe_tile_prefix(const Params& p, const Ctx& F, LAS int* tp) {
    __syncthreads();
    if (F.tid == 0) { const int* cnt = (const int*)(p.ws + WS_CTL); int acc = 0; for (int e = 0; e < 32; ++e) { tp[e] = acc; acc += (cnt[e * 64] + 255) / 256; } tp[32] = acc; }
    __syncthreads();
}
DI void phase_moe_up(const Params& p, const Ctx& F) {
    LAS int* tp = (LAS int*)(F.lds + pg8::STAGE_BYTES);
    moe_tile_prefix(p, F, tp);
    MoeOrder S{tp, (const int*)(p.ws + WS_CTL), 2, F.G, F.bid, 1024, (const char*)(p.ws + WS_H2), (const char*)(p.ws + WS_WGUT), (size_t)512 * 1024 * 2, (size_t)256 * 1024 * 2, (const int*)(p.ws + WS_PERM), true};
    pg8::EpiMoeUp E{(bf16_t*)(p.ws + WS_HID)};
    pg8::gemm_phase<pg8::EpiMoeUp, MoeOrder, true>(F.lds, 1024, S, E);
}
DI void phase_moe_down(const Params& p, const Ctx& F) {
    LAS int* tp = (LAS int*)(F.lds + pg8::STAGE_BYTES);
    moe_tile_prefix(p, F, tp);
    MoeOrder S{tp, (const int*)(p.ws + WS_CTL), 4, F.G, F.bid, 256, (const char*)(p.ws + WS_HID), (const char*)(p.ws + WS_WDT), (size_t)1024 * 256 * 2, (size_t)256 * 256 * 2, (const int*)(p.ws + WS_PERM), false};
    pg8::EpiMoeDown E{(bf16_t*)(p.ws + WS_YMOE), (const int*)(p.ws + WS_PERM), (const float*)(p.ws + WS_EW)};
    pg8::gemm_phase<pg8::EpiMoeDown, MoeOrder, false>(F.lds, 256, S, E);
}

DI void phase_final(const Params& p, const Ctx& F, const float fsc = 1.f) {
    const float* mod = (const float*)(p.ws + WS_MOD); const bf16_t* YM = (const bf16_t*)(p.ws + WS_YMOE);
    const int gw = F.bid * NWAVES + F.wave, NGW = F.G * NWAVES;
    struct FL { u32x2 a[4], b[4]; f32x4 x[4]; };
    auto issue = [&](FL& L, int row) { const u32x2* y0 = (const u32x2*)(YM + (size_t)row * D) + F.lane; const u32x2* y1 = (const u32x2*)(YM + ((size_t)NT + row) * D) + F.lane;
        const f32x4* xo = (const f32x4*)(p.out + (size_t)row * D) + F.lane;
#pragma unroll
        for (int j = 0; j < 4; ++j) { L.a[j] = y0[64 * j]; L.b[j] = y1[64 * j]; L.x[j] = xo[64 * j]; } };
    FL L;
    if (gw < NT) issue(L, gw);
    for (int row = gw; row < NT; row += NGW) {
        const int bt = row / SEQ;
        const FL C = L;
        if (row + NGW < NT) issue(L, row + NGW);
        f32x4 v[4]; float ss = 0.f;
#pragma unroll
        for (int j = 0; j < 4; ++j) { const u32x2 a = C.a[j], b = C.b[j];
            v[j] = (f32x4){bflo(a.x) + bflo(b.x), bfhi(a.x) + bfhi(b.x), bflo(a.y) + bflo(b.y), bfhi(a.y) + bfhi(b.y)};
            ss += (v[j].x * v[j].x + v[j].y * v[j].y) + (v[j].z * v[j].z + v[j].w * v[j].w); }
        const float rstd = __builtin_amdgcn_rsqf(wave_sum(ss) * (1.f / D) + 1e-6f);
        f32x4* xo = (f32x4*)(p.out + (size_t)row * D) + F.lane;
#pragma unroll
        for (int j = 0; j < 4; ++j) { const int col = 4 * (F.lane + 64 * j);
            const f32x4 g2 = *(const f32x4*)(mod + bt * 6144 + 5120 + col), gp = *(const f32x4*)(p.in[I_GPOST2] + col);
            xo[64 * j] = C.x[j] + g2 * (v[j] * (rstd * fsc) * gp); }
    }
}

#define XB_TMO      128
#define XB_XCNT(j)  (256  + 64 * (j))
#define XB_XSUB(j)  (1280 + 64 * (j))
#define XB_XGEN(j)  (2304 + 64 * (j))
#define XB_TOP      3328
#define XB_TOPGEN   3392
#define XCD_BAR_WORDS 3456
#define XB_SPIN_CAP (1u << 20)
constexpr int CW_BAR = 4096;
DI unsigned xb_ld(unsigned* p)              { return __hip_atomic_load(p, __ATOMIC_RELAXED, __HIP_MEMORY_SCOPE_AGENT); }
DI unsigned xb_add(unsigned* p, unsigned v) { return __hip_atomic_fetch_add(p, v, __ATOMIC_RELAXED, __HIP_MEMORY_SCOPE_AGENT); }
DI unsigned xb_xcc_id() { return (unsigned)__builtin_amdgcn_s_getreg((3 << 11) | 20) & 0xFu; }
#define XB_SPIN(cond, bar) do { unsigned _sp = 0; while (cond) { __builtin_amdgcn_s_sleep(1); \
    if ((++_sp & 255u) == 0u) { if (xb_ld(&(bar)[XB_TMO])) break; if (_sp > XB_SPIN_CAP) { atomicAdd(&(bar)[XB_TMO], 1u); break; } } } } while (0)
struct XcdBarrier { unsigned* bar; unsigned x; volatile LAS unsigned* st; };
DI XcdBarrier xcd_barrier_post(unsigned* bar, volatile LAS unsigned* st) {
    XcdBarrier b; b.bar = bar; b.x = xb_xcc_id(); b.st = st;
    if (threadIdx.x == 0) (void)xb_add(&bar[XB_XCNT(b.x)], 1u);
    return b;
}
DI void xcd_barrier_complete(unsigned* bar, unsigned x, unsigned& nloc, unsigned& nx) {
    const unsigned G = gridDim.x * gridDim.y * gridDim.z;
    unsigned sum, cnt, mine, sp = 0u;
    for (;;) {
        sum = 0u; cnt = 0u; mine = 0u;
#pragma unroll
        for (unsigned j = 0; j < 16; ++j) { const unsigned c = xb_ld(&bar[XB_XCNT(j)]); sum += c; cnt += (c > 0u) ? 1u : 0u; mine = (j == x) ? c : mine; }
        if (sum == G) break;
        __builtin_amdgcn_s_sleep(1);
        if ((++sp & 255u) == 0u) { if (xb_ld(&bar[XB_TMO])) break; if (sp > XB_SPIN_CAP) { atomicAdd(&bar[XB_TMO], 1u); break; } }
    }
    nloc = mine > 0u ? mine : 1u; nx = cnt > 0u ? cnt : 1u;
}
DI void xcd_barrier(const XcdBarrier& b) {
    asm volatile("s_waitcnt vmcnt(0)" ::: "memory");
    __syncthreads();
    if (threadIdx.x == 0) {
        unsigned* bar = b.bar;
        __builtin_amdgcn_s_waitcnt(0);
        unsigned nloc = b.st[0], nx = b.st[1];
        if (nloc == 0u) { xcd_barrier_complete(bar, b.x, nloc, nx); b.st[0] = nloc; b.st[1] = nx; }
        const unsigned old = xb_add(&bar[XB_XSUB(b.x)], 1u);
        const unsigned gen = old / nloc;
        if (old + 1u == (gen + 1u) * nloc) {
            __builtin_amdgcn_fence(__ATOMIC_RELEASE, "agent");
            asm volatile("s_waitcnt vmcnt(0)" ::: "memory");
            const unsigned og = xb_add(&bar[XB_TOP], 1u);
            const unsigned tg = og / nx;
            if (og + 1u == (tg + 1u) * nx) xb_add(&bar[XB_TOPGEN], 1u);
            else XB_SPIN(xb_ld(&bar[XB_TOPGEN]) == tg, bar);
            __builtin_amdgcn_fence(__ATOMIC_ACQUIRE, "agent");
            xb_add(&bar[XB_XGEN(b.x)], 1u);
            asm volatile("s_waitcnt vmcnt(0)" ::: "memory");
        } else {
            XB_SPIN(xb_ld(&bar[XB_XGEN(b.x)]) == gen, bar);
            __builtin_amdgcn_fence(__ATOMIC_ACQUIRE, "agent");
            asm volatile("s_waitcnt vmcnt(0)" ::: "memory");
        }
    }
    __syncthreads();
}

constexpr int NPHASES = 12;
#ifndef SEQ_SCAN
#define SEQ_SCAN 0
#endif
#ifndef DUP_PHASE
#define DUP_PHASE -1
#endif
#ifndef PROBE_T
#define PROBE_T -1
#endif
template <int PH> DI void run_phase(const Params& p, const Ctx& F) {
    if constexpr (PH == 0) phase_adaln(p, F);
    if constexpr (PH == 1) phase_convert(p, F);
    if constexpr (PH == 2) phase_hrows(p, F);
    if constexpr (PH == 3) phase_gemm1(p, F);
#ifndef OLD_PREP
#define OLD_PREP 0
#endif
    if constexpr (PH == 4) { if (OLD_PREP) phase_prep(p, F); else phase_prep2(p, F); __syncthreads(); phase_gmlp(p, F); }
#ifndef OLD_CHUNKPREP
#define OLD_CHUNKPREP 0
#endif
    if constexpr (PH == 5) { if (OLD_CHUNKPREP) phase_chunkprep(p, F); else phase_chunkprep2(p, F); }
    if constexpr (PH == 12) { phase_scan_chunk(p, F); if (F.G != 256) phase_convert_experts(p, F); }
    if constexpr (PH == 6) phase_post2(p, F);
    if constexpr (PH == 7) phase_gemm2(p, F);
    if constexpr (PH == 8) phase_route(p, F);
    if constexpr (PH == 28) phase_route(p, F, true);
    if constexpr (PH == 9) phase_moe_up(p, F);
    if constexpr (PH == 10) phase_moe_down(p, F);
    if constexpr (PH == 11) phase_final(p, F, DUP_PHASE == 11 ? 0.5f : 1.f);
}
DI Ctx make_ctx(unsigned char* lds) {
    Ctx F; F.lds = (LAS unsigned char*)lds; F.tid = threadIdx.x; F.lane = F.tid & 63; F.wave = __builtin_amdgcn_readfirstlane(F.tid >> 6); F.G = gridDim.x; F.bid = blockIdx.x; return F;
}
template <int PH> __global__ void __launch_bounds__(NTHREADS, 2) k_phase(Params p) {
    extern __shared__ __attribute__((aligned(16))) unsigned char lds[];
    const Ctx F = make_ctx(lds);
    run_phase<PH>(p, F);
}
#ifndef USE_CG_SYNC
#define USE_CG_SYNC 0
#endif
__global__ void __launch_bounds__(NTHREADS, 2) k_mega(Params p) {
    extern __shared__ __attribute__((aligned(16))) unsigned char lds[];
    const Ctx F = make_ctx(lds);
#if USE_CG_SYNC
    cg::grid_group grid = cg::this_grid();
#define GSYNC() grid.sync()
#else
    volatile LAS unsigned* misc = (volatile LAS unsigned*)(F.lds + LDS_MISC);
    if (F.tid < 4) misc[F.tid] = 0u;
    __syncthreads();
    const XcdBarrier bar = xcd_barrier_post((unsigned*)(p.ws + WS_CTL) + CW_BAR, misc);
#define GSYNC() xcd_barrier(bar)
#endif
#define DUP(X) if (DUP_PHASE == X) { run_phase<X>(p, F); GSYNC(); }
    unsigned long long ts_a = 0, ts_b = 0; int nst = 0;
#define STAMP() do { if (PROBE_T >= 0) { const unsigned long long t_ = __builtin_amdgcn_s_memrealtime(); if (nst == PROBE_T) ts_a = t_; if (nst == PROBE_T + 1) ts_b = t_; ++nst; } } while (0)
    STAMP();
    DUP(0) DUP(1)
    run_phase<0>(p, F); run_phase<1>(p, F); GSYNC(); STAMP();
    DUP(2) run_phase<2>(p, F); GSYNC(); STAMP();
    DUP(3) run_phase<3>(p, F); GSYNC(); STAMP();
    DUP(4) run_phase<4>(p, F); GSYNC(); STAMP();
    DUP(5) run_phase<5>(p, F); GSYNC(); STAMP();
    DUP(12)
    run_phase<12>(p, F); GSYNC(); STAMP();
    DUP(6) run_phase<6>(p, F); GSYNC(); STAMP();
    DUP(7) run_phase<7>(p, F); GSYNC(); STAMP();
    if (DUP_PHASE == 8) { run_phase<28>(p, F); GSYNC(); STAMP(); }
    run_phase<8>(p, F); GSYNC(); STAMP();
    DUP(9) run_phase<9>(p, F); GSYNC(); STAMP();
    DUP(10) run_phase<10>(p, F); GSYNC(); STAMP();
    if (DUP_PHASE == 11) { run_phase<11>(p, F); GSYNC(); STAMP(); }
    run_phase<11>(p, F); STAMP();
    if (PROBE_T >= 0 && F.bid == 0 && F.tid == 0) { const unsigned long long t0 = __builtin_amdgcn_s_memrealtime(); const unsigned long long w_ = ts_b - ts_a; while (__builtin_amdgcn_s_memrealtime() - t0 < w_) __builtin_amdgcn_s_sleep(8); }
}

template <int PH> static void launch_phase(const Params& p, int grid, hipStream_t stream) {
    static bool attr = false;
    if (!attr) { (void)hipFuncSetAttribute((const void*)k_phase<PH>, hipFuncAttributeMaxDynamicSharedMemorySize, LDS_BYTES); attr = true; }
    hipLaunchKernelGGL(k_phase<PH>, dim3(grid), dim3(NTHREADS), LDS_BYTES, stream, p);
}

extern "C" void kernel_launch(void* const* d_in, const int* in_sizes, int n_in, void* d_out, int out_size, void* d_ws, size_t ws_size, hipStream_t stream) {
    static int grid = 0;
    if (grid == 0) {
        int dev = 0, cus = 0, per_cu = 0;
        (void)hipGetDevice(&dev); (void)hipDeviceGetAttribute(&cus, hipDeviceAttributeMultiprocessorCount, dev);
        (void)hipFuncSetAttribute((const void*)k_mega, hipFuncAttributeMaxDynamicSharedMemorySize, LDS_BYTES);
        (void)hipOccupancyMaxActiveBlocksPerMultiprocessor(&per_cu, (const void*)k_mega, NTHREADS, LDS_BYTES);
        (void)hipGetLastError();
        grid = cus > 0 ? cus : 256;
        if (n_in != 34 || ws_size < 512 * MiB) fprintf(stderr, "kernel_launch: unexpected n_in %d / ws_size %zu\n", n_in, ws_size);
    }
    Params p{};
    for (int i = 0; i < 34; ++i) p.in[i] = (const float*)d_in[i];
    p.out = (float*)d_out; p.ws = (unsigned char*)d_ws;
    (void)hipMemsetAsync((char*)d_ws + WS_CTL, 0, CTL_BYTES, stream);
#if ONE_LAUNCH
    void* args[] = {&p};
    hipError_t e = hipLaunchCooperativeKernel((const void*)k_mega, dim3(grid), dim3(NTHREADS), args, LDS_BYTES, stream);
    if (e != hipSuccess) fprintf(stderr, "cooperative launch failed: %s (grid %d)\n", hipGetErrorString(e), grid);
#else
    launch_phase<0>(p, grid, stream); launch_phase<1>(p, grid, stream); launch_phase<2>(p, grid, stream); launch_phase<3>(p, grid, stream);
    launch_phase<4>(p, grid, stream); launch_phase<5>(p, grid, stream);
    launch_phase<12>(p, grid, stream);
    launch_phase<6>(p, grid, stream); launch_phase<7>(p, grid, stream);
    launch_phase<8>(p, grid, stream); launch_phase<9>(p, grid, stream); launch_phase<10>(p, grid, stream); launch_phase<11>(p, grid, stream);
#endif
}
```

```cpp
#include <hip/hip_runtime.h>
#include <hip/hip_cooperative_groups.h>
#include <cstdio>
#include <cstdint>
namespace cg = cooperative_groups;

#ifndef ONE_LAUNCH
#define ONE_LAUNCH 1
#endif

#define DI __device__ __forceinline__
#define LAS __attribute__((address_space(3)))
typedef unsigned short bf16_t;
typedef short bf16x8 __attribute__((ext_vector_type(8)));
typedef short s16x4 __attribute__((ext_vector_type(4)));
typedef float f32x4 __attribute__((ext_vector_type(4)));
typedef float f32x2 __attribute__((ext_vector_type(2)));
typedef unsigned u32x4 __attribute__((ext_vector_type(4)));
typedef unsigned u32x2 __attribute__((ext_vector_type(2)));

constexpr int D = 1024, BATCH = 4, SEQ = 8192, CTXL = 256;
constexpr int NT = BATCH * SEQ;
constexpr int NCX = BATCH * CTXL;
constexpr int MR = NT + NCX;
constexpr int BW = 512, AW = 512, NH = 8, HD = 64;
constexpr int DIN = 2944, DINP = 3072;
constexpr int OFF_K = 0, OFF_V = 512, OFF_R = 1024, OFF_WD = 1536, OFF_AD = 1664, OFF_GD = 1792, OFF_U = 1920, OFF_VA = 2432;
constexpr int NEXP = 32, DEXP = 256;
constexpr int NWAVES = 8, NTHREADS = 512;
constexpr int LDS_BYTES = 149504, LDS_MISC = 147456;

constexpr size_t MiB = 1u << 20;
constexpr size_t WS_CTL = 0, CTL_BYTES = 64 * 1024;
constexpr size_t WS_MOD = 1 * MiB;
constexpr size_t WS_DUPT = 2 * MiB;
constexpr size_t WS_AUPT = WS_DUPT + 131072;
constexpr size_t WS_GUPT = WS_AUPT + 131072;
constexpr size_t WS_WSP = WS_GUPT + 131072;
constexpr size_t WS_CONVW = WS_WSP + 262144;
constexpr size_t WS_WINT = 3 * MiB;
constexpr size_t WS_WOUTT = 9 * MiB;
constexpr size_t WS_H = 11 * MiB;
constexpr size_t WS_Z = 77 * MiB;
constexpr size_t ROWB = (size_t)MR * 512 * 2;
constexpr size_t WS_KC = 275 * MiB, WS_VC = WS_KC + ROWB, WS_RC = WS_VC + ROWB, WS_A0 = WS_RC + ROWB, WS_A1 = WS_A0 + ROWB, WS_L0 = WS_A1 + ROWB, WS_L1 = WS_L0 + ROWB;
constexpr size_t WS_OPS = 11 * MiB;
constexpr size_t WS_YS = 11 * MiB;
constexpr size_t WS_Y = 11 * MiB;
constexpr size_t WS_H2 = 139 * MiB;
constexpr size_t WS_EW = 203 * MiB;
constexpr size_t WS_PERM = 204 * MiB;
constexpr size_t WS_HID = 210 * MiB;
constexpr size_t WS_YMOE = 246 * MiB;
constexpr size_t WS_WGUT = 374 * MiB;
constexpr size_t WS_WDT = 406 * MiB;
constexpr size_t DO_MIXED = 0, DO_GATE = 64 * MiB, DO_BV = 96 * MiB;

struct Params { const float* in[34]; float* out; unsigned char* ws; };
enum { I_X = 0, I_C, I_CTX, I_CCTX, I_WMOD, I_BMOD, I_GPRE1, I_GPOST1, I_GPRE2, I_GPOST2, I_WIN, I_CONV, I_GMLNG, I_GMLNB, I_WSP, I_BSP,
       I_DW0, I_DUP, I_A0, I_AUP, I_KK, I_KA, I_RK, I_GUP, I_LNXG, I_LNXB, I_WOUT, I_WRG, I_BRG, I_WRE, I_BRE, I_WG, I_WU, I_WD };

typedef __bf16 bf16x2_t __attribute__((ext_vector_type(2)));
typedef _Float16 h2_t __attribute__((ext_vector_type(2)));
typedef _Float16 h4_t __attribute__((ext_vector_type(4)));
DI unsigned pkh2(float lo, float hi) { const f32x2 v = {lo, hi}; const h2_t h = __builtin_convertvector(v, h2_t); return __builtin_bit_cast(unsigned, h); }
DI unsigned pk2(float lo, float hi) { const f32x2 v = {lo, hi}; const bf16x2_t b = __builtin_convertvector(v, bf16x2_t); return __builtin_bit_cast(unsigned, b); }
DI unsigned f2bf(float f) { return pk2(f, f) & 0xffffu; }
DI float bf2f(unsigned b) { return __builtin_bit_cast(float, b << 16); }
DI float bflo(unsigned w) { return __builtin_bit_cast(float, w << 16); }
DI float bfhi(unsigned w) { return __builtin_bit_cast(float, w & 0xffff0000u); }
DI unsigned cvt_pk_bf16(float lo, float hi) { return pk2(lo, hi); }

template <int CTRL, int ROWMASK> DI float dppf(float v) { return __builtin_bit_cast(float, __builtin_amdgcn_update_dpp(0, __builtin_bit_cast(int, v), CTRL, ROWMASK, 0xf, false)); }
DI float wave_scan_incl(float v) {
    v += dppf<0x111, 0xf>(v); v += dppf<0x112, 0xf>(v); v += dppf<0x114, 0xf>(v); v += dppf<0x118, 0xf>(v);
    v += dppf<0x142, 0xa>(v); v += dppf<0x143, 0xc>(v); return v;
}
DI float lane63(float v) { return __builtin_bit_cast(float, __builtin_amdgcn_readlane(__builtin_bit_cast(int, v), 63)); }
DI float wave_sum(float v) { return lane63(wave_scan_incl(v)); }
DI float sigmoidf_(float x) { return __builtin_amdgcn_rcpf(1.f + __expf(-x)); }
DI float siluf_(float x) { return x * __builtin_amdgcn_rcpf(1.f + __expf(-x)); }
DI float softplusf_(float x) { return fmaxf(x, 0.f) + __logf(1.f + __expf(-fabsf(x))); }
DI float tanh_fast(float x) { const float e = __expf(-2.f * fabsf(x)); const float t = (1.f - e) * __builtin_amdgcn_rcpf(1.f + e); return x < 0.f ? -t : t; }
DI float gelu_tanh(float x) { const float u = 0.7978845608028654f * (x + 0.044715f * x * x * x); return 0.5f * x * (1.f + tanh_fast(u)); }
#define LDS_WAIT() asm volatile("s_waitcnt lgkmcnt(0)" ::: "memory")

namespace pg8 {
constexpr int BM = 256, BK = 64, HALF = 128, HTB = HALF * BK * 2, STAGE_BYTES = 8 * HTB, NXCD = 8, WGM = 8;
__host__ __device__ __forceinline__ int lds_byte(int r, int c) { const int st = (r >> 4) * 2 + (c >> 5), rr = r & 15, cc = c & 31, ob = rr * 64 + cc * 2; return st * 1024 + (ob ^ (((ob >> 9) & 1) << 5)); }
__host__ __device__ __forceinline__ void stage_rc(int b, int& R, int& C) { const int st = b / 1024, sb = b % 1024, swz = sb ^ (((sb >> 9) & 1) << 5); R = (st >> 1) * 16 + swz / 64; C = (st & 1) * 32 + (swz % 64) / 2; }
__host__ __device__ __forceinline__ int perm32(int rho) { const int n = rho >> 4, i = rho & 15; return 8 * (i >> 2) + 4 * n + (i & 3); }

struct Unit { const char* A; const char* B; const int* ridx; int pm, pn, e, lt, nvalid; };

struct StaticOrder {
    const char* A; const char* Bt; int K; int nM, nN, nwg, G, c;
    __device__ void init(const void* A_, const void* Bt_, int M, int N, int K_, int G_, int c_) { A = (const char*)A_; Bt = (const char*)Bt_; K = K_; nM = M / BM; nN = N / BM; nwg = nM * nN; G = G_; c = c_; }
    __device__ bool next(int i, Unit& u) const {
        const long L = (long)i * G + c; if (L >= nwg) return false;
        int wgid = (int)L; { const int q = nwg / NXCD, r = nwg % NXCD, xcd = wgid % NXCD, off = wgid / NXCD; wgid = (xcd < r ? xcd * (q + 1) : r * (q + 1) + (xcd - r) * q) + off; }
        const int nig = WGM * nN, gid = wgid / nig, fm = gid * WGM, gsz = (nM - fm) < WGM ? (nM - fm) : WGM;
        u.pm = fm + ((wgid % nig) % gsz); u.pn = (wgid % nig) / gsz;
        u.A = A + (size_t)u.pm * BM * K * 2; u.B = Bt + (size_t)u.pn * BM * K * 2; u.ridx = nullptr; u.e = 0; u.lt = 0; u.nvalid = BM; return true;
    }
};

DI int gidx(const Unit& u, int r) { return r < u.nvalid ? (u.ridx[r] >> 1) : 0; }

template <class Epi, class Sched, bool GATHER>
DI void gemm_phase(LAS unsigned char* lds, const int K, const Sched& S, const Epi& E) {
    int tid_ = threadIdx.x; asm volatile("" : "+v"(tid_));
    const int tid = tid_, wid = __builtin_amdgcn_readfirstlane(tid >> 6), lane = tid & 63, wr = wid >> 2, wc = wid & 3, fr = lane & 15, fq = lane >> 4;
    const int nt = K / BK;
    int Rr[2], Cc[2];
    unsigned voffB[2], vA[2][2], vAn[2][2];
#pragma unroll
    for (int i = 0; i < 2; ++i) { int R, C; stage_rc(tid * 16 + i * 8192, R, C); Rr[i] = R; Cc[i] = C; const int Rb = (R & ~31) + perm32(R & 31);
        voffB[i] = (unsigned)(Rb * K + C) * 2u;
        vA[0][i] = (unsigned)(R * K + C) * 2u; vA[1][i] = (unsigned)((R + HALF) * K + C) * 2u; vAn[0][i] = vA[0][i]; vAn[1][i] = vA[1][i]; }
    const size_t kstep = (size_t)(BK * 2);
    const size_t hstep = (size_t)HALF * K * 2;
    const unsigned ldsw = (unsigned)wid * 1024u;
    const int aoff = lds_byte(wr * 64 + fr, fq * 8), boff = lds_byte(wc * 32 + fr, fq * 8);
#define PG8_SA(b, h) (((b) * 2 + (h)) * HTB)
#define PG8_SB(b, h) ((4 + (b) * 2 + (h)) * HTB)
#define PG8_STAGE(bufoff, gbase, voff) do { _Pragma("unroll") for (int _i = 0; _i < 2; ++_i) \
        __builtin_amdgcn_global_load_lds((const unsigned*)((const char*)(gbase) + (voff)[_i]), (LAS unsigned*)(lds + (bufoff) + ldsw + _i * 8192), 16, 0, 0); } while (0)
#define PG8_LDA(dst, b, h) do { _Pragma("unroll") for (int m = 0; m < 4; ++m) _Pragma("unroll") for (int k = 0; k < 2; ++k) dst[m][k] = *(const LAS bf16x8*)(lds + PG8_SA(b, h) + aoff + m * 2048 + k * 1024); } while (0)
#define PG8_LDB(dst, b, h) do { _Pragma("unroll") for (int n = 0; n < 2; ++n) _Pragma("unroll") for (int k = 0; k < 2; ++k) dst[n][k] = *(const LAS bf16x8*)(lds + PG8_SB(b, h) + boff + n * 2048 + k * 1024); } while (0)
#define PG8_MMA(ai, bj, At, Bt) do { __builtin_amdgcn_s_setprio(1); _Pragma("unroll") for (int m = 0; m < 4; ++m) _Pragma("unroll") for (int n = 0; n < 2; ++n) _Pragma("unroll") for (int k = 0; k < 2; ++k) \
        acc[ai][bj][m][n] = __builtin_amdgcn_mfma_f32_16x16x32_bf16(Bt[n][k], At[m][k], acc[ai][bj][m][n], 0, 0, 0); __builtin_amdgcn_s_setprio(0); } while (0)
#define PG8_WAIT_V(n) asm volatile("s_waitcnt vmcnt(" #n ")" ::: "memory")
#define PG8_WAIT_L(n) asm volatile("s_waitcnt lgkmcnt(" #n ")" ::: "memory")
#define PG8_BAR __builtin_amdgcn_s_barrier()
#define PG8_SCHED __builtin_amdgcn_sched_barrier(0)
    Unit cur, nxt; int ui = 0;
    if (!S.next(0, cur)) return;
    if constexpr (GATHER) {
#pragma unroll
        for (int i = 0; i < 2; ++i) { vA[0][i] = (unsigned)(gidx(cur, Rr[i]) * K + Cc[i]) * 2u; vA[1][i] = (unsigned)(gidx(cur, Rr[i] + HALF) * K + Cc[i]) * 2u; }
    }
    f32x4 acc[2][2][4][2];
#pragma unroll
    for (int a = 0; a < 2; ++a)
#pragma unroll
        for (int b = 0; b < 2; ++b)
#pragma unroll
            for (int m = 0; m < 4; ++m)
#pragma unroll
                for (int n = 0; n < 2; ++n) acc[a][b][m][n] = (f32x4){0.f, 0.f, 0.f, 0.f};
    bf16x8 At[4][2], B0[2][2], B1[2][2];
    const char* cA = cur.A; const char* cB = cur.B;
    PG8_STAGE(PG8_SB(0, 0), cB, voffB); PG8_STAGE(PG8_SB(0, 1), cB + hstep, voffB); PG8_STAGE(PG8_SA(0, 0), cA, vA[0]); PG8_STAGE(PG8_SA(0, 1), cA, vA[1]);
    if (wr == 1) PG8_BAR;
    PG8_WAIT_V(2); PG8_BAR;
    PG8_STAGE(PG8_SB(1, 0), cB + kstep, voffB); PG8_STAGE(PG8_SA(1, 0), cA + kstep, vA[0]); PG8_STAGE(PG8_SB(1, 1), cB + hstep + kstep, voffB);
    PG8_WAIT_V(6); PG8_BAR;
    for (;;) {
        const bool has_next = S.next(ui + 1, nxt);
        const char* nA = has_next ? nxt.A : cA; const char* nB = has_next ? nxt.B : cB;
        if constexpr (GATHER) {
            if (has_next) {
#pragma unroll
                for (int i = 0; i < 2; ++i) { vAn[0][i] = (unsigned)(gidx(nxt, Rr[i]) * K + Cc[i]) * 2u; vAn[1][i] = (unsigned)(gidx(nxt, Rr[i] + HALF) * K + Cc[i]) * 2u; }
            } else {
#pragma unroll
                for (int i = 0; i < 2; ++i) { vAn[0][i] = vA[0][i]; vAn[1][i] = vA[1][i]; }
            }
        }
#pragma unroll 1
        for (int t = 0; t < nt; t += 2) {
            const bool last = (t == nt - 2);
            const char* a1 = cA + (size_t)(t + 1) * kstep;
            const char* a2 = last ? nA : cA + (size_t)(t + 2) * kstep; const char* b2 = last ? nB : cB + (size_t)(t + 2) * kstep;
            const char* a3 = a2 + kstep; const char* b3 = b2 + kstep;
            unsigned w0[2], w1[2];
            if constexpr (GATHER) { w0[0] = last ? vAn[0][0] : vA[0][0]; w0[1] = last ? vAn[0][1] : vA[0][1]; w1[0] = last ? vAn[1][0] : vA[1][0]; w1[1] = last ? vAn[1][1] : vA[1][1]; }
            else { w0[0] = vA[0][0]; w0[1] = vA[0][1]; w1[0] = vA[1][0]; w1[1] = vA[1][1]; }
            PG8_LDB(B0, 0, 0); PG8_LDB(B1, 0, 1); PG8_SCHED; PG8_LDA(At, 0, 0); PG8_STAGE(PG8_SA(1, 1), a1, vA[1]);
            PG8_WAIT_V(8); PG8_WAIT_L(0); PG8_BAR; PG8_MMA(0, 0, At, B0); PG8_MMA(0, 1, At, B1); PG8_BAR; PG8_SCHED;
            PG8_LDA(At, 0, 1); PG8_STAGE(PG8_SB(0, 0), b2, voffB); PG8_STAGE(PG8_SB(0, 1), b2 + hstep, voffB); PG8_STAGE(PG8_SA(0, 0), a2, w0);
            PG8_WAIT_V(8); PG8_WAIT_L(0); PG8_BAR; PG8_MMA(1, 0, At, B0); PG8_MMA(1, 1, At, B1); PG8_BAR; PG8_SCHED;
            PG8_LDB(B0, 1, 0); PG8_LDB(B1, 1, 1); PG8_SCHED; PG8_LDA(At, 1, 0); PG8_STAGE(PG8_SA(0, 1), a2, w1);
            PG8_WAIT_V(8); PG8_WAIT_L(0); PG8_BAR; PG8_MMA(0, 0, At, B0); PG8_MMA(0, 1, At, B1); PG8_BAR; PG8_SCHED;
            PG8_LDA(At, 1, 1); PG8_STAGE(PG8_SB(1, 0), b3, voffB); PG8_STAGE(PG8_SB(1, 1), b3 + hstep, voffB); PG8_STAGE(PG8_SA(1, 0), a3, w0);
            PG8_WAIT_V(8); PG8_WAIT_L(0); PG8_BAR; PG8_MMA(1, 0, At, B0); PG8_MMA(1, 1, At, B1); PG8_BAR; PG8_SCHED;
        }
        if (wr == 0) PG8_BAR;
        E(acc, cur, wr, wc, fr, fq);
        if (!has_next) break;
#pragma unroll
        for (int a = 0; a < 2; ++a)
#pragma unroll
            for (int b = 0; b < 2; ++b)
#pragma unroll
                for (int m = 0; m < 4; ++m)
#pragma unroll
                    for (int n = 0; n < 2; ++n) acc[a][b][m][n] = (f32x4){0.f, 0.f, 0.f, 0.f};
        cur = nxt; cA = nA; cB = nB; ++ui;
        if constexpr (GATHER) {
#pragma unroll
            for (int i = 0; i < 2; ++i) { vA[0][i] = vAn[0][i]; vA[1][i] = vAn[1][i]; }
        }
        if (wr == 1) PG8_BAR;
    }
    PG8_WAIT_V(0);
    PG8_BAR;
#undef PG8_SA
#undef PG8_SB
#undef PG8_STAGE
#undef PG8_LDA
#undef PG8_LDB
#undef PG8_MMA
#undef PG8_WAIT_V
#undef PG8_WAIT_L
#undef PG8_BAR
#undef PG8_SCHED
}

struct EpiBf16 {
    bf16_t* O; int ldc; bool zact;
    DI void operator()(const f32x4 (&acc)[2][2][4][2], const Unit& u, int wr, int wc, int fr, int fq) const {
        const int row0 = u.pm * BM + wr * 64 + fr, col0 = u.pn * BM + wc * 32 + 8 * fq;
#pragma unroll
        for (int bj = 0; bj < 2; ++bj) { const int hc = 2 * u.pn + bj; const int act = !zact ? 0 : (hc < 12 ? 4 : (hc == 12 ? 1 : (hc == 14 ? 2 : (hc >= 15 ? 3 : 0))));
#pragma unroll
            for (int ai = 0; ai < 2; ++ai)
#pragma unroll
                for (int m = 0; m < 4; ++m) { bf16_t* rowp = O + (size_t)(row0 + ai * HALF + m * 16) * ldc + col0;
                    f32x4 v0 = acc[ai][bj][m][0], v1 = acc[ai][bj][m][1];
                    if (act == 1) {
#pragma unroll
                        for (int j = 0; j < 4; ++j) { v0[j] = tanh_fast(v0[j]); v1[j] = tanh_fast(v1[j]); }
                    } else if (act == 2) {
#pragma unroll
                        for (int j = 0; j < 4; ++j) { v0[j] = sigmoidf_(v0[j]); v1[j] = sigmoidf_(v1[j]); }
                    } else if (act == 3) {
#pragma unroll
                        for (int j = 0; j < 4; ++j) { v0[j] = gelu_tanh(v0[j]); v1[j] = gelu_tanh(v1[j]); }
                    }
                    u32x4 w;
                    if (act == 4) { w.x = pkh2(v0[0], v0[1]); w.y = pkh2(v0[2], v0[3]); w.z = pkh2(v1[0], v1[1]); w.w = pkh2(v1[2], v1[3]); }
                    else { w.x = cvt_pk_bf16(v0[0], v0[1]); w.y = cvt_pk_bf16(v0[2], v0[3]); w.z = cvt_pk_bf16(v1[0], v1[1]); w.w = cvt_pk_bf16(v1[2], v1[3]); }
                    *(u32x4*)(rowp + bj * HALF) = w; } }
    }
};
struct EpiF32 {
    float* O; int ldc;
    DI void operator()(const f32x4 (&acc)[2][2][4][2], const Unit& u, int wr, int wc, int fr, int fq) const {
        const int row0 = u.pm * BM + wr * 64 + fr, col0 = u.pn * BM + wc * 32 + 8 * fq;
#pragma unroll
        for (int ai = 0; ai < 2; ++ai)
#pragma unroll
            for (int m = 0; m < 4; ++m) { float* rowp = O + (size_t)(row0 + ai * HALF + m * 16) * ldc + col0;
#pragma unroll
                for (int bj = 0; bj < 2; ++bj) { *(f32x4*)(rowp + bj * HALF) = acc[ai][bj][m][0]; *(f32x4*)(rowp + bj * HALF + 4) = acc[ai][bj][m][1]; } }
    }
};
struct EpiMoeUp {
    bf16_t* HID;
    DI void operator()(const f32x4 (&acc)[2][2][4][2], const Unit& u, int wr, int wc, int fr, int fq) const {
        const int row0 = u.pm * BM + wr * 64 + fr, col0 = u.pn * HALF + wc * 32 + 8 * fq;
#pragma unroll
        for (int ai = 0; ai < 2; ++ai)
#pragma unroll
            for (int m = 0; m < 4; ++m) { bf16_t* rowp = HID + (size_t)(row0 + ai * HALF + m * 16) * DEXP + col0;
                float h[8];
#pragma unroll
                for (int n = 0; n < 2; ++n)
#pragma unroll
                    for (int j = 0; j < 4; ++j) { const float g = acc[ai][0][m][n][j], up = acc[ai][1][m][n][j]; h[n * 4 + j] = siluf_(g) * up; }
                u32x4 w; w.x = cvt_pk_bf16(h[0], h[1]); w.y = cvt_pk_bf16(h[2], h[3]); w.z = cvt_pk_bf16(h[4], h[5]); w.w = cvt_pk_bf16(h[6], h[7]);
                *(u32x4*)rowp = w; }
    }
};
struct EpiMoeDown {
    bf16_t* YM; const int* perm; const float* ew;
    DI void operator()(const f32x4 (&acc)[2][2][4][2], const Unit& u, int wr, int wc, int fr, int fq) const {
        const int col0 = u.pn * BM + wc * 32 + 8 * fq;
        int pr[2][4]; float wgt[2][4];
#pragma unroll
        for (int ai = 0; ai < 2; ++ai)
#pragma unroll
            for (int m = 0; m < 4; ++m) { const int r = ai * HALF + wr * 64 + m * 16 + fr; pr[ai][m] = r < u.nvalid ? perm[(size_t)u.e * NT + u.lt * BM + r] : -1; }
#pragma unroll
        for (int ai = 0; ai < 2; ++ai)
#pragma unroll
            for (int m = 0; m < 4; ++m) wgt[ai][m] = pr[ai][m] >= 0 ? ew[pr[ai][m]] : 0.f;
#pragma unroll
        for (int ai = 0; ai < 2; ++ai)
#pragma unroll
            for (int m = 0; m < 4; ++m) {
                if (pr[ai][m] >= 0) { const int tok = pr[ai][m] >> 1, slot = pr[ai][m] & 1; const float wg = wgt[ai][m];
                    bf16_t* rowp = YM + ((size_t)slot * NT + tok) * D + col0;
#pragma unroll
                    for (int bj = 0; bj < 2; ++bj) { const f32x4 v0 = acc[ai][bj][m][0] * wg, v1 = acc[ai][bj][m][1] * wg;
                        u32x4 w; w.x = cvt_pk_bf16(v0[0], v0[1]); w.y = cvt_pk_bf16(v0[2], v0[3]); w.z = cvt_pk_bf16(v1[0], v1[1]); w.w = cvt_pk_bf16(v1[2], v1[3]);
                        *(u32x4*)(rowp + bj * HALF) = w; } } }
    }
};
}

struct MoeOrder {
    const LAS int* tp; const int* cnt; int npn, G, c, K; const char* A; const char* Bbase; size_t bstride_e, bstride_pn; const int* perm; bool gather;
    __device__ bool next(int i, pg8::Unit& u) const {
        const int TT = __builtin_amdgcn_readfirstlane(tp[32]); const long L = (long)i * G + c; if (L >= (long)TT * npn) return false;
        const int rt = (int)(L / npn), pn = (int)(L % npn);
        int e = 0;
#pragma unroll 1
        for (int j = 1; j < 32; ++j) e += (__builtin_amdgcn_readfirstlane(tp[j]) <= rt) ? 1 : 0;
        const int lt = rt - __builtin_amdgcn_readfirstlane(tp[e]);
        u.pm = rt; u.pn = pn; u.e = e; u.lt = lt; const int rem = cnt[e * 64] - lt * 256; u.nvalid = rem < 256 ? rem : 256;
        u.ridx = perm + (size_t)e * NT + lt * 256;
        u.A = gather ? A : A + (size_t)rt * 256 * K * 2;
        u.B = Bbase + (size_t)e * bstride_e + (size_t)pn * bstride_pn;
        return true;
    }
};

struct Ctx {
    LAS unsigned char* lds; int tid, lane, wave, G, bid;
};

DI void phase_adaln(const Params& p, const Ctx& F) {
    LAS float* s = (LAS float*)F.lds;
    LAS float* red = (LAS float*)(F.lds + 20480);
    const float* c = p.in[I_C]; const float* cc = p.in[I_CCTX]; const float* wm = p.in[I_WMOD]; const float* bm = p.in[I_BMOD];
    float* mod = (float*)(p.ws + WS_MOD);
    for (int i = F.tid; i < 5 * 1024; i += NTHREADS) { const float v = i < 4096 ? c[i] : cc[i - 4096]; s[i] = siluf_(v); }
    __syncthreads();
    for (int grp = F.bid; grp < 256; grp += F.G) {
        const int col0 = grp * 24, q = F.tid % 6, ks = F.tid / 6;
        float acc[5][4];
#pragma unroll
        for (int b = 0; b < 5; ++b)
#pragma unroll
            for (int j = 0; j < 4; ++j) acc[b][j] = 0.f;
        if (F.tid < 510) {
            f32x4 wv[13];
#pragma unroll
            for (int i = 0; i < 13; ++i) { const int k = ks + 85 * i; wv[i] = k < 1024 ? *(const f32x4*)(wm + (size_t)k * 6144 + col0 + 4 * q) : (f32x4){0.f, 0.f, 0.f, 0.f}; }
#pragma unroll
            for (int i = 0; i < 13; ++i) { const int k = ks + 85 * i; const int kc = k < 1024 ? k : 0;
#pragma unroll
                for (int b = 0; b < 5; ++b) { const float sv = s[b * 1024 + kc];
#pragma unroll
                    for (int j = 0; j < 4; ++j) acc[b][j] += sv * wv[i][j]; } }
#pragma unroll
            for (int b = 0; b < 5; ++b)
#pragma unroll
                for (int j = 0; j < 4; ++j) red[ks * 120 + q * 20 + b * 4 + j] = acc[b][j];
        }
        __syncthreads();
        if (F.tid < 120) {
            float sum = 0.f;
            for (int k2 = 0; k2 < 85; ++k2) sum += red[k2 * 120 + F.tid];
            const int qq = F.tid / 20, b = (F.tid % 20) / 4, j = F.tid % 4, col = col0 + 4 * qq + j;
            mod[b * 6144 + col] = sum + bm[col];
        }
        __syncthreads();
    }
}

DI void transpose_item(const float* W, int K, int N, bf16_t* WT, int row_off, LAS float* scr, int item, int lane) {
    const int nblk = N / 32, kb = item / nblk, nb = item % nblk, k0 = 64 * kb, n0 = 32 * nb;
#pragma unroll 8
    for (int i = 0; i < 32; ++i) { const int kk = 2 * i + (lane >> 5); scr[kk * 33 + (lane & 31)] = W[(size_t)(k0 + kk) * N + n0 + (lane & 31)]; }
    LDS_WAIT(); asm volatile("" ::: "memory");
    const int c = lane & 7;
#pragma unroll
    for (int j = 0; j < 4; ++j) { const int n = (lane >> 3) + 8 * j; const LAS float* s = scr + (8 * c) * 33 + n;
        u32x4 o; o.x = pk2(s[0 * 33], s[1 * 33]); o.y = pk2(s[2 * 33], s[3 * 33]); o.z = pk2(s[4 * 33], s[5 * 33]); o.w = pk2(s[6 * 33], s[7 * 33]);
        *(u32x4*)(WT + (size_t)(row_off + n0 + n) * K + k0 + 8 * c) = o; }
    LDS_WAIT(); asm volatile("" ::: "memory");
}
DI void phase_convert(const Params& p, const Ctx& F) {
    __syncthreads();
    LAS float* scr = (LAS float*)(F.lds + F.wave * 16384);
    const int gw = F.bid * NWAVES + F.wave, NGW = F.G * NWAVES;
    bf16_t* WinT = (bf16_t*)(p.ws + WS_WINT); bf16_t* WoutT = (bf16_t*)(p.ws + WS_WOUTT); bf16_t* WguT = (bf16_t*)(p.ws + WS_WGUT); bf16_t* WdT = (bf16_t*)(p.ws + WS_WDT);
    constexpr int I_IN = 16 * 92, I_OUT = 16 * 32;
    constexpr int NITEMS = I_IN + I_OUT;
    for (int it = gw; it < NITEMS; it += NGW) {
        int r = it;
        if (r < I_IN) { transpose_item(p.in[I_WIN], 1024, DIN, WinT, 0, scr, r, F.lane); continue; } r -= I_IN;
        transpose_item(p.in[I_WOUT], 1024, 1024, WoutT, 0, scr, r, F.lane);
    }
    (void)WguT; (void)WdT;
    { const int gt = F.bid * NTHREADS + F.tid, NG = F.G * NTHREADS; u32x4 z = {0u, 0u, 0u, 0u};
      for (int i = gt; i < 128 * 1024 / 8; i += NG) *(u32x4*)(WinT + (size_t)DIN * 1024 + (size_t)i * 8) = z;
      bf16_t* DupT = (bf16_t*)(p.ws + WS_DUPT); bf16_t* AupT = (bf16_t*)(p.ws + WS_AUPT); bf16_t* GupT = (bf16_t*)(p.ws + WS_GUPT); bf16_t* Wsp = (bf16_t*)(p.ws + WS_WSP);
      for (int i = gt; i < 2 * 512 * 64; i += NG) { const int d = i / (512 * 64), ch = (i / 64) % 512, l = i % 64;
          DupT[i] = (bf16_t)f2bf(p.in[I_DUP][(size_t)(d * 64 + l) * 512 + ch]); AupT[i] = (bf16_t)f2bf(p.in[I_AUP][(size_t)(d * 64 + l) * 512 + ch]); }
      for (int i = gt; i < 512 * 128; i += NG) { const int ch = i / 128, l = i % 128; GupT[i] = (bf16_t)f2bf(p.in[I_GUP][(size_t)l * 512 + ch]); }
      for (int i = gt; i < 8 * 128 * 128; i += NG) Wsp[i] = (bf16_t)f2bf(p.in[I_WSP][i]);
      float* cw2 = (float*)(p.ws + WS_CONVW);
      for (int i = gt; i < 128 * 9 * 3 * 4; i += NG) { const int j = i & 3, s3 = (i >> 2) % 3, tap = (i / 12) % 9, qd = i / 108; cw2[i] = p.in[I_CONV][tap * 1536 + s3 * 512 + 4 * qd + j]; } }
}


DI void phase_convert_experts(const Params& p, const Ctx& F) {
    constexpr int TP = 264;
    LAS bf16_t* tile = (LAS bf16_t*)F.lds;
    bf16_t* WguT = (bf16_t*)(p.ws + WS_WGUT); bf16_t* WdT = (bf16_t*)(p.ws + WS_WDT);
    constexpr int NIT = 32 * 2 * 16 + 32 * 16;
    const int b0 = F.bid, nb = F.G;
    for (int it = b0; it < NIT; it += nb) {
        const float* src; int ldn; bf16_t* dst; int ldk, k0; int rowmap;
        int n0 = 0;
        if (it < 1024) { const int e = it >> 5, up = (it >> 4) & 1, kt = it & 15; src = (up ? p.in[I_WU] : p.in[I_WG]) + (size_t)e * 1024 * 256 + (size_t)kt * 64 * 256; ldn = 256;
            dst = WguT + (size_t)e * 512 * 1024; ldk = 1024; k0 = kt * 64; rowmap = 1 + up; }
        else { const int r = it - 1024, e = r >> 4, kt = (r >> 2) & 3, ntl = r & 3; src = p.in[I_WD] + (size_t)e * 256 * 1024 + (size_t)kt * 64 * 1024 + ntl * 256; ldn = 1024;
            dst = WdT + (size_t)e * 1024 * 256; ldk = 256; k0 = kt * 64; rowmap = 0; n0 = ntl * 256; }
        __syncthreads();
#pragma unroll
        for (int i = 0; i < 8; ++i) { const int k = 8 * F.wave + i; const f32x4 v = *(const f32x4*)(src + (size_t)k * ldn + 4 * F.lane);
            u32x2 o; o.x = pk2(v[0], v[1]); o.y = pk2(v[2], v[3]); *(LAS u32x2*)(tile + k * TP + 4 * F.lane) = o; }
        __syncthreads();
        { const int n = F.tid >> 1, kh = F.tid & 1;
          u32x4 o[4];
#pragma unroll
          for (int q = 0; q < 4; ++q) { unsigned wds[4];
#pragma unroll
              for (int j = 0; j < 4; ++j) { const int k = 32 * kh + 8 * q + 2 * j; wds[j] = (unsigned)tile[k * TP + n] | ((unsigned)tile[(k + 1) * TP + n] << 16); }
              o[q] = (u32x4){wds[0], wds[1], wds[2], wds[3]}; }
          const int drow = rowmap == 0 ? n0 + n : ((n >> 7) * 256 + (n & 127) + (rowmap == 2 ? 128 : 0));
          bf16_t* dp = dst + (size_t)drow * ldk + k0 + 32 * kh;
#pragma unroll
          for (int q = 0; q < 4; ++q) *(u32x4*)(dp + 8 * q) = o[q]; }
    }
}

DI void phase_hrows(const Params& p, const Ctx& F) {
    const float* mod = (const float*)(p.ws + WS_MOD); const float* g = p.in[I_GPRE1]; bf16_t* H = (bf16_t*)(p.ws + WS_H);
    const int gw = F.bid * NWAVES + F.wave, NGW = F.G * NWAVES;
    auto rowsrc = [&](int row) -> const f32x4* { return (const f32x4*)(row < NT ? p.in[I_X] + (size_t)row * D : p.in[I_CTX] + (size_t)(row - NT) * D) + F.lane; };
    f32x4 nv[4];
    if (gw < MR) { const f32x4* xr = rowsrc(gw);
#pragma unroll
        for (int j = 0; j < 4; ++j) nv[j] = xr[64 * j]; }
    for (int row = gw; row < MR; row += NGW) {
        const int bt = row < NT ? row / SEQ : 4;
        f32x4 v[4]; float ss = 0.f;
#pragma unroll
        for (int j = 0; j < 4; ++j) { v[j] = nv[j]; ss += (v[j].x * v[j].x + v[j].y * v[j].y) + (v[j].z * v[j].z + v[j].w * v[j].w); }
        if (row + NGW < MR) { const f32x4* xr = rowsrc(row + NGW);
#pragma unroll
            for (int j = 0; j < 4; ++j) nv[j] = xr[64 * j]; }
        const float rstd = __builtin_amdgcn_rsqf(wave_sum(ss) * (1.f / D) + 1e-6f);
        unsigned long long* o8 = (unsigned long long*)(H + (size_t)row * D) + F.lane;
#pragma unroll
        for (int j = 0; j < 4; ++j) { const int col = 4 * (F.lane + 64 * j);
            const f32x4 gg = *(const f32x4*)(g + col), sh = *(const f32x4*)(mod + bt * 6144 + col), sc = *(const f32x4*)(mod + bt * 6144 + 1024 + col);
            const f32x4 h = v[j] * rstd * gg * (sc + 1.f) + sh;
            o8[64 * j] = (unsigned long long)pk2(h.x, h.y) | ((unsigned long long)pk2(h.z, h.w) << 32); }
    }
}

DI void phase_gemm1(const Params& p, const Ctx& F) {
    pg8::StaticOrder S; S.init(p.ws + WS_H, p.ws + WS_WINT, MR, DINP, 1024, F.G, F.bid);
    pg8::EpiBf16 E{(bf16_t*)(p.ws + WS_Z), DINP, true};
    pg8::gemm_phase<pg8::EpiBf16, pg8::StaticOrder, false>(F.lds, 1024, S, E);
}

DI void phase_prep(const Params& p, const Ctx& F) {
    const bf16_t* Z = (const bf16_t*)(p.ws + WS_Z);
    bf16_t* Kc = (bf16_t*)(p.ws + WS_KC); bf16_t* Vc = (bf16_t*)(p.ws + WS_VC); bf16_t* Rc = (bf16_t*)(p.ws + WS_RC);
    bf16_t* A0 = (bf16_t*)(p.ws + WS_A0); bf16_t* A1 = (bf16_t*)(p.ws + WS_A1); bf16_t* L0 = (bf16_t*)(p.ws + WS_L0); bf16_t* L1 = (bf16_t*)(p.ws + WS_L1);
    bf16_t* GATE = (bf16_t*)((unsigned char*)p.out + DO_GATE); bf16_t* BV = (bf16_t*)((unsigned char*)p.out + DO_BV);
    const float* conv = p.in[I_CONV];
    LAS float* sl = (LAS float*)F.lds;
    const int t = F.tid;
    for (int it = F.bid; it < MR / 8; it += F.G) {
        const int row0 = it * 8;
        __syncthreads();
        for (int i = t; i < 8 * 384; i += NTHREADS) { const int rr = i / 384, c = i % 384; const float zv = bf2f(Z[(size_t)(row0 + rr) * DINP + OFF_WD + c]);
            sl[i] = c < 128 ? tanhf(zv) : (c < 256 ? zv : sigmoidf_(zv)); }
        __syncthreads();
        float dw0[8], dw1[8], da0[8], da1[8], gt[8];
#pragma unroll
        for (int r = 0; r < 8; ++r) { dw0[r] = dw1[r] = da0[r] = da1[r] = gt[r] = 0.f; }
        for (int l = 0; l < 64; ++l) {
            const float u0 = p.in[I_DUP][(size_t)l * 512 + t], u1 = p.in[I_DUP][(size_t)(64 + l) * 512 + t];
            const float v0 = p.in[I_AUP][(size_t)l * 512 + t], v1 = p.in[I_AUP][(size_t)(64 + l) * 512 + t];
            const float g0 = p.in[I_GUP][(size_t)l * 512 + t], g1 = p.in[I_GUP][(size_t)(64 + l) * 512 + t];
#pragma unroll
            for (int r = 0; r < 8; ++r) { const LAS float* s = sl + r * 384;
                dw0[r] += s[l] * u0; dw1[r] += s[64 + l] * u1; da0[r] += s[128 + l] * v0; da1[r] += s[192 + l] * v1; gt[r] += s[256 + l] * g0 + s[320 + l] * g1; }
        }
        const float w00 = p.in[I_DW0][t], w01 = p.in[I_DW0][512 + t], a00 = p.in[I_A0][t], a01 = p.in[I_A0][512 + t];
        const float ka0 = p.in[I_KA][t], ka1 = p.in[I_KA][512 + t], rk = p.in[I_RK][t];
#pragma unroll 1
        for (int r = 0; r < 8; ++r) {
            const int row = row0 + r;
            float cv[3] = {0.f, 0.f, 0.f};
            if (row < NT) {
                const int tb = row % SEQ, gy = tb / 64, gx = tb % 64;
#pragma unroll
                for (int dy = 0; dy < 3; ++dy) { const int ny = gy + dy - 1; if (ny < 0 || ny >= 128) continue;
#pragma unroll
                    for (int dx = 0; dx < 3; ++dx) { const int nx = gx + dx - 1; if (nx < 0 || nx >= 64) continue;
                        const size_t nrow = (size_t)(row + (dy - 1) * 64 + (dx - 1));
#pragma unroll
                        for (int s3 = 0; s3 < 3; ++s3) cv[s3] += bf2f(Z[nrow * DINP + s3 * 512 + t]) * conv[(dy * 3 + dx) * 1536 + s3 * 512 + t]; } }
            } else {
                const int tb = (row - NT) % CTXL;
#pragma unroll
                for (int dx = 0; dx < 3; ++dx) { const int nx = tb + dx - 1; if (nx < 0 || nx >= CTXL) continue;
                    const size_t nrow = (size_t)(row + dx - 1);
#pragma unroll
                    for (int s3 = 0; s3 < 3; ++s3) cv[s3] += bf2f(Z[nrow * DINP + s3 * 512 + t]) * conv[(3 + dx) * 1536 + s3 * 512 + t]; }
            }
            const float k = cv[0], v = cv[1], rr = cv[2];
            const float wl0 = w00 + dw0[r], wl1 = w01 + dw1[r];
            const float lg0 = -__expf(-softplusf_(-wl0) - 0.5f), lg1 = -__expf(-softplusf_(-wl1) - 0.5f);
            const float a0 = sigmoidf_(a00 + da0[r]), a1 = sigmoidf_(a01 + da1[r]);
            const size_t o = (size_t)row * 512 + t;
            Kc[o] = (bf16_t)f2bf(k); Vc[o] = (bf16_t)f2bf(v); Rc[o] = (bf16_t)f2bf(rr);
            A0[o] = (bf16_t)f2bf(a0); A1[o] = (bf16_t)f2bf(a1); L0[o] = (bf16_t)f2bf(lg0); L1[o] = (bf16_t)f2bf(lg1);
            if (row < NT) {
                const float km0 = k * (1.f + (a0 - 1.f) * ka0), km1 = k * (1.f + (a1 - 1.f) * ka1);
                const float bon = wave_sum(rr * (km0 + km1) * rk);
                GATE[o] = (bf16_t)f2bf(gt[r]); BV[o] = (bf16_t)f2bf(bon * v);
            }
        }
    }
}


constexpr int ZS_TOKB = 400, ZS_ROWB = 66 * ZS_TOKB, ZS_BYTES = 3 * ZS_ROWB;
constexpr int XS_OFF = ZS_BYTES, XS_ARR = 64 * 144, XSG_OFF = XS_OFF + 4 * XS_ARR, XSG_PITCH = 272, BON_OFF = XSG_OFF + 64 * XSG_PITCH;
constexpr int CWL_OFF = BON_OFF + 1024;
static_assert(CWL_OFF + 6912 <= LDS_MISC, "prep LDS");
struct PrepLd { u32x4 zv[9]; u32x4 hv; u32x4 xv[6]; };
DI void prep_issue(PrepLd& L, const bf16_t* Z, int item, int tidv) {
    const int h = item & 7, ck = item >> 3; const bool lat = ck < 512;
    const int b = lat ? ck >> 7 : (ck - 512) >> 2, c = lat ? ck & 127 : (ck - 512) & 3;
    const int rowbase = lat ? b * SEQ + c * 64 : NT + b * CTXL + c * 64;
    const int q8 = tidv & 7, tsl = tidv >> 3;
    const bf16_t* zc = Z + (size_t)(rowbase + tsl) * DINP + 64 * h + 8 * q8;
#pragma unroll
    for (int rr = 0; rr < 3; ++rr) {
        const bool ok = lat ? (c + rr - 1 >= 0 && c + rr - 1 < 128) : (rr == 1);
        const bf16_t* zr = ok ? zc + (long)(rr - 1) * 64 * DINP : zc;
#pragma unroll
        for (int sec = 0; sec < 3; ++sec) { const u32x4 v = *(const u32x4*)(zr + sec * 512); L.zv[rr * 3 + sec] = ok ? v : (u32x4){0u, 0u, 0u, 0u}; }
    }
    {
      const int hq8 = tidv & 7, hsec = (tidv >> 3) % 3, hside = (tidv >> 3) / 3 & 1, hrr = (tidv >> 3) / 6;
      const int tx = c * 64 + (hside ? 64 : -1);
      const bool ok = !lat && tidv < 144 && hrr == 1 && tx >= 0 && tx < CTXL;
      const size_t off = ok ? (size_t)(NT + b * CTXL + tx) * DINP + hsec * 512 + 64 * h + 8 * hq8 : 0;
      const u32x4 v = *(const u32x4*)(Z + off); L.hv = ok ? v : (u32x4){0u, 0u, 0u, 0u}; }
    const bf16_t* zx = Z + (size_t)(rowbase + tsl) * DINP + OFF_WD + 8 * q8;
#pragma unroll
    for (int it = 0; it < 6; ++it) L.xv[it] = *(const u32x4*)(zx + 64 * it);
}
DI void phase_prep2(const Params& p, const Ctx& F) {
    const bf16_t* Z = (const bf16_t*)(p.ws + WS_Z);
    bf16_t* Kc = (bf16_t*)(p.ws + WS_KC); bf16_t* Vc = (bf16_t*)(p.ws + WS_VC); bf16_t* Rc = (bf16_t*)(p.ws + WS_RC);
    bf16_t* A0 = (bf16_t*)(p.ws + WS_A0); bf16_t* A1 = (bf16_t*)(p.ws + WS_A1); bf16_t* L0 = (bf16_t*)(p.ws + WS_L0); bf16_t* L1 = (bf16_t*)(p.ws + WS_L1);
    bf16_t* GATE = (bf16_t*)((unsigned char*)p.out + DO_GATE); bf16_t* BV = (bf16_t*)((unsigned char*)p.out + DO_BV);
    const bf16_t* DupT = (const bf16_t*)(p.ws + WS_DUPT); const bf16_t* AupT = (const bf16_t*)(p.ws + WS_AUPT); const bf16_t* GupT = (const bf16_t*)(p.ws + WS_GUPT);
    const float* cw2 = (const float*)(p.ws + WS_CONVW);
    LAS unsigned char* ZS = F.lds; LAS float* BON = (LAS float*)(F.lds + BON_OFF);
    const int w = F.wave, fr0 = F.lane & 15, fq0 = F.lane >> 4, ct = w >> 1, tt0 = 2 * (w & 1);
    constexpr int NITEM = 528 * 8;
    const bool xmap = (F.G == 256);
    auto item_of = [&](int i) -> int { if (!xmap) { const int it = F.bid + i * F.G; return it < NITEM ? it : -1; }
        const int x = F.bid & 7, y = F.bid >> 3, j = y + 32 * i; return j < 528 ? (x * 66 + (j >> 3)) * 8 + (j & 7) : -1; };
    PrepLd L;
    bf16x8 wf[4][2], gf[4]; f32x4 w00, w01, a00, a01, ka0, ka1, rk; int hcur = -1;
    int itx = 0, item = item_of(0);
    if (item >= 0) prep_issue(L, Z, item, F.tid);
    for (; item >= 0; ) {
        const int item_next = item_of(++itx);
        const int h = item & 7, ck = item >> 3;
        const bool lat = ck < 512;
        const int b = lat ? ck >> 7 : (ck - 512) >> 2, c = lat ? ck & 127 : (ck - 512) & 3;
        const int rowbase = lat ? b * SEQ + c * 64 : NT + b * CTXL + c * 64;
        int tidv = F.tid, fr = fr0, fq = fq0; asm volatile("" : "+v"(tidv), "+v"(fr), "+v"(fq));
        __syncthreads();
        { const int q8 = tidv & 7, tsl = tidv >> 3;
#pragma unroll
          for (int rr = 0; rr < 3; ++rr)
#pragma unroll
              for (int sec = 0; sec < 3; ++sec) *(LAS u32x4*)(ZS + rr * ZS_ROWB + (tsl + 1) * ZS_TOKB + sec * 128 + q8 * 16) = L.zv[rr * 3 + sec];
          if (tidv < 144) { const int hsec = (tidv >> 3) % 3, hside = (tidv >> 3) / 3 & 1, hrr = (tidv >> 3) / 6;
              *(LAS u32x4*)(ZS + hrr * ZS_ROWB + (hside ? 65 : 0) * ZS_TOKB + hsec * 128 + q8 * 16) = L.hv; }
#pragma unroll
          for (int it = 0; it < 6; ++it) {
              const u32x4 o = L.xv[it];
              if (it < 4) *(LAS u32x4*)(F.lds + XS_OFF + it * XS_ARR + tsl * 144 + q8 * 16) = o;
              else *(LAS u32x4*)(F.lds + XSG_OFF + tsl * XSG_PITCH + ((it - 4) * 8 + q8) * 16) = o; } }
        if (h != hcur) {
            hcur = h;
            const int chrow = 64 * h + 16 * ct + fr, gch0 = 64 * h + 16 * ct + 4 * fq;
#pragma unroll
            for (int q = 0; q < 4; ++q) { const bf16_t* WT = (q < 2 ? DupT : AupT) + ((size_t)(q & 1) * 512 + chrow) * 64;
#pragma unroll
                for (int s2 = 0; s2 < 2; ++s2) wf[q][s2] = *(const bf16x8*)(WT + 32 * s2 + 8 * fq); }
#pragma unroll
            for (int s2 = 0; s2 < 4; ++s2) gf[s2] = *(const bf16x8*)(GupT + (size_t)chrow * 128 + 32 * s2 + 8 * fq);
            w00 = *(const f32x4*)(p.in[I_DW0] + gch0); w01 = *(const f32x4*)(p.in[I_DW0] + 512 + gch0); a00 = *(const f32x4*)(p.in[I_A0] + gch0); a01 = *(const f32x4*)(p.in[I_A0] + 512 + gch0);
            ka0 = *(const f32x4*)(p.in[I_KA] + gch0); ka1 = *(const f32x4*)(p.in[I_KA] + 512 + gch0); rk = *(const f32x4*)(p.in[I_RK] + gch0);
            if (tidv < 432) { const f32x4 wv4 = *(const f32x4*)(cw2 + (size_t)h * 16 * 108 + tidv * 4); u32x2 hw; hw.x = pkh2(wv4[0], wv4[1]); hw.y = pkh2(wv4[2], wv4[3]); *(LAS u32x2*)(F.lds + CWL_OFF + tidv * 8) = hw; }
        }
        if (item_next >= 0) prep_issue(L, Z, item_next, tidv);
        const int gch = 64 * h + 16 * ct + 4 * fq;
        const LAS h4_t* cwl = (const LAS h4_t*)(F.lds + CWL_OFF) + (4 * ct + fq) * 27;
        __syncthreads();
        f32x4 vkeep[2];
#pragma unroll
        for (int t2 = 0; t2 < 2; ++t2) {
            const int tok = 16 * (tt0 + t2) + fr;
            f32x4 acc[5];
#pragma unroll
            for (int q = 0; q < 5; ++q) acc[q] = (f32x4){0.f, 0.f, 0.f, 0.f};
#pragma unroll
            for (int q = 0; q < 4; ++q) {
#pragma unroll
                for (int s2 = 0; s2 < 2; ++s2) { const bf16x8 bfr = *(const LAS bf16x8*)(F.lds + XS_OFF + q * XS_ARR + tok * 144 + (32 * s2 + 8 * fq) * 2);
                    acc[q] = __builtin_amdgcn_mfma_f32_16x16x32_bf16(wf[q][s2], bfr, acc[q], 0, 0, 0); }
            }
#pragma unroll
            for (int s2 = 0; s2 < 4; ++s2) { const bf16x8 bfr = *(const LAS bf16x8*)(F.lds + XSG_OFF + tok * XSG_PITCH + (32 * s2 + 8 * fq) * 2);
                acc[4] = __builtin_amdgcn_mfma_f32_16x16x32_bf16(gf[s2], bfr, acc[4], 0, 0, 0); }
            f32x4 cv[3];
            { h4_t hc[3];
#pragma unroll
              for (int s3 = 0; s3 < 3; ++s3) hc[s3] = (h4_t){(_Float16)0.f, (_Float16)0.f, (_Float16)0.f, (_Float16)0.f};
#pragma unroll
              for (int dy = 0; dy < 3; ++dy)
#pragma unroll
                  for (int dx = 0; dx < 3; ++dx) {
#pragma unroll
                      for (int s3 = 0; s3 < 3; ++s3) { const h4_t wv = cwl[(dy * 3 + dx) * 3 + s3];
                          const h4_t zz = *(const LAS h4_t*)(ZS + dy * ZS_ROWB + (tok + dx) * ZS_TOKB + s3 * 128 + (16 * ct + 4 * fq) * 2);
                          hc[s3] += zz * wv; }
                  }
#pragma unroll
              for (int s3 = 0; s3 < 3; ++s3) cv[s3] = (f32x4){(float)hc[s3][0], (float)hc[s3][1], (float)hc[s3][2], (float)hc[s3][3]}; }
            const size_t o = (size_t)(rowbase + tok) * 512 + gch;
            float lg0[4], lg1[4], a0[4], a1[4]; float bs = 0.f;
#pragma unroll
            for (int i = 0; i < 4; ++i) { const float wl0 = w00[i] + acc[0][i], wl1 = w01[i] + acc[1][i];
                lg0[i] = -__expf(-softplusf_(-wl0) - 0.5f); lg1[i] = -__expf(-softplusf_(-wl1) - 0.5f);
                a0[i] = sigmoidf_(a00[i] + acc[2][i]); a1[i] = sigmoidf_(a01[i] + acc[3][i]);
                const float k = cv[0][i]; const float km0 = k * (1.f + (a0[i] - 1.f) * ka0[i]), km1 = k * (1.f + (a1[i] - 1.f) * ka1[i]);
                bs += cv[2][i] * (km0 + km1) * rk[i]; }
            bs += __shfl_xor(bs, 16); bs += __shfl_xor(bs, 32);
            u32x2 wv2;
            wv2.x = pk2(cv[0][0], cv[0][1]); wv2.y = pk2(cv[0][2], cv[0][3]); *(u32x2*)(Kc + o) = wv2;
            wv2.x = pk2(cv[1][0], cv[1][1]); wv2.y = pk2(cv[1][2], cv[1][3]); *(u32x2*)(Vc + o) = wv2;
            wv2.x = pk2(cv[2][0], cv[2][1]); wv2.y = pk2(cv[2][2], cv[2][3]); *(u32x2*)(Rc + o) = wv2;
            wv2.x = pk2(a0[0], a0[1]); wv2.y = pk2(a0[2], a0[3]); *(u32x2*)(A0 + o) = wv2;
            wv2.x = pk2(a1[0], a1[1]); wv2.y = pk2(a1[2], a1[3]); *(u32x2*)(A1 + o) = wv2;
            wv2.x = pk2(lg0[0], lg0[1]); wv2.y = pk2(lg0[2], lg0[3]); *(u32x2*)(L0 + o) = wv2;
            wv2.x = pk2(lg1[0], lg1[1]); wv2.y = pk2(lg1[2], lg1[3]); *(u32x2*)(L1 + o) = wv2;
            if (lat) { wv2.x = pk2(acc[4][0], acc[4][1]); wv2.y = pk2(acc[4][2], acc[4][3]); *(u32x2*)(GATE + o) = wv2; }
            if (fq == 0) BON[tok * 4 + ct] = bs;
            if (t2 == 0) vkeep[0] = cv[1]; else vkeep[1] = cv[1];
        }
        __syncthreads();
        if (lat) {
#pragma unroll
            for (int t2 = 0; t2 < 2; ++t2) { const int tok = 16 * (tt0 + t2) + fr; const f32x4 bq = *(const LAS f32x4*)(BON + tok * 4); const float bon = (bq[0] + bq[1]) + (bq[2] + bq[3]);
                const size_t o = (size_t)(rowbase + tok) * 512 + gch;
                u32x2 wv2; wv2.x = pk2(bon * vkeep[t2][0], bon * vkeep[t2][1]); wv2.y = pk2(bon * vkeep[t2][2], bon * vkeep[t2][3]); *(u32x2*)(BV + o) = wv2; }
        }
        item = item_next;
    }
}

DI void phase_gmlp(const Params& p, const Ctx& F) {
    const bf16_t* Z = (const bf16_t*)(p.ws + WS_Z); const bf16_t* Wsp = (const bf16_t*)(p.ws + WS_WSP);
    bf16_t* MIXED = (bf16_t*)((unsigned char*)p.out + DO_MIXED);
    constexpr int LDV = 136;
    LAS bf16_t* vnT = (LAS bf16_t*)F.lds;
    LAS float* gu = (LAS float*)(F.lds + 17408);
    constexpr int LDG = 68;
    const int fr = F.lane & 15, fq = F.lane >> 4;
    for (int un = F.bid; un < 4 * 64 * 8; un += F.G) {
        const int g = un & 7, cc = (un >> 3) & 63, b = un >> 9;
        const size_t tok0 = (size_t)b * SEQ + cc * 128;
        __syncthreads();
        { const int pq = F.tid >> 2, seg = F.tid & 3;
          const bf16_t* zr = Z + (tok0 + pq) * DINP;
          const u32x4 ua = *(const u32x4*)(zr + OFF_U + 64 * g + 16 * seg), ub = *(const u32x4*)(zr + OFF_U + 64 * g + 16 * seg + 8);
          const u32x4 va = *(const u32x4*)(zr + OFF_VA + 64 * g + 16 * seg), vb = *(const u32x4*)(zr + OFF_VA + 64 * g + 16 * seg + 8);
          float u[16], v[16];
#pragma unroll
          for (int j = 0; j < 4; ++j) { u[2 * j] = bflo(ua[j]); u[2 * j + 1] = bfhi(ua[j]); u[8 + 2 * j] = bflo(ub[j]); u[8 + 2 * j + 1] = bfhi(ub[j]);
              v[2 * j] = bflo(va[j]); v[2 * j + 1] = bfhi(va[j]); v[8 + 2 * j] = bflo(vb[j]); v[8 + 2 * j + 1] = bfhi(vb[j]); }
          float s = 0.f;
#pragma unroll
          for (int j = 0; j < 16; ++j) s += v[j];
          s += __shfl_xor(s, 1); s += __shfl_xor(s, 2);
          const float mu = s * (1.f / 64.f); float q = 0.f;
#pragma unroll
          for (int j = 0; j < 16; ++j) { v[j] -= mu; q += v[j] * v[j]; }
          q += __shfl_xor(q, 1); q += __shfl_xor(q, 2);
          const float rstd = 1.f / sqrtf(q * (1.f / 64.f) + 1e-5f);
#pragma unroll
          for (int j = 0; j < 16; ++j) { const int ch = 16 * seg + j; const float vn = v[j] * rstd * p.in[I_GMLNG][64 * g + ch] + p.in[I_GMLNB][64 * g + ch];
              vnT[ch * LDV + pq] = (bf16_t)f2bf(vn); gu[pq * LDG + ch] = u[j]; }
        }
        __syncthreads();
        f32x4 acc[4];
#pragma unroll
        for (int n = 0; n < 4; ++n) acc[n] = (f32x4){0.f, 0.f, 0.f, 0.f};
        const int pp = 16 * F.wave + fr;
#pragma unroll
        for (int s = 0; s < 4; ++s) {
            const bf16x8 bfrag = *(const bf16x8*)(Wsp + ((size_t)(g * 128 + pp)) * 128 + 32 * s + 8 * fq);
#pragma unroll
            for (int n = 0; n < 4; ++n) { const bf16x8 afrag = *(const LAS bf16x8*)(vnT + (16 * n + fr) * LDV + 32 * s + 8 * fq);
                acc[n] = __builtin_amdgcn_mfma_f32_16x16x32_bf16(afrag, bfrag, acc[n], 0, 0, 0); }
        }
        const float bs = p.in[I_BSP][g * 128 + pp];
#pragma unroll
        for (int n = 0; n < 4; ++n) { const int d0 = 16 * n + 4 * fq; const f32x4 gv = *(const LAS f32x4*)(gu + pp * LDG + d0);
            const f32x4 o = gv * (acc[n] + bs);
            u32x2 w; w.x = pk2(o[0], o[1]); w.y = pk2(o[2], o[3]);
            *(u32x2*)(MIXED + (tok0 + pp) * D + 64 * g + d0) = w; }
    }
}

DI void phase_scan_seq(const Params& p, const Ctx& F) {
    const bf16_t* Kc = (const bf16_t*)(p.ws + WS_KC); const bf16_t* Vc = (const bf16_t*)(p.ws + WS_VC); const bf16_t* Rc = (const bf16_t*)(p.ws + WS_RC);
    float* YS = (float*)(p.ws + WS_YS);
    const int vrow = F.tid >> 3, q = F.tid & 7;
    for (int ch = F.bid; ch < 64; ch += F.G) {
        const int d = ch & 1, h = (ch >> 1) & 7, b = ch >> 4;
        const bf16_t* Ad = (const bf16_t*)(p.ws + (d ? WS_A1 : WS_A0)); const bf16_t* Ld = (const bf16_t*)(p.ws + (d ? WS_L1 : WS_L0));
        float kkw[8], kaw[8];
#pragma unroll
        for (int j = 0; j < 8; ++j) { kkw[j] = p.in[I_KK][64 * h + 8 * q + j]; kaw[j] = p.in[I_KA][d * 512 + 64 * h + 8 * q + j]; }
        float S[8];
#pragma unroll
        for (int j = 0; j < 8; ++j) S[j] = 0.f;
        const int TOT = CTXL + SEQ;
        for (int step = 0; step < TOT; ++step) {
            size_t row;
            if (step < CTXL) { const int tc = d ? (CTXL - 1 - step) : step; row = (size_t)NT + b * CTXL + tc; }
            else { const int tl = d ? (SEQ - 1 - (step - CTXL)) : (step - CTXL); row = (size_t)b * SEQ + tl; }
            const size_t o = row * 512 + 64 * h + 8 * q;
            const u32x4 kq = *(const u32x4*)(Kc + o), rq = *(const u32x4*)(Rc + o), aq = *(const u32x4*)(Ad + o), lq = *(const u32x4*)(Ld + o);
            const float vv = bf2f(Vc[row * 512 + 64 * h + vrow]);
            float k[8], r[8], a[8], l[8];
#pragma unroll
            for (int j = 0; j < 4; ++j) { k[2 * j] = bflo(kq[j]); k[2 * j + 1] = bfhi(kq[j]); r[2 * j] = bflo(rq[j]); r[2 * j + 1] = bfhi(rq[j]);
                a[2 * j] = bflo(aq[j]); a[2 * j + 1] = bfhi(aq[j]); l[2 * j] = bflo(lq[j]); l[2 * j + 1] = bfhi(lq[j]); }
            float kk[8], ss = 0.f;
#pragma unroll
            for (int j = 0; j < 8; ++j) { kk[j] = k[j] * kkw[j]; ss += kk[j] * kk[j]; }
            ss += __shfl_xor(ss, 1); ss += __shfl_xor(ss, 2); ss += __shfl_xor(ss, 4);
            const float rn = 1.f / sqrtf(fmaxf(ss, 1e-24f));
            float dot = 0.f;
#pragma unroll
            for (int j = 0; j < 8; ++j) { kk[j] *= rn; dot += S[j] * kk[j]; }
            dot += __shfl_xor(dot, 1); dot += __shfl_xor(dot, 2); dot += __shfl_xor(dot, 4);
            float y = 0.f;
#pragma unroll
            for (int j = 0; j < 8; ++j) { const float w = __expf(l[j]); const float km = k[j] * (1.f + (a[j] - 1.f) * kaw[j]);
                S[j] = S[j] * w - dot * (kk[j] * a[j]) + vv * km; y += S[j] * r[j]; }
            y += __shfl_xor(y, 1); y += __shfl_xor(y, 2); y += __shfl_xor(y, 4);
            if (step >= CTXL && q == 0) YS[((size_t)d * NT + row) * 512 + 64 * h + vrow] = y;
        }
    }
}


constexpr int LDP = 72;
constexpr int SLOTB = 64 * LDP * 2;
constexpr int CP_CUM = 12 * SLOTB, CP_TOT = CP_CUM + 16384, CP_ADIAG = CP_TOT + 2048, CP_GC = CP_ADIAG + 4096;

DI void mm64(f32x4 (&acc)[2], const LAS bf16_t* P, const LAS bf16_t* Q, int r0, int c0, int fr, int fq) {
#pragma unroll
    for (int s = 0; s < 2; ++s) { const bf16x8 b = *(const LAS bf16x8*)(Q + (c0 + fr) * LDP + 32 * s + 8 * fq);
#pragma unroll
        for (int m = 0; m < 2; ++m) { const bf16x8 a = *(const LAS bf16x8*)(P + (r0 + 16 * m + fr) * LDP + 32 * s + 8 * fq);
            acc[m] = __builtin_amdgcn_mfma_f32_16x16x32_bf16(a, b, acc[m], 0, 0, 0); } }
}
DI void zero2(f32x4 (&a)[2]) { a[0] = (f32x4){0.f, 0.f, 0.f, 0.f}; a[1] = a[0]; }
DI void writeT(LAS bf16_t* dst, const f32x4 (&acc)[2], int r0, int c0, int fr, int fq) {
#pragma unroll
    for (int m = 0; m < 2; ++m) { u32x2 w; w.x = pk2(acc[m][0], acc[m][1]); w.y = pk2(acc[m][2], acc[m][3]); *(LAS u32x2*)(dst + (c0 + fr) * LDP + r0 + 16 * m + 4 * fq) = w; }
}
DI void writeN(LAS bf16_t* dst, const f32x4 (&acc)[2], int r0, int c0, int fr, int fq) {
#pragma unroll
    for (int m = 0; m < 2; ++m)
#pragma unroll
        for (int i = 0; i < 4; ++i) dst[(r0 + 16 * m + 4 * fq + i) * LDP + c0 + fr] = (bf16_t)f2bf(acc[m][i]);
}
DI size_t chunk_row(int d, int b, int pc, int pp) {
    const int base = pc < 4 ? NT + b * CTXL : b * SEQ, len = pc < 4 ? CTXL : SEQ, q = 64 * (pc < 4 ? pc : pc - 4) + pp;
    return (size_t)(d ? base + len - 1 - q : base + q);
}

DI void phase_chunkprep(const Params& p, const Ctx& F) {
    const bf16_t* Kc = (const bf16_t*)(p.ws + WS_KC); const bf16_t* Vc = (const bf16_t*)(p.ws + WS_VC); const bf16_t* Rc = (const bf16_t*)(p.ws + WS_RC);
    unsigned char* OPS = p.ws + WS_OPS;
    LAS bf16_t* SL[12];
#pragma unroll
    for (int i = 0; i < 12; ++i) SL[i] = (LAS bf16_t*)(F.lds + i * SLOTB);
    LAS float* CUM = (LAS float*)(F.lds + CP_CUM); LAS float* TOT = (LAS float*)(F.lds + CP_TOT); LAS float* ADIAG = (LAS float*)(F.lds + CP_ADIAG); LAS float* GC = (LAS float*)(F.lds + CP_GC);
    const int w = F.wave, fr = F.lane & 15, fq = F.lane >> 4, r0 = 32 * (w >> 2), c0 = 16 * (w & 3);
    const int pp = F.tid >> 3, cg8 = F.tid & 7;
    const bool fixedmap = (F.G == 256);
    auto unit_of = [&](int i) -> int { if (fixedmap) return i < 33 ? (F.bid >> 2) * 132 + (F.bid & 3) * 33 + i : -1; const int u = F.bid + i * F.G; return u < 2 * 32 * 132 ? u : -1; };
    struct RawLd { u32x4 kq, vq, rq, aq, lq; };
    auto raw_issue = [&](RawLd& R, int unit) { const int d = unit / (32 * 132), chain = (unit / 132) & 31, pc = unit % 132, b = chain >> 3, h = chain & 7;
        const size_t o = chunk_row(d, b, pc, pp) * 512 + 64 * h + 8 * cg8;
        R.kq = *(const u32x4*)(Kc + o); R.vq = *(const u32x4*)(Vc + o); R.rq = *(const u32x4*)(Rc + o);
        R.aq = *(const u32x4*)((const bf16_t*)(p.ws + (d ? WS_A1 : WS_A0)) + o); R.lq = *(const u32x4*)((const bf16_t*)(p.ws + (d ? WS_L1 : WS_L0)) + o); };
    RawLd R;
    float kkw[8], kaw[8]; int hdcur = -1;
    int uix = 0, unit = unit_of(0);
    if (unit >= 0) raw_issue(R, unit);
    for (; unit >= 0; ) {
        const int unit_next = unit_of(++uix);
        const int d = unit / (32 * 132), chain = (unit / 132) & 31, pc = unit % 132, b = chain >> 3, h = chain & 7;
        if (d * 8 + h != hdcur) { hdcur = d * 8 + h;
#pragma unroll
            for (int j = 0; j < 8; ++j) { kkw[j] = p.in[I_KK][64 * h + 8 * cg8 + j]; kaw[j] = p.in[I_KA][d * 512 + 64 * h + 8 * cg8 + j]; } }
        __syncthreads();
        float kk[8], km[8], ka[8], vv[8], rr[8], ll[8];
        { float k[8], a[8]; float ss = 0.f;
#pragma unroll
          for (int j = 0; j < 4; ++j) { k[2 * j] = bflo(R.kq[j]); k[2 * j + 1] = bfhi(R.kq[j]); vv[2 * j] = bflo(R.vq[j]); vv[2 * j + 1] = bfhi(R.vq[j]); rr[2 * j] = bflo(R.rq[j]); rr[2 * j + 1] = bfhi(R.rq[j]);
              a[2 * j] = bflo(R.aq[j]); a[2 * j + 1] = bfhi(R.aq[j]); ll[2 * j] = bflo(R.lq[j]); ll[2 * j + 1] = bfhi(R.lq[j]); }
          if (unit_next >= 0) raw_issue(R, unit_next);
#pragma unroll
          for (int j = 0; j < 8; ++j) { kk[j] = k[j] * kkw[j]; ss += kk[j] * kk[j]; }
          ss += __shfl_xor(ss, 1); ss += __shfl_xor(ss, 2); ss += __shfl_xor(ss, 4);
          const float rn = 1.f / sqrtf(fmaxf(ss, 1e-24f));
#pragma unroll
          for (int j = 0; j < 8; ++j) { kk[j] *= rn; km[j] = k[j] * (1.f + (a[j] - 1.f) * kaw[j]); ka[j] = kk[j] * a[j]; }
          *(LAS f32x4*)(CUM + pp * 64 + 8 * cg8) = (f32x4){ll[0], ll[1], ll[2], ll[3]}; *(LAS f32x4*)(CUM + pp * 64 + 8 * cg8 + 4) = (f32x4){ll[4], ll[5], ll[6], ll[7]}; }
        for (int i = F.tid; i < 2 * SLOTB / 4; i += NTHREADS) ((LAS unsigned*)(F.lds + 9 * SLOTB))[i] = 0u;
        __syncthreads();
        { const int ch = F.tid & 63, seg = F.tid >> 6; float run = 0.f;
#pragma unroll
          for (int i = 0; i < 8; ++i) { run += CUM[(8 * seg + i) * 64 + ch]; CUM[(8 * seg + i) * 64 + ch] = run; }
          TOT[seg * 64 + ch] = run; }
        __syncthreads();
        { const int ch = F.tid & 63, seg = F.tid >> 6; float off = 0.f;
          for (int s2 = 0; s2 < seg; ++s2) off += TOT[s2 * 64 + ch];
#pragma unroll
          for (int i = 0; i < 8; ++i) CUM[(8 * seg + i) * 64 + ch] += off;
          if (seg == 7) GC[ch] = off + TOT[7 * 64 + ch]; }
        __syncthreads();
        { float g[8], gc[8];
          { const f32x4 g0 = *(const LAS f32x4*)(CUM + pp * 64 + 8 * cg8), g1 = *(const LAS f32x4*)(CUM + pp * 64 + 8 * cg8 + 4);
            const f32x4 c0v = *(const LAS f32x4*)(GC + 8 * cg8), c1v = *(const LAS f32x4*)(GC + 8 * cg8 + 4);
#pragma unroll
            for (int j = 0; j < 4; ++j) { g[j] = g0[j]; g[4 + j] = g1[j]; gc[j] = c0v[j]; gc[4 + j] = c1v[j]; } }
          float kkg[8], rg[8], ki[8], kai[8], kd[8], kad[8];
#pragma unroll
          for (int j = 0; j < 8; ++j) { const float eg = __expf(g[j]), egp = __expf(g[j] - ll[j]), eng = __expf(-g[j]), ecg = __expf(gc[j] - g[j]);
              kkg[j] = kk[j] * egp; rg[j] = rr[j] * eg; ki[j] = km[j] * eng; kai[j] = ka[j] * eng; kd[j] = km[j] * ecg; kad[j] = ka[j] * ecg; }
          u32x4 w4;
          w4 = (u32x4){pk2(kkg[0], kkg[1]), pk2(kkg[2], kkg[3]), pk2(kkg[4], kkg[5]), pk2(kkg[6], kkg[7])}; *(LAS u32x4*)(SL[0] + pp * LDP + 8 * cg8) = w4;
          w4 = (u32x4){pk2(rg[0], rg[1]), pk2(rg[2], rg[3]), pk2(rg[4], rg[5]), pk2(rg[6], rg[7])}; *(LAS u32x4*)(SL[1] + pp * LDP + 8 * cg8) = w4;
          w4 = (u32x4){pk2(ki[0], ki[1]), pk2(ki[2], ki[3]), pk2(ki[4], ki[5]), pk2(ki[6], ki[7])}; *(LAS u32x4*)(SL[2] + pp * LDP + 8 * cg8) = w4;
          w4 = (u32x4){pk2(kai[0], kai[1]), pk2(kai[2], kai[3]), pk2(kai[4], kai[5]), pk2(kai[6], kai[7])}; *(LAS u32x4*)(SL[3] + pp * LDP + 8 * cg8) = w4;
#pragma unroll
          for (int j = 0; j < 8; ++j) { const int ch = 8 * cg8 + j;
              SL[4][ch * LDP + pp] = (bf16_t)f2bf(kkg[j]); SL[5][ch * LDP + pp] = (bf16_t)f2bf(vv[j]); SL[6][ch * LDP + pp] = (bf16_t)f2bf(kd[j]); SL[7][ch * LDP + pp] = (bf16_t)f2bf(kad[j]); } }
        __syncthreads();
        { f32x4 aAk[2], aAa[2], aBk[2], aBa[2]; zero2(aAk); zero2(aAa); zero2(aBk); zero2(aBa);
          mm64(aAk, SL[2], SL[0], r0, c0, fr, fq);
          mm64(aAa, SL[0], SL[3], r0, c0, fr, fq);
          mm64(aBk, SL[2], SL[1], r0, c0, fr, fq);
          mm64(aBa, SL[3], SL[1], r0, c0, fr, fq);
          __syncthreads();
          const int tcol = c0 + fr;
#pragma unroll
          for (int m = 0; m < 2; ++m)
#pragma unroll
              for (int i = 0; i < 4; ++i) { const int jr = r0 + 16 * m + 4 * fq + i;
                  aAk[m][i] = jr < tcol ? aAk[m][i] : 0.f; aBk[m][i] = jr <= tcol ? aBk[m][i] : 0.f; aBa[m][i] = jr <= tcol ? aBa[m][i] : 0.f; }
          writeT(SL[0], aAk, r0, c0, fr, fq); writeT(SL[8], aBk, r0, c0, fr, fq); writeT(SL[2], aBa, r0, c0, fr, fq);
          const int jb = w & 3;
#pragma unroll
          for (int m = 0; m < 2; ++m) { const int tb = 2 * (w >> 2) + m;
              if (tb == jb) {
#pragma unroll
                  for (int i = 0; i < 4; ++i) ADIAG[tb * 256 + (4 * fq + i) * 16 + fr] = (fr < 4 * fq + i) ? aAa[m][i] : 0.f; }
#pragma unroll
              for (int i = 0; i < 4; ++i) aAa[m][i] = tb > jb ? aAa[m][i] : 0.f; }
          writeT(SL[3], aAa, r0, c0, fr, fq);
        }
        __syncthreads();
        if (F.tid < 64) { const int blk = F.tid >> 4, c = F.tid & 15; const LAS float* A = ADIAG + blk * 256; float x[16];
#pragma unroll
            for (int r = 0; r < 16; ++r) { float sa = (r == c) ? 1.f : 0.f;
#pragma unroll
                for (int j = 0; j < r; ++j) sa -= A[r * 16 + j] * x[j];
                x[r] = sa; }
#pragma unroll
            for (int r = 0; r < 16; ++r) SL[9][(16 * blk + r) * LDP + 16 * blk + c] = (bf16_t)f2bf(x[r]);
            u32x4 lo = (u32x4){pk2(x[0], x[1]), pk2(x[2], x[3]), pk2(x[4], x[5]), pk2(x[6], x[7])}, hi = (u32x4){pk2(x[8], x[9]), pk2(x[10], x[11]), pk2(x[12], x[13]), pk2(x[14], x[15])};
            *(LAS u32x4*)(SL[10] + (16 * blk + c) * LDP + 16 * blk) = lo; *(LAS u32x4*)(SL[10] + (16 * blk + c) * LDP + 16 * blk + 8) = hi; }
        __syncthreads();
        f32x4 a1[2], a2[2], a3[2];
        zero2(a1); mm64(a1, SL[3], SL[9], r0, c0, fr, fq);
        __syncthreads();
        writeT(SL[11], a1, r0, c0, fr, fq);
        writeN(SL[3], a1, r0, c0, fr, fq);
        __syncthreads();
        zero2(a2); mm64(a2, SL[11], SL[3], r0, c0, fr, fq);
#pragma unroll
        for (int m = 0; m < 2; ++m)
#pragma unroll
            for (int i = 0; i < 4; ++i) a2[m][i] += (r0 + 16 * m + 4 * fq + i == c0 + fr) ? 1.f : 0.f;
        writeT(SL[9], a2, r0, c0, fr, fq);
        __syncthreads();
        zero2(a3); mm64(a3, SL[11], SL[9], r0, c0, fr, fq);
        a3[0] = a2[0] - a3[0]; a3[1] = a2[1] - a3[1];
        writeN(SL[3], a3, r0, c0, fr, fq);
        __syncthreads();
        zero2(a1); mm64(a1, SL[3], SL[10], r0, c0, fr, fq);
        zero2(a2); mm64(a2, SL[0], SL[5], r0, c0, fr, fq);
        writeN(SL[9], a1, r0, c0, fr, fq); writeT(SL[11], a2, r0, c0, fr, fq);
        __syncthreads();
        zero2(a1); mm64(a1, SL[9], SL[4], r0, c0, fr, fq);
        zero2(a2); mm64(a2, SL[9], SL[11], r0, c0, fr, fq);
        writeT(SL[3], a1, r0, c0, fr, fq); writeT(SL[10], a2, r0, c0, fr, fq);
        __syncthreads();
        unsigned char* ob = OPS + ((size_t)(d * 32 + chain) * 132 + pc) * 32768;
        const int fragoff = (((w & 3) * 2 + (w >> 2)) * 64 + F.lane) * 16;
        {
          zero2(a1); mm64(a1, SL[3], SL[2], r0, c0, fr, fq);
          u32x4 o;
#pragma unroll
          for (int m = 0; m < 2; ++m) { const u32x2 rgv = *(const LAS u32x2*)(SL[1] + (c0 + fr) * LDP + r0 + 16 * m + 4 * fq);
              const float q0 = bflo(rgv.x) - a1[m][0], q1 = bfhi(rgv.x) - a1[m][1], q2 = bflo(rgv.y) - a1[m][2], q3 = bfhi(rgv.y) - a1[m][3];
              o[2 * m] = pk2(q0, q1); o[2 * m + 1] = pk2(q2, q3); }
          *(u32x4*)(ob + fragoff) = o; }
        {
          zero2(a1); mm64(a1, SL[3], SL[7], r0, c0, fr, fq);
          const float gcv = __expf(GC[c0 + fr]); u32x4 o;
#pragma unroll
          for (int m = 0; m < 2; ++m) { float q[4];
#pragma unroll
              for (int i = 0; i < 4; ++i) q[i] = ((r0 + 16 * m + 4 * fq + i == c0 + fr) ? gcv : 0.f) - a1[m][i];
              o[2 * m] = pk2(q[0], q[1]); o[2 * m + 1] = pk2(q[2], q[3]); }
          *(u32x4*)(ob + 8192 + fragoff) = o; }
        {
          zero2(a1); mm64(a1, SL[8], SL[5], r0, c0, fr, fq); zero2(a2); mm64(a2, SL[2], SL[10], r0, c0, fr, fq);
#pragma unroll
          for (int m = 0; m < 2; ++m) { const f32x4 q = a1[m] - a2[m]; u32x2 o; o.x = pk2(q[0], q[1]); o.y = pk2(q[2], q[3]);
              *(u32x2*)(ob + 16384 + (((w & 3) * 4 + 2 * (w >> 2) + m) * 64 + F.lane) * 8) = o; } }
        {
          zero2(a1); mm64(a1, SL[6], SL[5], r0, c0, fr, fq); zero2(a2); mm64(a2, SL[7], SL[10], r0, c0, fr, fq);
#pragma unroll
          for (int m = 0; m < 2; ++m) { const f32x4 q = a1[m] - a2[m]; u32x2 o; o.x = pk2(q[0], q[1]); o.y = pk2(q[2], q[3]);
              *(u32x2*)(ob + 24576 + (((w & 3) * 4 + 2 * (w >> 2) + m) * 64 + F.lane) * 8) = o; } }
        unit = unit_next;
    }
}


typedef short s16x4v __attribute__((ext_vector_type(4)));
DI f32x4 mfma16(s16x4v a, s16x4v b, f32x4 c) { return __builtin_amdgcn_mfma_f32_16x16x16bf16_1k(a, b, c, 0, 0, 0); }
DI s16x4v pack4(const f32x4& v) { u32x2 t; t.x = pk2(v[0], v[1]); t.y = pk2(v[2], v[3]); return __builtin_bit_cast(s16x4v, t); }
DI void slab64(f32x4 (&acc)[4], const LAS bf16_t* P, const LAS bf16_t* Q, int s4, int fr, int fq) {
#pragma unroll
    for (int s2 = 0; s2 < 2; ++s2) { const bf16x8 b = *(const LAS bf16x8*)(Q + (16 * s4 + fr) * LDP + 32 * s2 + 8 * fq);
#pragma unroll
        for (int m = 0; m < 4; ++m) { const bf16x8 a = *(const LAS bf16x8*)(P + (16 * m + fr) * LDP + 32 * s2 + 8 * fq);
            acc[m] = __builtin_amdgcn_mfma_f32_16x16x32_bf16(a, b, acc[m], 0, 0, 0); } }
}
constexpr int C2_NORM = 12 * SLOTB, C2_GC = C2_NORM + 4096, C2_ADIAG = C2_GC + 512, C2_DINV = C2_ADIAG + 4096;
static_assert(C2_DINV + 2048 <= LDS_MISC, "chunkprep2 LDS");
DI void phase_chunkprep2(const Params& p, const Ctx& F) {
    const bf16_t* Kc = (const bf16_t*)(p.ws + WS_KC); const bf16_t* Vc = (const bf16_t*)(p.ws + WS_VC); const bf16_t* Rc = (const bf16_t*)(p.ws + WS_RC);
    unsigned char* OPS = p.ws + WS_OPS;
    LAS bf16_t* SL[12];
#pragma unroll
    for (int i = 0; i < 12; ++i) SL[i] = (LAS bf16_t*)(F.lds + i * SLOTB);
    LAS float* ADIAG = (LAS float*)(F.lds + C2_ADIAG); LAS bf16_t* DINV = (LAS bf16_t*)(F.lds + C2_DINV);
    const int w = F.wave, s4 = w & 3, g2 = w >> 2;
    const bool fixedmap = (F.G == 256);
    auto unit_of = [&](int i) -> int { if (fixedmap) return i < 33 ? (F.bid >> 2) * 132 + (F.bid & 3) * 33 + i : -1; const int u = F.bid + i * F.G; return u < 2 * 32 * 132 ? u : -1; };
    struct RawLd { u32x4 kq, vq, rq, aq, lq; };
    auto raw_issue = [&](RawLd& R, int unit, int lane) { const int d = unit / (32 * 132), chain = (unit / 132) & 31, pc = unit % 132, b = chain >> 3, h = chain & 7;
        const size_t o = chunk_row(d, b, pc, lane) * 512 + 64 * h + 8 * w;
        R.kq = *(const u32x4*)(Kc + o); R.vq = *(const u32x4*)(Vc + o); R.rq = *(const u32x4*)(Rc + o);
        R.aq = *(const u32x4*)((const bf16_t*)(p.ws + (d ? WS_A1 : WS_A0)) + o); R.lq = *(const u32x4*)((const bf16_t*)(p.ws + (d ? WS_L1 : WS_L0)) + o); };
    RawLd R;
    float kkw[8], kaw[8]; int hdcur = -1;
    int uix = 0, unit = unit_of(0);
    if (unit >= 0) raw_issue(R, unit, F.lane);
    for (; unit >= 0; ) {
        const int unit_next = unit_of(++uix);
        const int d = unit / (32 * 132), chain = (unit / 132) & 31, pc = unit % 132, h = chain & 7;
        if (d * 8 + h != hdcur) { hdcur = d * 8 + h;
#pragma unroll
            for (int j = 0; j < 8; ++j) { kkw[j] = p.in[I_KK][64 * h + 8 * w + j]; kaw[j] = p.in[I_KA][d * 512 + 64 * h + 8 * w + j]; } }
        int lane = F.lane; asm volatile("" : "+v"(lane));
        const int fr = lane & 15, fq = lane >> 4, pp = lane;
        LAS float* NORM = (LAS float*)(F.lds + C2_NORM) + (uix & 1) * 512; LAS float* GC = (LAS float*)(F.lds + C2_GC) + (uix & 1) * 64;
        float k[8], a[8], rr[8], ll[8], kk[8]; const u32x4 R0v = R.vq;
        { float ss = 0.f;
#pragma unroll
          for (int j = 0; j < 4; ++j) { k[2 * j] = bflo(R.kq[j]); k[2 * j + 1] = bfhi(R.kq[j]); rr[2 * j] = bflo(R.rq[j]); rr[2 * j + 1] = bfhi(R.rq[j]);
              a[2 * j] = bflo(R.aq[j]); a[2 * j + 1] = bfhi(R.aq[j]); ll[2 * j] = bflo(R.lq[j]); ll[2 * j + 1] = bfhi(R.lq[j]); }
          if (unit_next >= 0) raw_issue(R, unit_next, lane);
#pragma unroll
          for (int j = 0; j < 8; ++j) { kk[j] = k[j] * kkw[j]; ss += kk[j] * kk[j]; }
          NORM[w * 64 + pp] = ss; }
        float g[8], gc[8];
#pragma unroll
        for (int j = 0; j < 8; ++j) { g[j] = wave_scan_incl(ll[j]); gc[j] = lane63(g[j]); }
        if (lane == 0) { *(LAS f32x4*)(GC + 8 * w) = (f32x4){__expf(gc[0]), __expf(gc[1]), __expf(gc[2]), __expf(gc[3])}; *(LAS f32x4*)(GC + 8 * w + 4) = (f32x4){__expf(gc[4]), __expf(gc[5]), __expf(gc[6]), __expf(gc[7])}; }
        __syncthreads();
        { float ss = 0.f;
#pragma unroll
          for (int q = 0; q < 8; ++q) ss += NORM[q * 64 + pp];
          const float rn = __builtin_amdgcn_rsqf(fmaxf(ss, 1e-24f));
          float kkg[8], rg[8], ki[8], kai[8];
#pragma unroll
          for (int j = 0; j < 8; ++j) { const float kkn = kk[j] * rn, km = k[j] * (1.f + (a[j] - 1.f) * kaw[j]), kan = kkn * a[j];
              const float eg = __expf(g[j]), egp = __expf(g[j] - ll[j]), eng = __expf(-g[j]);
              kkg[j] = kkn * egp; rg[j] = rr[j] * eg; ki[j] = km * eng; kai[j] = kan * eng; }
          const u32x4 wkkg = (u32x4){pk2(kkg[0], kkg[1]), pk2(kkg[2], kkg[3]), pk2(kkg[4], kkg[5]), pk2(kkg[6], kkg[7])};
          const u32x4 wki = (u32x4){pk2(ki[0], ki[1]), pk2(ki[2], ki[3]), pk2(ki[4], ki[5]), pk2(ki[6], ki[7])};
          const u32x4 wkai = (u32x4){pk2(kai[0], kai[1]), pk2(kai[2], kai[3]), pk2(kai[4], kai[5]), pk2(kai[6], kai[7])};
          *(LAS u32x4*)(SL[0] + pp * LDP + 8 * w) = wkkg;
          *(LAS u32x4*)(SL[1] + pp * LDP + 8 * w) = (u32x4){pk2(rg[0], rg[1]), pk2(rg[2], rg[3]), pk2(rg[4], rg[5]), pk2(rg[6], rg[7])};
          *(LAS u32x4*)(SL[2] + pp * LDP + 8 * w) = wki;
          *(LAS u32x4*)(SL[3] + pp * LDP + 8 * w) = wkai;
#pragma unroll
          for (int j = 0; j < 8; ++j) { const int ch = 8 * w + j;
              SL[4][ch * LDP + pp] = (bf16_t)((j & 1) ? wkkg[j >> 1] >> 16 : wkkg[j >> 1]); SL[5][ch * LDP + pp] = (bf16_t)((j & 1) ? R0v[j >> 1] >> 16 : R0v[j >> 1]);
              SL[6][ch * LDP + pp] = (bf16_t)((j & 1) ? wki[j >> 1] >> 16 : wki[j >> 1]); SL[7][ch * LDP + pp] = (bf16_t)((j & 1) ? wkai[j >> 1] >> 16 : wkai[j >> 1]); } }
        __syncthreads();
        { f32x4 accA[4], accK[4];
#pragma unroll
          for (int m = 0; m < 4; ++m) { accA[m] = (f32x4){0.f, 0.f, 0.f, 0.f}; accK[m] = accA[m]; }
          const LAS bf16_t* Qop = g2 == 0 ? SL[0] : SL[1];
          slab64(accA, SL[3], Qop, s4, fr, fq);
          slab64(accK, SL[2], Qop, s4, fr, fq);
          const int tcol = 16 * s4 + fr;
#pragma unroll
          for (int m = 0; m < 4; ++m) {
              if (m > s4) { accA[m] = (f32x4){0.f, 0.f, 0.f, 0.f}; accK[m] = accA[m]; }
              else if (m == s4) {
#pragma unroll
                  for (int i = 0; i < 4; ++i) { const int jl = 4 * fq + i; const bool keep = g2 == 0 ? jl < fr : jl <= fr; accA[m][i] = keep ? accA[m][i] : 0.f; accK[m][i] = keep ? accK[m][i] : 0.f; } }
              u32x2 wa, wk; wa.x = pk2(accA[m][0], accA[m][1]); wa.y = pk2(accA[m][2], accA[m][3]); wk.x = pk2(accK[m][0], accK[m][1]); wk.y = pk2(accK[m][2], accK[m][3]);
              *(LAS u32x2*)((g2 == 0 ? SL[9] : SL[8]) + tcol * LDP + 16 * m + 4 * fq) = wa;
              *(LAS u32x2*)((g2 == 0 ? SL[10] : SL[11]) + tcol * LDP + 16 * m + 4 * fq) = wk;
              if (g2 == 0 && m == s4) {
#pragma unroll
                  for (int i = 0; i < 4; ++i) ADIAG[s4 * 256 + fr * 16 + 4 * fq + i] = accA[m][i]; } } }
        __syncthreads();
        if (F.tid < 64) { const int blk = F.tid >> 4, c = F.tid & 15; const LAS float* A = ADIAG + blk * 256; float x[16];
            f32x4 Ar[16][4];
#pragma unroll
            for (int r = 1; r < 16; ++r)
#pragma unroll
                for (int q = 0; q < 4; ++q) if (4 * q < r) Ar[r][q] = *(const LAS f32x4*)(A + r * 16 + 4 * q);
#pragma unroll
            for (int r = 0; r < 16; ++r) { float sa = (r == c) ? 1.f : 0.f;
#pragma unroll
                for (int j = 0; j < r; ++j) sa -= Ar[r][j >> 2][j & 3] * x[j];
                x[r] = sa; }
#pragma unroll
            for (int r = 0; r < 16; ++r) DINV[(blk * 16 + r) * 16 + c] = (bf16_t)f2bf(x[r]); }
        f32x4 X[4];
        if (g2 == 0) {
#pragma unroll
            for (int m = 0; m < 4; ++m) { const u32x2 v2 = *(const LAS u32x2*)(SL[4] + (16 * s4 + fr) * LDP + 16 * m + 4 * fq); X[m] = (f32x4){bflo(v2.x), bfhi(v2.x), bflo(v2.y), bfhi(v2.y)}; }
        } else {
#pragma unroll
            for (int m = 0; m < 4; ++m) X[m] = (f32x4){0.f, 0.f, 0.f, 0.f};
            slab64(X, SL[10], SL[5], s4, fr, fq);
        }
        __syncthreads();
        s16x4v xb[4];
#pragma unroll
        for (int bi = 0; bi < 4; ++bi) {
            f32x4 sacc = (f32x4){0.f, 0.f, 0.f, 0.f};
#pragma unroll
            for (int bj = 0; bj < bi; ++bj) { const s16x4v af = *(const LAS s16x4v*)(SL[9] + (16 * bi + fr) * LDP + 16 * bj + 4 * fq); sacc = mfma16(af, xb[bj], sacc); }
            const f32x4 rhs = X[bi] - sacc;
            const s16x4v df = *(const LAS s16x4v*)(DINV + (bi * 16 + fr) * 16 + 4 * fq);
            X[bi] = mfma16(df, pack4(rhs), (f32x4){0.f, 0.f, 0.f, 0.f});
            xb[bi] = pack4(X[bi]);
        }
        unsigned char* ob = OPS + (size_t)unit * 32768;
        if (g2 == 0) {
#pragma unroll
            for (int mt = 0; mt < 4; ++mt) {
                f32x4 aq = (f32x4){0.f, 0.f, 0.f, 0.f}, am = aq;
#pragma unroll
                for (int kb = 0; kb < 4; ++kb) { const s16x4v bq = *(const LAS s16x4v*)(SL[8] + (16 * mt + fr) * LDP + 16 * kb + 4 * fq);
                    const s16x4v bm = *(const LAS s16x4v*)(SL[7] + (16 * mt + fr) * LDP + 16 * kb + 4 * fq);
                    aq = mfma16(xb[kb], bq, aq); am = mfma16(xb[kb], bm, am); }
                const u32x2 rgv = *(const LAS u32x2*)(SL[1] + (16 * mt + fr) * LDP + 16 * s4 + 4 * fq);
                u32x2 oq; oq.x = pk2(bflo(rgv.x) - aq[0], bfhi(rgv.x) - aq[1]); oq.y = pk2(bflo(rgv.y) - aq[2], bfhi(rgv.y) - aq[3]);
                *(u32x2*)(ob + ((mt * 2 + (s4 >> 1)) * 64 + lane) * 16 + (s4 & 1) * 8) = oq;
                const float egc = GC[16 * mt + fr]; float mv[4];
#pragma unroll
                for (int i = 0; i < 4; ++i) mv[i] = egc * (((16 * s4 + 4 * fq + i) == (16 * mt + fr) ? 1.f : 0.f) - am[i]);
                u32x2 om; om.x = pk2(mv[0], mv[1]); om.y = pk2(mv[2], mv[3]);
                *(u32x2*)(ob + 8192 + ((mt * 2 + (s4 >> 1)) * 64 + lane) * 16 + (s4 & 1) * 8) = om;
            }
        } else {
            f32x4 y1[4], b1[4];
#pragma unroll
            for (int m = 0; m < 4; ++m) { y1[m] = (f32x4){0.f, 0.f, 0.f, 0.f}; b1[m] = y1[m]; }
            slab64(y1, SL[11], SL[5], s4, fr, fq);
            slab64(b1, SL[6], SL[5], s4, fr, fq);
#pragma unroll
            for (int m = 0; m < 4; ++m) {
                f32x4 y2 = (f32x4){0.f, 0.f, 0.f, 0.f}, b2 = y2;
#pragma unroll
                for (int kb = 0; kb < 4; ++kb) { const s16x4v ay = *(const LAS s16x4v*)(SL[8] + (16 * m + fr) * LDP + 16 * kb + 4 * fq);
                    const s16x4v ab = *(const LAS s16x4v*)(SL[7] + (16 * m + fr) * LDP + 16 * kb + 4 * fq);
                    y2 = mfma16(ay, xb[kb], y2); b2 = mfma16(ab, xb[kb], b2); }
                const f32x4 yv = y1[m] - y2; u32x2 oy; oy.x = pk2(yv[0], yv[1]); oy.y = pk2(yv[2], yv[3]);
                *(u32x2*)(ob + 16384 + ((s4 * 4 + m) * 64 + lane) * 8) = oy;
                const f32x4 gcv = *(const LAS f32x4*)(GC + 16 * m + 4 * fq);
                const f32x4 bv = (b1[m] - b2) * gcv; u32x2 obc; obc.x = pk2(bv[0], bv[1]); obc.y = pk2(bv[2], bv[3]);
                *(u32x2*)(ob + 24576 + ((s4 * 4 + m) * 64 + lane) * 8) = obc;
            }
        }
        unit = unit_next;
    }
}

constexpr int SC_SLOT = 10240, SC_NSLOT = 8, SC_TILE = SC_NSLOT * SC_SLOT, CV_TP = 264;
static_assert(SC_TILE + 64 * CV_TP * 2 <= LDS_MISC, "scan ring + conversion tile");
DI void scan_issue(const unsigned char* st, LAS unsigned char* slot, int w4, int wave, int lane) {
    if (wave == 0 || wave > 3) return;
#pragma unroll
    for (int i = 0; i < 4; ++i) { const int f = wave - 1 + 3 * i;
        if (f < 10) { const unsigned char* src = f < 8 ? st + 8192 + f * 1024 : st + 24576 + w4 * 2048 + (f - 8) * 1024;
            __builtin_amdgcn_global_load_lds((const unsigned*)(src + lane * 16), (LAS unsigned*)(slot + f * 1024), 16, 0, 0); } }
}
struct CvTile { const float* src; bf16_t* dst; int ldn, ldk, k0, n0, rowmap; bool ok; };
DI CvTile cv_tile(const Params& p, int it) {
    CvTile t; t.ok = it < 32 * 2 * 16 + 32 * 16; t.n0 = 0;
    if (it < 1024) { const int e = it >> 5, up = (it >> 4) & 1, kt = it & 15; t.src = (up ? p.in[I_WU] : p.in[I_WG]) + (size_t)e * 1024 * 256 + (size_t)kt * 64 * 256; t.ldn = 256;
        t.dst = (bf16_t*)(p.ws + WS_WGUT) + (size_t)e * 512 * 1024; t.ldk = 1024; t.k0 = kt * 64; t.rowmap = 1 + up; }
    else { const int r = (it - 1024) & 511, e = r >> 4, kt = (r >> 2) & 3, ntl = r & 3; t.src = p.in[I_WD] + (size_t)e * 256 * 1024 + (size_t)kt * 64 * 1024 + ntl * 256; t.ldn = 1024;
        t.dst = (bf16_t*)(p.ws + WS_WDT) + (size_t)e * 1024 * 256; t.ldk = 256; t.k0 = kt * 64; t.rowmap = 0; t.n0 = ntl * 256; }
    return t;
}
DI void phase_scan_chunk(const Params& p, const Ctx& F) {
    unsigned char* OPS = p.ws + WS_OPS;
    LAS unsigned char* ring = F.lds; LAS bf16_t* tile = (LAS bf16_t*)(F.lds + SC_TILE);
    const bool fused_cv = (F.G == 256);
    for (int item = F.bid; item < 256; item += F.G) {
        const int xq = item & 7, yq = item >> 3, w4 = yq & 3, chainid = xq + 8 * (yq >> 2);
        unsigned char* ops = OPS + (size_t)chainid * 132 * 32768;
        f32x4 H[4];
#pragma unroll
        for (int m = 0; m < 4; ++m) H[m] = (f32x4){0.f, 0.f, 0.f, 0.f};
        f32x4 cvr[8];
#pragma unroll
        for (int i = 0; i < 8; ++i) cvr[i] = (f32x4){0.f, 0.f, 0.f, 0.f};
        __syncthreads();
#pragma unroll
        for (int i = 0; i < SC_NSLOT - 1; ++i) scan_issue(ops + (size_t)i * 32768, ring + i * SC_SLOT, w4, F.wave, F.lane);
        auto scan_step = [&](int pc) {
            if (F.wave == 1) asm volatile("s_waitcnt vmcnt(24)" ::: "memory"); else if (F.wave == 2 || F.wave == 3) asm volatile("s_waitcnt vmcnt(18)" ::: "memory");
            __builtin_amdgcn_s_barrier();
            const LAS unsigned char* slot = ring + (pc % SC_NSLOT) * SC_SLOT;
            { const int nx = pc + SC_NSLOT - 1 < 132 ? pc + SC_NSLOT - 1 : 131;
              scan_issue(ops + (size_t)nx * 32768, ring + ((pc + SC_NSLOT - 1) % SC_NSLOT) * SC_SLOT, w4, F.wave, F.lane); }
            if (F.wave == 0) {
                bf16x8 ma[4][2]; u32x2 bc[4];
#pragma unroll
                for (int m = 0; m < 4; ++m) {
#pragma unroll
                    for (int s2 = 0; s2 < 2; ++s2) ma[m][s2] = *(const LAS bf16x8*)(slot + ((m * 2 + s2) * 64 + F.lane) * 16);
                    bc[m] = *(const LAS u32x2*)(slot + 8192 + (m * 64 + F.lane) * 8); }
                asm volatile("s_waitcnt lgkmcnt(0)" ::: "memory");
                bf16x8 hb[2];
#pragma unroll
                for (int s2 = 0; s2 < 2; ++s2) { u32x4 t; t.x = pk2(H[2 * s2][0], H[2 * s2][1]); t.y = pk2(H[2 * s2][2], H[2 * s2][3]); t.z = pk2(H[2 * s2 + 1][0], H[2 * s2 + 1][1]); t.w = pk2(H[2 * s2 + 1][2], H[2 * s2 + 1][3]);
                    hb[s2] = __builtin_bit_cast(bf16x8, t); }
                if (pc >= 4) {
#pragma unroll
                    for (int s2 = 0; s2 < 2; ++s2) *(bf16x8*)(ops + (size_t)pc * 32768 + 24576 + w4 * 2048 + (s2 * 64 + F.lane) * 16) = hb[s2]; }
#pragma unroll
                for (int m = 0; m < 4; ++m) {
                    f32x4 hn = (f32x4){bflo(bc[m].x), bfhi(bc[m].x), bflo(bc[m].y), bfhi(bc[m].y)};
#pragma unroll
                    for (int s2 = 0; s2 < 2; ++s2) hn = __builtin_amdgcn_mfma_f32_16x16x32_bf16(ma[m][s2], hb[s2], hn, 0, 0, 0);
                    H[m] = hn;
                }
            }
        };
#pragma unroll 1
        for (int pc4 = 0; pc4 < 132; pc4 += 4) {
            const CvTile T = cv_tile(p, item + 256 * (pc4 / 4));
            const bool cvon = fused_cv && F.wave >= 4 && T.ok;
            const int r0 = 16 * (F.wave - 4);
            scan_step(pc4);
            if (cvon) {
#pragma unroll
                for (int i = 0; i < 8; ++i) cvr[i] = *(const f32x4*)(T.src + (size_t)(r0 + i) * T.ldn + 4 * F.lane); }
            scan_step(pc4 + 1);
            if (cvon) {
#pragma unroll
                for (int i = 0; i < 8; ++i) { u32x2 o; o.x = pk2(cvr[i][0], cvr[i][1]); o.y = pk2(cvr[i][2], cvr[i][3]); *(LAS u32x2*)(tile + (r0 + i) * CV_TP + 4 * F.lane) = o; }
#pragma unroll
                for (int i = 0; i < 8; ++i) cvr[i] = *(const f32x4*)(T.src + (size_t)(r0 + 8 + i) * T.ldn + 4 * F.lane); }
            scan_step(pc4 + 2);
            if (cvon) {
#pragma unroll
                for (int i = 0; i < 8; ++i) { u32x2 o; o.x = pk2(cvr[i][0], cvr[i][1]); o.y = pk2(cvr[i][2], cvr[i][3]); *(LAS u32x2*)(tile + (r0 + 8 + i) * CV_TP + 4 * F.lane) = o; } }
            scan_step(pc4 + 3);
            if (cvon) {
                const int n = F.tid - 256;
                const int drow = T.rowmap == 0 ? T.n0 + n : ((n >> 7) * 256 + (n & 127) + (T.rowmap == 2 ? 128 : 0));
                bf16_t* dp = T.dst + (size_t)drow * T.ldk + T.k0;
#pragma unroll
                for (int q = 0; q < 8; ++q) { unsigned wds[4];
#pragma unroll
                    for (int jj = 0; jj < 4; ++jj) { const int k = 8 * q + 2 * jj; wds[jj] = (unsigned)tile[k * CV_TP + n] | ((unsigned)tile[(k + 1) * CV_TP + n] << 16); }
                    *(u32x4*)(dp + 8 * q) = (u32x4){wds[0], wds[1], wds[2], wds[3]}; } }
        }
        asm volatile("s_waitcnt vmcnt(0)" ::: "memory");
    }
}

DI void phase_post2(const Params& p, const Ctx& F) {
    const unsigned char* OPS = p.ws + WS_OPS;
    const bf16_t* GATE = (const bf16_t*)((unsigned char*)p.out + DO_GATE); const bf16_t* BV = (const bf16_t*)((unsigned char*)p.out + DO_BV);
    bf16_t* MIXED = (bf16_t*)((unsigned char*)p.out + DO_MIXED);
    constexpr int LDY = 68;
    const int fr = F.lane & 15, fq = F.lane >> 4, w4 = F.wave & 3, dd = F.wave >> 2, tk = F.tid >> 3, cg8 = F.tid & 7;
    constexpr int NU = 4 * 128 * 8;
    struct PLd { bf16x8 qa[4][2], hb[2]; u32x2 y0[4]; u32x4 gq, bq; };
    auto issue = [&](PLd& L, int unit) { const int h = unit & 7, j = (unit >> 3) & 127, b = unit >> 10, chain = b * 8 + h;
        const unsigned char* ops = OPS + ((size_t)(dd * 32 + chain) * 132 + 4 + (dd ? 127 - j : j)) * 32768;
#pragma unroll
        for (int m = 0; m < 4; ++m) {
#pragma unroll
            for (int s2 = 0; s2 < 2; ++s2) L.qa[m][s2] = *(const bf16x8*)(ops + ((m * 2 + s2) * 64 + F.lane) * 16);
            L.y0[m] = *(const u32x2*)(ops + 16384 + ((w4 * 4 + m) * 64 + F.lane) * 8); }
#pragma unroll
        for (int s2 = 0; s2 < 2; ++s2) L.hb[s2] = *(const bf16x8*)(ops + 24576 + w4 * 2048 + (s2 * 64 + F.lane) * 16);
        const size_t o = ((size_t)b * SEQ + 64 * j + tk) * 512 + 64 * h + 8 * cg8;
        L.gq = *(const u32x4*)(GATE + o); L.bq = *(const u32x4*)(BV + o); };
    PLd L;
    if (F.bid < NU) issue(L, F.bid);
    int par = 0;
    for (int unit = F.bid; unit < NU; unit += F.G, par ^= 1) {
        const int h = unit & 7, j = (unit >> 3) & 127, b = unit >> 10;
        LAS float* ys = (LAS float*)F.lds + par * 64 * LDY;
        f32x4 y[4];
#pragma unroll
        for (int m = 0; m < 4; ++m) { y[m] = (f32x4){bflo(L.y0[m].x), bfhi(L.y0[m].x), bflo(L.y0[m].y), bfhi(L.y0[m].y)};
#pragma unroll
            for (int s2 = 0; s2 < 2; ++s2) y[m] = __builtin_amdgcn_mfma_f32_16x16x32_bf16(L.qa[m][s2], L.hb[s2], y[m], 0, 0, 0); }
        const u32x4 gq = L.gq, bq = L.bq;
        if (unit + F.G < NU) issue(L, unit + F.G);
        const int n = 16 * w4 + fr;
        if (dd == 0) {
#pragma unroll
            for (int m = 0; m < 4; ++m) { const int t0 = 16 * m + 4 * fq;
#pragma unroll
                for (int i = 0; i < 4; ++i) ys[(t0 + i) * LDY + n] = y[m][i]; } }
        __syncthreads();
        if (dd == 1) {
#pragma unroll
            for (int m = 0; m < 4; ++m) { const int t0 = 16 * m + 4 * fq;
#pragma unroll
                for (int i = 0; i < 4; ++i) ys[(63 - t0 - i) * LDY + n] += y[m][i]; } }
        __syncthreads();
        { const size_t row = (size_t)b * SEQ + 64 * j + tk;
          const f32x4 ya = *(const LAS f32x4*)(ys + tk * LDY + 8 * cg8), yb = *(const LAS f32x4*)(ys + tk * LDY + 8 * cg8 + 4);
          float yv[8] = {ya[0], ya[1], ya[2], ya[3], yb[0], yb[1], yb[2], yb[3]};
          float s1 = 0.f;
#pragma unroll
          for (int i = 0; i < 8; ++i) s1 += yv[i];
          s1 += __shfl_xor(s1, 1); s1 += __shfl_xor(s1, 2); s1 += __shfl_xor(s1, 4);
          const float mu = s1 * (1.f / 64.f); float s2 = 0.f;
#pragma unroll
          for (int i = 0; i < 8; ++i) { yv[i] -= mu; s2 += yv[i] * yv[i]; }
          s2 += __shfl_xor(s2, 1); s2 += __shfl_xor(s2, 2); s2 += __shfl_xor(s2, 4);
          const float rstd = __builtin_amdgcn_rsqf(s2 * (1.f / 64.f) + 64e-5f);
          const f32x4 lg0 = *(const f32x4*)(p.in[I_LNXG] + 64 * h + 8 * cg8), lg1 = *(const f32x4*)(p.in[I_LNXG] + 64 * h + 8 * cg8 + 4), lb0 = *(const f32x4*)(p.in[I_LNXB] + 64 * h + 8 * cg8), lb1 = *(const f32x4*)(p.in[I_LNXB] + 64 * h + 8 * cg8 + 4);
          float ov[8];
#pragma unroll
          for (int i = 0; i < 8; ++i) { const float yn = yv[i] * rstd * (i < 4 ? lg0[i & 3] : lg1[i & 3]) + (i < 4 ? lb0[i & 3] : lb1[i & 3]);
              const float gt = (i & 1) ? bfhi(gq[i >> 1]) : bflo(gq[i >> 1]), bb = (i & 1) ? bfhi(bq[i >> 1]) : bflo(bq[i >> 1]);
              ov[i] = (yn + bb) * gt; }
          u32x4 ow = (u32x4){pk2(ov[0], ov[1]), pk2(ov[2], ov[3]), pk2(ov[4], ov[5]), pk2(ov[6], ov[7])};
          *(u32x4*)(MIXED + row * D + 512 + 64 * h + 8 * cg8) = ow; }
    }
}

DI void phase_post(const Params& p, const Ctx& F) {
    const float* YS = (const float*)(p.ws + WS_YS);
    const bf16_t* GATE = (const bf16_t*)((unsigned char*)p.out + DO_GATE); const bf16_t* BV = (const bf16_t*)((unsigned char*)p.out + DO_BV);
    bf16_t* MIXED = (bf16_t*)((unsigned char*)p.out + DO_MIXED);
    const int t = F.tid; const float lg = p.in[I_LNXG][t], lb = p.in[I_LNXB][t];
    for (int row = F.bid; row < NT; row += F.G) {
        const size_t o = (size_t)row * 512 + t;
        const float y = YS[o] + YS[(size_t)NT * 512 + o];
        const float mu = wave_sum(y) * (1.f / 64.f); const float dd = y - mu; const float var = wave_sum(dd * dd) * (1.f / 64.f);
        const float yn = dd * (1.f / sqrtf(var + 64e-5f)) * lg + lb;
        const float ob = (yn + bf2f(BV[o])) * bf2f(GATE[o]);
        MIXED[(size_t)row * D + 512 + t] = (bf16_t)f2bf(ob);
    }
}

DI void phase_gemm2(const Params& p, const Ctx& F) {
    pg8::StaticOrder S; S.init((unsigned char*)p.out + DO_MIXED, p.ws + WS_WOUTT, NT, 1024, 1024, F.G, F.bid);
    pg8::EpiBf16 E{(bf16_t*)(p.ws + WS_Y), 1024, false};
    pg8::gemm_phase<pg8::EpiBf16, pg8::StaticOrder, false>(F.lds, 1024, S, E);
}

DI void phase_route(const Params& p, const Ctx& F, const bool dry = false) {
    LAS float* wr_ = (LAS float*)F.lds;
    for (int i = F.tid; i < 4 * 1024; i += NTHREADS) wr_[(i & 3) * 1024 + (i >> 2)] = p.in[I_WRG][i];
    for (int i = F.tid; i < 32 * 1024; i += NTHREADS) wr_[(4 + (i & 31)) * 1024 + (i >> 5)] = p.in[I_WRE][i];
    __syncthreads();
    const float* mod = (const float*)(p.ws + WS_MOD); const bf16_t* Y = (const bf16_t*)(p.ws + WS_Y);
    bf16_t* H2 = (bf16_t*)(p.ws + WS_H2); int* cnt = (int*)(p.ws + WS_CTL); int* perm = (int*)(p.ws + WS_PERM); float* ew = (float*)(p.ws + WS_EW);
    const int gw = F.bid * NWAVES + F.wave, NGW = F.G * NWAVES;
    LAS int* hist = (LAS int*)(F.lds + LDS_MISC + 64); LAS int* basel = (LAS int*)(F.lds + LDS_MISC + 192); LAS int* sel = (LAS int*)(F.lds + LDS_MISC + 320);
    if (F.tid < 32) hist[F.tid] = 0;
    __syncthreads();
    int itn = -1;
    u32x2 nyy[4]; f32x4 nxx[4];
    auto rissue = [&](int row) { const u32x2* yr = (const u32x2*)(Y + (size_t)row * D) + F.lane; const f32x4* xr = (const f32x4*)(p.in[I_X] + (size_t)row * D) + F.lane;
#pragma unroll
        for (int j = 0; j < 4; ++j) { nyy[j] = yr[64 * j]; nxx[j] = xr[64 * j]; } };
    if (gw < NT) rissue(gw);
    for (int row = gw; row < NT; row += NGW) {
        ++itn;
        const int bt = row / SEQ;
        f32x4 v[4], xv[4]; float ss = 0.f;
#pragma unroll
        for (int j = 0; j < 4; ++j) xv[j] = nxx[j];
#pragma unroll
        for (int j = 0; j < 4; ++j) { const u32x2 yy = nyy[j]; v[j] = (f32x4){bflo(yy.x), bfhi(yy.x), bflo(yy.y), bfhi(yy.y)}; ss += (v[j].x * v[j].x + v[j].y * v[j].y) + (v[j].z * v[j].z + v[j].w * v[j].w); }
        if (row + NGW < NT) rissue(row + NGW);
        const float rstd = __builtin_amdgcn_rsqf(wave_sum(ss) * (1.f / D) + 1e-6f);
        float s2 = 0.f;
        f32x4* xo = (f32x4*)(p.out + (size_t)row * D) + F.lane;
#pragma unroll
        for (int j = 0; j < 4; ++j) { const int col = 4 * (F.lane + 64 * j);
            const f32x4 g1 = *(const f32x4*)(mod + bt * 6144 + 2048 + col), gp = *(const f32x4*)(p.in[I_GPOST1] + col);
            v[j] = xv[j] + g1 * (v[j] * rstd * gp);
            xo[64 * j] = v[j];
            s2 += (v[j].x * v[j].x + v[j].y * v[j].y) + (v[j].z * v[j].z + v[j].w * v[j].w); }
        const float rstd2 = __builtin_amdgcn_rsqf(wave_sum(s2) * (1.f / D) + 1e-6f);
        unsigned long long* o8 = (unsigned long long*)(H2 + (size_t)row * D) + F.lane;
#pragma unroll
        for (int j = 0; j < 4; ++j) { const int col = 4 * (F.lane + 64 * j);
            const f32x4 gg = *(const f32x4*)(p.in[I_GPRE2] + col), sh = *(const f32x4*)(mod + bt * 6144 + 3072 + col), sc = *(const f32x4*)(mod + bt * 6144 + 4096 + col);
            v[j] = v[j] * rstd2 * gg * (sc + 1.f) + sh;
            o8[64 * j] = (unsigned long long)pk2(v[j].x, v[j].y) | ((unsigned long long)pk2(v[j].z, v[j].w) << 32); }
        float part[36];
#pragma unroll
        for (int o = 0; o < 36; ++o) { float a = 0.f;
#pragma unroll
            for (int j = 0; j < 4; ++j) { const f32x4 w = *(const LAS f32x4*)(wr_ + o * 1024 + 4 * (F.lane + 64 * j)); a += (v[j].x * w.x + v[j].y * w.y) + (v[j].z * w.z + v[j].w * w.w); }
            part[o] = a; if ((o & 3) == 3) __builtin_amdgcn_sched_barrier(0); }
        float v32[32], v16[16], v8[8], v4[4], v2[2], mylg;
        { const bool b5 = (F.lane & 32) != 0, b4 = (F.lane & 16) != 0, b3 = (F.lane & 8) != 0, b2 = (F.lane & 4) != 0, b1 = (F.lane & 2) != 0, b0 = (F.lane & 1) != 0;
#pragma unroll
          for (int i = 0; i < 32; ++i) { const float lo = part[i], hi = (i < 4) ? part[32 + (i & 3)] : 0.f; const float mine = b5 ? hi : lo, th = b5 ? lo : hi; v32[i] = mine + __shfl_xor(th, 32); }
#pragma unroll
          for (int i = 0; i < 16; ++i) { const float mine = b4 ? v32[16 + i] : v32[i], th = b4 ? v32[i] : v32[16 + i]; v16[i] = mine + __shfl_xor(th, 16); }
#pragma unroll
          for (int i = 0; i < 8; ++i) { const float mine = b3 ? v16[8 + i] : v16[i], th = b3 ? v16[i] : v16[8 + i]; v8[i] = mine + __shfl_xor(th, 8); }
#pragma unroll
          for (int i = 0; i < 4; ++i) { const float mine = b2 ? v8[4 + i] : v8[i], th = b2 ? v8[i] : v8[4 + i]; v4[i] = mine + __shfl_xor(th, 4); }
#pragma unroll
          for (int i = 0; i < 2; ++i) { const float mine = b1 ? v4[2 + i] : v4[i], th = b1 ? v4[i] : v4[2 + i]; v2[i] = mine + __shfl_xor(th, 2); }
          { const float mine = b0 ? v2[1] : v2[0], th = b0 ? v2[0] : v2[1]; mylg = mine + __shfl_xor(th, 1); } }
        mylg += (F.lane < 4) ? p.in[I_BRG][F.lane & 3] : p.in[I_BRE][(F.lane - 4) & 31];
        float gl[4];
#pragma unroll
        for (int j = 0; j < 4; ++j) gl[j] = __shfl(mylg, j);
        int gi = 0; float gm = gl[0];
#pragma unroll
        for (int j = 1; j < 4; ++j) if (gl[j] > gm) { gm = gl[j]; gi = j; }
        float gsum = 0.f;
#pragma unroll
        for (int j = 0; j < 4; ++j) gsum += __expf(gl[j] - gm);
        const float gw_ = 1.f / gsum;
        float el[8];
#pragma unroll
        for (int j = 0; j < 8; ++j) el[j] = __shfl(mylg, 4 + gi * 8 + j);
        int i1 = 0; float m1 = el[0];
#pragma unroll
        for (int j = 1; j < 8; ++j) if (el[j] > m1) { m1 = el[j]; i1 = j; }
        int i2 = 0; float m2 = -3.0e38f;
#pragma unroll
        for (int j = 0; j < 8; ++j) if (j != i1 && el[j] > m2) { m2 = el[j]; i2 = j; }
        const float p2 = __expf(m2 - m1);
        const float w1 = gw_ / (1.f + p2), w2 = gw_ * p2 / (1.f + p2);
        if (F.lane == 0 && !dry) {
            const int e1 = gi * 8 + i1, e2 = gi * 8 + i2;
            if (itn < 16) {
                const int s1 = atomicAdd((int*)(hist + e1), 1), s2 = atomicAdd((int*)(hist + e2), 1);
                sel[(F.wave * 16 + itn) * 2] = (e1 << 16) | s1; sel[(F.wave * 16 + itn) * 2 + 1] = (e2 << 16) | s2;
            } else {
                const int p1 = atomicAdd(&cnt[e1 * 64], 1); perm[(size_t)e1 * NT + p1] = row * 2;
                const int q2 = atomicAdd(&cnt[e2 * 64], 1); perm[(size_t)e2 * NT + q2] = row * 2 + 1;
            }
            ew[row * 2] = w1; ew[row * 2 + 1] = w2;
        }
    }
    if (!dry) {
        __syncthreads();
        if (F.tid < 32) basel[F.tid] = atomicAdd(&cnt[F.tid * 64], (int)hist[F.tid]);
        __syncthreads();
        if (F.tid < 256) { const int wv = F.tid >> 5, it2 = (F.tid >> 1) & 15, sl = F.tid & 1; const int row = F.bid * NWAVES + wv + it2 * NGW;
            if (row < NT) { const int sv = sel[F.tid]; const int e = sv >> 16, ps = sv & 0xffff; perm[(size_t)e * NT + basel[e] + ps] = row * 2 + sl; } }
    }
}

DI void moe_tile_prefix(const Params& p, const Ctx& F, LAS int* tp) {
    __syncthreads();
    if (F.tid == 0) { const int* cnt = (const int*)(p.ws + WS_CTL); int acc = 0; for (int e = 0; e < 32; ++e) { tp[e] = acc; acc += (cnt[e * 64] + 255) / 256; } tp[32] = acc; }
    __syncthreads();
}
DI void phase_moe_up(const Params& p, const Ctx& F) {
    LAS int* tp = (LAS int*)(F.lds + pg8::STAGE_BYTES);
    moe_tile_prefix(p, F, tp);
    MoeOrder S{tp, (const int*)(p.ws + WS_CTL), 2, F.G, F.bid, 1024, (const char*)(p.ws + WS_H2), (const char*)(p.ws + WS_WGUT), (size_t)512 * 1024 * 2, (size_t)256 * 1024 * 2, (const int*)(p.ws + WS_PERM), true};
    pg8::EpiMoeUp E{(bf16_t*)(p.ws + WS_HID)};
    pg8::gemm_phase<pg8::EpiMoeUp, MoeOrder, true>(F.lds, 1024, S, E);
}
DI void phase_moe_down(const Params& p, const Ctx& F) {
    LAS int* tp = (LAS int*)(F.lds + pg8::STAGE_BYTES);
    moe_tile_prefix(p, F, tp);
    MoeOrder S{tp, (const int*)(p.ws + WS_CTL), 4, F.G, F.bid, 256, (const char*)(p.ws + WS_HID), (const char*)(p.ws + WS_WDT), (size_t)1024 * 256 * 2, (size_t)256 * 256 * 2, (const int*)(p.ws + WS_PERM), false};
    pg8::EpiMoeDown E{(bf16_t*)(p.ws + WS_YMOE), (const int*)(p.ws + WS_PERM), (const float*)(p.ws + WS_EW)};
    pg8::gemm_phase<pg8::EpiMoeDown, MoeOrder, false>(F.lds, 256, S, E);
}

DI void phase_final(const Params& p, const Ctx& F, const float fsc = 1.f) {
    const float* mod = (const float*)(p.ws + WS_MOD); const bf16_t* YM = (const bf16_t*)(p.ws + WS_YMOE);
    const int gw = F.bid * NWAVES + F.wave, NGW = F.G * NWAVES;
    struct FL { u32x2 a[4], b[4]; f32x4 x[4]; };
    auto issue = [&](FL& L, int row) { const u32x2* y0 = (const u32x2*)(YM + (size_t)row * D) + F.lane; const u32x2* y1 = (const u32x2*)(YM + ((size_t)NT + row) * D) + F.lane;
        const f32x4* xo = (const f32x4*)(p.out + (size_t)row * D) + F.lane;
#pragma unroll
        for (int j = 0; j < 4; ++j) { L.a[j] = y0[64 * j]; L.b[j] = y1[64 * j]; L.x[j] = xo[64 * j]; } };
    FL L;
    if (gw < NT) issue(L, gw);
    for (int row = gw; row < NT; row += NGW) {
        const int bt = row / SEQ;
        const FL C = L;
        if (row + NGW < NT) issue(L, row + NGW);
        f32x4 v[4]; float ss = 0.f;
#pragma unroll
        for (int j = 0; j < 4; ++j) { const u32x2 a = C.a[j], b = C.b[j];
            v[j] = (f32x4){bflo(a.x) + bflo(b.x), bfhi(a.x) + bfhi(b.x), bflo(a.y) + bflo(b.y), bfhi(a.y) + bfhi(b.y)};
            ss += (v[j].x * v[j].x + v[j].y * v[j].y) + (v[j].z * v[j].z + v[j].w * v[j].w); }
        const float rstd = __builtin_amdgcn_rsqf(wave_sum(ss) * (1.f / D) + 1e-6f);
        f32x4* xo = (f32x4*)(p.out + (size_t)row * D) + F.lane;
#pragma unroll
        for (int j = 0; j < 4; ++j) { const int col = 4 * (F.lane + 64 * j);
            const f32x4 g2 = *(const f32x4*)(mod + bt * 6144 + 5120 + col), gp = *(const f32x4*)(p.in[I_GPOST2] + col);
            xo[64 * j] = C.x[j] + g2 * (v[j] * (rstd * fsc) * gp); }
    }
}

#define XB_TMO      128
#define XB_XCNT(j)  (256  + 64 * (j))
#define XB_XSUB(j)  (1280 + 64 * (j))
#define XB_XGEN(j)  (2304 + 64 * (j))
#define XB_TOP      3328
#define XB_TOPGEN   3392
#define XCD_BAR_WORDS 3456
#define XB_SPIN_CAP (1u << 20)
constexpr int CW_BAR = 4096;
DI unsigned xb_ld(unsigned* p)              { return __hip_atomic_load(p, __ATOMIC_RELAXED, __HIP_MEMORY_SCOPE_AGENT); }
DI unsigned xb_add(unsigned* p, unsigned v) { return __hip_atomic_fetch_add(p, v, __ATOMIC_RELAXED, __HIP_MEMORY_SCOPE_AGENT); }
DI unsigned xb_xcc_id() { return (unsigned)__builtin_amdgcn_s_getreg((3 << 11) | 20) & 0xFu; }
#define XB_SPIN(cond, bar) do { unsigned _sp = 0; while (cond) { __builtin_amdgcn_s_sleep(1); \
    if ((++_sp & 255u) == 0u) { if (xb_ld(&(bar)[XB_TMO])) break; if (_sp > XB_SPIN_CAP) { atomicAdd(&(bar)[XB_TMO], 1u); break; } } } } while (0)
struct XcdBarrier { unsigned* bar; unsigned x; volatile LAS unsigned* st; };
DI XcdBarrier xcd_barrier_post(unsigned* bar, volatile LAS unsigned* st) {
    XcdBarrier b; b.bar = bar; b.x = xb_xcc_id(); b.st = st;
    if (threadIdx.x == 0) (void)xb_add(&bar[XB_XCNT(b.x)], 1u);
    return b;
}
DI void xcd_barrier_complete(unsigned* bar, unsigned x, unsigned& nloc, unsigned& nx) {
    const unsigned G = gridDim.x * gridDim.y * gridDim.z;
    unsigned sum, cnt, mine, sp = 0u;
    for (;;) {
        sum = 0u; cnt = 0u; mine = 0u;
#pragma unroll
        for (unsigned j = 0; j < 16; ++j) { const unsigned c = xb_ld(&bar[XB_XCNT(j)]); sum += c; cnt += (c > 0u) ? 1u : 0u; mine = (j == x) ? c : mine; }
        if (sum == G) break;
        __builtin_amdgcn_s_sleep(1);
        if ((++sp & 255u) == 0u) { if (xb_ld(&bar[XB_TMO])) break; if (sp > XB_SPIN_CAP) { atomicAdd(&bar[XB_TMO], 1u); break; } }
    }
    nloc = mine > 0u ? mine : 1u; nx = cnt > 0u ? cnt : 1u;
}
DI void xcd_barrier(const XcdBarrier& b) {
    asm volatile("s_waitcnt vmcnt(0)" ::: "memory");
    __syncthreads();
    if (threadIdx.x == 0) {
        unsigned* bar = b.bar;
        __builtin_amdgcn_s_waitcnt(0);
        unsigned nloc = b.st[0], nx = b.st[1];
        if (nloc == 0u) { xcd_barrier_complete(bar, b.x, nloc, nx); b.st[0] = nloc; b.st[1] = nx; }
        const unsigned old = xb_add(&bar[XB_XSUB(b.x)], 1u);
        const unsigned gen = old / nloc;
        if (old + 1u == (gen + 1u) * nloc) {
            __builtin_amdgcn_fence(__ATOMIC_RELEASE, "agent");
            asm volatile("s_waitcnt vmcnt(0)" ::: "memory");
            const unsigned og = xb_add(&bar[XB_TOP], 1u);
            const unsigned tg = og / nx;
            if (og + 1u == (tg + 1u) * nx) xb_add(&bar[XB_TOPGEN], 1u);
            else XB_SPIN(xb_ld(&bar[XB_TOPGEN]) == tg, bar);
            __builtin_amdgcn_fence(__ATOMIC_ACQUIRE, "agent");
            xb_add(&bar[XB_XGEN(b.x)], 1u);
            asm volatile("s_waitcnt vmcnt(0)" ::: "memory");
        } else {
            XB_SPIN(xb_ld(&bar[XB_XGEN(b.x)]) == gen, bar);
            __builtin_amdgcn_fence(__ATOMIC_ACQUIRE, "agent");
            asm volatile("s_waitcnt vmcnt(0)" ::: "memory");
        }
    }
    __syncthreads();
}

constexpr int NPHASES = 12;
#ifndef SEQ_SCAN
#define SEQ_SCAN 0
#endif
#ifndef DUP_PHASE
#define DUP_PHASE -1
#endif
#ifndef PROBE_T
#define PROBE_T -1
#endif
template <int PH> DI void run_phase(const Params& p, const Ctx& F) {
    if constexpr (PH == 0) phase_adaln(p, F);
    if constexpr (PH == 1) phase_convert(p, F);
    if constexpr (PH == 2) phase_hrows(p, F);
    if constexpr (PH == 3) phase_gemm1(p, F);
#ifndef OLD_PREP
#define OLD_PREP 0
#endif
    if constexpr (PH == 4) { if (OLD_PREP) phase_prep(p, F); else phase_prep2(p, F); __syncthreads(); phase_gmlp(p, F); }
#ifndef OLD_CHUNKPREP
#define OLD_CHUNKPREP 0
#endif
    if constexpr (PH == 5) { if (OLD_CHUNKPREP) phase_chunkprep(p, F); else phase_chunkprep2(p, F); }
    if constexpr (PH == 12) { phase_scan_chunk(p, F); if (F.G != 256) phase_convert_experts(p, F); }
    if constexpr (PH == 6) phase_post2(p, F);
    if constexpr (PH == 7) phase_gemm2(p, F);
    if constexpr (PH == 8) phase_route(p, F);
    if constexpr (PH == 28) phase_route(p, F, true);
    if constexpr (PH == 9) phase_moe_up(p, F);
    if constexpr (PH == 10) phase_moe_down(p, F);
    if constexpr (PH == 11) phase_final(p, F, DUP_PHASE == 11 ? 0.5f : 1.f);
}
DI Ctx make_ctx(unsigned char* lds) {
    Ctx F; F.lds = (LAS unsigned char*)lds; F.tid = threadIdx.x; F.lane = F.tid & 63; F.wave = __builtin_amdgcn_readfirstlane(F.tid >> 6); F.G = gridDim.x; F.bid = blockIdx.x; return F;
}
template <int PH> __global__ void __launch_bounds__(NTHREADS, 2) k_phase(Params p) {
    extern __shared__ __attribute__((aligned(16))) unsigned char lds[];
    const Ctx F = make_ctx(lds);
    run_phase<PH>(p, F);
}
#ifndef USE_CG_SYNC
#define USE_CG_SYNC 0
#endif
__global__ void __launch_bounds__(NTHREADS, 2) k_mega(Params p) {
    extern __shared__ __attribute__((aligned(16))) unsigned char lds[];
    const Ctx F = make_ctx(lds);
#if USE_CG_SYNC
    cg::grid_group grid = cg::this_grid();
#define GSYNC() grid.sync()
#else
    volatile LAS unsigned* misc = (volatile LAS unsigned*)(F.lds + LDS_MISC);
    if (F.tid < 4) misc[F.tid] = 0u;
    __syncthreads();
    const XcdBarrier bar = xcd_barrier_post((unsigned*)(p.ws + WS_CTL) + CW_BAR, misc);
#define GSYNC() xcd_barrier(bar)
#endif
#define DUP(X) if (DUP_PHASE == X) { run_phase<X>(p, F); GSYNC(); }
    unsigned long long ts_a = 0, ts_b = 0; int nst = 0;
#define STAMP() do { if (PROBE_T >= 0) { const unsigned long long t_ = __builtin_amdgcn_s_memrealtime(); if (nst == PROBE_T) ts_a = t_; if (nst == PROBE_T + 1) ts_b = t_; ++nst; } } while (0)
    STAMP();
    DUP(0) DUP(1)
    run_phase<0>(p, F); run_phase<1>(p, F); GSYNC(); STAMP();
    DUP(2) run_phase<2>(p, F); GSYNC(); STAMP();
    DUP(3) run_phase<3>(p, F); GSYNC(); STAMP();
    DUP(4) run_phase<4>(p, F); GSYNC(); STAMP();
    DUP(5) run_phase<5>(p, F); GSYNC(); STAMP();
    DUP(12)
    run_phase<12>(p, F); GSYNC(); STAMP();
    DUP(6) run_phase<6>(p, F); GSYNC(); STAMP();
    DUP(7) run_phase<7>(p, F); GSYNC(); STAMP();
    if (DUP_PHASE == 8) { run_phase<28>(p, F); GSYNC(); STAMP(); }
    run_phase<8>(p, F); GSYNC(); STAMP();
    DUP(9) run_phase<9>(p, F); GSYNC(); STAMP();
    DUP(10) run_phase<10>(p, F); GSYNC(); STAMP();
    if (DUP_PHASE == 11) { run_phase<11>(p, F); GSYNC(); STAMP(); }
    run_phase<11>(p, F); STAMP();
    if (PROBE_T >= 0 && F.bid == 0 && F.tid == 0) { const unsigned long long t0 = __builtin_amdgcn_s_memrealtime(); const unsigned long long w_ = ts_b - ts_a; while (__builtin_amdgcn_s_memrealtime() - t0 < w_) __builtin_amdgcn_s_sleep(8); }
}

template <int PH> static void launch_phase(const Params& p, int grid, hipStream_t stream) {
    static bool attr = false;
    if (!attr) { (void)hipFuncSetAttribute((const void*)k_phase<PH>, hipFuncAttributeMaxDynamicSharedMemorySize, LDS_BYTES); attr = true; }
    hipLaunchKernelGGL(k_phase<PH>, dim3(grid), dim3(NTHREADS), LDS_BYTES, stream, p);
}

extern "C" void kernel_launch(void* const* d_in, const int* in_sizes, int n_in, void* d_out, int out_size, void* d_ws, size_t ws_size, hipStream_t stream) {
    static int grid = 0;
    if (grid == 0) {
        int dev = 0, cus = 0, per_cu = 0;
        (void)hipGetDevice(&dev); (void)hipDeviceGetAttribute(&cus, hipDeviceAttributeMultiprocessorCount, dev);
        (void)hipFuncSetAttribute((const void*)k_mega, hipFuncAttributeMaxDynamicSharedMemorySize, LDS_BYTES);
        (void)hipOccupancyMaxActiveBlocksPerMultiprocessor(&per_cu, (const void*)k_mega, NTHREADS, LDS_BYTES);
        (void)hipGetLastError();
        grid = cus > 0 ? cus : 256;
        if (n_in != 34 || ws_size < 512 * MiB) fprintf(stderr, "kernel_launch: unexpected n_in %d / ws_size %zu\n", n_in, ws_size);
    }
    Params p{};
    for (int i = 0; i < 34; ++i) p.in[i] = (const float*)d_in[i];
    p.out = (float*)d_out; p.ws = (unsigned char*)d_ws;
    (void)hipMemsetAsync((char*)d_ws + WS_CTL, 0, CTL_BYTES, stream);
#if ONE_LAUNCH
    void* args[] = {&p};
    hipError_t e = hipLaunchCooperativeKernel((const void*)k_mega, dim3(grid), dim3(NTHREADS), args, LDS_BYTES, stream);
    if (e != hipSuccess) fprintf(stderr, "cooperative launch failed: %s (grid %d)\n", hipGetErrorString(e), grid);
#else
    launch_phase<0>(p, grid, stream); launch_phase<1>(p, grid, stream); launch_phase<2>(p, grid, stream); launch_phase<3>(p, grid, stream);
    launch_phase<4>(p, grid, stream); launch_phase<5>(p, grid, stream);
    launch_phase<12>(p, grid, stream);
    launch_phase<6>(p, grid, stream); launch_phase<7>(p, grid, stream);
    launch_phase<8>(p, grid, stream); launch_phase<9>(p, grid, stream); launch_phase<10>(p, grid, stream); launch_phase<11>(p, grid, stream);
#endif
}
```

```cpp
#include <hip/hip_runtime.h>
#include <hip/hip_cooperative_groups.h>
#include <cstdio>
#include <cstdint>
namespace cg = cooperative_groups;

#ifndef ONE_LAUNCH
#define ONE_LAUNCH 1
#endif

#define DI __device__ __forceinline__
#define LAS __attribute__((address_space(3)))
typedef unsigned short bf16_t;
typedef short bf16x8 __attribute__((ext_vector_type(8)));
typedef short s16x4 __attribute__((ext_vector_type(4)));
typedef float f32x4 __attribute__((ext_vector_type(4)));
typedef float f32x2 __attribute__((ext_vector_type(2)));
typedef unsigned u32x4 __attribute__((ext_vector_type(4)));
typedef unsigned u32x2 __attribute__((ext_vector_type(2)));

constexpr int D = 1024, BATCH = 4, SEQ = 8192, CTXL = 256;
constexpr int NT = BATCH * SEQ;
constexpr int NCX = BATCH * CTXL;
constexpr int MR = NT + NCX;
constexpr int BW = 512, AW = 512, NH = 8, HD = 64;
constexpr int DIN = 2944, DINP = 3072;
constexpr int OFF_K = 0, OFF_V = 512, OFF_R = 1024, OFF_WD = 1536, OFF_AD = 1664, OFF_GD = 1792, OFF_U = 1920, OFF_VA = 2432;
constexpr int NEXP = 32, DEXP = 256;
constexpr int NWAVES = 8, NTHREADS = 512;
constexpr int LDS_BYTES = 149504, LDS_MISC = 147456;

constexpr size_t MiB = 1u << 20;
constexpr size_t WS_CTL = 0, CTL_BYTES = 64 * 1024;
constexpr size_t WS_MOD = 1 * MiB;
constexpr size_t WS_DUPT = 2 * MiB;
constexpr size_t WS_AUPT = WS_DUPT + 131072;
constexpr size_t WS_GUPT = WS_AUPT + 131072;
constexpr size_t WS_WSP = WS_GUPT + 131072;
constexpr size_t WS_CONVW = WS_WSP + 262144;
constexpr size_t WS_WINT = 3 * MiB;
constexpr size_t WS_WOUTT = 9 * MiB;
constexpr size_t WS_H = 11 * MiB;
constexpr size_t WS_Z = 77 * MiB;
constexpr size_t ROWB = (size_t)MR * 512 * 2;
constexpr size_t WS_KC = 275 * MiB, WS_VC = WS_KC + ROWB, WS_RC = WS_VC + ROWB, WS_A0 = WS_RC + ROWB, WS_A1 = WS_A0 + ROWB, WS_L0 = WS_A1 + ROWB, WS_L1 = WS_L0 + ROWB;
constexpr size_t WS_OPS = 11 * MiB;
constexpr size_t WS_YS = 11 * MiB;
constexpr size_t WS_Y = 11 * MiB;
constexpr size_t WS_H2 = 139 * MiB;
constexpr size_t WS_EW = 203 * MiB;
constexpr size_t WS_PERM = 204 * MiB;
constexpr size_t WS_HID = 210 * MiB;
constexpr size_t WS_YMOE = 246 * MiB;
constexpr size_t WS_WGUT = 374 * MiB;
constexpr size_t WS_WDT = 406 * MiB;
constexpr size_t DO_MIXED = 0, DO_GATE = 64 * MiB, DO_BV = 96 * MiB;

struct Params { const float* in[34]; float* out; unsigned char* ws; };
enum { I_X = 0, I_C, I_CTX, I_CCTX, I_WMOD, I_BMOD, I_GPRE1, I_GPOST1, I_GPRE2, I_GPOST2, I_WIN, I_CONV, I_GMLNG, I_GMLNB, I_WSP, I_BSP,
       I_DW0, I_DUP, I_A0, I_AUP, I_KK, I_KA, I_RK, I_GUP, I_LNXG, I_LNXB, I_WOUT, I_WRG, I_BRG, I_WRE, I_BRE, I_WG, I_WU, I_WD };

typedef __bf16 bf16x2_t __attribute__((ext_vector_type(2)));
typedef _Float16 h2_t __attribute__((ext_vector_type(2)));
typedef _Float16 h4_t __attribute__((ext_vector_type(4)));
DI unsigned pkh2(float lo, float hi) { const f32x2 v = {lo, hi}; const h2_t h = __builtin_convertvector(v, h2_t); return __builtin_bit_cast(unsigned, h); }
DI unsigned pk2(float lo, float hi) { const f32x2 v = {lo, hi}; const bf16x2_t b = __builtin_convertvector(v, bf16x2_t); return __builtin_bit_cast(unsigned, b); }
DI unsigned f2bf(float f) { return pk2(f, f) & 0xffffu; }
DI float bf2f(unsigned b) { return __builtin_bit_cast(float, b << 16); }
DI float bflo(unsigned w) { return __builtin_bit_cast(float, w << 16); }
DI float bfhi(unsigned w) { return __builtin_bit_cast(float, w & 0xffff0000u); }
DI unsigned cvt_pk_bf16(float lo, float hi) { return pk2(lo, hi); }

template <int CTRL, int ROWMASK> DI float dppf(float v) { return __builtin_bit_cast(float, __builtin_amdgcn_update_dpp(0, __builtin_bit_cast(int, v), CTRL, ROWMASK, 0xf, false)); }
DI float wave_scan_incl(float v) {
    v += dppf<0x111, 0xf>(v); v += dppf<0x112, 0xf>(v); v += dppf<0x114, 0xf>(v); v += dppf<0x118, 0xf>(v);
    v += dppf<0x142, 0xa>(v); v += dppf<0x143, 0xc>(v); return v;
}
DI float lane63(float v) { return __builtin_bit_cast(float, __builtin_amdgcn_readlane(__builtin_bit_cast(int, v), 63)); }
DI float wave_sum(float v) { return lane63(wave_scan_incl(v)); }
DI float sigmoidf_(float x) { return __builtin_amdgcn_rcpf(1.f + __expf(-x)); }
DI float siluf_(float x) { return x * __builtin_amdgcn_rcpf(1.f + __expf(-x)); }
DI float softplusf_(float x) { return fmaxf(x, 0.f) + __logf(1.f + __expf(-fabsf(x))); }
DI float tanh_fast(float x) { return 2.f * __builtin_amdgcn_rcpf(1.f + __expf(-2.f * x)) - 1.f; }
DI float gelu_tanh(float x) { const float u2 = 1.5957691216057308f * (x + 0.044715f * x * x * x); return x * __builtin_amdgcn_rcpf(1.f + __expf(-u2)); }
#define LDS_WAIT() asm volatile("s_waitcnt lgkmcnt(0)" ::: "memory")

namespace pg8 {
constexpr int BM = 256, BK = 64, HALF = 128, HTB = HALF * BK * 2, STAGE_BYTES = 8 * HTB, NXCD = 8, WGM = 8;
__host__ __device__ __forceinline__ int lds_byte(int r, int c) { const int st = (r >> 4) * 2 + (c >> 5), rr = r & 15, cc = c & 31, ob = rr * 64 + cc * 2; return st * 1024 + (ob ^ (((ob >> 9) & 1) << 5)); }
__host__ __device__ __forceinline__ void stage_rc(int b, int& R, int& C) { const int st = b / 1024, sb = b % 1024, swz = sb ^ (((sb >> 9) & 1) << 5); R = (st >> 1) * 16 + swz / 64; C = (st & 1) * 32 + (swz % 64) / 2; }
__host__ __device__ __forceinline__ int perm32(int rho) { const int n = rho >> 4, i = rho & 15; return 8 * (i >> 2) + 4 * n + (i & 3); }

struct Unit { const char* A; const char* B; const int* ridx; int pm, pn, e, lt, nvalid; };

struct StaticOrder {
    const char* A; const char* Bt; int K; int nM, nN, nwg, G, c;
    __device__ void init(const void* A_, const void* Bt_, int M, int N, int K_, int G_, int c_) { A = (const char*)A_; Bt = (const char*)Bt_; K = K_; nM = M / BM; nN = N / BM; nwg = nM * nN; G = G_; c = c_; }
    __device__ bool next(int i, Unit& u) const {
        const long L = (long)i * G + c; if (L >= nwg) return false;
        int wgid = (int)L; { const int q = nwg / NXCD, r = nwg % NXCD, xcd = wgid % NXCD, off = wgid / NXCD; wgid = (xcd < r ? xcd * (q + 1) : r * (q + 1) + (xcd - r) * q) + off; }
        const int nig = WGM * nN, gid = wgid / nig, fm = gid * WGM, gsz = (nM - fm) < WGM ? (nM - fm) : WGM;
        u.pm = fm + ((wgid % nig) % gsz); u.pn = (wgid % nig) / gsz;
        u.A = A + (size_t)u.pm * BM * K * 2; u.B = Bt + (size_t)u.pn * BM * K * 2; u.ridx = nullptr; u.e = 0; u.lt = 0; u.nvalid = BM; return true;
    }
};

DI int gidx(const Unit& u, int r) { return r < u.nvalid ? (u.ridx[r] >> 1) : 0; }

template <class Epi, class Sched, bool GATHER>
DI void gemm_phase(LAS unsigned char* lds, const int K, const Sched& S, const Epi& E) {
    int tid_ = threadIdx.x; asm volatile("" : "+v"(tid_));
    const int tid = tid_, wid = __builtin_amdgcn_readfirstlane(tid >> 6), lane = tid & 63, wr = wid >> 2, wc = wid & 3, fr = lane & 15, fq = lane >> 4;
    const int nt = K / BK;
    int Rr[2], Cc[2];
    unsigned voffB[2], vA[2][2], vAn[2][2];
#pragma unroll
    for (int i = 0; i < 2; ++i) { int R, C; stage_rc(tid * 16 + i * 8192, R, C); Rr[i] = R; Cc[i] = C; const int Rb = (R & ~31) + perm32(R & 31);
        voffB[i] = (unsigned)(Rb * K + C) * 2u;
        vA[0][i] = (unsigned)(R * K + C) * 2u; vA[1][i] = (unsigned)((R + HALF) * K + C) * 2u; vAn[0][i] = vA[0][i]; vAn[1][i] = vA[1][i]; }
    const size_t kstep = (size_t)(BK * 2);
    const size_t hstep = (size_t)HALF * K * 2;
    const unsigned ldsw = (unsigned)wid * 1024u;
    const int aoff = lds_byte(wr * 64 + fr, fq * 8), boff = lds_byte(wc * 32 + fr, fq * 8);
#define PG8_SA(b, h) (((b) * 2 + (h)) * HTB)
#define PG8_SB(b, h) ((4 + (b) * 2 + (h)) * HTB)
#define PG8_STAGE(bufoff, gbase, voff) do { _Pragma("unroll") for (int _i = 0; _i < 2; ++_i) \
        __builtin_amdgcn_global_load_lds((const unsigned*)((const char*)(gbase) + (voff)[_i]), (LAS unsigned*)(lds + (bufoff) + ldsw + _i * 8192), 16, 0, 0); } while (0)
#define PG8_LDA(dst, b, h) do { _Pragma("unroll") for (int m = 0; m < 4; ++m) _Pragma("unroll") for (int k = 0; k < 2; ++k) dst[m][k] = *(const LAS bf16x8*)(lds + PG8_SA(b, h) + aoff + m * 2048 + k * 1024); } while (0)
#define PG8_LDB(dst, b, h) do { _Pragma("unroll") for (int n = 0; n < 2; ++n) _Pragma("unroll") for (int k = 0; k < 2; ++k) dst[n][k] = *(const LAS bf16x8*)(lds + PG8_SB(b, h) + boff + n * 2048 + k * 1024); } while (0)
#define PG8_MMA(ai, bj, At, Bt) do { __builtin_amdgcn_s_setprio(1); _Pragma("unroll") for (int m = 0; m < 4; ++m) _Pragma("unroll") for (int n = 0; n < 2; ++n) _Pragma("unroll") for (int k = 0; k < 2; ++k) \
        acc[ai][bj][m][n] = __builtin_amdgcn_mfma_f32_16x16x32_bf16(Bt[n][k], At[m][k], acc[ai][bj][m][n], 0, 0, 0); __builtin_amdgcn_s_setprio(0); } while (0)
#define PG8_WAIT_V(n) asm volatile("s_waitcnt vmcnt(" #n ")" ::: "memory")
#define PG8_WAIT_L(n) asm volatile("s_waitcnt lgkmcnt(" #n ")" ::: "memory")
#define PG8_BAR __builtin_amdgcn_s_barrier()
#define PG8_SCHED __builtin_amdgcn_sched_barrier(0)
    Unit cur, nxt; int ui = 0;
    if (!S.next(0, cur)) return;
    if constexpr (GATHER) {
#pragma unroll
        for (int i = 0; i < 2; ++i) { vA[0][i] = (unsigned)(gidx(cur, Rr[i]) * K + Cc[i]) * 2u; vA[1][i] = (unsigned)(gidx(cur, Rr[i] + HALF) * K + Cc[i]) * 2u; }
    }
    f32x4 acc[2][2][4][2];
#pragma unroll
    for (int a = 0; a < 2; ++a)
#pragma unroll
        for (int b = 0; b < 2; ++b)
#pragma unroll
            for (int m = 0; m < 4; ++m)
#pragma unroll
                for (int n = 0; n < 2; ++n) acc[a][b][m][n] = (f32x4){0.f, 0.f, 0.f, 0.f};
    bf16x8 At[4][2], B0[2][2], B1[2][2];
    const char* cA = cur.A; const char* cB = cur.B;
    PG8_STAGE(PG8_SB(0, 0), cB, voffB); PG8_STAGE(PG8_SB(0, 1), cB + hstep, voffB); PG8_STAGE(PG8_SA(0, 0), cA, vA[0]); PG8_STAGE(PG8_SA(0, 1), cA, vA[1]);
    if (wr == 1) PG8_BAR;
    PG8_WAIT_V(2); PG8_BAR;
    PG8_STAGE(PG8_SB(1, 0), cB + kstep, voffB); PG8_STAGE(PG8_SA(1, 0), cA + kstep, vA[0]); PG8_STAGE(PG8_SB(1, 1), cB + hstep + kstep, voffB);
    PG8_WAIT_V(6); PG8_BAR;
    for (;;) {
        const bool has_next = S.next(ui + 1, nxt);
        const char* nA = has_next ? nxt.A : cA; const char* nB = has_next ? nxt.B : cB;
        if constexpr (GATHER) {
            if (has_next) {
#pragma unroll
                for (int i = 0; i < 2; ++i) { vAn[0][i] = (unsigned)(gidx(nxt, Rr[i]) * K + Cc[i]) * 2u; vAn[1][i] = (unsigned)(gidx(nxt, Rr[i] + HALF) * K + Cc[i]) * 2u; }
            } else {
#pragma unroll
                for (int i = 0; i < 2; ++i) { vAn[0][i] = vA[0][i]; vAn[1][i] = vA[1][i]; }
            }
        }
#pragma unroll 1
        for (int t = 0; t < nt; t += 2) {
            const bool last = (t == nt - 2);
            const char* a1 = cA + (size_t)(t + 1) * kstep;
            const char* a2 = last ? nA : cA + (size_t)(t + 2) * kstep; const char* b2 = last ? nB : cB + (size_t)(t + 2) * kstep;
            const char* a3 = a2 + kstep; const char* b3 = b2 + kstep;
            unsigned w0[2], w1[2];
            if constexpr (GATHER) { w0[0] = last ? vAn[0][0] : vA[0][0]; w0[1] = last ? vAn[0][1] : vA[0][1]; w1[0] = last ? vAn[1][0] : vA[1][0]; w1[1] = last ? vAn[1][1] : vA[1][1]; }
            else { w0[0] = vA[0][0]; w0[1] = vA[0][1]; w1[0] = vA[1][0]; w1[1] = vA[1][1]; }
            PG8_LDB(B0, 0, 0); PG8_LDB(B1, 0, 1); PG8_SCHED; PG8_LDA(At, 0, 0); PG8_STAGE(PG8_SA(1, 1), a1, vA[1]);
            PG8_WAIT_V(8); PG8_WAIT_L(0); PG8_BAR; PG8_MMA(0, 0, At, B0); PG8_MMA(0, 1, At, B1); PG8_BAR; PG8_SCHED;
            PG8_LDA(At, 0, 1); PG8_STAGE(PG8_SB(0, 0), b2, voffB); PG8_STAGE(PG8_SB(0, 1), b2 + hstep, voffB); PG8_STAGE(PG8_SA(0, 0), a2, w0);
            PG8_WAIT_V(8); PG8_WAIT_L(0); PG8_BAR; PG8_MMA(1, 0, At, B0); PG8_MMA(1, 1, At, B1); PG8_BAR; PG8_SCHED;
            PG8_LDB(B0, 1, 0); PG8_LDB(B1, 1, 1); PG8_SCHED; PG8_LDA(At, 1, 0); PG8_STAGE(PG8_SA(0, 1), a2, w1);
            PG8_WAIT_V(8); PG8_WAIT_L(0); PG8_BAR; PG8_MMA(0, 0, At, B0); PG8_MMA(0, 1, At, B1); PG8_BAR; PG8_SCHED;
            PG8_LDA(At, 1, 1); PG8_STAGE(PG8_SB(1, 0), b3, voffB); PG8_STAGE(PG8_SB(1, 1), b3 + hstep, voffB); PG8_STAGE(PG8_SA(1, 0), a3, w0);
            PG8_WAIT_V(8); PG8_WAIT_L(0); PG8_BAR; PG8_MMA(1, 0, At, B0); PG8_MMA(1, 1, At, B1); PG8_BAR; PG8_SCHED;
        }
        if (wr == 0) PG8_BAR;
        E(acc, cur, wr, wc, fr, fq);
        if (!has_next) break;
#pragma unroll
        for (int a = 0; a < 2; ++a)
#pragma unroll
            for (int b = 0; b < 2; ++b)
#pragma unroll
                for (int m = 0; m < 4; ++m)
#pragma unroll
                    for (int n = 0; n < 2; ++n) acc[a][b][m][n] = (f32x4){0.f, 0.f, 0.f, 0.f};
        cur = nxt; cA = nA; cB = nB; ++ui;
        if constexpr (GATHER) {
#pragma unroll
            for (int i = 0; i < 2; ++i) { vA[0][i] = vAn[0][i]; vA[1][i] = vAn[1][i]; }
        }
        if (wr == 1) PG8_BAR;
    }
    PG8_WAIT_V(0);
    PG8_BAR;
#undef PG8_SA
#undef PG8_SB
#undef PG8_STAGE
#undef PG8_LDA
#undef PG8_LDB
#undef PG8_MMA
#undef PG8_WAIT_V
#undef PG8_WAIT_L
#undef PG8_BAR
#undef PG8_SCHED
}

struct EpiBf16 {
    bf16_t* O; int ldc; bool zact;
    DI void operator()(const f32x4 (&acc)[2][2][4][2], const Unit& u, int wr, int wc, int fr, int fq) const {
        const int row0 = u.pm * BM + wr * 64 + fr, col0 = u.pn * BM + wc * 32 + 8 * fq;
#pragma unroll
        for (int bj = 0; bj < 2; ++bj) { const int hc = 2 * u.pn + bj; const int act = !zact ? 0 : (hc < 12 ? 4 : (hc == 12 ? 1 : (hc == 14 ? 2 : (hc >= 15 ? 3 : 0))));
#pragma unroll
            for (int ai = 0; ai < 2; ++ai)
#pragma unroll
                for (int m = 0; m < 4; ++m) { bf16_t* rowp = O + (size_t)(row0 + ai * HALF + m * 16) * ldc + col0;
                    f32x4 v0 = acc[ai][bj][m][0], v1 = acc[ai][bj][m][1];
                    if (act == 1) {
#pragma unroll
                        for (int j = 0; j < 4; ++j) { v0[j] = tanh_fast(v0[j]); v1[j] = tanh_fast(v1[j]); }
                    } else if (act == 2) {
#pragma unroll
                        for (int j = 0; j < 4; ++j) { v0[j] = sigmoidf_(v0[j]); v1[j] = sigmoidf_(v1[j]); }
                    } else if (act == 3) {
#pragma unroll
                        for (int j = 0; j < 4; ++j) { v0[j] = gelu_tanh(v0[j]); v1[j] = gelu_tanh(v1[j]); }
                    }
                    u32x4 w;
                    if (act == 4) { w.x = pkh2(v0[0], v0[1]); w.y = pkh2(v0[2], v0[3]); w.z = pkh2(v1[0], v1[1]); w.w = pkh2(v1[2], v1[3]); }
                    else { w.x = cvt_pk_bf16(v0[0], v0[1]); w.y = cvt_pk_bf16(v0[2], v0[3]); w.z = cvt_pk_bf16(v1[0], v1[1]); w.w = cvt_pk_bf16(v1[2], v1[3]); }
                    *(u32x4*)(rowp + bj * HALF) = w; } }
    }
};
struct EpiF32 {
    float* O; int ldc;
    DI void operator()(const f32x4 (&acc)[2][2][4][2], const Unit& u, int wr, int wc, int fr, int fq) const {
        const int row0 = u.pm * BM + wr * 64 + fr, col0 = u.pn * BM + wc * 32 + 8 * fq;
#pragma unroll
        for (int ai = 0; ai < 2; ++ai)
#pragma unroll
            for (int m = 0; m < 4; ++m) { float* rowp = O + (size_t)(row0 + ai * HALF + m * 16) * ldc + col0;
#pragma unroll
                for (int bj = 0; bj < 2; ++bj) { *(f32x4*)(rowp + bj * HALF) = acc[ai][bj][m][0]; *(f32x4*)(rowp + bj * HALF + 4) = acc[ai][bj][m][1]; } }
    }
};
struct EpiMoeUp {
    bf16_t* HID;
    DI void operator()(const f32x4 (&acc)[2][2][4][2], const Unit& u, int wr, int wc, int fr, int fq) const {
        const int row0 = u.pm * BM + wr * 64 + fr, col0 = u.pn * HALF + wc * 32 + 8 * fq;
#pragma unroll
        for (int ai = 0; ai < 2; ++ai)
#pragma unroll
            for (int m = 0; m < 4; ++m) { bf16_t* rowp = HID + (size_t)(row0 + ai * HALF + m * 16) * DEXP + col0;
                float h[8];
#pragma unroll
                for (int n = 0; n < 2; ++n)
#pragma unroll
                    for (int j = 0; j < 4; ++j) { const float g = acc[ai][0][m][n][j], up = acc[ai][1][m][n][j]; h[n * 4 + j] = siluf_(g) * up; }
                u32x4 w; w.x = cvt_pk_bf16(h[0], h[1]); w.y = cvt_pk_bf16(h[2], h[3]); w.z = cvt_pk_bf16(h[4], h[5]); w.w = cvt_pk_bf16(h[6], h[7]);
                *(u32x4*)rowp = w; }
    }
};
struct EpiMoeDown {
    bf16_t* YM; const int* perm; const float* ew;
    DI void operator()(const f32x4 (&acc)[2][2][4][2], const Unit& u, int wr, int wc, int fr, int fq) const {
        const int col0 = u.pn * BM + wc * 32 + 8 * fq;
        int pr[2][4]; float wgt[2][4];
#pragma unroll
        for (int ai = 0; ai < 2; ++ai)
#pragma unroll
            for (int m = 0; m < 4; ++m) { const int r = ai * HALF + wr * 64 + m * 16 + fr; pr[ai][m] = r < u.nvalid ? perm[(size_t)u.e * NT + u.lt * BM + r] : -1; }
#pragma unroll
        for (int ai = 0; ai < 2; ++ai)
#pragma unroll
            for (int m = 0; m < 4; ++m) wgt[ai][m] = pr[ai][m] >= 0 ? ew[pr[ai][m]] : 0.f;
#pragma unroll
        for (int ai = 0; ai < 2; ++ai)
#pragma unroll
            for (int m = 0; m < 4; ++m) {
                if (pr[ai][m] >= 0) { const int tok = pr[ai][m] >> 1, slot = pr[ai][m] & 1; const float wg = wgt[ai][m];
                    bf16_t* rowp = YM + ((size_t)slot * NT + tok) * D + col0;
#pragma unroll
                    for (int bj = 0; bj < 2; ++bj) { const f32x4 v0 = acc[ai][bj][m][0] * wg, v1 = acc[ai][bj][m][1] * wg;
                        u32x4 w; w.x = cvt_pk_bf16(v0[0], v0[1]); w.y = cvt_pk_bf16(v0[2], v0[3]); w.z = cvt_pk_bf16(v1[0], v1[1]); w.w = cvt_pk_bf16(v1[2], v1[3]);
                        *(u32x4*)(rowp + bj * HALF) = w; } } }
    }
};
}

struct MoeOrder {
    const LAS int* tp; const int* cnt; int npn, G, c, K; const char* A; const char* Bbase; size_t bstride_e, bstride_pn; const int* perm; bool gather;
    __device__ bool next(int i, pg8::Unit& u) const {
        const int TT = __builtin_amdgcn_readfirstlane(tp[32]); const long L = (long)i * G + c; if (L >= (long)TT * npn) return false;
        const int rt = (int)(L / npn), pn = (int)(L % npn);
        int e = 0;
#pragma unroll 1
        for (int j = 1; j < 32; ++j) e += (__builtin_amdgcn_readfirstlane(tp[j]) <= rt) ? 1 : 0;
        const int lt = rt - __builtin_amdgcn_readfirstlane(tp[e]);
        u.pm = rt; u.pn = pn; u.e = e; u.lt = lt; const int rem = cnt[e * 64] - lt * 256; u.nvalid = rem < 256 ? rem : 256;
        u.ridx = perm + (size_t)e * NT + lt * 256;
        u.A = gather ? A : A + (size_t)rt * 256 * K * 2;
        u.B = Bbase + (size_t)e * bstride_e + (size_t)pn * bstride_pn;
        return true;
    }
};

struct Ctx {
    LAS unsigned char* lds; int tid, lane, wave, G, bid;
};

DI void phase_adaln(const Params& p, const Ctx& F) {
    LAS float* s = (LAS float*)F.lds;
    LAS float* red = (LAS float*)(F.lds + 20480);
    const float* c = p.in[I_C]; const float* cc = p.in[I_CCTX]; const float* wm = p.in[I_WMOD]; const float* bm = p.in[I_BMOD];
    float* mod = (float*)(p.ws + WS_MOD);
    for (int i = F.tid; i < 5 * 1024; i += NTHREADS) { const float v = i < 4096 ? c[i] : cc[i - 4096]; s[i] = siluf_(v); }
    __syncthreads();
    for (int grp = F.bid; grp < 256; grp += F.G) {
        const int col0 = grp * 24, q = F.tid % 6, ks = F.tid / 6;
        float acc[5][4];
#pragma unroll
        for (int b = 0; b < 5; ++b)
#pragma unroll
            for (int j = 0; j < 4; ++j) acc[b][j] = 0.f;
        if (F.tid < 510) {
            f32x4 wv[13];
#pragma unroll
            for (int i = 0; i < 13; ++i) { const int k = ks + 85 * i; wv[i] = k < 1024 ? *(const f32x4*)(wm + (size_t)k * 6144 + col0 + 4 * q) : (f32x4){0.f, 0.f, 0.f, 0.f}; }
#pragma unroll
            for (int i = 0; i < 13; ++i) { const int k = ks + 85 * i; const int kc = k < 1024 ? k : 0;
#pragma unroll
                for (int b = 0; b < 5; ++b) { const float sv = s[b * 1024 + kc];
#pragma unroll
                    for (int j = 0; j < 4; ++j) acc[b][j] += sv * wv[i][j]; } }
#pragma unroll
            for (int b = 0; b < 5; ++b)
#pragma unroll
                for (int j = 0; j < 4; ++j) red[ks * 120 + q * 20 + b * 4 + j] = acc[b][j];
        }
        __syncthreads();
        if (F.tid < 120) {
            float sum = 0.f;
            for (int k2 = 0; k2 < 85; ++k2) sum += red[k2 * 120 + F.tid];
            const int qq = F.tid / 20, b = (F.tid % 20) / 4, j = F.tid % 4, col = col0 + 4 * qq + j;
            mod[b * 6144 + col] = sum + bm[col];
        }
        __syncthreads();
    }
}

DI void transpose_item(const float* W, int K, int N, bf16_t* WT, int row_off, LAS float* scr, int item, int lane) {
    const int nblk = N / 32, kb = item / nblk, nb = item % nblk, k0 = 64 * kb, n0 = 32 * nb;
#pragma unroll 8
    for (int i = 0; i < 32; ++i) { const int kk = 2 * i + (lane >> 5); scr[kk * 33 + (lane & 31)] = W[(size_t)(k0 + kk) * N + n0 + (lane & 31)]; }
    LDS_WAIT(); asm volatile("" ::: "memory");
    const int c = lane & 7;
#pragma unroll
    for (int j = 0; j < 4; ++j) { const int n = (lane >> 3) + 8 * j; const LAS float* s = scr + (8 * c) * 33 + n;
        u32x4 o; o.x = pk2(s[0 * 33], s[1 * 33]); o.y = pk2(s[2 * 33], s[3 * 33]); o.z = pk2(s[4 * 33], s[5 * 33]); o.w = pk2(s[6 * 33], s[7 * 33]);
        *(u32x4*)(WT + (size_t)(row_off + n0 + n) * K + k0 + 8 * c) = o; }
    LDS_WAIT(); asm volatile("" ::: "memory");
}
DI void phase_convert(const Params& p, const Ctx& F) {
    __syncthreads();
    LAS float* scr = (LAS float*)(F.lds + F.wave * 16384);
    const int gw = F.bid * NWAVES + F.wave, NGW = F.G * NWAVES;
    bf16_t* WinT = (bf16_t*)(p.ws + WS_WINT); bf16_t* WoutT = (bf16_t*)(p.ws + WS_WOUTT); bf16_t* WguT = (bf16_t*)(p.ws + WS_WGUT); bf16_t* WdT = (bf16_t*)(p.ws + WS_WDT);
    constexpr int I_IN = 16 * 92, I_OUT = 16 * 32;
    constexpr int NITEMS = I_IN + I_OUT;
    for (int it = gw; it < NITEMS; it += NGW) {
        int r = it;
        if (r < I_IN) { transpose_item(p.in[I_WIN], 1024, DIN, WinT, 0, scr, r, F.lane); continue; } r -= I_IN;
        transpose_item(p.in[I_WOUT], 1024, 1024, WoutT, 0, scr, r, F.lane);
    }
    (void)WguT; (void)WdT;
    { const int gt = F.bid * NTHREADS + F.tid, NG = F.G * NTHREADS; u32x4 z = {0u, 0u, 0u, 0u};
      for (int i = gt; i < 128 * 1024 / 8; i += NG) *(u32x4*)(WinT + (size_t)DIN * 1024 + (size_t)i * 8) = z;
      bf16_t* DupT = (bf16_t*)(p.ws + WS_DUPT); bf16_t* AupT = (bf16_t*)(p.ws + WS_AUPT); bf16_t* GupT = (bf16_t*)(p.ws + WS_GUPT); bf16_t* Wsp = (bf16_t*)(p.ws + WS_WSP);
      for (int i = gt; i < 2 * 512 * 64; i += NG) { const int d = i / (512 * 64), ch = (i / 64) % 512, l = i % 64;
          DupT[i] = (bf16_t)f2bf(p.in[I_DUP][(size_t)(d * 64 + l) * 512 + ch]); AupT[i] = (bf16_t)f2bf(p.in[I_AUP][(size_t)(d * 64 + l) * 512 + ch]); }
      for (int i = gt; i < 512 * 128; i += NG) { const int ch = i / 128, l = i % 128; GupT[i] = (bf16_t)f2bf(p.in[I_GUP][(size_t)l * 512 + ch]); }
      for (int i = gt; i < 8 * 128 * 128; i += NG) Wsp[i] = (bf16_t)f2bf(p.in[I_WSP][i]);
      float* cw2 = (float*)(p.ws + WS_CONVW);
      for (int i = gt; i < 128 * 9 * 3 * 4; i += NG) { const int j = i & 3, s3 = (i >> 2) % 3, tap = (i / 12) % 9, qd = i / 108; cw2[i] = p.in[I_CONV][tap * 1536 + s3 * 512 + 4 * qd + j]; } }
}


DI void phase_convert_experts(const Params& p, const Ctx& F) {
    constexpr int TP = 264;
    LAS bf16_t* tile = (LAS bf16_t*)F.lds;
    bf16_t* WguT = (bf16_t*)(p.ws + WS_WGUT); bf16_t* WdT = (bf16_t*)(p.ws + WS_WDT);
    constexpr int NIT = 32 * 2 * 16 + 32 * 16;
    const int b0 = F.bid, nb = F.G;
    for (int it = b0; it < NIT; it += nb) {
        const float* src; int ldn; bf16_t* dst; int ldk, k0; int rowmap;
        int n0 = 0;
        if (it < 1024) { const int e = it >> 5, up = (it >> 4) & 1, kt = it & 15; src = (up ? p.in[I_WU] : p.in[I_WG]) + (size_t)e * 1024 * 256 + (size_t)kt * 64 * 256; ldn = 256;
            dst = WguT + (size_t)e * 512 * 1024; ldk = 1024; k0 = kt * 64; rowmap = 1 + up; }
        else { const int r = it - 1024, e = r >> 4, kt = (r >> 2) & 3, ntl = r & 3; src = p.in[I_WD] + (size_t)e * 256 * 1024 + (size_t)kt * 64 * 1024 + ntl * 256; ldn = 1024;
            dst = WdT + (size_t)e * 1024 * 256; ldk = 256; k0 = kt * 64; rowmap = 0; n0 = ntl * 256; }
        __syncthreads();
#pragma unroll
        for (int i = 0; i < 8; ++i) { const int k = 8 * F.wave + i; const f32x4 v = *(const f32x4*)(src + (size_t)k * ldn + 4 * F.lane);
            u32x2 o; o.x = pk2(v[0], v[1]); o.y = pk2(v[2], v[3]); *(LAS u32x2*)(tile + k * TP + 4 * F.lane) = o; }
        __syncthreads();
        { const int n = F.tid >> 1, kh = F.tid & 1;
          u32x4 o[4];
#pragma unroll
          for (int q = 0; q < 4; ++q) { unsigned wds[4];
#pragma unroll
              for (int j = 0; j < 4; ++j) { const int k = 32 * kh + 8 * q + 2 * j; wds[j] = (unsigned)tile[k * TP + n] | ((unsigned)tile[(k + 1) * TP + n] << 16); }
              o[q] = (u32x4){wds[0], wds[1], wds[2], wds[3]}; }
          const int drow = rowmap == 0 ? n0 + n : ((n >> 7) * 256 + (n & 127) + (rowmap == 2 ? 128 : 0));
          bf16_t* dp = dst + (size_t)drow * ldk + k0 + 32 * kh;
#pragma unroll
          for (int q = 0; q < 4; ++q) *(u32x4*)(dp + 8 * q) = o[q]; }
    }
}

DI void phase_hrows(const Params& p, const Ctx& F) {
    const float* mod = (const float*)(p.ws + WS_MOD); const float* g = p.in[I_GPRE1]; bf16_t* H = (bf16_t*)(p.ws + WS_H);
    const int gw = F.bid * NWAVES + F.wave, NGW = F.G * NWAVES;
    auto rowsrc = [&](int row) -> const f32x4* { return (const f32x4*)(row < NT ? p.in[I_X] + (size_t)row * D : p.in[I_CTX] + (size_t)(row - NT) * D) + F.lane; };
    f32x4 nv[4];
    if (gw < MR) { const f32x4* xr = rowsrc(gw);
#pragma unroll
        for (int j = 0; j < 4; ++j) nv[j] = xr[64 * j]; }
    for (int row = gw; row < MR; row += NGW) {
        const int bt = row < NT ? row / SEQ : 4;
        f32x4 v[4]; float ss = 0.f;
#pragma unroll
        for (int j = 0; j < 4; ++j) { v[j] = nv[j]; ss += (v[j].x * v[j].x + v[j].y * v[j].y) + (v[j].z * v[j].z + v[j].w * v[j].w); }
        if (row + NGW < MR) { const f32x4* xr = rowsrc(row + NGW);
#pragma unroll
            for (int j = 0; j < 4; ++j) nv[j] = xr[64 * j]; }
        const float rstd = __builtin_amdgcn_rsqf(wave_sum(ss) * (1.f / D) + 1e-6f);
        unsigned long long* o8 = (unsigned long long*)(H + (size_t)row * D) + F.lane;
#pragma unroll
        for (int j = 0; j < 4; ++j) { const int col = 4 * (F.lane + 64 * j);
            const f32x4 gg = *(const f32x4*)(g + col), sh = *(const f32x4*)(mod + bt * 6144 + col), sc = *(const f32x4*)(mod + bt * 6144 + 1024 + col);
            const f32x4 h = v[j] * rstd * gg * (sc + 1.f) + sh;
            o8[64 * j] = (unsigned long long)pk2(h.x, h.y) | ((unsigned long long)pk2(h.z, h.w) << 32); }
    }
}

DI void phase_gemm1(const Params& p, const Ctx& F) {
    pg8::StaticOrder S; S.init(p.ws + WS_H, p.ws + WS_WINT, MR, DINP, 1024, F.G, F.bid);
    pg8::EpiBf16 E{(bf16_t*)(p.ws + WS_Z), DINP, true};
    pg8::gemm_phase<pg8::EpiBf16, pg8::StaticOrder, false>(F.lds, 1024, S, E);
}

DI void phase_prep(const Params& p, const Ctx& F) {
    const bf16_t* Z = (const bf16_t*)(p.ws + WS_Z);
    bf16_t* Kc = (bf16_t*)(p.ws + WS_KC); bf16_t* Vc = (bf16_t*)(p.ws + WS_VC); bf16_t* Rc = (bf16_t*)(p.ws + WS_RC);
    bf16_t* A0 = (bf16_t*)(p.ws + WS_A0); bf16_t* A1 = (bf16_t*)(p.ws + WS_A1); bf16_t* L0 = (bf16_t*)(p.ws + WS_L0); bf16_t* L1 = (bf16_t*)(p.ws + WS_L1);
    bf16_t* GATE = (bf16_t*)((unsigned char*)p.out + DO_GATE); bf16_t* BV = (bf16_t*)((unsigned char*)p.out + DO_BV);
    const float* conv = p.in[I_CONV];
    LAS float* sl = (LAS float*)F.lds;
    const int t = F.tid;
    for (int it = F.bid; it < MR / 8; it += F.G) {
        const int row0 = it * 8;
        __syncthreads();
        for (int i = t; i < 8 * 384; i += NTHREADS) { const int rr = i / 384, c = i % 384; const float zv = bf2f(Z[(size_t)(row0 + rr) * DINP + OFF_WD + c]);
            sl[i] = c < 128 ? tanhf(zv) : (c < 256 ? zv : sigmoidf_(zv)); }
        __syncthreads();
        float dw0[8], dw1[8], da0[8], da1[8], gt[8];
#pragma unroll
        for (int r = 0; r < 8; ++r) { dw0[r] = dw1[r] = da0[r] = da1[r] = gt[r] = 0.f; }
        for (int l = 0; l < 64; ++l) {
            const float u0 = p.in[I_DUP][(size_t)l * 512 + t], u1 = p.in[I_DUP][(size_t)(64 + l) * 512 + t];
            const float v0 = p.in[I_AUP][(size_t)l * 512 + t], v1 = p.in[I_AUP][(size_t)(64 + l) * 512 + t];
            const float g0 = p.in[I_GUP][(size_t)l * 512 + t], g1 = p.in[I_GUP][(size_t)(64 + l) * 512 + t];
#pragma unroll
            for (int r = 0; r < 8; ++r) { const LAS float* s = sl + r * 384;
                dw0[r] += s[l] * u0; dw1[r] += s[64 + l] * u1; da0[r] += s[128 + l] * v0; da1[r] += s[192 + l] * v1; gt[r] += s[256 + l] * g0 + s[320 + l] * g1; }
        }
        const float w00 = p.in[I_DW0][t], w01 = p.in[I_DW0][512 + t], a00 = p.in[I_A0][t], a01 = p.in[I_A0][512 + t];
        const float ka0 = p.in[I_KA][t], ka1 = p.in[I_KA][512 + t], rk = p.in[I_RK][t];
#pragma unroll 1
        for (int r = 0; r < 8; ++r) {
            const int row = row0 + r;
            float cv[3] = {0.f, 0.f, 0.f};
            if (row < NT) {
                const int tb = row % SEQ, gy = tb / 64, gx = tb % 64;
#pragma unroll
                for (int dy = 0; dy < 3; ++dy) { const int ny = gy + dy - 1; if (ny < 0 || ny >= 128) continue;
#pragma unroll
                    for (int dx = 0; dx < 3; ++dx) { const int nx = gx + dx - 1; if (nx < 0 || nx >= 64) continue;
                        const size_t nrow = (size_t)(row + (dy - 1) * 64 + (dx - 1));
#pragma unroll
                        for (int s3 = 0; s3 < 3; ++s3) cv[s3] += bf2f(Z[nrow * DINP + s3 * 512 + t]) * conv[(dy * 3 + dx) * 1536 + s3 * 512 + t]; } }
            } else {
                const int tb = (row - NT) % CTXL;
#pragma unroll
                for (int dx = 0; dx < 3; ++dx) { const int nx = tb + dx - 1; if (nx < 0 || nx >= CTXL) continue;
                    const size_t nrow = (size_t)(row + dx - 1);
#pragma unroll
                    for (int s3 = 0; s3 < 3; ++s3) cv[s3] += bf2f(Z[nrow * DINP + s3 * 512 + t]) * conv[(3 + dx) * 1536 + s3 * 512 + t]; }
            }
            const float k = cv[0], v = cv[1], rr = cv[2];
            const float wl0 = w00 + dw0[r], wl1 = w01 + dw1[r];
            const float lg0 = -__expf(-softplusf_(-wl0) - 0.5f), lg1 = -__expf(-softplusf_(-wl1) - 0.5f);
            const float a0 = sigmoidf_(a00 + da0[r]), a1 = sigmoidf_(a01 + da1[r]);
            const size_t o = (size_t)row * 512 + t;
            Kc[o] = (bf16_t)f2bf(k); Vc[o] = (bf16_t)f2bf(v); Rc[o] = (bf16_t)f2bf(rr);
            A0[o] = (bf16_t)f2bf(a0); A1[o] = (bf16_t)f2bf(a1); L0[o] = (bf16_t)f2bf(lg0); L1[o] = (bf16_t)f2bf(lg1);
            if (row < NT) {
                const float km0 = k * (1.f + (a0 - 1.f) * ka0), km1 = k * (1.f + (a1 - 1.f) * ka1);
                const float bon = wave_sum(rr * (km0 + km1) * rk);
                GATE[o] = (bf16_t)f2bf(gt[r]); BV[o] = (bf16_t)f2bf(bon * v);
            }
        }
    }
}


constexpr int ZS_TOKB = 400, ZS_ROWB = 66 * ZS_TOKB, ZS_BYTES = 3 * ZS_ROWB;
constexpr int XS_OFF = ZS_BYTES, XS_ARR = 64 * 144, XSG_OFF = XS_OFF + 4 * XS_ARR, XSG_PITCH = 272, BON_OFF = XSG_OFF + 64 * XSG_PITCH;
constexpr int CWL_OFF = BON_OFF + 1024;
static_assert(CWL_OFF + 6912 <= LDS_MISC, "prep LDS");
struct PrepLd { u32x4 zv[9]; u32x4 hv; u32x4 xv[6]; };
DI void prep_issue(PrepLd& L, const bf16_t* Z, int item, int tidv) {
    const int h = item & 7, ck = item >> 3; const bool lat = ck < 512;
    const int b = lat ? ck >> 7 : (ck - 512) >> 2, c = lat ? ck & 127 : (ck - 512) & 3;
    const int rowbase = lat ? b * SEQ + c * 64 : NT + b * CTXL + c * 64;
    const int q8 = tidv & 7, tsl = tidv >> 3;
    const bf16_t* zc = Z + (size_t)(rowbase + tsl) * DINP + 64 * h + 8 * q8;
#pragma unroll
    for (int rr = 0; rr < 3; ++rr) {
        const bool ok = lat ? (c + rr - 1 >= 0 && c + rr - 1 < 128) : (rr == 1);
        const bf16_t* zr = ok ? zc + (long)(rr - 1) * 64 * DINP : zc;
#pragma unroll
        for (int sec = 0; sec < 3; ++sec) { const u32x4 v = *(const u32x4*)(zr + sec * 512); L.zv[rr * 3 + sec] = ok ? v : (u32x4){0u, 0u, 0u, 0u}; }
    }
    {
      const int hq8 = tidv & 7, hsec = (tidv >> 3) % 3, hside = (tidv >> 3) / 3 & 1, hrr = (tidv >> 3) / 6;
      const int tx = c * 64 + (hside ? 64 : -1);
      const bool ok = !lat && tidv < 144 && hrr == 1 && tx >= 0 && tx < CTXL;
      const size_t off = ok ? (size_t)(NT + b * CTXL + tx) * DINP + hsec * 512 + 64 * h + 8 * hq8 : 0;
      const u32x4 v = *(const u32x4*)(Z + off); L.hv = ok ? v : (u32x4){0u, 0u, 0u, 0u}; }
    const bf16_t* zx = Z + (size_t)(rowbase + tsl) * DINP + OFF_WD + 8 * q8;
#pragma unroll
    for (int it = 0; it < 6; ++it) L.xv[it] = *(const u32x4*)(zx + 64 * it);
}
DI void phase_prep2(const Params& p, const Ctx& F) {
    const bf16_t* Z = (const bf16_t*)(p.ws + WS_Z);
    bf16_t* Kc = (bf16_t*)(p.ws + WS_KC); bf16_t* Vc = (bf16_t*)(p.ws + WS_VC); bf16_t* Rc = (bf16_t*)(p.ws + WS_RC);
    bf16_t* A0 = (bf16_t*)(p.ws + WS_A0); bf16_t* A1 = (bf16_t*)(p.ws + WS_A1); bf16_t* L0 = (bf16_t*)(p.ws + WS_L0); bf16_t* L1 = (bf16_t*)(p.ws + WS_L1);
    bf16_t* GATE = (bf16_t*)((unsigned char*)p.out + DO_GATE); bf16_t* BV = (bf16_t*)((unsigned char*)p.out + DO_BV);
    const bf16_t* DupT = (const bf16_t*)(p.ws + WS_DUPT); const bf16_t* AupT = (const bf16_t*)(p.ws + WS_AUPT); const bf16_t* GupT = (const bf16_t*)(p.ws + WS_GUPT);
    const float* cw2 = (const float*)(p.ws + WS_CONVW);
    LAS unsigned char* ZS = F.lds; LAS float* BON = (LAS float*)(F.lds + BON_OFF);
    const int w = F.wave, fr0 = F.lane & 15, fq0 = F.lane >> 4, ct = w >> 1, tt0 = 2 * (w & 1);
    constexpr int NITEM = 528 * 8;
    const bool xmap = (F.G == 256);
    auto item_of = [&](int i) -> int { if (!xmap) { const int it = F.bid + i * F.G; return it < NITEM ? it : -1; }
        const int x = F.bid & 7, y = F.bid >> 3, j = y + 32 * i; return j < 528 ? (x * 66 + (j >> 3)) * 8 + (j & 7) : -1; };
    PrepLd L;
    bf16x8 wf[4][2], gf[4]; f32x4 w00, w01, a00, a01, ka0, ka1, rk; int hcur = -1;
    int itx = 0, item = item_of(0);
    if (item >= 0) prep_issue(L, Z, item, F.tid);
    for (; item >= 0; ) {
        const int item_next = item_of(++itx);
        const int h = item & 7, ck = item >> 3;
        const bool lat = ck < 512;
        const int b = lat ? ck >> 7 : (ck - 512) >> 2, c = lat ? ck & 127 : (ck - 512) & 3;
        const int rowbase = lat ? b * SEQ + c * 64 : NT + b * CTXL + c * 64;
        const int tidv = F.tid; int fr = fr0, fq = fq0; asm volatile("" : "+v"(fr), "+v"(fq));
        __syncthreads();
        { const int q8 = tidv & 7, tsl = tidv >> 3;
#pragma unroll
          for (int rr = 0; rr < 3; ++rr)
#pragma unroll
              for (int sec = 0; sec < 3; ++sec) *(LAS u32x4*)(ZS + rr * ZS_ROWB + (tsl + 1) * ZS_TOKB + sec * 128 + q8 * 16) = L.zv[rr * 3 + sec];
          if (tidv < 144) { const int hsec = (tidv >> 3) % 3, hside = (tidv >> 3) / 3 & 1, hrr = (tidv >> 3) / 6;
              *(LAS u32x4*)(ZS + hrr * ZS_ROWB + (hside ? 65 : 0) * ZS_TOKB + hsec * 128 + q8 * 16) = L.hv; }
#pragma unroll
          for (int it = 0; it < 6; ++it) {
              const u32x4 o = L.xv[it];
              if (it < 4) *(LAS u32x4*)(F.lds + XS_OFF + it * XS_ARR + tsl * 144 + q8 * 16) = o;
              else *(LAS u32x4*)(F.lds + XSG_OFF + tsl * XSG_PITCH + ((it - 4) * 8 + q8) * 16) = o; } }
        if (h != hcur) {
            hcur = h;
            const int chrow = 64 * h + 16 * ct + fr, gch0 = 64 * h + 16 * ct + 4 * fq;
#pragma unroll
            for (int q = 0; q < 4; ++q) { const bf16_t* WT = (q < 2 ? DupT : AupT) + ((size_t)(q & 1) * 512 + chrow) * 64;
#pragma unroll
                for (int s2 = 0; s2 < 2; ++s2) wf[q][s2] = *(const bf16x8*)(WT + 32 * s2 + 8 * fq); }
#pragma unroll
            for (int s2 = 0; s2 < 4; ++s2) gf[s2] = *(const bf16x8*)(GupT + (size_t)chrow * 128 + 32 * s2 + 8 * fq);
            w00 = *(const f32x4*)(p.in[I_DW0] + gch0); w01 = *(const f32x4*)(p.in[I_DW0] + 512 + gch0); a00 = *(const f32x4*)(p.in[I_A0] + gch0); a01 = *(const f32x4*)(p.in[I_A0] + 512 + gch0);
            ka0 = *(const f32x4*)(p.in[I_KA] + gch0); ka1 = *(const f32x4*)(p.in[I_KA] + 512 + gch0); rk = *(const f32x4*)(p.in[I_RK] + gch0);
            if (tidv < 432) { const f32x4 wv4 = *(const f32x4*)(cw2 + (size_t)h * 16 * 108 + tidv * 4); u32x2 hw; hw.x = pkh2(wv4[0], wv4[1]); hw.y = pkh2(wv4[2], wv4[3]); *(LAS u32x2*)(F.lds + CWL_OFF + tidv * 8) = hw; }
        }
        if (item_next >= 0) prep_issue(L, Z, item_next, tidv);
        const int gch = 64 * h + 16 * ct + 4 * fq;
        const LAS h4_t* cwl = (const LAS h4_t*)(F.lds + CWL_OFF) + (4 * ct + fq) * 27;
        __syncthreads();
        f32x4 vkeep[2];
#pragma unroll
        for (int t2 = 0; t2 < 2; ++t2) {
            const int tok = 16 * (tt0 + t2) + fr;
            f32x4 acc[5];
#pragma unroll
            for (int q = 0; q < 5; ++q) acc[q] = (f32x4){0.f, 0.f, 0.f, 0.f};
#pragma unroll
            for (int q = 0; q < 4; ++q) {
#pragma unroll
                for (int s2 = 0; s2 < 2; ++s2) { const bf16x8 bfr = *(const LAS bf16x8*)(F.lds + XS_OFF + q * XS_ARR + tok * 144 + (32 * s2 + 8 * fq) * 2);
                    acc[q] = __builtin_amdgcn_mfma_f32_16x16x32_bf16(wf[q][s2], bfr, acc[q], 0, 0, 0); }
            }
#pragma unroll
            for (int s2 = 0; s2 < 4; ++s2) { const bf16x8 bfr = *(const LAS bf16x8*)(F.lds + XSG_OFF + tok * XSG_PITCH + (32 * s2 + 8 * fq) * 2);
                acc[4] = __builtin_amdgcn_mfma_f32_16x16x32_bf16(gf[s2], bfr, acc[4], 0, 0, 0); }
            f32x4 cv[3];
            { h4_t hc[3];
#pragma unroll
              for (int s3 = 0; s3 < 3; ++s3) hc[s3] = (h4_t){(_Float16)0.f, (_Float16)0.f, (_Float16)0.f, (_Float16)0.f};
#pragma unroll
              for (int dy = 0; dy < 3; ++dy)
#pragma unroll
                  for (int dx = 0; dx < 3; ++dx) {
#pragma unroll
                      for (int s3 = 0; s3 < 3; ++s3) { const h4_t wv = cwl[(dy * 3 + dx) * 3 + s3];
                          const h4_t zz = *(const LAS h4_t*)(ZS + dy * ZS_ROWB + (tok + dx) * ZS_TOKB + s3 * 128 + (16 * ct + 4 * fq) * 2);
                          hc[s3] += zz * wv; }
                  }
#pragma unroll
              for (int s3 = 0; s3 < 3; ++s3) cv[s3] = (f32x4){(float)hc[s3][0], (float)hc[s3][1], (float)hc[s3][2], (float)hc[s3][3]}; }
            const size_t o = (size_t)(rowbase + tok) * 512 + gch;
            float lg0[4], lg1[4], a0[4], a1[4]; float bs = 0.f;
#pragma unroll
            for (int i = 0; i < 4; ++i) { const float wl0 = w00[i] + acc[0][i], wl1 = w01[i] + acc[1][i];
                lg0[i] = -0.6065306597f * sigmoidf_(wl0); lg1[i] = -0.6065306597f * sigmoidf_(wl1);
                a0[i] = sigmoidf_(a00[i] + acc[2][i]); a1[i] = sigmoidf_(a01[i] + acc[3][i]);
                const float k = cv[0][i]; const float km0 = k * (1.f + (a0[i] - 1.f) * ka0[i]), km1 = k * (1.f + (a1[i] - 1.f) * ka1[i]);
                bs += cv[2][i] * (km0 + km1) * rk[i]; }
            bs += __shfl_xor(bs, 16); bs += __shfl_xor(bs, 32);
            u32x2 wv2;
            wv2.x = pk2(cv[0][0], cv[0][1]); wv2.y = pk2(cv[0][2], cv[0][3]); *(u32x2*)(Kc + o) = wv2;
            wv2.x = pk2(cv[1][0], cv[1][1]); wv2.y = pk2(cv[1][2], cv[1][3]); *(u32x2*)(Vc + o) = wv2;
            wv2.x = pk2(cv[2][0], cv[2][1]); wv2.y = pk2(cv[2][2], cv[2][3]); *(u32x2*)(Rc + o) = wv2;
            wv2.x = pk2(a0[0], a0[1]); wv2.y = pk2(a0[2], a0[3]); *(u32x2*)(A0 + o) = wv2;
            wv2.x = pk2(a1[0], a1[1]); wv2.y = pk2(a1[2], a1[3]); *(u32x2*)(A1 + o) = wv2;
            wv2.x = pk2(lg0[0], lg0[1]); wv2.y = pk2(lg0[2], lg0[3]); *(u32x2*)(L0 + o) = wv2;
            wv2.x = pk2(lg1[0], lg1[1]); wv2.y = pk2(lg1[2], lg1[3]); *(u32x2*)(L1 + o) = wv2;
            if (lat) { wv2.x = pk2(acc[4][0], acc[4][1]); wv2.y = pk2(acc[4][2], acc[4][3]); *(u32x2*)(GATE + o) = wv2; }
            if (fq == 0) BON[tok * 4 + ct] = bs;
            if (t2 == 0) vkeep[0] = cv[1]; else vkeep[1] = cv[1];
        }
        __syncthreads();
        if (lat) {
#pragma unroll
            for (int t2 = 0; t2 < 2; ++t2) { const int tok = 16 * (tt0 + t2) + fr; const f32x4 bq = *(const LAS f32x4*)(BON + tok * 4); const float bon = (bq[0] + bq[1]) + (bq[2] + bq[3]);
                const size_t o = (size_t)(rowbase + tok) * 512 + gch;
                u32x2 wv2; wv2.x = pk2(bon * vkeep[t2][0], bon * vkeep[t2][1]); wv2.y = pk2(bon * vkeep[t2][2], bon * vkeep[t2][3]); *(u32x2*)(BV + o) = wv2; }
        }
        item = item_next;
    }
}

DI void phase_gmlp(const Params& p, const Ctx& F) {
    const bf16_t* Z = (const bf16_t*)(p.ws + WS_Z); const bf16_t* Wsp = (const bf16_t*)(p.ws + WS_WSP);
    bf16_t* MIXED = (bf16_t*)((unsigned char*)p.out + DO_MIXED);
    constexpr int LDV = 136;
    LAS bf16_t* vnT = (LAS bf16_t*)F.lds;
    LAS float* gu = (LAS float*)(F.lds + 17408);
    constexpr int LDG = 68;
    const int fr = F.lane & 15, fq = F.lane >> 4;
    for (int un = F.bid; un < 4 * 64 * 8; un += F.G) {
        const int g = un & 7, cc = (un >> 3) & 63, b = un >> 9;
        const size_t tok0 = (size_t)b * SEQ + cc * 128;
        __syncthreads();
        { const int pq = F.tid >> 2, seg = F.tid & 3;
          const bf16_t* zr = Z + (tok0 + pq) * DINP;
          const u32x4 ua = *(const u32x4*)(zr + OFF_U + 64 * g + 16 * seg), ub = *(const u32x4*)(zr + OFF_U + 64 * g + 16 * seg + 8);
          const u32x4 va = *(const u32x4*)(zr + OFF_VA + 64 * g + 16 * seg), vb = *(const u32x4*)(zr + OFF_VA + 64 * g + 16 * seg + 8);
          float u[16], v[16];
#pragma unroll
          for (int j = 0; j < 4; ++j) { u[2 * j] = bflo(ua[j]); u[2 * j + 1] = bfhi(ua[j]); u[8 + 2 * j] = bflo(ub[j]); u[8 + 2 * j + 1] = bfhi(ub[j]);
              v[2 * j] = bflo(va[j]); v[2 * j + 1] = bfhi(va[j]); v[8 + 2 * j] = bflo(vb[j]); v[8 + 2 * j + 1] = bfhi(vb[j]); }
          float s = 0.f;
#pragma unroll
          for (int j = 0; j < 16; ++j) s += v[j];
          s += __shfl_xor(s, 1); s += __shfl_xor(s, 2);
          const float mu = s * (1.f / 64.f); float q = 0.f;
#pragma unroll
          for (int j = 0; j < 16; ++j) { v[j] -= mu; q += v[j] * v[j]; }
          q += __shfl_xor(q, 1); q += __shfl_xor(q, 2);
          const float rstd = 1.f / sqrtf(q * (1.f / 64.f) + 1e-5f);
#pragma unroll
          for (int j = 0; j < 16; ++j) { const int ch = 16 * seg + j; const float vn = v[j] * rstd * p.in[I_GMLNG][64 * g + ch] + p.in[I_GMLNB][64 * g + ch];
              vnT[ch * LDV + pq] = (bf16_t)f2bf(vn); gu[pq * LDG + ch] = u[j]; }
        }
        __syncthreads();
        f32x4 acc[4];
#pragma unroll
        for (int n = 0; n < 4; ++n) acc[n] = (f32x4){0.f, 0.f, 0.f, 0.f};
        const int pp = 16 * F.wave + fr;
#pragma unroll
        for (int s = 0; s < 4; ++s) {
            const bf16x8 bfrag = *(const bf16x8*)(Wsp + ((size_t)(g * 128 + pp)) * 128 + 32 * s + 8 * fq);
#pragma unroll
            for (int n = 0; n < 4; ++n) { const bf16x8 afrag = *(const LAS bf16x8*)(vnT + (16 * n + fr) * LDV + 32 * s + 8 * fq);
                acc[n] = __builtin_amdgcn_mfma_f32_16x16x32_bf16(afrag, bfrag, acc[n], 0, 0, 0); }
        }
        const float bs = p.in[I_BSP][g * 128 + pp];
#pragma unroll
        for (int n = 0; n < 4; ++n) { const int d0 = 16 * n + 4 * fq; const f32x4 gv = *(const LAS f32x4*)(gu + pp * LDG + d0);
            const f32x4 o = gv * (acc[n] + bs);
            u32x2 w; w.x = pk2(o[0], o[1]); w.y = pk2(o[2], o[3]);
            *(u32x2*)(MIXED + (tok0 + pp) * D + 64 * g + d0) = w; }
    }
}

DI void phase_scan_seq(const Params& p, const Ctx& F) {
    const bf16_t* Kc = (const bf16_t*)(p.ws + WS_KC); const bf16_t* Vc = (const bf16_t*)(p.ws + WS_VC); const bf16_t* Rc = (const bf16_t*)(p.ws + WS_RC);
    float* YS = (float*)(p.ws + WS_YS);
    const int vrow = F.tid >> 3, q = F.tid & 7;
    for (int ch = F.bid; ch < 64; ch += F.G) {
        const int d = ch & 1, h = (ch >> 1) & 7, b = ch >> 4;
        const bf16_t* Ad = (const bf16_t*)(p.ws + (d ? WS_A1 : WS_A0)); const bf16_t* Ld = (const bf16_t*)(p.ws + (d ? WS_L1 : WS_L0));
        float kkw[8], kaw[8];
#pragma unroll
        for (int j = 0; j < 8; ++j) { kkw[j] = p.in[I_KK][64 * h + 8 * q + j]; kaw[j] = p.in[I_KA][d * 512 + 64 * h + 8 * q + j]; }
        float S[8];
#pragma unroll
        for (int j = 0; j < 8; ++j) S[j] = 0.f;
        const int TOT = CTXL + SEQ;
        for (int step = 0; step < TOT; ++step) {
            size_t row;
            if (step < CTXL) { const int tc = d ? (CTXL - 1 - step) : step; row = (size_t)NT + b * CTXL + tc; }
            else { const int tl = d ? (SEQ - 1 - (step - CTXL)) : (step - CTXL); row = (size_t)b * SEQ + tl; }
            const size_t o = row * 512 + 64 * h + 8 * q;
            const u32x4 kq = *(const u32x4*)(Kc + o), rq = *(const u32x4*)(Rc + o), aq = *(const u32x4*)(Ad + o), lq = *(const u32x4*)(Ld + o);
            const float vv = bf2f(Vc[row * 512 + 64 * h + vrow]);
            float k[8], r[8], a[8], l[8];
#pragma unroll
            for (int j = 0; j < 4; ++j) { k[2 * j] = bflo(kq[j]); k[2 * j + 1] = bfhi(kq[j]); r[2 * j] = bflo(rq[j]); r[2 * j + 1] = bfhi(rq[j]);
                a[2 * j] = bflo(aq[j]); a[2 * j + 1] = bfhi(aq[j]); l[2 * j] = bflo(lq[j]); l[2 * j + 1] = bfhi(lq[j]); }
            float kk[8], ss = 0.f;
#pragma unroll
            for (int j = 0; j < 8; ++j) { kk[j] = k[j] * kkw[j]; ss += kk[j] * kk[j]; }
            ss += __shfl_xor(ss, 1); ss += __shfl_xor(ss, 2); ss += __shfl_xor(ss, 4);
            const float rn = 1.f / sqrtf(fmaxf(ss, 1e-24f));
            float dot = 0.f;
#pragma unroll
            for (int j = 0; j < 8; ++j) { kk[j] *= rn; dot += S[j] * kk[j]; }
            dot += __shfl_xor(dot, 1); dot += __shfl_xor(dot, 2); dot += __shfl_xor(dot, 4);
            float y = 0.f;
#pragma unroll
            for (int j = 0; j < 8; ++j) { const float w = __expf(l[j]); const float km = k[j] * (1.f + (a[j] - 1.f) * kaw[j]);
                S[j] = S[j] * w - dot * (kk[j] * a[j]) + vv * km; y += S[j] * r[j]; }
            y += __shfl_xor(y, 1); y += __shfl_xor(y, 2); y += __shfl_xor(y, 4);
            if (step >= CTXL && q == 0) YS[((size_t)d * NT + row) * 512 + 64 * h + vrow] = y;
        }
    }
}


constexpr int LDP = 72;
constexpr int SLOTB = 64 * LDP * 2;
constexpr int CP_CUM = 12 * SLOTB, CP_TOT = CP_CUM + 16384, CP_ADIAG = CP_TOT + 2048, CP_GC = CP_ADIAG + 4096;

DI void mm64(f32x4 (&acc)[2], const LAS bf16_t* P, const LAS bf16_t* Q, int r0, int c0, int fr, int fq) {
#pragma unroll
    for (int s = 0; s < 2; ++s) { const bf16x8 b = *(const LAS bf16x8*)(Q + (c0 + fr) * LDP + 32 * s + 8 * fq);
#pragma unroll
        for (int m = 0; m < 2; ++m) { const bf16x8 a = *(const LAS bf16x8*)(P + (r0 + 16 * m + fr) * LDP + 32 * s + 8 * fq);
            acc[m] = __builtin_amdgcn_mfma_f32_16x16x32_bf16(a, b, acc[m], 0, 0, 0); } }
}
DI void zero2(f32x4 (&a)[2]) { a[0] = (f32x4){0.f, 0.f, 0.f, 0.f}; a[1] = a[0]; }
DI void writeT(LAS bf16_t* dst, const f32x4 (&acc)[2], int r0, int c0, int fr, int fq) {
#pragma unroll
    for (int m = 0; m < 2; ++m) { u32x2 w; w.x = pk2(acc[m][0], acc[m][1]); w.y = pk2(acc[m][2], acc[m][3]); *(LAS u32x2*)(dst + (c0 + fr) * LDP + r0 + 16 * m + 4 * fq) = w; }
}
DI void writeN(LAS bf16_t* dst, const f32x4 (&acc)[2], int r0, int c0, int fr, int fq) {
#pragma unroll
    for (int m = 0; m < 2; ++m)
#pragma unroll
        for (int i = 0; i < 4; ++i) dst[(r0 + 16 * m + 4 * fq + i) * LDP + c0 + fr] = (bf16_t)f2bf(acc[m][i]);
}
DI size_t chunk_row(int d, int b, int pc, int pp) {
    const int base = pc < 4 ? NT + b * CTXL : b * SEQ, len = pc < 4 ? CTXL : SEQ, q = 64 * (pc < 4 ? pc : pc - 4) + pp;
    return (size_t)(d ? base + len - 1 - q : base + q);
}

DI void phase_chunkprep(const Params& p, const Ctx& F) {
    const bf16_t* Kc = (const bf16_t*)(p.ws + WS_KC); const bf16_t* Vc = (const bf16_t*)(p.ws + WS_VC); const bf16_t* Rc = (const bf16_t*)(p.ws + WS_RC);
    unsigned char* OPS = p.ws + WS_OPS;
    LAS bf16_t* SL[12];
#pragma unroll
    for (int i = 0; i < 12; ++i) SL[i] = (LAS bf16_t*)(F.lds + i * SLOTB);
    LAS float* CUM = (LAS float*)(F.lds + CP_CUM); LAS float* TOT = (LAS float*)(F.lds + CP_TOT); LAS float* ADIAG = (LAS float*)(F.lds + CP_ADIAG); LAS float* GC = (LAS float*)(F.lds + CP_GC);
    const int w = F.wave, fr = F.lane & 15, fq = F.lane >> 4, r0 = 32 * (w >> 2), c0 = 16 * (w & 3);
    const int pp = F.tid >> 3, cg8 = F.tid & 7;
    const bool fixedmap = (F.G == 256);
    auto unit_of = [&](int i) -> int { if (fixedmap) return i < 33 ? (F.bid >> 2) * 132 + (F.bid & 3) * 33 + i : -1; const int u = F.bid + i * F.G; return u < 2 * 32 * 132 ? u : -1; };
    struct RawLd { u32x4 kq, vq, rq, aq, lq; };
    auto raw_issue = [&](RawLd& R, int unit) { const int d = unit / (32 * 132), chain = (unit / 132) & 31, pc = unit % 132, b = chain >> 3, h = chain & 7;
        const size_t o = chunk_row(d, b, pc, pp) * 512 + 64 * h + 8 * cg8;
        R.kq = *(const u32x4*)(Kc + o); R.vq = *(const u32x4*)(Vc + o); R.rq = *(const u32x4*)(Rc + o);
        R.aq = *(const u32x4*)((const bf16_t*)(p.ws + (d ? WS_A1 : WS_A0)) + o); R.lq = *(const u32x4*)((const bf16_t*)(p.ws + (d ? WS_L1 : WS_L0)) + o); };
    RawLd R;
    float kkw[8], kaw[8]; int hdcur = -1;
    int uix = 0, unit = unit_of(0);
    if (unit >= 0) raw_issue(R, unit);
    for (; unit >= 0; ) {
        const int unit_next = unit_of(++uix);
        const int d = unit / (32 * 132), chain = (unit / 132) & 31, pc = unit % 132, b = chain >> 3, h = chain & 7;
        if (d * 8 + h != hdcur) { hdcur = d * 8 + h;
#pragma unroll
            for (int j = 0; j < 8; ++j) { kkw[j] = p.in[I_KK][64 * h + 8 * cg8 + j]; kaw[j] = p.in[I_KA][d * 512 + 64 * h + 8 * cg8 + j]; } }
        __syncthreads();
        float kk[8], km[8], ka[8], vv[8], rr[8], ll[8];
        { float k[8], a[8]; float ss = 0.f;
#pragma unroll
          for (int j = 0; j < 4; ++j) { k[2 * j] = bflo(R.kq[j]); k[2 * j + 1] = bfhi(R.kq[j]); vv[2 * j] = bflo(R.vq[j]); vv[2 * j + 1] = bfhi(R.vq[j]); rr[2 * j] = bflo(R.rq[j]); rr[2 * j + 1] = bfhi(R.rq[j]);
              a[2 * j] = bflo(R.aq[j]); a[2 * j + 1] = bfhi(R.aq[j]); ll[2 * j] = bflo(R.lq[j]); ll[2 * j + 1] = bfhi(R.lq[j]); }
          if (unit_next >= 0) raw_issue(R, unit_next);
#pragma unroll
          for (int j = 0; j < 8; ++j) { kk[j] = k[j] * kkw[j]; ss += kk[j] * kk[j]; }
          ss += __shfl_xor(ss, 1); ss += __shfl_xor(ss, 2); ss += __shfl_xor(ss, 4);
          const float rn = 1.f / sqrtf(fmaxf(ss, 1e-24f));
#pragma unroll
          for (int j = 0; j < 8; ++j) { kk[j] *= rn; km[j] = k[j] * (1.f + (a[j] - 1.f) * kaw[j]); ka[j] = kk[j] * a[j]; }
          *(LAS f32x4*)(CUM + pp * 64 + 8 * cg8) = (f32x4){ll[0], ll[1], ll[2], ll[3]}; *(LAS f32x4*)(CUM + pp * 64 + 8 * cg8 + 4) = (f32x4){ll[4], ll[5], ll[6], ll[7]}; }
        for (int i = F.tid; i < 2 * SLOTB / 4; i += NTHREADS) ((LAS unsigned*)(F.lds + 9 * SLOTB))[i] = 0u;
        __syncthreads();
        { const int ch = F.tid & 63, seg = F.tid >> 6; float run = 0.f;
#pragma unroll
          for (int i = 0; i < 8; ++i) { run += CUM[(8 * seg + i) * 64 + ch]; CUM[(8 * seg + i) * 64 + ch] = run; }
          TOT[seg * 64 + ch] = run; }
        __syncthreads();
        { const int ch = F.tid & 63, seg = F.tid >> 6; float off = 0.f;
          for (int s2 = 0; s2 < seg; ++s2) off += TOT[s2 * 64 + ch];
#pragma unroll
          for (int i = 0; i < 8; ++i) CUM[(8 * seg + i) * 64 + ch] += off;
          if (seg == 7) GC[ch] = off + TOT[7 * 64 + ch]; }
        __syncthreads();
        { float g[8], gc[8];
          { const f32x4 g0 = *(const LAS f32x4*)(CUM + pp * 64 + 8 * cg8), g1 = *(const LAS f32x4*)(CUM + pp * 64 + 8 * cg8 + 4);
            const f32x4 c0v = *(const LAS f32x4*)(GC + 8 * cg8), c1v = *(const LAS f32x4*)(GC + 8 * cg8 + 4);
#pragma unroll
            for (int j = 0; j < 4; ++j) { g[j] = g0[j]; g[4 + j] = g1[j]; gc[j] = c0v[j]; gc[4 + j] = c1v[j]; } }
          float kkg[8], rg[8], ki[8], kai[8], kd[8], kad[8];
#pragma unroll
          for (int j = 0; j < 8; ++j) { const float eg = __expf(g[j]), egp = __expf(g[j] - ll[j]), eng = __expf(-g[j]), ecg = __expf(gc[j] - g[j]);
              kkg[j] = kk[j] * egp; rg[j] = rr[j] * eg; ki[j] = km[j] * eng; kai[j] = ka[j] * eng; kd[j] = km[j] * ecg; kad[j] = ka[j] * ecg; }
          u32x4 w4;
          w4 = (u32x4){pk2(kkg[0], kkg[1]), pk2(kkg[2], kkg[3]), pk2(kkg[4], kkg[5]), pk2(kkg[6], kkg[7])}; *(LAS u32x4*)(SL[0] + pp * LDP + 8 * cg8) = w4;
          w4 = (u32x4){pk2(rg[0], rg[1]), pk2(rg[2], rg[3]), pk2(rg[4], rg[5]), pk2(rg[6], rg[7])}; *(LAS u32x4*)(SL[1] + pp * LDP + 8 * cg8) = w4;
          w4 = (u32x4){pk2(ki[0], ki[1]), pk2(ki[2], ki[3]), pk2(ki[4], ki[5]), pk2(ki[6], ki[7])}; *(LAS u32x4*)(SL[2] + pp * LDP + 8 * cg8) = w4;
          w4 = (u32x4){pk2(kai[0], kai[1]), pk2(kai[2], kai[3]), pk2(kai[4], kai[5]), pk2(kai[6], kai[7])}; *(LAS u32x4*)(SL[3] + pp * LDP + 8 * cg8) = w4;
#pragma unroll
          for (int j = 0; j < 8; ++j) { const int ch = 8 * cg8 + j;
              SL[4][ch * LDP + pp] = (bf16_t)f2bf(kkg[j]); SL[5][ch * LDP + pp] = (bf16_t)f2bf(vv[j]); SL[6][ch * LDP + pp] = (bf16_t)f2bf(kd[j]); SL[7][ch * LDP + pp] = (bf16_t)f2bf(kad[j]); } }
        __syncthreads();
        { f32x4 aAk[2], aAa[2], aBk[2], aBa[2]; zero2(aAk); zero2(aAa); zero2(aBk); zero2(aBa);
          mm64(aAk, SL[2], SL[0], r0, c0, fr, fq);
          mm64(aAa, SL[0], SL[3], r0, c0, fr, fq);
          mm64(aBk, SL[2], SL[1], r0, c0, fr, fq);
          mm64(aBa, SL[3], SL[1], r0, c0, fr, fq);
          __syncthreads();
          const int tcol = c0 + fr;
#pragma unroll
          for (int m = 0; m < 2; ++m)
#pragma unroll
              for (int i = 0; i < 4; ++i) { const int jr = r0 + 16 * m + 4 * fq + i;
                  aAk[m][i] = jr < tcol ? aAk[m][i] : 0.f; aBk[m][i] = jr <= tcol ? aBk[m][i] : 0.f; aBa[m][i] = jr <= tcol ? aBa[m][i] : 0.f; }
          writeT(SL[0], aAk, r0, c0, fr, fq); writeT(SL[8], aBk, r0, c0, fr, fq); writeT(SL[2], aBa, r0, c0, fr, fq);
          const int jb = w & 3;
#pragma unroll
          for (int m = 0; m < 2; ++m) { const int tb = 2 * (w >> 2) + m;
              if (tb == jb) {
#pragma unroll
                  for (int i = 0; i < 4; ++i) ADIAG[tb * 256 + (4 * fq + i) * 16 + fr] = (fr < 4 * fq + i) ? aAa[m][i] : 0.f; }
#pragma unroll
              for (int i = 0; i < 4; ++i) aAa[m][i] = tb > jb ? aAa[m][i] : 0.f; }
          writeT(SL[3], aAa, r0, c0, fr, fq);
        }
        __syncthreads();
        if (F.tid < 64) { const int blk = F.tid >> 4, c = F.tid & 15; const LAS float* A = ADIAG + blk * 256; float x[16];
#pragma unroll
            for (int r = 0; r < 16; ++r) { float sa = (r == c) ? 1.f : 0.f;
#pragma unroll
                for (int j = 0; j < r; ++j) sa -= A[r * 16 + j] * x[j];
                x[r] = sa; }
#pragma unroll
            for (int r = 0; r < 16; ++r) SL[9][(16 * blk + r) * LDP + 16 * blk + c] = (bf16_t)f2bf(x[r]);
            u32x4 lo = (u32x4){pk2(x[0], x[1]), pk2(x[2], x[3]), pk2(x[4], x[5]), pk2(x[6], x[7])}, hi = (u32x4){pk2(x[8], x[9]), pk2(x[10], x[11]), pk2(x[12], x[13]), pk2(x[14], x[15])};
            *(LAS u32x4*)(SL[10] + (16 * blk + c) * LDP + 16 * blk) = lo; *(LAS u32x4*)(SL[10] + (16 * blk + c) * LDP + 16 * blk + 8) = hi; }
        __syncthreads();
        f32x4 a1[2], a2[2], a3[2];
        zero2(a1); mm64(a1, SL[3], SL[9], r0, c0, fr, fq);
        __syncthreads();
        writeT(SL[11], a1, r0, c0, fr, fq);
        writeN(SL[3], a1, r0, c0, fr, fq);
        __syncthreads();
        zero2(a2); mm64(a2, SL[11], SL[3], r0, c0, fr, fq);
#pragma unroll
        for (int m = 0; m < 2; ++m)
#pragma unroll
            for (int i = 0; i < 4; ++i) a2[m][i] += (r0 + 16 * m + 4 * fq + i == c0 + fr) ? 1.f : 0.f;
        writeT(SL[9], a2, r0, c0, fr, fq);
        __syncthreads();
        zero2(a3); mm64(a3, SL[11], SL[9], r0, c0, fr, fq);
        a3[0] = a2[0] - a3[0]; a3[1] = a2[1] - a3[1];
        writeN(SL[3], a3, r0, c0, fr, fq);
        __syncthreads();
        zero2(a1); mm64(a1, SL[3], SL[10], r0, c0, fr, fq);
        zero2(a2); mm64(a2, SL[0], SL[5], r0, c0, fr, fq);
        writeN(SL[9], a1, r0, c0, fr, fq); writeT(SL[11], a2, r0, c0, fr, fq);
        __syncthreads();
        zero2(a1); mm64(a1, SL[9], SL[4], r0, c0, fr, fq);
        zero2(a2); mm64(a2, SL[9], SL[11], r0, c0, fr, fq);
        writeT(SL[3], a1, r0, c0, fr, fq); writeT(SL[10], a2, r0, c0, fr, fq);
        __syncthreads();
        unsigned char* ob = OPS + ((size_t)(d * 32 + chain) * 132 + pc) * 32768;
        const int fragoff = (((w & 3) * 2 + (w >> 2)) * 64 + F.lane) * 16;
        {
          zero2(a1); mm64(a1, SL[3], SL[2], r0, c0, fr, fq);
          u32x4 o;
#pragma unroll
          for (int m = 0; m < 2; ++m) { const u32x2 rgv = *(const LAS u32x2*)(SL[1] + (c0 + fr) * LDP + r0 + 16 * m + 4 * fq);
              const float q0 = bflo(rgv.x) - a1[m][0], q1 = bfhi(rgv.x) - a1[m][1], q2 = bflo(rgv.y) - a1[m][2], q3 = bfhi(rgv.y) - a1[m][3];
              o[2 * m] = pk2(q0, q1); o[2 * m + 1] = pk2(q2, q3); }
          *(u32x4*)(ob + fragoff) = o; }
        {
          zero2(a1); mm64(a1, SL[3], SL[7], r0, c0, fr, fq);
          const float gcv = __expf(GC[c0 + fr]); u32x4 o;
#pragma unroll
          for (int m = 0; m < 2; ++m) { float q[4];
#pragma unroll
              for (int i = 0; i < 4; ++i) q[i] = ((r0 + 16 * m + 4 * fq + i == c0 + fr) ? gcv : 0.f) - a1[m][i];
              o[2 * m] = pk2(q[0], q[1]); o[2 * m + 1] = pk2(q[2], q[3]); }
          *(u32x4*)(ob + 8192 + fragoff) = o; }
        {
          zero2(a1); mm64(a1, SL[8], SL[5], r0, c0, fr, fq); zero2(a2); mm64(a2, SL[2], SL[10], r0, c0, fr, fq);
#pragma unroll
          for (int m = 0; m < 2; ++m) { const f32x4 q = a1[m] - a2[m]; u32x2 o; o.x = pk2(q[0], q[1]); o.y = pk2(q[2], q[3]);
              *(u32x2*)(ob + 16384 + (((w & 3) * 4 + 2 * (w >> 2) + m) * 64 + F.lane) * 8) = o; } }
        {
          zero2(a1); mm64(a1, SL[6], SL[5], r0, c0, fr, fq); zero2(a2); mm64(a2, SL[7], SL[10], r0, c0, fr, fq);
#pragma unroll
          for (int m = 0; m < 2; ++m) { const f32x4 q = a1[m] - a2[m]; u32x2 o; o.x = pk2(q[0], q[1]); o.y = pk2(q[2], q[3]);
              *(u32x2*)(ob + 24576 + (((w & 3) * 4 + 2 * (w >> 2) + m) * 64 + F.lane) * 8) = o; } }
        unit = unit_next;
    }
}


typedef short s16x4v __attribute__((ext_vector_type(4)));
DI f32x4 mfma16(s16x4v a, s16x4v b, f32x4 c) { return __builtin_amdgcn_mfma_f32_16x16x16bf16_1k(a, b, c, 0, 0, 0); }
DI s16x4v pack4(const f32x4& v) { u32x2 t; t.x = pk2(v[0], v[1]); t.y = pk2(v[2], v[3]); return __builtin_bit_cast(s16x4v, t); }
DI void slab64(f32x4 (&acc)[4], const LAS bf16_t* P, const LAS bf16_t* Q, int s4, int fr, int fq) {
#pragma unroll
    for (int s2 = 0; s2 < 2; ++s2) { const bf16x8 b = *(const LAS bf16x8*)(Q + (16 * s4 + fr) * LDP + 32 * s2 + 8 * fq);
#pragma unroll
        for (int m = 0; m < 4; ++m) { const bf16x8 a = *(const LAS bf16x8*)(P + (16 * m + fr) * LDP + 32 * s2 + 8 * fq);
            acc[m] = __builtin_amdgcn_mfma_f32_16x16x32_bf16(a, b, acc[m], 0, 0, 0); } }
}
constexpr int C2_NORM = 12 * SLOTB, C2_GC = C2_NORM + 4096, C2_ADIAG = C2_GC + 512, C2_DINV = C2_ADIAG + 4096;
static_assert(C2_DINV + 2048 <= LDS_MISC, "chunkprep2 LDS");
DI void phase_chunkprep2(const Params& p, const Ctx& F) {
    const bf16_t* Kc = (const bf16_t*)(p.ws + WS_KC); const bf16_t* Vc = (const bf16_t*)(p.ws + WS_VC); const bf16_t* Rc = (const bf16_t*)(p.ws + WS_RC);
    unsigned char* OPS = p.ws + WS_OPS;
    LAS bf16_t* SL[12];
#pragma unroll
    for (int i = 0; i < 12; ++i) SL[i] = (LAS bf16_t*)(F.lds + i * SLOTB);
    LAS float* ADIAG = (LAS float*)(F.lds + C2_ADIAG); LAS bf16_t* DINV = (LAS bf16_t*)(F.lds + C2_DINV);
    const int w = F.wave, s4 = w & 3, g2 = w >> 2;
    const bool fixedmap = (F.G == 256);
    auto unit_of = [&](int i) -> int { if (fixedmap) return i < 33 ? (F.bid >> 2) * 132 + (F.bid & 3) * 33 + i : -1; const int u = F.bid + i * F.G; return u < 2 * 32 * 132 ? u : -1; };
    struct RawLd { u32x4 kq, vq, rq, aq, lq; };
    auto raw_issue = [&](RawLd& R, int unit, int lane) { const int d = unit / (32 * 132), chain = (unit / 132) & 31, pc = unit % 132, b = chain >> 3, h = chain & 7;
        const size_t o = chunk_row(d, b, pc, lane) * 512 + 64 * h + 8 * w;
        R.kq = *(const u32x4*)(Kc + o); R.vq = *(const u32x4*)(Vc + o); R.rq = *(const u32x4*)(Rc + o);
        R.aq = *(const u32x4*)((const bf16_t*)(p.ws + (d ? WS_A1 : WS_A0)) + o); R.lq = *(const u32x4*)((const bf16_t*)(p.ws + (d ? WS_L1 : WS_L0)) + o); };
    RawLd R;
    float kkw[8], kaw[8]; int hdcur = -1;
    int uix = 0, unit = unit_of(0);
    if (unit >= 0) raw_issue(R, unit, F.lane);
    for (; unit >= 0; ) {
        const int unit_next = unit_of(++uix);
        const int d = unit / (32 * 132), chain = (unit / 132) & 31, pc = unit % 132, h = chain & 7;
        if (d * 8 + h != hdcur) { hdcur = d * 8 + h;
#pragma unroll
            for (int j = 0; j < 8; ++j) { kkw[j] = p.in[I_KK][64 * h + 8 * w + j]; kaw[j] = p.in[I_KA][d * 512 + 64 * h + 8 * w + j]; } }
        int lane = F.lane; asm volatile("" : "+v"(lane));
        const int fr = lane & 15, fq = lane >> 4, pp = lane;
        LAS float* NORM = (LAS float*)(F.lds + C2_NORM) + (uix & 1) * 512; LAS float* GC = (LAS float*)(F.lds + C2_GC) + (uix & 1) * 64;
        float k[8], a[8], rr[8], ll[8], kk[8]; const u32x4 R0v = R.vq;
        { float ss = 0.f;
#pragma unroll
          for (int j = 0; j < 4; ++j) { k[2 * j] = bflo(R.kq[j]); k[2 * j + 1] = bfhi(R.kq[j]); rr[2 * j] = bflo(R.rq[j]); rr[2 * j + 1] = bfhi(R.rq[j]);
              a[2 * j] = bflo(R.aq[j]); a[2 * j + 1] = bfhi(R.aq[j]); ll[2 * j] = bflo(R.lq[j]); ll[2 * j + 1] = bfhi(R.lq[j]); }
          if (unit_next >= 0) raw_issue(R, unit_next, lane);
#pragma unroll
          for (int j = 0; j < 8; ++j) { kk[j] = k[j] * kkw[j]; ss += kk[j] * kk[j]; }
          NORM[w * 64 + pp] = ss; }
        float g[8], gc[8];
#pragma unroll
        for (int j = 0; j < 8; ++j) { g[j] = wave_scan_incl(ll[j]); gc[j] = lane63(g[j]); }
        if (lane == 0) { *(LAS f32x4*)(GC + 8 * w) = (f32x4){__expf(gc[0]), __expf(gc[1]), __expf(gc[2]), __expf(gc[3])}; *(LAS f32x4*)(GC + 8 * w + 4) = (f32x4){__expf(gc[4]), __expf(gc[5]), __expf(gc[6]), __expf(gc[7])}; }
        __syncthreads();
        { float ss = 0.f;
#pragma unroll
          for (int q = 0; q < 8; ++q) ss += NORM[q * 64 + pp];
          const float rn = __builtin_amdgcn_rsqf(fmaxf(ss, 1e-24f));
          float kkg[8], rg[8], ki[8], kai[8];
#pragma unroll
          for (int j = 0; j < 8; ++j) { const float kkn = kk[j] * rn, km = k[j] * (1.f + (a[j] - 1.f) * kaw[j]), kan = kkn * a[j];
              const float eg = __expf(g[j]), egp = __expf(g[j] - ll[j]), eng = __expf(-g[j]);
              kkg[j] = kkn * egp; rg[j] = rr[j] * eg; ki[j] = km * eng; kai[j] = kan * eng; }
          const u32x4 wkkg = (u32x4){pk2(kkg[0], kkg[1]), pk2(kkg[2], kkg[3]), pk2(kkg[4], kkg[5]), pk2(kkg[6], kkg[7])};
          const u32x4 wki = (u32x4){pk2(ki[0], ki[1]), pk2(ki[2], ki[3]), pk2(ki[4], ki[5]), pk2(ki[6], ki[7])};
          const u32x4 wkai = (u32x4){pk2(kai[0], kai[1]), pk2(kai[2], kai[3]), pk2(kai[4], kai[5]), pk2(kai[6], kai[7])};
          *(LAS u32x4*)(SL[0] + pp * LDP + 8 * w) = wkkg;
          *(LAS u32x4*)(SL[1] + pp * LDP + 8 * w) = (u32x4){pk2(rg[0], rg[1]), pk2(rg[2], rg[3]), pk2(rg[4], rg[5]), pk2(rg[6], rg[7])};
          *(LAS u32x4*)(SL[2] + pp * LDP + 8 * w) = wki;
          *(LAS u32x4*)(SL[3] + pp * LDP + 8 * w) = wkai;
#pragma unroll
          for (int j = 0; j < 8; ++j) { const int ch = 8 * w + j;
              SL[4][ch * LDP + pp] = (bf16_t)((j & 1) ? wkkg[j >> 1] >> 16 : wkkg[j >> 1]); SL[5][ch * LDP + pp] = (bf16_t)((j & 1) ? R0v[j >> 1] >> 16 : R0v[j >> 1]);
              SL[6][ch * LDP + pp] = (bf16_t)((j & 1) ? wki[j >> 1] >> 16 : wki[j >> 1]); SL[7][ch * LDP + pp] = (bf16_t)((j & 1) ? wkai[j >> 1] >> 16 : wkai[j >> 1]); } }
        __syncthreads();
        { f32x4 accA[4], accK[4];
#pragma unroll
          for (int m = 0; m < 4; ++m) { accA[m] = (f32x4){0.f, 0.f, 0.f, 0.f}; accK[m] = accA[m]; }
          const LAS bf16_t* Qop = g2 == 0 ? SL[0] : SL[1];
          slab64(accA, SL[3], Qop, s4, fr, fq);
          slab64(accK, SL[2], Qop, s4, fr, fq);
          const int tcol = 16 * s4 + fr;
#pragma unroll
          for (int m = 0; m < 4; ++m) {
              if (m > s4) { accA[m] = (f32x4){0.f, 0.f, 0.f, 0.f}; accK[m] = accA[m]; }
              else if (m == s4) {
#pragma unroll
                  for (int i = 0; i < 4; ++i) { const int jl = 4 * fq + i; const bool keep = g2 == 0 ? jl < fr : jl <= fr; accA[m][i] = keep ? accA[m][i] : 0.f; accK[m][i] = keep ? accK[m][i] : 0.f; } }
              u32x2 wa, wk; wa.x = pk2(accA[m][0], accA[m][1]); wa.y = pk2(accA[m][2], accA[m][3]); wk.x = pk2(accK[m][0], accK[m][1]); wk.y = pk2(accK[m][2], accK[m][3]);
              *(LAS u32x2*)((g2 == 0 ? SL[9] : SL[8]) + tcol * LDP + 16 * m + 4 * fq) = wa;
              *(LAS u32x2*)((g2 == 0 ? SL[10] : SL[11]) + tcol * LDP + 16 * m + 4 * fq) = wk;
              if (g2 == 0 && m == s4) {
#pragma unroll
                  for (int i = 0; i < 4; ++i) ADIAG[s4 * 256 + fr * 16 + 4 * fq + i] = accA[m][i]; } } }
        __syncthreads();
        if (F.tid < 64) { const int blk = F.tid >> 4, c = F.tid & 15; const LAS float* A = ADIAG + blk * 256; float x[16];
            f32x4 Ar[16][4];
#pragma unroll
            for (int r = 1; r < 16; ++r)
#pragma unroll
                for (int q = 0; q < 4; ++q) if (4 * q < r) Ar[r][q] = *(const LAS f32x4*)(A + r * 16 + 4 * q);
#pragma unroll
            for (int r = 0; r < 16; ++r) { float sa = (r == c) ? 1.f : 0.f;
#pragma unroll
                for (int j = 0; j < r; ++j) sa -= Ar[r][j >> 2][j & 3] * x[j];
                x[r] = sa; }
#pragma unroll
            for (int r = 0; r < 16; ++r) DINV[(blk * 16 + r) * 16 + c] = (bf16_t)f2bf(x[r]); }
        f32x4 X[4];
        if (g2 == 0) {
#pragma unroll
            for (int m = 0; m < 4; ++m) { const u32x2 v2 = *(const LAS u32x2*)(SL[4] + (16 * s4 + fr) * LDP + 16 * m + 4 * fq); X[m] = (f32x4){bflo(v2.x), bfhi(v2.x), bflo(v2.y), bfhi(v2.y)}; }
        } else {
#pragma unroll
            for (int m = 0; m < 4; ++m) X[m] = (f32x4){0.f, 0.f, 0.f, 0.f};
            slab64(X, SL[10], SL[5], s4, fr, fq);
        }
        __syncthreads();
        s16x4v xb[4];
#pragma unroll
        for (int bi = 0; bi < 4; ++bi) {
            f32x4 sacc = (f32x4){0.f, 0.f, 0.f, 0.f};
#pragma unroll
            for (int bj = 0; bj < bi; ++bj) { const s16x4v af = *(const LAS s16x4v*)(SL[9] + (16 * bi + fr) * LDP + 16 * bj + 4 * fq); sacc = mfma16(af, xb[bj], sacc); }
            const f32x4 rhs = X[bi] - sacc;
            const s16x4v df = *(const LAS s16x4v*)(DINV + (bi * 16 + fr) * 16 + 4 * fq);
            X[bi] = mfma16(df, pack4(rhs), (f32x4){0.f, 0.f, 0.f, 0.f});
            xb[bi] = pack4(X[bi]);
        }
        unsigned char* ob = OPS + (size_t)unit * 32768;
        if (g2 == 0) {
#pragma unroll
            for (int mt = 0; mt < 4; ++mt) {
                f32x4 aq = (f32x4){0.f, 0.f, 0.f, 0.f}, am = aq;
#pragma unroll
                for (int kb = 0; kb < 4; ++kb) { const s16x4v bq = *(const LAS s16x4v*)(SL[8] + (16 * mt + fr) * LDP + 16 * kb + 4 * fq);
                    const s16x4v bm = *(const LAS s16x4v*)(SL[7] + (16 * mt + fr) * LDP + 16 * kb + 4 * fq);
                    aq = mfma16(xb[kb], bq, aq); am = mfma16(xb[kb], bm, am); }
                const u32x2 rgv = *(const LAS u32x2*)(SL[1] + (16 * mt + fr) * LDP + 16 * s4 + 4 * fq);
                u32x2 oq; oq.x = pk2(bflo(rgv.x) - aq[0], bfhi(rgv.x) - aq[1]); oq.y = pk2(bflo(rgv.y) - aq[2], bfhi(rgv.y) - aq[3]);
                *(u32x2*)(ob + ((mt * 2 + (s4 >> 1)) * 64 + lane) * 16 + (s4 & 1) * 8) = oq;
                const float egc = GC[16 * mt + fr]; float mv[4];
#pragma unroll
                for (int i = 0; i < 4; ++i) mv[i] = egc * (((16 * s4 + 4 * fq + i) == (16 * mt + fr) ? 1.f : 0.f) - am[i]);
                u32x2 om; om.x = pk2(mv[0], mv[1]); om.y = pk2(mv[2], mv[3]);
                *(u32x2*)(ob + 8192 + ((mt * 2 + (s4 >> 1)) * 64 + lane) * 16 + (s4 & 1) * 8) = om;
            }
        } else {
            f32x4 y1[4], b1[4];
#pragma unroll
            for (int m = 0; m < 4; ++m) { y1[m] = (f32x4){0.f, 0.f, 0.f, 0.f}; b1[m] = y1[m]; }
            slab64(y1, SL[11], SL[5], s4, fr, fq);
            slab64(b1, SL[6], SL[5], s4, fr, fq);
#pragma unroll
            for (int m = 0; m < 4; ++m) {
                f32x4 y2 = (f32x4){0.f, 0.f, 0.f, 0.f}, b2 = y2;
#pragma unroll
                for (int kb = 0; kb < 4; ++kb) { const s16x4v ay = *(const LAS s16x4v*)(SL[8] + (16 * m + fr) * LDP + 16 * kb + 4 * fq);
                    const s16x4v ab = *(const LAS s16x4v*)(SL[7] + (16 * m + fr) * LDP + 16 * kb + 4 * fq);
                    y2 = mfma16(ay, xb[kb], y2); b2 = mfma16(ab, xb[kb], b2); }
                const f32x4 yv = y1[m] - y2; u32x2 oy; oy.x = pk2(yv[0], yv[1]); oy.y = pk2(yv[2], yv[3]);
                *(u32x2*)(ob + 16384 + ((s4 * 4 + m) * 64 + lane) * 8) = oy;
                const f32x4 gcv = *(const LAS f32x4*)(GC + 16 * m + 4 * fq);
                const f32x4 bv = (b1[m] - b2) * gcv; u32x2 obc; obc.x = pk2(bv[0], bv[1]); obc.y = pk2(bv[2], bv[3]);
                *(u32x2*)(ob + 24576 + ((s4 * 4 + m) * 64 + lane) * 8) = obc;
            }
        }
        unit = unit_next;
    }
}

constexpr int SC_SLOT = 10240, SC_NSLOT = 8, SC_TILE = SC_NSLOT * SC_SLOT, CV_TP = 264;
static_assert(SC_TILE + 64 * CV_TP * 2 <= LDS_MISC, "scan ring + conversion tile");
DI void scan_issue(const unsigned char* st, LAS unsigned char* slot, int w4, int wave, int lane) {
    if (wave == 0 || wave > 3) return;
#pragma unroll
    for (int i = 0; i < 4; ++i) { const int f = wave - 1 + 3 * i;
        if (f < 10) { const unsigned char* src = f < 8 ? st + 8192 + f * 1024 : st + 24576 + w4 * 2048 + (f - 8) * 1024;
            __builtin_amdgcn_global_load_lds((const unsigned*)(src + lane * 16), (LAS unsigned*)(slot + f * 1024), 16, 0, 0); } }
}
struct CvTile { const float* src; bf16_t* dst; int ldn, ldk, k0, n0, rowmap; bool ok; };
DI CvTile cv_tile(const Params& p, int it) {
    CvTile t; t.ok = it < 32 * 2 * 16 + 32 * 16; t.n0 = 0;
    if (it < 1024) { const int e = it >> 5, up = (it >> 4) & 1, kt = it & 15; t.src = (up ? p.in[I_WU] : p.in[I_WG]) + (size_t)e * 1024 * 256 + (size_t)kt * 64 * 256; t.ldn = 256;
        t.dst = (bf16_t*)(p.ws + WS_WGUT) + (size_t)e * 512 * 1024; t.ldk = 1024; t.k0 = kt * 64; t.rowmap = 1 + up; }
    else { const int r = (it - 1024) & 511, e = r >> 4, kt = (r >> 2) & 3, ntl = r & 3; t.src = p.in[I_WD] + (size_t)e * 256 * 1024 + (size_t)kt * 64 * 1024 + ntl * 256; t.ldn = 1024;
        t.dst = (bf16_t*)(p.ws + WS_WDT) + (size_t)e * 1024 * 256; t.ldk = 256; t.k0 = kt * 64; t.rowmap = 0; t.n0 = ntl * 256; }
    return t;
}
DI void phase_scan_chunk(const Params& p, const Ctx& F) {
    unsigned char* OPS = p.ws + WS_OPS;
    LAS unsigned char* ring = F.lds; LAS bf16_t* tile = (LAS bf16_t*)(F.lds + SC_TILE);
    const bool fused_cv = (F.G == 256);
    for (int item = F.bid; item < 256; item += F.G) {
        const int xq = item & 7, yq = item >> 3, w4 = yq & 3, chainid = xq + 8 * (yq >> 2);
        unsigned char* ops = OPS + (size_t)chainid * 132 * 32768;
        f32x4 H[4];
#pragma unroll
        for (int m = 0; m < 4; ++m) H[m] = (f32x4){0.f, 0.f, 0.f, 0.f};
        f32x4 cvr[8];
#pragma unroll
        for (int i = 0; i < 8; ++i) cvr[i] = (f32x4){0.f, 0.f, 0.f, 0.f};
        __syncthreads();
#pragma unroll
        for (int i = 0; i < SC_NSLOT - 1; ++i) scan_issue(ops + (size_t)i * 32768, ring + i * SC_SLOT, w4, F.wave, F.lane);
        auto scan_step = [&](int pc) {
            if (F.wave == 1) asm volatile("s_waitcnt vmcnt(24)" ::: "memory"); else if (F.wave == 2 || F.wave == 3) asm volatile("s_waitcnt vmcnt(18)" ::: "memory");
            __builtin_amdgcn_s_barrier();
            const LAS unsigned char* slot = ring + (pc % SC_NSLOT) * SC_SLOT;
            { const int nx = pc + SC_NSLOT - 1 < 132 ? pc + SC_NSLOT - 1 : 131;
              scan_issue(ops + (size_t)nx * 32768, ring + ((pc + SC_NSLOT - 1) % SC_NSLOT) * SC_SLOT, w4, F.wave, F.lane); }
            if (F.wave == 0) {
                bf16x8 ma[4][2]; u32x2 bc[4];
#pragma unroll
                for (int m = 0; m < 4; ++m) {
#pragma unroll
                    for (int s2 = 0; s2 < 2; ++s2) ma[m][s2] = *(const LAS bf16x8*)(slot + ((m * 2 + s2) * 64 + F.lane) * 16);
                    bc[m] = *(const LAS u32x2*)(slot + 8192 + (m * 64 + F.lane) * 8); }
                asm volatile("s_waitcnt lgkmcnt(0)" ::: "memory");
                bf16x8 hb[2];
#pragma unroll
                for (int s2 = 0; s2 < 2; ++s2) { u32x4 t; t.x = pk2(H[2 * s2][0], H[2 * s2][1]); t.y = pk2(H[2 * s2][2], H[2 * s2][3]); t.z = pk2(H[2 * s2 + 1][0], H[2 * s2 + 1][1]); t.w = pk2(H[2 * s2 + 1][2], H[2 * s2 + 1][3]);
                    hb[s2] = __builtin_bit_cast(bf16x8, t); }
                if (pc >= 4) {
#pragma unroll
                    for (int s2 = 0; s2 < 2; ++s2) *(bf16x8*)(ops + (size_t)pc * 32768 + 24576 + w4 * 2048 + (s2 * 64 + F.lane) * 16) = hb[s2]; }
#pragma unroll
                for (int m = 0; m < 4; ++m) {
                    f32x4 hn = (f32x4){bflo(bc[m].x), bfhi(bc[m].x), bflo(bc[m].y), bfhi(bc[m].y)};
#pragma unroll
                    for (int s2 = 0; s2 < 2; ++s2) hn = __builtin_amdgcn_mfma_f32_16x16x32_bf16(ma[m][s2], hb[s2], hn, 0, 0, 0);
                    H[m] = hn;
                }
            }
        };
#pragma unroll 1
        for (int pc4 = 0; pc4 < 132; pc4 += 4) {
            const CvTile T = cv_tile(p, item + 256 * (pc4 / 4));
            const bool cvon = fused_cv && F.wave >= 4 && T.ok;
            const int r0 = 16 * (F.wave - 4);
            scan_step(pc4);
            if (cvon) {
#pragma unroll
                for (int i = 0; i < 8; ++i) cvr[i] = *(const f32x4*)(T.src + (size_t)(r0 + i) * T.ldn + 4 * F.lane); }
            scan_step(pc4 + 1);
            if (cvon) {
#pragma unroll
                for (int i = 0; i < 8; ++i) { u32x2 o; o.x = pk2(cvr[i][0], cvr[i][1]); o.y = pk2(cvr[i][2], cvr[i][3]); *(LAS u32x2*)(tile + (r0 + i) * CV_TP + 4 * F.lane) = o; }
#pragma unroll
                for (int i = 0; i < 8; ++i) cvr[i] = *(const f32x4*)(T.src + (size_t)(r0 + 8 + i) * T.ldn + 4 * F.lane); }
            scan_step(pc4 + 2);
            if (cvon) {
#pragma unroll
                for (int i = 0; i < 8; ++i) { u32x2 o; o.x = pk2(cvr[i][0], cvr[i][1]); o.y = pk2(cvr[i][2], cvr[i][3]); *(LAS u32x2*)(tile + (r0 + 8 + i) * CV_TP + 4 * F.lane) = o; } }
            scan_step(pc4 + 3);
            if (cvon) {
                const int n = F.tid - 256;
                const int drow = T.rowmap == 0 ? T.n0 + n : ((n >> 7) * 256 + (n & 127) + (T.rowmap == 2 ? 128 : 0));
                bf16_t* dp = T.dst + (size_t)drow * T.ldk + T.k0;
#pragma unroll
                for (int q = 0; q < 8; ++q) { unsigned wds[4];
#pragma unroll
                    for (int jj = 0; jj < 4; ++jj) { const int k = 8 * q + 2 * jj; wds[jj] = (unsigned)tile[k * CV_TP + n] | ((unsigned)tile[(k + 1) * CV_TP + n] << 16); }
                    *(u32x4*)(dp + 8 * q) = (u32x4){wds[0], wds[1], wds[2], wds[3]}; } }
        }
        asm volatile("s_waitcnt vmcnt(0)" ::: "memory");
    }
}

DI void phase_post2(const Params& p, const Ctx& F) {
    const unsigned char* OPS = p.ws + WS_OPS;
    const bf16_t* GATE = (const bf16_t*)((unsigned char*)p.out + DO_GATE); const bf16_t* BV = (const bf16_t*)((unsigned char*)p.out + DO_BV);
    bf16_t* MIXED = (bf16_t*)((unsigned char*)p.out + DO_MIXED);
    constexpr int LDY = 68;
    const int fr = F.lane & 15, fq = F.lane >> 4, w4 = F.wave & 3, dd = F.wave >> 2, tk = F.tid >> 3, cg8 = F.tid & 7;
    constexpr int NU = 4 * 128 * 8;
    struct PLd { bf16x8 qa[4][2], hb[2]; u32x2 y0[4]; u32x4 gq, bq; };
    auto issue = [&](PLd& L, int unit) { const int h = unit & 7, j = (unit >> 3) & 127, b = unit >> 10, chain = b * 8 + h;
        const unsigned char* ops = OPS + ((size_t)(dd * 32 + chain) * 132 + 4 + (dd ? 127 - j : j)) * 32768;
#pragma unroll
        for (int m = 0; m < 4; ++m) {
#pragma unroll
            for (int s2 = 0; s2 < 2; ++s2) L.qa[m][s2] = *(const bf16x8*)(ops + ((m * 2 + s2) * 64 + F.lane) * 16);
            L.y0[m] = *(const u32x2*)(ops + 16384 + ((w4 * 4 + m) * 64 + F.lane) * 8); }
#pragma unroll
        for (int s2 = 0; s2 < 2; ++s2) L.hb[s2] = *(const bf16x8*)(ops + 24576 + w4 * 2048 + (s2 * 64 + F.lane) * 16);
        const size_t o = ((size_t)b * SEQ + 64 * j + tk) * 512 + 64 * h + 8 * cg8;
        L.gq = *(const u32x4*)(GATE + o); L.bq = *(const u32x4*)(BV + o); };
    PLd L;
    if (F.bid < NU) issue(L, F.bid);
    int par = 0;
    for (int unit = F.bid; unit < NU; unit += F.G, par ^= 1) {
        const int h = unit & 7, j = (unit >> 3) & 127, b = unit >> 10;
        LAS float* ys = (LAS float*)F.lds + par * 64 * LDY;
        f32x4 y[4];
#pragma unroll
        for (int m = 0; m < 4; ++m) { y[m] = (f32x4){bflo(L.y0[m].x), bfhi(L.y0[m].x), bflo(L.y0[m].y), bfhi(L.y0[m].y)};
#pragma unroll
            for (int s2 = 0; s2 < 2; ++s2) y[m] = __builtin_amdgcn_mfma_f32_16x16x32_bf16(L.qa[m][s2], L.hb[s2], y[m], 0, 0, 0); }
        const u32x4 gq = L.gq, bq = L.bq;
        if (unit + F.G < NU) issue(L, unit + F.G);
        const int n = 16 * w4 + fr;
        if (dd == 0) {
#pragma unroll
            for (int m = 0; m < 4; ++m) { const int t0 = 16 * m + 4 * fq;
#pragma unroll
                for (int i = 0; i < 4; ++i) ys[(t0 + i) * LDY + n] = y[m][i]; } }
        __syncthreads();
        if (dd == 1) {
#pragma unroll
            for (int m = 0; m < 4; ++m) { const int t0 = 16 * m + 4 * fq;
#pragma unroll
                for (int i = 0; i < 4; ++i) ys[(63 - t0 - i) * LDY + n] += y[m][i]; } }
        __syncthreads();
        { const size_t row = (size_t)b * SEQ + 64 * j + tk;
          const f32x4 ya = *(const LAS f32x4*)(ys + tk * LDY + 8 * cg8), yb = *(const LAS f32x4*)(ys + tk * LDY + 8 * cg8 + 4);
          float yv[8] = {ya[0], ya[1], ya[2], ya[3], yb[0], yb[1], yb[2], yb[3]};
          float s1 = 0.f;
#pragma unroll
          for (int i = 0; i < 8; ++i) s1 += yv[i];
          s1 += __shfl_xor(s1, 1); s1 += __shfl_xor(s1, 2); s1 += __shfl_xor(s1, 4);
          const float mu = s1 * (1.f / 64.f); float s2 = 0.f;
#pragma unroll
          for (int i = 0; i < 8; ++i) { yv[i] -= mu; s2 += yv[i] * yv[i]; }
          s2 += __shfl_xor(s2, 1); s2 += __shfl_xor(s2, 2); s2 += __shfl_xor(s2, 4);
          const float rstd = __builtin_amdgcn_rsqf(s2 * (1.f / 64.f) + 64e-5f);
          const f32x4 lg0 = *(const f32x4*)(p.in[I_LNXG] + 64 * h + 8 * cg8), lg1 = *(const f32x4*)(p.in[I_LNXG] + 64 * h + 8 * cg8 + 4), lb0 = *(const f32x4*)(p.in[I_LNXB] + 64 * h + 8 * cg8), lb1 = *(const f32x4*)(p.in[I_LNXB] + 64 * h + 8 * cg8 + 4);
          float ov[8];
#pragma unroll
          for (int i = 0; i < 8; ++i) { const float yn = yv[i] * rstd * (i < 4 ? lg0[i & 3] : lg1[i & 3]) + (i < 4 ? lb0[i & 3] : lb1[i & 3]);
              const float gt = (i & 1) ? bfhi(gq[i >> 1]) : bflo(gq[i >> 1]), bb = (i & 1) ? bfhi(bq[i >> 1]) : bflo(bq[i >> 1]);
              ov[i] = (yn + bb) * gt; }
          u32x4 ow = (u32x4){pk2(ov[0], ov[1]), pk2(ov[2], ov[3]), pk2(ov[4], ov[5]), pk2(ov[6], ov[7])};
          *(u32x4*)(MIXED + row * D + 512 + 64 * h + 8 * cg8) = ow; }
    }
}

DI void phase_post(const Params& p, const Ctx& F) {
    const float* YS = (const float*)(p.ws + WS_YS);
    const bf16_t* GATE = (const bf16_t*)((unsigned char*)p.out + DO_GATE); const bf16_t* BV = (const bf16_t*)((unsigned char*)p.out + DO_BV);
    bf16_t* MIXED = (bf16_t*)((unsigned char*)p.out + DO_MIXED);
    const int t = F.tid; const float lg = p.in[I_LNXG][t], lb = p.in[I_LNXB][t];
    for (int row = F.bid; row < NT; row += F.G) {
        const size_t o = (size_t)row * 512 + t;
        const float y = YS[o] + YS[(size_t)NT * 512 + o];
        const float mu = wave_sum(y) * (1.f / 64.f); const float dd = y - mu; const float var = wave_sum(dd * dd) * (1.f / 64.f);
        const float yn = dd * (1.f / sqrtf(var + 64e-5f)) * lg + lb;
        const float ob = (yn + bf2f(BV[o])) * bf2f(GATE[o]);
        MIXED[(size_t)row * D + 512 + t] = (bf16_t)f2bf(ob);
    }
}

DI void phase_gemm2(const Params& p, const Ctx& F) {
    pg8::StaticOrder S; S.init((unsigned char*)p.out + DO_MIXED, p.ws + WS_WOUTT, NT, 1024, 1024, F.G, F.bid);
    pg8::EpiBf16 E{(bf16_t*)(p.ws + WS_Y), 1024, false};
    pg8::gemm_phase<pg8::EpiBf16, pg8::StaticOrder, false>(F.lds, 1024, S, E);
}

DI void phase_route(const Params& p, const Ctx& F, const bool dry = false) {
    LAS float* wr_ = (LAS float*)F.lds;
    for (int i = F.tid; i < 4 * 1024; i += NTHREADS) wr_[(i & 3) * 1024 + (i >> 2)] = p.in[I_WRG][i];
    for (int i = F.tid; i < 32 * 1024; i += NTHREADS) wr_[(4 + (i & 31)) * 1024 + (i >> 5)] = p.in[I_WRE][i];
    __syncthreads();
    const float* mod = (const float*)(p.ws + WS_MOD); const bf16_t* Y = (const bf16_t*)(p.ws + WS_Y);
    bf16_t* H2 = (bf16_t*)(p.ws + WS_H2); int* cnt = (int*)(p.ws + WS_CTL); int* perm = (int*)(p.ws + WS_PERM); float* ew = (float*)(p.ws + WS_EW);
    const int gw = F.bid * NWAVES + F.wave, NGW = F.G * NWAVES;
    LAS int* hist = (LAS int*)(F.lds + LDS_MISC + 64); LAS int* basel = (LAS int*)(F.lds + LDS_MISC + 192); LAS int* sel = (LAS int*)(F.lds + LDS_MISC + 320);
    if (F.tid < 32) hist[F.tid] = 0;
    __syncthreads();
    int itn = -1;
    u32x2 nyy[4]; f32x4 nxx[4];
    auto rissue = [&](int row) { const u32x2* yr = (const u32x2*)(Y + (size_t)row * D) + F.lane; const f32x4* xr = (const f32x4*)(p.in[I_X] + (size_t)row * D) + F.lane;
#pragma unroll
        for (int j = 0; j < 4; ++j) { nyy[j] = yr[64 * j]; nxx[j] = xr[64 * j]; } };
    if (gw < NT) rissue(gw);
    for (int row = gw; row < NT; row += NGW) {
        ++itn;
        const int bt = row / SEQ;
        f32x4 v[4], xv[4]; float ss = 0.f;
#pragma unroll
        for (int j = 0; j < 4; ++j) xv[j] = nxx[j];
#pragma unroll
        for (int j = 0; j < 4; ++j) { const u32x2 yy = nyy[j]; v[j] = (f32x4){bflo(yy.x), bfhi(yy.x), bflo(yy.y), bfhi(yy.y)}; ss += (v[j].x * v[j].x + v[j].y * v[j].y) + (v[j].z * v[j].z + v[j].w * v[j].w); }
        if (row + NGW < NT) rissue(row + NGW);
        const float rstd = __builtin_amdgcn_rsqf(wave_sum(ss) * (1.f / D) + 1e-6f);
        float s2 = 0.f;
        f32x4* xo = (f32x4*)(p.out + (size_t)row * D) + F.lane;
#pragma unroll
        for (int j = 0; j < 4; ++j) { const int col = 4 * (F.lane + 64 * j);
            const f32x4 g1 = *(const f32x4*)(mod + bt * 6144 + 2048 + col), gp = *(const f32x4*)(p.in[I_GPOST1] + col);
            v[j] = xv[j] + g1 * (v[j] * rstd * gp);
            xo[64 * j] = v[j];
            s2 += (v[j].x * v[j].x + v[j].y * v[j].y) + (v[j].z * v[j].z + v[j].w * v[j].w); }
        const float rstd2 = __builtin_amdgcn_rsqf(wave_sum(s2) * (1.f / D) + 1e-6f);
        unsigned long long* o8 = (unsigned long long*)(H2 + (size_t)row * D) + F.lane;
#pragma unroll
        for (int j = 0; j < 4; ++j) { const int col = 4 * (F.lane + 64 * j);
            const f32x4 gg = *(const f32x4*)(p.in[I_GPRE2] + col), sh = *(const f32x4*)(mod + bt * 6144 + 3072 + col), sc = *(const f32x4*)(mod + bt * 6144 + 4096 + col);
            v[j] = v[j] * rstd2 * gg * (sc + 1.f) + sh;
            o8[64 * j] = (unsigned long long)pk2(v[j].x, v[j].y) | ((unsigned long long)pk2(v[j].z, v[j].w) << 32); }
        float part[36];
#pragma unroll
        for (int o = 0; o < 36; ++o) { float a = 0.f;
#pragma unroll
            for (int j = 0; j < 4; ++j) { const f32x4 w = *(const LAS f32x4*)(wr_ + o * 1024 + 4 * (F.lane + 64 * j)); a += (v[j].x * w.x + v[j].y * w.y) + (v[j].z * w.z + v[j].w * w.w); }
            part[o] = a; if ((o & 3) == 3) __builtin_amdgcn_sched_barrier(0); }
        float v32[32], v16[16], v8[8], v4[4], v2[2], mylg;
        { const bool b5 = (F.lane & 32) != 0, b4 = (F.lane & 16) != 0, b3 = (F.lane & 8) != 0, b2 = (F.lane & 4) != 0, b1 = (F.lane & 2) != 0, b0 = (F.lane & 1) != 0;
#pragma unroll
          for (int i = 0; i < 32; ++i) { const float lo = part[i], hi = (i < 4) ? part[32 + (i & 3)] : 0.f; const float mine = b5 ? hi : lo, th = b5 ? lo : hi; v32[i] = mine + __shfl_xor(th, 32); }
#pragma unroll
          for (int i = 0; i < 16; ++i) { const float mine = b4 ? v32[16 + i] : v32[i], th = b4 ? v32[i] : v32[16 + i]; v16[i] = mine + __shfl_xor(th, 16); }
#pragma unroll
          for (int i = 0; i < 8; ++i) { const float mine = b3 ? v16[8 + i] : v16[i], th = b3 ? v16[i] : v16[8 + i]; v8[i] = mine + __shfl_xor(th, 8); }
#pragma unroll
          for (int i = 0; i < 4; ++i) { const float mine = b2 ? v8[4 + i] : v8[i], th = b2 ? v8[i] : v8[4 + i]; v4[i] = mine + __shfl_xor(th, 4); }
#pragma unroll
          for (int i = 0; i < 2; ++i) { const float mine = b1 ? v4[2 + i] : v4[i], th = b1 ? v4[i] : v4[2 + i]; v2[i] = mine + __shfl_xor(th, 2); }
          { const float mine = b0 ? v2[1] : v2[0], th = b0 ? v2[0] : v2[1]; mylg = mine + __shfl_xor(th, 1); } }
        mylg += (F.lane < 4) ? p.in[I_BRG][F.lane & 3] : p.in[I_BRE][(F.lane - 4) & 31];
        float gl[4];
#pragma unroll
        for (int j = 0; j < 4; ++j) gl[j] = __shfl(mylg, j);
        int gi = 0; float gm = gl[0];
#pragma unroll
        for (int j = 1; j < 4; ++j) if (gl[j] > gm) { gm = gl[j]; gi = j; }
        float gsum = 0.f;
#pragma unroll
        for (int j = 0; j < 4; ++j) gsum += __expf(gl[j] - gm);
        const float gw_ = 1.f / gsum;
        float el[8];
#pragma unroll
        for (int j = 0; j < 8; ++j) el[j] = __shfl(mylg, 4 + gi * 8 + j);
        int i1 = 0; float m1 = el[0];
#pragma unroll
        for (int j = 1; j < 8; ++j) if (el[j] > m1) { m1 = el[j]; i1 = j; }
        int i2 = 0; float m2 = -3.0e38f;
#pragma unroll
        for (int j = 0; j < 8; ++j) if (j != i1 && el[j] > m2) { m2 = el[j]; i2 = j; }
        const float p2 = __expf(m2 - m1);
        const float w1 = gw_ / (1.f + p2), w2 = gw_ * p2 / (1.f + p2);
        if (F.lane == 0 && !dry) {
            const int e1 = gi * 8 + i1, e2 = gi * 8 + i2;
            if (itn < 16) {
                const int s1 = atomicAdd((int*)(hist + e1), 1), s2 = atomicAdd((int*)(hist + e2), 1);
                sel[(F.wave * 16 + itn) * 2] = (e1 << 16) | s1; sel[(F.wave * 16 + itn) * 2 + 1] = (e2 << 16) | s2;
            } else {
                const int p1 = atomicAdd(&cnt[e1 * 64], 1); perm[(size_t)e1 * NT + p1] = row * 2;
                const int q2 = atomicAdd(&cnt[e2 * 64], 1); perm[(size_t)e2 * NT + q2] = row * 2 + 1;
            }
            ew[row * 2] = w1; ew[row * 2 + 1] = w2;
        }
    }
    if (!dry) {
        __syncthreads();
        if (F.tid < 32) basel[F.tid] = atomicAdd(&cnt[F.tid * 64], (int)hist[F.tid]);
        __syncthreads();
        if (F.tid < 256) { const int wv = F.tid >> 5, it2 = (F.tid >> 1) & 15, sl = F.tid & 1; const int row = F.bid * NWAVES + wv + it2 * NGW;
            if (row < NT) { const int sv = sel[F.tid]; const int e = sv >> 16, ps = sv & 0xffff; perm[(size_t)e * NT + basel[e] + ps] = row * 2 + sl; } }
    }
}

DI void moe_tile_prefix(const Params& p, const Ctx& F, LAS int* tp) {
    __syncthreads();
    if (F.tid == 0) { const int* cnt = (const int*)(p.ws + WS_CTL); int acc = 0; for (int e = 0; e < 32; ++e) { tp[e] = acc; acc += (cnt[e * 64] + 255) / 256; } tp[32] = acc; }
    __syncthreads();
}
DI void phase_moe_up(const Params& p, const Ctx& F) {
    LAS int* tp = (LAS int*)(F.lds + pg8::STAGE_BYTES);
    moe_tile_prefix(p, F, tp);
    MoeOrder S{tp, (const int*)(p.ws + WS_CTL), 2, F.G, F.bid, 1024, (const char*)(p.ws + WS_H2), (const char*)(p.ws + WS_WGUT), (size_t)512 * 1024 * 2, (size_t)256 * 1024 * 2, (const int*)(p.ws + WS_PERM), true};
    pg8::EpiMoeUp E{(bf16_t*)(p.ws + WS_HID)};
    pg8::gemm_phase<pg8::EpiMoeUp, MoeOrder, true>(F.lds, 1024, S, E);
}
DI void phase_moe_down(const Params& p, const Ctx& F) {
    LAS int* tp = (LAS int*)(F.lds + pg8::STAGE_BYTES);
    moe_tile_prefix(p, F, tp);
    MoeOrder S{tp, (const int*)(p.ws + WS_CTL), 4, F.G, F.bid, 256, (const char*)(p.ws + WS_HID), (const char*)(p.ws + WS_WDT), (size_t)1024 * 256 * 2, (size_t)256 * 256 * 2, (const int*)(p.ws + WS_PERM), false};
    pg8::EpiMoeDown E{(bf16_t*)(p.ws + WS_YMOE), (const int*)(p.ws + WS_PERM), (const float*)(p.ws + WS_EW)};
    pg8::gemm_phase<pg8::EpiMoeDown, MoeOrder, false>(F.lds, 256, S, E);
}

DI void phase_final(const Params& p, const Ctx& F, const float fsc = 1.f) {
    const float* mod = (const float*)(p.ws + WS_MOD); const bf16_t* YM = (const bf16_t*)(p.ws + WS_YMOE);
    const int gw = F.bid * NWAVES + F.wave, NGW = F.G * NWAVES;
    struct FL { u32x2 a[4], b[4]; f32x4 x[4]; };
    auto issue = [&](FL& L, int row) { const u32x2* y0 = (const u32x2*)(YM + (size_t)row * D) + F.lane; const u32x2* y1 = (const u32x2*)(YM + ((size_t)NT + row) * D) + F.lane;
        const f32x4* xo = (const f32x4*)(p.out + (size_t)row * D) + F.lane;
#pragma unroll
        for (int j = 0; j < 4; ++j) { L.a[j] = y0[64 * j]; L.b[j] = y1[64 * j]; L.x[j] = xo[64 * j]; } };
    FL L;
    if (gw < NT) issue(L, gw);
    for (int row = gw; row < NT; row += NGW) {
        const int bt = row / SEQ;
        const FL C = L;
        if (row + NGW < NT) issue(L, row + NGW);
        f32x4 v[4]; float ss = 0.f;
#pragma unroll
        for (int j = 0; j < 4; ++j) { const u32x2 a = C.a[j], b = C.b[j];
            v[j] = (f32x4){bflo(a.x) + bflo(b.x), bfhi(a.x) + bfhi(b.x), bflo(a.y) + bflo(b.y), bfhi(a.y) + bfhi(b.y)};
            ss += (v[j].x * v[j].x + v[j].y * v[j].y) + (v[j].z * v[j].z + v[j].w * v[j].w); }
        const float rstd = __builtin_amdgcn_rsqf(wave_sum(ss) * (1.f / D) + 1e-6f);
        f32x4* xo = (f32x4*)(p.out + (size_t)row * D) + F.lane;
#pragma unroll
        for (int j = 0; j < 4; ++j) { const int col = 4 * (F.lane + 64 * j);
            const f32x4 g2 = *(const f32x4*)(mod + bt * 6144 + 5120 + col), gp = *(const f32x4*)(p.in[I_GPOST2] + col);
            xo[64 * j] = C.x[j] + g2 * (v[j] * (rstd * fsc) * gp); }
    }
}

#define XB_TMO      128
#define XB_XCNT(j)  (256  + 64 * (j))
#define XB_XSUB(j)  (1280 + 64 * (j))
#define XB_XGEN(j)  (2304 + 64 * (j))
#define XB_TOP      3328
#define XB_TOPGEN   3392
#define XCD_BAR_WORDS 3456
#define XB_SPIN_CAP (1u << 20)
constexpr int CW_BAR = 4096;
DI unsigned xb_ld(unsigned* p)              { return __hip_atomic_load(p, __ATOMIC_RELAXED, __HIP_MEMORY_SCOPE_AGENT); }
DI unsigned xb_add(unsigned* p, unsigned v) { return __hip_atomic_fetch_add(p, v, __ATOMIC_RELAXED, __HIP_MEMORY_SCOPE_AGENT); }
DI unsigned xb_xcc_id() { return (unsigned)__builtin_amdgcn_s_getreg((3 << 11) | 20) & 0xFu; }
#define XB_SPIN(cond, bar) do { unsigned _sp = 0; while (cond) { __builtin_amdgcn_s_sleep(1); \
    if ((++_sp & 255u) == 0u) { if (xb_ld(&(bar)[XB_TMO])) break; if (_sp > XB_SPIN_CAP) { atomicAdd(&(bar)[XB_TMO], 1u); break; } } } } while (0)
struct XcdBarrier { unsigned* bar; unsigned x; volatile LAS unsigned* st; };
DI XcdBarrier xcd_barrier_post(unsigned* bar, volatile LAS unsigned* st) {
    XcdBarrier b; b.bar = bar; b.x = xb_xcc_id(); b.st = st;
    if (threadIdx.x == 0) (void)xb_add(&bar[XB_XCNT(b.x)], 1u);
    return b;
}
DI void xcd_barrier_complete(unsigned* bar, unsigned x, unsigned& nloc, unsigned& nx) {
    const unsigned G = gridDim.x * gridDim.y * gridDim.z;
    unsigned sum, cnt, mine, sp = 0u;
    for (;;) {
        sum = 0u; cnt = 0u; mine = 0u;
#pragma unroll
        for (unsigned j = 0; j < 16; ++j) { const unsigned c = xb_ld(&bar[XB_XCNT(j)]); sum += c; cnt += (c > 0u) ? 1u : 0u; mine = (j == x) ? c : mine; }
        if (sum == G) break;
        __builtin_amdgcn_s_sleep(1);
        if ((++sp & 255u) == 0u) { if (xb_ld(&bar[XB_TMO])) break; if (sp > XB_SPIN_CAP) { atomicAdd(&bar[XB_TMO], 1u); break; } }
    }
    nloc = mine > 0u ? mine : 1u; nx = cnt > 0u ? cnt : 1u;
}
DI void xcd_barrier(const XcdBarrier& b) {
    asm volatile("s_waitcnt vmcnt(0)" ::: "memory");
    __syncthreads();
    if (threadIdx.x == 0) {
        unsigned* bar = b.bar;
        __builtin_amdgcn_s_waitcnt(0);
        unsigned nloc = b.st[0], nx = b.st[1];
        if (nloc == 0u) { xcd_barrier_complete(bar, b.x, nloc, nx); b.st[0] = nloc; b.st[1] = nx; }
        const unsigned old = xb_add(&bar[XB_XSUB(b.x)], 1u);
        const unsigned gen = old / nloc;
        if (old + 1u == (gen + 1u) * nloc) {
            __builtin_amdgcn_fence(__ATOMIC_RELEASE, "agent");
            asm volatile("s_waitcnt vmcnt(0)" ::: "memory");
            const unsigned og = xb_add(&bar[XB_TOP], 1u);
            const unsigned tg = og / nx;
            if (og + 1u == (tg + 1u) * nx) xb_add(&bar[XB_TOPGEN], 1u);
            else XB_SPIN(xb_ld(&bar[XB_TOPGEN]) == tg, bar);
            __builtin_amdgcn_fence(__ATOMIC_ACQUIRE, "agent");
            xb_add(&bar[XB_XGEN(b.x)], 1u);
            asm volatile("s_waitcnt vmcnt(0)" ::: "memory");
        } else {
            XB_SPIN(xb_ld(&bar[XB_XGEN(b.x)]) == gen, bar);
            __builtin_amdgcn_fence(__ATOMIC_ACQUIRE, "agent");
            asm volatile("s_waitcnt vmcnt(0)" ::: "memory");
        }
    }
    __syncthreads();
}

constexpr int NPHASES = 12;
#ifndef SEQ_SCAN
#define SEQ_SCAN 0
#endif
#ifndef DUP_PHASE
#define DUP_PHASE -1
#endif
#ifndef PROBE_T
#define PROBE_T -1
#endif
template <int PH> DI void run_phase(const Params& p, const Ctx& F) {
    if constexpr (PH == 0) phase_adaln(p, F);
    if constexpr (PH == 1) phase_convert(p, F);
    if constexpr (PH == 2) phase_hrows(p, F);
    if constexpr (PH == 3) phase_gemm1(p, F);
#ifndef OLD_PREP
#define OLD_PREP 0
#endif
    if constexpr (PH == 4) { if (OLD_PREP) phase_prep(p, F); else phase_prep2(p, F); __syncthreads(); phase_gmlp(p, F); }
#ifndef OLD_CHUNKPREP
#define OLD_CHUNKPREP 0
#endif
    if constexpr (PH == 5) { if (OLD_CHUNKPREP) phase_chunkprep(p, F); else phase_chunkprep2(p, F); }
    if constexpr (PH == 12) { phase_scan_chunk(p, F); if (F.G != 256) phase_convert_experts(p, F); }
    if constexpr (PH == 6) phase_post2(p, F);
    if constexpr (PH == 7) phase_gemm2(p, F);
    if constexpr (PH == 8) phase_route(p, F);
    if constexpr (PH == 28) phase_route(p, F, true);
    if constexpr (PH == 9) phase_moe_up(p, F);
    if constexpr (PH == 10) phase_moe_down(p, F);
    if constexpr (PH == 11) phase_final(p, F, DUP_PHASE == 11 ? 0.5f : 1.f);
}
DI Ctx make_ctx(unsigned char* lds) {
    Ctx F; F.lds = (LAS unsigned char*)lds; F.tid = threadIdx.x; F.lane = F.tid & 63; F.wave = __builtin_amdgcn_readfirstlane(F.tid >> 6); F.G = gridDim.x; F.bid = blockIdx.x; return F;
}
template <int PH> __global__ void __launch_bounds__(NTHREADS, 2) k_phase(Params p) {
    extern __shared__ __attribute__((aligned(16))) unsigned char lds[];
    const Ctx F = make_ctx(lds);
    run_phase<PH>(p, F);
}
#ifndef USE_CG_SYNC
#define USE_CG_SYNC 0
#endif
__global__ void __launch_bounds__(NTHREADS, 2) k_mega(Params p) {
    extern __shared__ __attribute__((aligned(16))) unsigned char lds[];
    const Ctx F = make_ctx(lds);
#if USE_CG_SYNC
    cg::grid_group grid = cg::this_grid();
#define GSYNC() grid.sync()
#else
    volatile LAS unsigned* misc = (volatile LAS unsigned*)(F.lds + LDS_MISC);
    if (F.tid < 4) misc[F.tid] = 0u;
    __syncthreads();
    const XcdBarrier bar = xcd_barrier_post((unsigned*)(p.ws + WS_CTL) + CW_BAR, misc);
#define GSYNC() xcd_barrier(bar)
#endif
#define DUP(X) if (DUP_PHASE == X) { run_phase<X>(p, F); GSYNC(); }
    unsigned long long ts_a = 0, ts_b = 0; int nst = 0;
#define STAMP() do { if (PROBE_T >= 0) { const unsigned long long t_ = __builtin_amdgcn_s_memrealtime(); if (nst == PROBE_T) ts_a = t_; if (nst == PROBE_T + 1) ts_b = t_; ++nst; } } while (0)
    STAMP();
    DUP(0) DUP(1)
    run_phase<0>(p, F); run_phase<1>(p, F); GSYNC(); STAMP();
    DUP(2) run_phase<2>(p, F); GSYNC(); STAMP();
    DUP(3) run_phase<3>(p, F); GSYNC(); STAMP();
    DUP(4) run_phase<4>(p, F); GSYNC(); STAMP();
    DUP(5) run_phase<5>(p, F); GSYNC(); STAMP();
    DUP(12)
    run_phase<12>(p, F); GSYNC(); STAMP();
    DUP(6) run_phase<6>(p, F); GSYNC(); STAMP();
    DUP(7) run_phase<7>(p, F); GSYNC(); STAMP();
    if (DUP_PHASE == 8) { run_phase<28>(p, F); GSYNC(); STAMP(); }
    run_phase<8>(p, F); GSYNC(); STAMP();
    DUP(9) run_phase<9>(p, F); GSYNC(); STAMP();
    DUP(10) run_phase<10>(p, F); GSYNC(); STAMP();
    if (DUP_PHASE == 11) { run_phase<11>(p, F); GSYNC(); STAMP(); }
    run_phase<11>(p, F); STAMP();
    if (PROBE_T >= 0 && F.bid == 0 && F.tid == 0) { const unsigned long long t0 = __builtin_amdgcn_s_memrealtime(); const unsigned long long w_ = ts_b - ts_a; while (__builtin_amdgcn_s_memrealtime() - t0 < w_) __builtin_amdgcn_s_sleep(8); }
}

template <int PH> static void launch_phase(const Params& p, int grid, hipStream_t stream) {
    static bool attr = false;
    if (!attr) { (void)hipFuncSetAttribute((const void*)k_phase<PH>, hipFuncAttributeMaxDynamicSharedMemorySize, LDS_BYTES); attr = true; }
    hipLaunchKernelGGL(k_phase<PH>, dim3(grid), dim3(NTHREADS), LDS_BYTES, stream, p);
}

extern "C" void kernel_launch(void* const* d_in, const int* in_sizes, int n_in, void* d_out, int out_size, void* d_ws, size_t ws_size, hipStream_t stream) {
    static int grid = 0;
    if (grid == 0) {
        int dev = 0, cus = 0, per_cu = 0;
        (void)hipGetDevice(&dev); (void)hipDeviceGetAttribute(&cus, hipDeviceAttributeMultiprocessorCount, dev);
        (void)hipFuncSetAttribute((const void*)k_mega, hipFuncAttributeMaxDynamicSharedMemorySize, LDS_BYTES);
        (void)hipOccupancyMaxActiveBlocksPerMultiprocessor(&per_cu, (const void*)k_mega, NTHREADS, LDS_BYTES);
        (void)hipGetLastError();
        grid = cus > 0 ? cus : 256;
        if (n_in != 34 || ws_size < 512 * MiB) fprintf(stderr, "kernel_launch: unexpected n_in %d / ws_size %zu\n", n_in, ws_size);
    }
    Params p{};
    for (int i = 0; i < 34; ++i) p.in[i] = (const float*)d_in[i];
    p.out = (float*)d_out; p.ws = (unsigned char*)d_ws;
    (void)hipMemsetAsync((char*)d_ws + WS_CTL, 0, CTL_BYTES, stream);
#if ONE_LAUNCH
    void* args[] = {&p};
    hipError_t e = hipLaunchCooperativeKernel((const void*)k_mega, dim3(grid), dim3(NTHREADS), args, LDS_BYTES, stream);
    if (e != hipSuccess) fprintf(stderr, "cooperative launch failed: %s (grid %d)\n", hipGetErrorString(e), grid);
#else
    launch_phase<0>(p, grid, stream); launch_phase<1>(p, grid, stream); launch_phase<2>(p, grid, stream); launch_phase<3>(p, grid, stream);
    launch_phase<4>(p, grid, stream); launch_phase<5>(p, grid, stream);
    launch_phase<12>(p, grid, stream);
    launch_phase<6>(p, grid, stream); launch_phase<7>(p, grid, stream);
    launch_phase<8>(p, grid, stream); launch_phase<9>(p, grid, stream); launch_phase<10>(p, grid, stream); launch_phase<11>(p, grid, stream);
#endif
}
```

```cpp
#include <hip/hip_runtime.h>
#include <hip/hip_cooperative_groups.h>
#include <cstdio>
#include <cstdint>
namespace cg = cooperative_groups;

#ifndef ONE_LAUNCH
#define ONE_LAUNCH 1
#endif

#define DI __device__ __forceinline__
#define LAS __attribute__((address_space(3)))
typedef unsigned short bf16_t;
typedef short bf16x8 __attribute__((ext_vector_type(8)));
typedef short s16x4 __attribute__((ext_vector_type(4)));
typedef float f32x4 __attribute__((ext_vector_type(4)));
typedef float f32x2 __attribute__((ext_vector_type(2)));
typedef unsigned u32x4 __attribute__((ext_vector_type(4)));
typedef unsigned u32x2 __attribute__((ext_vector_type(2)));

constexpr int D = 1024, BATCH = 4, SEQ = 8192, CTXL = 256;
constexpr int NT = BATCH * SEQ;
constexpr int NCX = BATCH * CTXL;
constexpr int MR = NT + NCX;
constexpr int BW = 512, AW = 512, NH = 8, HD = 64;
constexpr int DIN = 2944, DINP = 3072;
constexpr int OFF_K = 0, OFF_V = 512, OFF_R = 1024, OFF_WD = 1536, OFF_AD = 1664, OFF_GD = 1792, OFF_U = 1920, OFF_VA = 2432;
constexpr int NEXP = 32, DEXP = 256;
constexpr int NWAVES = 8, NTHREADS = 512;
constexpr int LDS_BYTES = 149504, LDS_MISC = 147456;

constexpr size_t MiB = 1u << 20;
constexpr size_t WS_CTL = 0, CTL_BYTES = 64 * 1024;
constexpr size_t WS_MOD = 1 * MiB;
constexpr size_t WS_WRH = 1 * MiB + 256 * 1024, WS_WRL = WS_WRH + 64 * 1024;
constexpr size_t WS_DUPT = 2 * MiB;
constexpr size_t WS_AUPT = WS_DUPT + 131072;
constexpr size_t WS_GUPT = WS_AUPT + 131072;
constexpr size_t WS_WSP = WS_GUPT + 131072;
constexpr size_t WS_CONVW = WS_WSP + 262144;
constexpr size_t WS_WRT = 2 * MiB + 768 * 1024;
constexpr size_t WS_WINT = 3 * MiB;
constexpr size_t WS_WOUTT = 9 * MiB;
constexpr size_t WS_H = 11 * MiB;
constexpr size_t WS_Z = 77 * MiB;
constexpr size_t ROWB = (size_t)MR * 512 * 2;
constexpr size_t WS_KC = 275 * MiB, WS_VC = WS_KC + ROWB, WS_RC = WS_VC + ROWB, WS_A0 = WS_RC + ROWB, WS_A1 = WS_A0 + ROWB, WS_L0 = WS_A1 + ROWB, WS_L1 = WS_L0 + ROWB;
constexpr size_t WS_OPS = 11 * MiB;
constexpr size_t WS_YS = 11 * MiB;
constexpr size_t WS_Y = 11 * MiB;
constexpr size_t WS_H2 = 139 * MiB;
constexpr size_t WS_EW = 203 * MiB;
constexpr size_t WS_PERM = 204 * MiB;
constexpr size_t WS_HID = 210 * MiB;
constexpr size_t WS_YMOE = 246 * MiB;
constexpr size_t WS_X1 = 430 * MiB;
constexpr size_t WS_WGUT = 374 * MiB;
constexpr size_t WS_WDT = 406 * MiB;
constexpr size_t DO_MIXED = 0, DO_GATE = 64 * MiB, DO_BV = 96 * MiB;

struct Params { const float* in[34]; float* out; unsigned char* ws; };
enum { I_X = 0, I_C, I_CTX, I_CCTX, I_WMOD, I_BMOD, I_GPRE1, I_GPOST1, I_GPRE2, I_GPOST2, I_WIN, I_CONV, I_GMLNG, I_GMLNB, I_WSP, I_BSP,
       I_DW0, I_DUP, I_A0, I_AUP, I_KK, I_KA, I_RK, I_GUP, I_LNXG, I_LNXB, I_WOUT, I_WRG, I_BRG, I_WRE, I_BRE, I_WG, I_WU, I_WD };

typedef __bf16 bf16x2_t __attribute__((ext_vector_type(2)));
typedef _Float16 h2_t __attribute__((ext_vector_type(2)));
typedef _Float16 h4_t __attribute__((ext_vector_type(4)));
DI unsigned pkh2(float lo, float hi) { const f32x2 v = {lo, hi}; const h2_t h = __builtin_convertvector(v, h2_t); return __builtin_bit_cast(unsigned, h); }
DI f32x2 unpkh2(unsigned w) { return __builtin_convertvector(__builtin_bit_cast(h2_t, w), f32x2); }
DI unsigned pk2(float lo, float hi) { const f32x2 v = {lo, hi}; const bf16x2_t b = __builtin_convertvector(v, bf16x2_t); return __builtin_bit_cast(unsigned, b); }
DI unsigned f2bf(float f) { return pk2(f, f) & 0xffffu; }
DI float bf2f(unsigned b) { return __builtin_bit_cast(float, b << 16); }
DI float bflo(unsigned w) { return __builtin_bit_cast(float, w << 16); }
DI float bfhi(unsigned w) { return __builtin_bit_cast(float, w & 0xffff0000u); }
DI unsigned cvt_pk_bf16(float lo, float hi) { return pk2(lo, hi); }

template <int CTRL, int ROWMASK> DI float dppf(float v) { return __builtin_bit_cast(float, __builtin_amdgcn_update_dpp(0, __builtin_bit_cast(int, v), CTRL, ROWMASK, 0xf, false)); }
DI float wave_scan_incl(float v) {
    v += dppf<0x111, 0xf>(v); v += dppf<0x112, 0xf>(v); v += dppf<0x114, 0xf>(v); v += dppf<0x118, 0xf>(v);
    v += dppf<0x142, 0xa>(v); v += dppf<0x143, 0xc>(v); return v;
}
DI float lane63(float v) { return __builtin_bit_cast(float, __builtin_amdgcn_readlane(__builtin_bit_cast(int, v), 63)); }
DI float wave_sum(float v) { return lane63(wave_scan_incl(v)); }
DI float sigmoidf_(float x) { return __builtin_amdgcn_rcpf(1.f + __expf(-x)); }
DI f32x4 sigmoid4(f32x4 x) { const f32x4 t = x * -1.4426950409f; f32x4 e; e.x = __builtin_amdgcn_exp2f(t.x); e.y = __builtin_amdgcn_exp2f(t.y); e.z = __builtin_amdgcn_exp2f(t.z); e.w = __builtin_amdgcn_exp2f(t.w);
    const f32x4 d = e + 1.f; return (f32x4){__builtin_amdgcn_rcpf(d.x), __builtin_amdgcn_rcpf(d.y), __builtin_amdgcn_rcpf(d.z), __builtin_amdgcn_rcpf(d.w)}; }
DI float siluf_(float x) { return x * __builtin_amdgcn_rcpf(1.f + __expf(-x)); }
DI float softplusf_(float x) { return fmaxf(x, 0.f) + __logf(1.f + __expf(-fabsf(x))); }
DI float tanh_fast(float x) { return 2.f * __builtin_amdgcn_rcpf(1.f + __expf(-2.f * x)) - 1.f; }
DI float gelu_tanh(float x) { const float u2 = 1.5957691216057308f * (x + 0.044715f * x * x * x); return x * __builtin_amdgcn_rcpf(1.f + __expf(-u2)); }
#define LDS_WAIT() asm volatile("s_waitcnt lgkmcnt(0)" ::: "memory")

namespace pg8 {
constexpr int BM = 256, BK = 64, HALF = 128, HTB = HALF * BK * 2, STAGE_BYTES = 8 * HTB, NXCD = 8, WGM = 8;
__host__ __device__ __forceinline__ int lds_byte(int r, int c) { const int st = (r >> 4) * 2 + (c >> 5), rr = r & 15, cc = c & 31, ob = rr * 64 + cc * 2; return st * 1024 + (ob ^ (((ob >> 9) & 1) << 5)); }
__host__ __device__ __forceinline__ void stage_rc(int b, int& R, int& C) { const int st = b / 1024, sb = b % 1024, swz = sb ^ (((sb >> 9) & 1) << 5); R = (st >> 1) * 16 + swz / 64; C = (st & 1) * 32 + (swz % 64) / 2; }
__host__ __device__ __forceinline__ int perm32(int rho) { const int n = rho >> 4, i = rho & 15; return 8 * (i >> 2) + 4 * n + (i & 3); }

struct Unit { const char* A; const char* B; const int* ridx; int pm, pn, e, lt, nvalid; };

struct StaticOrder {
    const char* A; const char* Bt; int K; int nM, nN, nwg, G, c;
    __device__ void init(const void* A_, const void* Bt_, int M, int N, int K_, int G_, int c_) { A = (const char*)A_; Bt = (const char*)Bt_; K = K_; nM = M / BM; nN = N / BM; nwg = nM * nN; G = G_; c = c_; }
    __device__ bool next(int i, Unit& u) const {
        const long L = (long)i * G + c; if (L >= nwg) return false;
        int wgid = (int)L; { const int q = nwg / NXCD, r = nwg % NXCD, xcd = wgid % NXCD, off = wgid / NXCD; wgid = (xcd < r ? xcd * (q + 1) : r * (q + 1) + (xcd - r) * q) + off; }
        const int nig = WGM * nN, gid = wgid / nig, fm = gid * WGM, gsz = (nM - fm) < WGM ? (nM - fm) : WGM;
        u.pm = fm + ((wgid % nig) % gsz); u.pn = (wgid % nig) / gsz;
        u.A = A + (size_t)u.pm * BM * K * 2; u.B = Bt + (size_t)u.pn * BM * K * 2; u.ridx = nullptr; u.e = 0; u.lt = 0; u.nvalid = BM; return true;
    }
};

DI int gidx(const Unit& u, int r) { return r < u.nvalid ? (u.ridx[r] >> 1) : 0; }

template <class Epi, class Sched, bool GATHER, bool HALFN = false>
DI void gemm_phase(LAS unsigned char* lds, const int K, const Sched& S, const Epi& E) {
    int tid_ = threadIdx.x; asm volatile("" : "+v"(tid_));
    const int tid = tid_, wid = __builtin_amdgcn_readfirstlane(tid >> 6), lane = tid & 63, wr = wid >> 2, wc = wid & 3, fr = lane & 15, fq = lane >> 4;
    const int nt = K / BK;
    int Rr[2], Cc[2];
    unsigned voffB[2], vA[2][2], vAn[2][2];
#pragma unroll
    for (int i = 0; i < 2; ++i) { int R, C; stage_rc(tid * 16 + i * 8192, R, C); Rr[i] = R; Cc[i] = C; const int Rb = (R & ~31) + perm32(R & 31);
        voffB[i] = (unsigned)(Rb * K + C) * 2u;
        vA[0][i] = (unsigned)(R * K + C) * 2u; vA[1][i] = (unsigned)((R + HALF) * K + C) * 2u; vAn[0][i] = vA[0][i]; vAn[1][i] = vA[1][i]; }
    const size_t kstep = (size_t)(BK * 2);
    const size_t hstep = (size_t)HALF * K * 2;
    const unsigned ldsw = (unsigned)wid * 1024u;
    const int aoff = lds_byte(wr * 64 + fr, fq * 8), boff = lds_byte(wc * 32 + fr, fq * 8);
#define PG8_SA(b, h) (((b) * 2 + (h)) * HTB)
#define PG8_SB(b, h) ((4 + (b) * 2 + (h)) * HTB)
#define PG8_STAGE(bufoff, gbase, voff) do { _Pragma("unroll") for (int _i = 0; _i < 2; ++_i) \
        __builtin_amdgcn_global_load_lds((const unsigned*)((const char*)(gbase) + (voff)[_i]), (LAS unsigned*)(lds + (bufoff) + ldsw + _i * 8192), 16, 0, 0); } while (0)
#define PG8_LDA(dst, b, h) do { _Pragma("unroll") for (int m = 0; m < 4; ++m) _Pragma("unroll") for (int k = 0; k < 2; ++k) dst[m][k] = *(const LAS bf16x8*)(lds + PG8_SA(b, h) + aoff + m * 2048 + k * 1024); } while (0)
#define PG8_LDB(dst, b, h) do { _Pragma("unroll") for (int n = 0; n < 2; ++n) _Pragma("unroll") for (int k = 0; k < 2; ++k) dst[n][k] = *(const LAS bf16x8*)(lds + PG8_SB(b, h) + boff + n * 2048 + k * 1024); } while (0)
#define PG8_MMA(ai, bj, At, Bt) do { __builtin_amdgcn_s_setprio(1); _Pragma("unroll") for (int m = 0; m < 4; ++m) _Pragma("unroll") for (int n = 0; n < 2; ++n) _Pragma("unroll") for (int k = 0; k < 2; ++k) \
        acc[ai][bj][m][n] = __builtin_amdgcn_mfma_f32_16x16x32_bf16(Bt[n][k], At[m][k], acc[ai][bj][m][n], 0, 0, 0); __builtin_amdgcn_s_setprio(0); } while (0)
#define PG8_WAIT_V(n) asm volatile("s_waitcnt vmcnt(" #n ")" ::: "memory")
#define PG8_WAIT_VK() do { if constexpr (HALFN) PG8_WAIT_V(6); else PG8_WAIT_V(8); } while (0)
#define PG8_WAIT_L(n) asm volatile("s_waitcnt lgkmcnt(" #n ")" ::: "memory")
#define PG8_BAR __builtin_amdgcn_s_barrier()
#define PG8_SCHED __builtin_amdgcn_sched_barrier(0)
    Unit cur, nxt; int ui = 0;
    if (!S.next(0, cur)) return;
    if constexpr (GATHER) {
#pragma unroll
        for (int i = 0; i < 2; ++i) { vA[0][i] = (unsigned)(gidx(cur, Rr[i]) * K + Cc[i]) * 2u; vA[1][i] = (unsigned)(gidx(cur, Rr[i] + HALF) * K + Cc[i]) * 2u; }
    }
    f32x4 acc[2][2][4][2];
#pragma unroll
    for (int a = 0; a < 2; ++a)
#pragma unroll
        for (int b = 0; b < 2; ++b)
#pragma unroll
            for (int m = 0; m < 4; ++m)
#pragma unroll
                for (int n = 0; n < 2; ++n) acc[a][b][m][n] = (f32x4){0.f, 0.f, 0.f, 0.f};
    bf16x8 At[4][2], B0[2][2], B1[2][2];
    const char* cA = cur.A; const char* cB = cur.B;
    PG8_STAGE(PG8_SB(0, 0), cB, voffB); if constexpr (!HALFN) PG8_STAGE(PG8_SB(0, 1), cB + hstep, voffB); PG8_STAGE(PG8_SA(0, 0), cA, vA[0]); PG8_STAGE(PG8_SA(0, 1), cA, vA[1]);
    if (wr == 1) PG8_BAR;
    PG8_WAIT_V(2); PG8_BAR;
    PG8_STAGE(PG8_SB(1, 0), cB + kstep, voffB); PG8_STAGE(PG8_SA(1, 0), cA + kstep, vA[0]); if constexpr (!HALFN) PG8_STAGE(PG8_SB(1, 1), cB + hstep + kstep, voffB);
    if constexpr (HALFN) PG8_WAIT_V(4); else PG8_WAIT_V(6);
    PG8_BAR;
    for (;;) {
        const bool has_next = S.next(ui + 1, nxt);
        const char* nA = has_next ? nxt.A : cA; const char* nB = has_next ? nxt.B : cB;
        if constexpr (GATHER) {
            if (has_next) {
#pragma unroll
                for (int i = 0; i < 2; ++i) { vAn[0][i] = (unsigned)(gidx(nxt, Rr[i]) * K + Cc[i]) * 2u; vAn[1][i] = (unsigned)(gidx(nxt, Rr[i] + HALF) * K + Cc[i]) * 2u; }
            } else {
#pragma unroll
                for (int i = 0; i < 2; ++i) { vAn[0][i] = vA[0][i]; vAn[1][i] = vA[1][i]; }
            }
        }
#pragma unroll 1
        for (int t = 0; t < nt; t += 2) {
            const bool last = (t == nt - 2);
            const char* a1 = cA + (size_t)(t + 1) * kstep;
            const char* a2 = last ? nA : cA + (size_t)(t + 2) * kstep; const char* b2 = last ? nB : cB + (size_t)(t + 2) * kstep;
            const char* a3 = a2 + kstep; const char* b3 = b2 + kstep;
            unsigned w0[2], w1[2];
            if constexpr (GATHER) { w0[0] = last ? vAn[0][0] : vA[0][0]; w0[1] = last ? vAn[0][1] : vA[0][1]; w1[0] = last ? vAn[1][0] : vA[1][0]; w1[1] = last ? vAn[1][1] : vA[1][1]; }
            else { w0[0] = vA[0][0]; w0[1] = vA[0][1]; w1[0] = vA[1][0]; w1[1] = vA[1][1]; }
            PG8_LDB(B0, 0, 0); if constexpr (!HALFN) PG8_LDB(B1, 0, 1); PG8_SCHED; PG8_LDA(At, 0, 0); PG8_STAGE(PG8_SA(1, 1), a1, vA[1]);
            PG8_WAIT_VK(); PG8_WAIT_L(0); PG8_BAR; PG8_MMA(0, 0, At, B0); if constexpr (!HALFN) PG8_MMA(0, 1, At, B1); PG8_BAR; PG8_SCHED;
            PG8_LDA(At, 0, 1); PG8_STAGE(PG8_SB(0, 0), b2, voffB); if constexpr (!HALFN) PG8_STAGE(PG8_SB(0, 1), b2 + hstep, voffB); PG8_STAGE(PG8_SA(0, 0), a2, w0);
            PG8_WAIT_VK(); PG8_WAIT_L(0); PG8_BAR; PG8_MMA(1, 0, At, B0); if constexpr (!HALFN) PG8_MMA(1, 1, At, B1); PG8_BAR; PG8_SCHED;
            PG8_LDB(B0, 1, 0); if constexpr (!HALFN) PG8_LDB(B1, 1, 1); PG8_SCHED; PG8_LDA(At, 1, 0); PG8_STAGE(PG8_SA(0, 1), a2, w1);
            PG8_WAIT_VK(); PG8_WAIT_L(0); PG8_BAR; PG8_MMA(0, 0, At, B0); if constexpr (!HALFN) PG8_MMA(0, 1, At, B1); PG8_BAR; PG8_SCHED;
            PG8_LDA(At, 1, 1); PG8_STAGE(PG8_SB(1, 0), b3, voffB); if constexpr (!HALFN) PG8_STAGE(PG8_SB(1, 1), b3 + hstep, voffB); PG8_STAGE(PG8_SA(1, 0), a3, w0);
            PG8_WAIT_VK(); PG8_WAIT_L(0); PG8_BAR; PG8_MMA(1, 0, At, B0); if constexpr (!HALFN) PG8_MMA(1, 1, At, B1); PG8_BAR; PG8_SCHED;
        }
        if (wr == 0) PG8_BAR;
        E(acc, cur, wr, wc, fr, fq);
        if (!has_next) break;
#pragma unroll
        for (int a = 0; a < 2; ++a)
#pragma unroll
            for (int b = 0; b < 2; ++b)
#pragma unroll
                for (int m = 0; m < 4; ++m)
#pragma unroll
                    for (int n = 0; n < 2; ++n) acc[a][b][m][n] = (f32x4){0.f, 0.f, 0.f, 0.f};
        cur = nxt; cA = nA; cB = nB; ++ui;
        if constexpr (GATHER) {
#pragma unroll
            for (int i = 0; i < 2; ++i) { vA[0][i] = vAn[0][i]; vA[1][i] = vAn[1][i]; }
        }
        if (wr == 1) PG8_BAR;
    }
    PG8_WAIT_V(0);
    PG8_BAR;
#undef PG8_SA
#undef PG8_SB
#undef PG8_STAGE
#undef PG8_LDA
#undef PG8_LDB
#undef PG8_MMA
#undef PG8_WAIT_V
#undef PG8_WAIT_VK
#undef PG8_WAIT_L
#undef PG8_BAR
#undef PG8_SCHED
}

struct EpiBf16 {
    bf16_t* O; int ldc; bool zact; int nbj = 2;
    DI void operator()(const f32x4 (&acc)[2][2][4][2], const Unit& u, int wr, int wc, int fr, int fq) const {
        const int row0 = u.pm * BM + wr * 64 + fr, col0 = u.pn * BM + wc * 32 + 8 * fq;
#pragma unroll
        for (int bj = 0; bj < 2; ++bj) { if (bj >= nbj) break; const int hc = 2 * u.pn + bj; const int act = !zact ? 0 : (hc < 12 ? 4 : (hc == 12 ? 1 : (hc == 14 ? 2 : (hc >= 15 ? 3 : 0))));
#pragma unroll
            for (int ai = 0; ai < 2; ++ai)
#pragma unroll
                for (int m = 0; m < 4; ++m) { bf16_t* rowp = O + (size_t)(row0 + ai * HALF + m * 16) * ldc + col0;
                    f32x4 v0 = acc[ai][bj][m][0], v1 = acc[ai][bj][m][1];
                    if (act == 1) {
#pragma unroll
                        for (int j = 0; j < 4; ++j) { v0[j] = tanh_fast(v0[j]); v1[j] = tanh_fast(v1[j]); }
                    } else if (act == 2) {
#pragma unroll
                        for (int j = 0; j < 4; ++j) { v0[j] = sigmoidf_(v0[j]); v1[j] = sigmoidf_(v1[j]); }
                    } else if (act == 3) {
#pragma unroll
                        for (int j = 0; j < 4; ++j) { v0[j] = gelu_tanh(v0[j]); v1[j] = gelu_tanh(v1[j]); }
                    }
                    u32x4 w;
                    if (act == 4) { w.x = pkh2(v0[0], v0[1]); w.y = pkh2(v0[2], v0[3]); w.z = pkh2(v1[0], v1[1]); w.w = pkh2(v1[2], v1[3]); }
                    else { w.x = cvt_pk_bf16(v0[0], v0[1]); w.y = cvt_pk_bf16(v0[2], v0[3]); w.z = cvt_pk_bf16(v1[0], v1[1]); w.w = cvt_pk_bf16(v1[2], v1[3]); }
                    *(u32x4*)(rowp + bj * HALF) = w; } }
    }
};
struct EpiF32 {
    float* O; int ldc;
    DI void operator()(const f32x4 (&acc)[2][2][4][2], const Unit& u, int wr, int wc, int fr, int fq) const {
        const int row0 = u.pm * BM + wr * 64 + fr, col0 = u.pn * BM + wc * 32 + 8 * fq;
#pragma unroll
        for (int ai = 0; ai < 2; ++ai)
#pragma unroll
            for (int m = 0; m < 4; ++m) { float* rowp = O + (size_t)(row0 + ai * HALF + m * 16) * ldc + col0;
#pragma unroll
                for (int bj = 0; bj < 2; ++bj) { *(f32x4*)(rowp + bj * HALF) = acc[ai][bj][m][0]; *(f32x4*)(rowp + bj * HALF + 4) = acc[ai][bj][m][1]; } }
    }
};
struct EpiMoeUp {
    bf16_t* HID;
    DI void operator()(const f32x4 (&acc)[2][2][4][2], const Unit& u, int wr, int wc, int fr, int fq) const {
        const int row0 = u.pm * BM + wr * 64 + fr, col0 = u.pn * HALF + wc * 32 + 8 * fq;
#pragma unroll
        for (int ai = 0; ai < 2; ++ai)
#pragma unroll
            for (int m = 0; m < 4; ++m) { bf16_t* rowp = HID + (size_t)(row0 + ai * HALF + m * 16) * DEXP + col0;
                float h[8];
#pragma unroll
                for (int n = 0; n < 2; ++n)
#pragma unroll
                    for (int j = 0; j < 4; ++j) { const float g = acc[ai][0][m][n][j], up = acc[ai][1][m][n][j]; h[n * 4 + j] = siluf_(g) * up; }
                u32x4 w; w.x = cvt_pk_bf16(h[0], h[1]); w.y = cvt_pk_bf16(h[2], h[3]); w.z = cvt_pk_bf16(h[4], h[5]); w.w = cvt_pk_bf16(h[6], h[7]);
                *(u32x4*)rowp = w; }
    }
};
struct EpiMoeDown {
    bf16_t* YM; const int* perm; const float* ew;
    DI void operator()(const f32x4 (&acc)[2][2][4][2], const Unit& u, int wr, int wc, int fr, int fq) const {
        const int col0 = u.pn * BM + wc * 32 + 8 * fq;
        int pr[2][4]; float wgt[2][4];
#pragma unroll
        for (int ai = 0; ai < 2; ++ai)
#pragma unroll
            for (int m = 0; m < 4; ++m) { const int r = ai * HALF + wr * 64 + m * 16 + fr; pr[ai][m] = r < u.nvalid ? perm[(size_t)u.e * NT + u.lt * BM + r] : -1; }
#pragma unroll
        for (int ai = 0; ai < 2; ++ai)
#pragma unroll
            for (int m = 0; m < 4; ++m) wgt[ai][m] = pr[ai][m] >= 0 ? ew[pr[ai][m]] : 0.f;
#pragma unroll
        for (int ai = 0; ai < 2; ++ai)
#pragma unroll
            for (int m = 0; m < 4; ++m) {
                if (pr[ai][m] >= 0) { const int tok = pr[ai][m] >> 1, slot = pr[ai][m] & 1; const float wg = wgt[ai][m];
                    bf16_t* rowp = YM + ((size_t)slot * NT + tok) * D + col0;
#pragma unroll
                    for (int bj = 0; bj < 2; ++bj) { const f32x4 v0 = acc[ai][bj][m][0] * wg, v1 = acc[ai][bj][m][1] * wg;
                        u32x4 w; w.x = cvt_pk_bf16(v0[0], v0[1]); w.y = cvt_pk_bf16(v0[2], v0[3]); w.z = cvt_pk_bf16(v1[0], v1[1]); w.w = cvt_pk_bf16(v1[2], v1[3]);
                        *(u32x4*)(rowp + bj * HALF) = w; } } }
    }
};
}

struct MoeOrder {
    const LAS int* tp; const int* cnt; int npn, G, c, K; const char* A; const char* Bbase; size_t bstride_e, bstride_pn; const int* perm; bool gather;
    __device__ bool next(int i, pg8::Unit& u) const {
        const int TT = __builtin_amdgcn_readfirstlane(tp[32]); const long L = (long)i * G + c; if (L >= (long)TT * npn) return false;
        const int rt = (int)(L / npn), pn = (int)(L % npn);
        const int e = __builtin_amdgcn_readfirstlane(tp[72 + rt]);
        const int lt = rt - __builtin_amdgcn_readfirstlane(tp[e]);
        u.pm = rt; u.pn = pn; u.e = e; u.lt = lt; const int rem = __builtin_amdgcn_readfirstlane(tp[36 + e]) - lt * 256; u.nvalid = rem < 256 ? rem : 256;
        u.ridx = perm + (size_t)e * NT + lt * 256;
        u.A = gather ? A : A + (size_t)rt * 256 * K * 2;
        u.B = Bbase + (size_t)e * bstride_e + (size_t)pn * bstride_pn;
        return true;
    }
};

struct Ctx {
    LAS unsigned char* lds; int tid, lane, wave, G, bid;
};

DI void phase_adaln(const Params& p, const Ctx& F) {
    LAS float* s = (LAS float*)F.lds;
    LAS float* red = (LAS float*)(F.lds + 20480);
    const float* c = p.in[I_C]; const float* cc = p.in[I_CCTX]; const float* wm = p.in[I_WMOD]; const float* bm = p.in[I_BMOD];
    float* mod = (float*)(p.ws + WS_MOD);
    for (int i = F.tid; i < 5 * 1024; i += NTHREADS) { const float v = i < 4096 ? c[i] : cc[i - 4096]; s[i] = siluf_(v); }
    __syncthreads();
    for (int grp = F.bid; grp < 256; grp += F.G) {
        const int col0 = grp * 24, q = F.tid % 6, ks = F.tid / 6;
        float acc[5][4];
#pragma unroll
        for (int b = 0; b < 5; ++b)
#pragma unroll
            for (int j = 0; j < 4; ++j) acc[b][j] = 0.f;
        if (F.tid < 510) {
            f32x4 wv[13];
#pragma unroll
            for (int i = 0; i < 13; ++i) { const int k = ks + 85 * i; wv[i] = k < 1024 ? __builtin_nontemporal_load((const f32x4*)(wm + (size_t)k * 6144 + col0 + 4 * q)) : (f32x4){0.f, 0.f, 0.f, 0.f}; }
#pragma unroll
            for (int i = 0; i < 13; ++i) { const int k = ks + 85 * i; const int kc = k < 1024 ? k : 0;
#pragma unroll
                for (int b = 0; b < 5; ++b) { const float sv = s[b * 1024 + kc];
#pragma unroll
                    for (int j = 0; j < 4; ++j) acc[b][j] += sv * wv[i][j]; } }
#pragma unroll
            for (int b = 0; b < 5; ++b)
#pragma unroll
                for (int j = 0; j < 4; ++j) red[ks * 120 + q * 20 + b * 4 + j] = acc[b][j];
        }
        __syncthreads();
        if (F.tid < 120) {
            float sum = 0.f;
            for (int k2 = 0; k2 < 85; ++k2) sum += red[k2 * 120 + F.tid];
            const int qq = F.tid / 20, b = (F.tid % 20) / 4, j = F.tid % 4, col = col0 + 4 * qq + j;
            mod[b * 6144 + col] = sum + bm[col];
        }
        __syncthreads();
    }
}

DI void transpose_item(const float* W, int K, int N, bf16_t* WT, int row_off, LAS float* scr, int item, int lane) {
    const int nblk = N / 32, kb = item / nblk, nb = item % nblk, k0 = 64 * kb, n0 = 32 * nb;
#pragma unroll 8
    for (int i = 0; i < 32; ++i) { const int kk = 2 * i + (lane >> 5); scr[kk * 33 + (lane & 31)] = W[(size_t)(k0 + kk) * N + n0 + (lane & 31)]; }
    LDS_WAIT(); asm volatile("" ::: "memory");
    const int c = lane & 7;
#pragma unroll
    for (int j = 0; j < 4; ++j) { const int n = (lane >> 3) + 8 * j; const LAS float* s = scr + (8 * c) * 33 + n;
        u32x4 o; o.x = pk2(s[0 * 33], s[1 * 33]); o.y = pk2(s[2 * 33], s[3 * 33]); o.z = pk2(s[4 * 33], s[5 * 33]); o.w = pk2(s[6 * 33], s[7 * 33]);
        *(u32x4*)(WT + (size_t)(row_off + n0 + n) * K + k0 + 8 * c) = o; }
    LDS_WAIT(); asm volatile("" ::: "memory");
}
DI void phase_convert(const Params& p, const Ctx& F) {
    __syncthreads();
    LAS float* scr = (LAS float*)(F.lds + F.wave * 16384);
    const int gw = F.bid * NWAVES + F.wave, NGW = F.G * NWAVES;
    bf16_t* WinT = (bf16_t*)(p.ws + WS_WINT); bf16_t* WoutT = (bf16_t*)(p.ws + WS_WOUTT); bf16_t* WguT = (bf16_t*)(p.ws + WS_WGUT); bf16_t* WdT = (bf16_t*)(p.ws + WS_WDT);
    constexpr int I_IN = 16 * 92, I_OUT = 16 * 32;
    constexpr int NITEMS = I_IN + I_OUT;
    for (int it = gw; it < NITEMS; it += NGW) {
        int r = it;
        if (r < I_IN) { transpose_item(p.in[I_WIN], 1024, DIN, WinT, 0, scr, r, F.lane); continue; } r -= I_IN;
        transpose_item(p.in[I_WOUT], 1024, 1024, WoutT, 0, scr, r, F.lane);
    }
    (void)WguT; (void)WdT;
    { const int gt = F.bid * NTHREADS + F.tid, NG = F.G * NTHREADS; u32x4 z = {0u, 0u, 0u, 0u};
      for (int i = gt; i < 128 * 1024 / 8; i += NG) *(u32x4*)(WinT + (size_t)DIN * 1024 + (size_t)i * 8) = z;
      bf16_t* DupT = (bf16_t*)(p.ws + WS_DUPT); bf16_t* AupT = (bf16_t*)(p.ws + WS_AUPT); bf16_t* GupT = (bf16_t*)(p.ws + WS_GUPT); bf16_t* Wsp = (bf16_t*)(p.ws + WS_WSP);
      for (int i = gt; i < 2 * 512 * 64; i += NG) { const int d = i / (512 * 64), ch = (i / 64) % 512, l = i % 64;
          DupT[i] = (bf16_t)f2bf(p.in[I_DUP][(size_t)(d * 64 + l) * 512 + ch]); AupT[i] = (bf16_t)f2bf(p.in[I_AUP][(size_t)(d * 64 + l) * 512 + ch]); }
      for (int i = gt; i < 512 * 128; i += NG) { const int ch = i / 128, l = i % 128; GupT[i] = (bf16_t)f2bf(p.in[I_GUP][(size_t)l * 512 + ch]); }
      for (int i = gt; i < 8 * 128 * 128; i += NG) Wsp[i] = (bf16_t)f2bf(p.in[I_WSP][i]);
      float* wrt = (float*)(p.ws + WS_WRT);
      for (int i = gt; i < 36 * 1024; i += NG) { const int o = i >> 10, k = i & 1023; wrt[i] = o < 4 ? p.in[I_WRG][k * 4 + o] : p.in[I_WRE][k * 32 + (o - 4)]; }
      { bf16_t* wrh = (bf16_t*)(p.ws + WS_WRH); bf16_t* wrl = (bf16_t*)(p.ws + WS_WRL);
        for (int i = gt; i < 32 * 1024; i += NG) { const int n = i >> 10, k = i & 1023; const float wv = p.in[I_WRE][k * 32 + n]; const unsigned hi = f2bf(wv); wrh[i] = (bf16_t)hi; wrl[i] = (bf16_t)f2bf(wv - __builtin_bit_cast(float, hi << 16)); } }
      float* cw2 = (float*)(p.ws + WS_CONVW);
      for (int i = gt; i < 128 * 9 * 3 * 4; i += NG) { const int j = i & 3, s3 = (i >> 2) % 3, tap = (i / 12) % 9, qd = i / 108; cw2[i] = p.in[I_CONV][tap * 1536 + s3 * 512 + 4 * qd + j]; } }
}


DI void phase_convert_experts(const Params& p, const Ctx& F) {
    constexpr int TP = 264;
    LAS bf16_t* tile = (LAS bf16_t*)F.lds;
    bf16_t* WguT = (bf16_t*)(p.ws + WS_WGUT); bf16_t* WdT = (bf16_t*)(p.ws + WS_WDT);
    constexpr int NIT = 32 * 2 * 16 + 32 * 16;
    const int b0 = F.bid, nb = F.G;
    for (int it = b0; it < NIT; it += nb) {
        const float* src; int ldn; bf16_t* dst; int ldk, k0; int rowmap;
        int n0 = 0;
        if (it < 1024) { const int e = it >> 5, up = (it >> 4) & 1, kt = it & 15; src = (up ? p.in[I_WU] : p.in[I_WG]) + (size_t)e * 1024 * 256 + (size_t)kt * 64 * 256; ldn = 256;
            dst = WguT + (size_t)e * 512 * 1024; ldk = 1024; k0 = kt * 64; rowmap = 1 + up; }
        else { const int r = it - 1024, e = r >> 4, kt = (r >> 2) & 3, ntl = r & 3; src = p.in[I_WD] + (size_t)e * 256 * 1024 + (size_t)kt * 64 * 1024 + ntl * 256; ldn = 1024;
            dst = WdT + (size_t)e * 1024 * 256; ldk = 256; k0 = kt * 64; rowmap = 0; n0 = ntl * 256; }
        __syncthreads();
#pragma unroll
        for (int i = 0; i < 8; ++i) { const int k = 8 * F.wave + i; const f32x4 v = __builtin_nontemporal_load((const f32x4*)(src + (size_t)k * ldn + 4 * F.lane));
            u32x2 o; o.x = pk2(v[0], v[1]); o.y = pk2(v[2], v[3]); *(LAS u32x2*)(tile + k * TP + 4 * F.lane) = o; }
        __syncthreads();
        { const int n = F.tid >> 1, kh = F.tid & 1;
          u32x4 o[4];
#pragma unroll
          for (int q = 0; q < 4; ++q) { unsigned wds[4];
#pragma unroll
              for (int j = 0; j < 4; ++j) { const int k = 32 * kh + 8 * q + 2 * j; wds[j] = (unsigned)tile[k * TP + n] | ((unsigned)tile[(k + 1) * TP + n] << 16); }
              o[q] = (u32x4){wds[0], wds[1], wds[2], wds[3]}; }
          const int drow = rowmap == 0 ? n0 + n : ((n >> 7) * 256 + (n & 127) + (rowmap == 2 ? 128 : 0));
          bf16_t* dp = dst + (size_t)drow * ldk + k0 + 32 * kh;
#pragma unroll
          for (int q = 0; q < 4; ++q) *(u32x4*)(dp + 8 * q) = o[q]; }
    }
}

DI void phase_hrows(const Params& p, const Ctx& F) {
    const float* mod = (const float*)(p.ws + WS_MOD); const float* g = p.in[I_GPRE1]; bf16_t* H = (bf16_t*)(p.ws + WS_H);
    const int gw = F.bid * NWAVES + F.wave, NGW = F.G * NWAVES;
    auto rowsrc = [&](int row) -> const f32x4* { return (const f32x4*)(row < NT ? p.in[I_X] + (size_t)row * D : p.in[I_CTX] + (size_t)(row - NT) * D) + F.lane; };
    f32x4 nv[2][4];
    auto issue = [&](int pr) {
#pragma unroll
        for (int r = 0; r < 2; ++r) { const f32x4* xr = rowsrc(2 * pr + r);
#pragma unroll
            for (int j = 0; j < 4; ++j) nv[r][j] = __builtin_nontemporal_load(xr + 64 * j); } };
    if (2 * gw < MR) issue(gw);
    int btcur = -1; f32x4 gs[4], shv[4];
    for (int pr = gw; 2 * pr < MR; pr += NGW) {
        const int row0 = 2 * pr;
        const int bt = row0 < NT ? row0 / SEQ : 4;
        f32x4 v[2][4]; float ss[2] = {0.f, 0.f};
#pragma unroll
        for (int r = 0; r < 2; ++r)
#pragma unroll
            for (int j = 0; j < 4; ++j) { v[r][j] = nv[r][j]; ss[r] += (v[r][j].x * v[r][j].x + v[r][j].y * v[r][j].y) + (v[r][j].z * v[r][j].z + v[r][j].w * v[r][j].w); }
        if (bt != btcur) { btcur = bt;
#pragma unroll
            for (int j = 0; j < 4; ++j) { const int col = 4 * (F.lane + 64 * j); gs[j] = *(const f32x4*)(g + col) * (*(const f32x4*)(mod + bt * 6144 + 1024 + col) + 1.f); shv[j] = *(const f32x4*)(mod + bt * 6144 + col); } }
        if (2 * (pr + NGW) < MR) issue(pr + NGW);
#pragma unroll
        for (int r = 0; r < 2; ++r) {
            const float rstd = __builtin_amdgcn_rsqf(wave_sum(ss[r]) * (1.f / D) + 1e-6f);
            unsigned long long* o8 = (unsigned long long*)(H + (size_t)(row0 + r) * D) + F.lane;
#pragma unroll
            for (int j = 0; j < 4; ++j) {
                const f32x4 h = v[r][j] * rstd * gs[j] + shv[j];
                o8[64 * j] = (unsigned long long)pk2(h.x, h.y) | ((unsigned long long)pk2(h.z, h.w) << 32); }
        }
    }
}

struct HalfOrder {
    const char* A; const char* Bt; int K, nM, pn, G, c;
    __device__ bool next(int i, pg8::Unit& u) const {
        const int j = c + i * G; if (c < 0 || j >= nM) return false;
        u.pm = j; u.pn = pn; u.A = A + (size_t)j * 256 * K * 2; u.B = Bt + (size_t)pn * 256 * K * 2; u.ridx = nullptr; u.e = 0; u.lt = 0; u.nvalid = 256; return true;
    }
};
DI void phase_gemm1(const Params& p, const Ctx& F) {
    constexpr int NFULL = (DIN / 256) * 256, nfu = (MR / 256) * (DIN / 256), nhu = MR / 256;
    pg8::StaticOrder S; S.init(p.ws + WS_H, p.ws + WS_WINT, MR, NFULL, 1024, F.G, F.bid);
    pg8::EpiBf16 E{(bf16_t*)(p.ws + WS_Z), DINP, true};
    pg8::gemm_phase<pg8::EpiBf16, pg8::StaticOrder, false>(F.lds, 1024, S, E);
    const int rem = nfu % F.G, nlate = rem ? F.G - rem : F.G;
    HalfOrder HS{(const char*)(p.ws + WS_H), (const char*)(p.ws + WS_WINT), 1024, nhu, DIN / 256, nlate, rem ? F.bid - rem : F.bid};
    pg8::EpiBf16 EH{(bf16_t*)(p.ws + WS_Z), DINP, true, 1};
    pg8::gemm_phase<pg8::EpiBf16, HalfOrder, false, true>(F.lds, 1024, HS, EH);
}

DI void phase_prep(const Params& p, const Ctx& F) {
    const bf16_t* Z = (const bf16_t*)(p.ws + WS_Z);
    bf16_t* Kc = (bf16_t*)(p.ws + WS_KC); bf16_t* Vc = (bf16_t*)(p.ws + WS_VC); bf16_t* Rc = (bf16_t*)(p.ws + WS_RC);
    bf16_t* A0 = (bf16_t*)(p.ws + WS_A0); bf16_t* A1 = (bf16_t*)(p.ws + WS_A1); bf16_t* L0 = (bf16_t*)(p.ws + WS_L0); bf16_t* L1 = (bf16_t*)(p.ws + WS_L1);
    bf16_t* GATE = (bf16_t*)((unsigned char*)p.out + DO_GATE); bf16_t* BV = (bf16_t*)((unsigned char*)p.out + DO_BV);
    const float* conv = p.in[I_CONV];
    LAS float* sl = (LAS float*)F.lds;
    const int t = F.tid;
    for (int it = F.bid; it < MR / 8; it += F.G) {
        const int row0 = it * 8;
        __syncthreads();
        for (int i = t; i < 8 * 384; i += NTHREADS) { const int rr = i / 384, c = i % 384; const float zv = bf2f(Z[(size_t)(row0 + rr) * DINP + OFF_WD + c]);
            sl[i] = c < 128 ? tanhf(zv) : (c < 256 ? zv : sigmoidf_(zv)); }
        __syncthreads();
        float dw0[8], dw1[8], da0[8], da1[8], gt[8];
#pragma unroll
        for (int r = 0; r < 8; ++r) { dw0[r] = dw1[r] = da0[r] = da1[r] = gt[r] = 0.f; }
        for (int l = 0; l < 64; ++l) {
            const float u0 = p.in[I_DUP][(size_t)l * 512 + t], u1 = p.in[I_DUP][(size_t)(64 + l) * 512 + t];
            const float v0 = p.in[I_AUP][(size_t)l * 512 + t], v1 = p.in[I_AUP][(size_t)(64 + l) * 512 + t];
            const float g0 = p.in[I_GUP][(size_t)l * 512 + t], g1 = p.in[I_GUP][(size_t)(64 + l) * 512 + t];
#pragma unroll
            for (int r = 0; r < 8; ++r) { const LAS float* s = sl + r * 384;
                dw0[r] += s[l] * u0; dw1[r] += s[64 + l] * u1; da0[r] += s[128 + l] * v0; da1[r] += s[192 + l] * v1; gt[r] += s[256 + l] * g0 + s[320 + l] * g1; }
        }
        const float w00 = p.in[I_DW0][t], w01 = p.in[I_DW0][512 + t], a00 = p.in[I_A0][t], a01 = p.in[I_A0][512 + t];
        const float ka0 = p.in[I_KA][t], ka1 = p.in[I_KA][512 + t], rk = p.in[I_RK][t];
#pragma unroll 1
        for (int r = 0; r < 8; ++r) {
            const int row = row0 + r;
            float cv[3] = {0.f, 0.f, 0.f};
            if (row < NT) {
                const int tb = row % SEQ, gy = tb / 64, gx = tb % 64;
#pragma unroll
                for (int dy = 0; dy < 3; ++dy) { const int ny = gy + dy - 1; if (ny < 0 || ny >= 128) continue;
#pragma unroll
                    for (int dx = 0; dx < 3; ++dx) { const int nx = gx + dx - 1; if (nx < 0 || nx >= 64) continue;
                        const size_t nrow = (size_t)(row + (dy - 1) * 64 + (dx - 1));
#pragma unroll
                        for (int s3 = 0; s3 < 3; ++s3) cv[s3] += bf2f(Z[nrow * DINP + s3 * 512 + t]) * conv[(dy * 3 + dx) * 1536 + s3 * 512 + t]; } }
            } else {
                const int tb = (row - NT) % CTXL;
#pragma unroll
                for (int dx = 0; dx < 3; ++dx) { const int nx = tb + dx - 1; if (nx < 0 || nx >= CTXL) continue;
                    const size_t nrow = (size_t)(row + dx - 1);
#pragma unroll
                    for (int s3 = 0; s3 < 3; ++s3) cv[s3] += bf2f(Z[nrow * DINP + s3 * 512 + t]) * conv[(3 + dx) * 1536 + s3 * 512 + t]; }
            }
            const float k = cv[0], v = cv[1], rr = cv[2];
            const float wl0 = w00 + dw0[r], wl1 = w01 + dw1[r];
            const float lg0 = -__expf(-softplusf_(-wl0) - 0.5f), lg1 = -__expf(-softplusf_(-wl1) - 0.5f);
            const float a0 = sigmoidf_(a00 + da0[r]), a1 = sigmoidf_(a01 + da1[r]);
            const size_t o = (size_t)row * 512 + t;
            Kc[o] = (bf16_t)f2bf(k); Vc[o] = (bf16_t)f2bf(v); Rc[o] = (bf16_t)f2bf(rr);
            A0[o] = (bf16_t)f2bf(a0); A1[o] = (bf16_t)f2bf(a1); L0[o] = (bf16_t)f2bf(lg0); L1[o] = (bf16_t)f2bf(lg1);
            if (row < NT) {
                const float km0 = k * (1.f + (a0 - 1.f) * ka0), km1 = k * (1.f + (a1 - 1.f) * ka1);
                const float bon = wave_sum(rr * (km0 + km1) * rk);
                GATE[o] = (bf16_t)f2bf(gt[r]); BV[o] = (bf16_t)f2bf(bon * v);
            }
        }
    }
}


constexpr int ZS_TOKB = 400, ZS_ROWB = 66 * ZS_TOKB, ZS_BYTES = 3 * ZS_ROWB;
constexpr int XS_OFF = ZS_BYTES, XS_ARR = 64 * 144, XSG_OFF = XS_OFF + 4 * XS_ARR, XSG_PITCH = 272, BON_OFF = XSG_OFF + 64 * XSG_PITCH;
constexpr int CWL_OFF = BON_OFF + 1024;
static_assert(CWL_OFF + 6912 <= LDS_MISC, "prep LDS");
struct PrepLd { u32x4 zv[9]; u32x4 hv; u32x4 xv[6]; };
DI void prep_issue(PrepLd& L, const bf16_t* Z, int item, int tidv) {
    const int h = item & 7, ck = item >> 3; const bool lat = ck < 512;
    const int b = lat ? ck >> 7 : (ck - 512) >> 2, c = lat ? ck & 127 : (ck - 512) & 3;
    const int rowbase = lat ? b * SEQ + c * 64 : NT + b * CTXL + c * 64;
    const int q8 = tidv & 7, tsl = tidv >> 3;
    const bf16_t* zc = Z + (size_t)(rowbase + tsl) * DINP + 64 * h + 8 * q8;
#pragma unroll
    for (int rr = 0; rr < 3; ++rr) {
        const bool ok = lat ? (c + rr - 1 >= 0 && c + rr - 1 < 128) : (rr == 1);
        const bf16_t* zr = ok ? zc + (long)(rr - 1) * 64 * DINP : zc;
#pragma unroll
        for (int sec = 0; sec < 3; ++sec) { const u32x4 v = *(const u32x4*)(zr + sec * 512); L.zv[rr * 3 + sec] = ok ? v : (u32x4){0u, 0u, 0u, 0u}; }
    }
    {
      const int hq8 = tidv & 7, hsec = (tidv >> 3) % 3, hside = (tidv >> 3) / 3 & 1, hrr = (tidv >> 3) / 6;
      const int tx = c * 64 + (hside ? 64 : -1);
      const bool ok = !lat && tidv < 144 && hrr == 1 && tx >= 0 && tx < CTXL;
      const size_t off = ok ? (size_t)(NT + b * CTXL + tx) * DINP + hsec * 512 + 64 * h + 8 * hq8 : 0;
      const u32x4 v = *(const u32x4*)(Z + off); L.hv = ok ? v : (u32x4){0u, 0u, 0u, 0u}; }
    const bf16_t* zx = Z + (size_t)(rowbase + tsl) * DINP + OFF_WD + 8 * q8;
#pragma unroll
    for (int it = 0; it < 6; ++it) L.xv[it] = *(const u32x4*)(zx + 64 * it);
}
DI void phase_prep2(const Params& p, const Ctx& F) {
    const bf16_t* Z = (const bf16_t*)(p.ws + WS_Z);
    bf16_t* Kc = (bf16_t*)(p.ws + WS_KC); bf16_t* Vc = (bf16_t*)(p.ws + WS_VC); bf16_t* Rc = (bf16_t*)(p.ws + WS_RC);
    bf16_t* A0 = (bf16_t*)(p.ws + WS_A0); bf16_t* A1 = (bf16_t*)(p.ws + WS_A1); bf16_t* L0 = (bf16_t*)(p.ws + WS_L0); bf16_t* L1 = (bf16_t*)(p.ws + WS_L1);
    bf16_t* GATE = (bf16_t*)((unsigned char*)p.out + DO_GATE); bf16_t* BV = (bf16_t*)((unsigned char*)p.out + DO_BV);
    const bf16_t* DupT = (const bf16_t*)(p.ws + WS_DUPT); const bf16_t* AupT = (const bf16_t*)(p.ws + WS_AUPT); const bf16_t* GupT = (const bf16_t*)(p.ws + WS_GUPT);
    const float* cw2 = (const float*)(p.ws + WS_CONVW);
    LAS unsigned char* ZS = F.lds; LAS float* BON = (LAS float*)(F.lds + BON_OFF);
    const int w = F.wave, fr0 = F.lane & 15, fq0 = F.lane >> 4, ct = w >> 1, tt0 = 2 * (w & 1);
    constexpr int NITEM = 528 * 8;
    const bool xmap = (F.G == 256);
    auto item_of = [&](int i) -> int { if (!xmap) { const int it = F.bid + i * F.G; return it < NITEM ? it : -1; }
        const int x = F.bid & 7, y = F.bid >> 3, j = y + 32 * i; return j < 528 ? (x * 66 + (j >> 3)) * 8 + (j & 7) : -1; };
    PrepLd L;
    bf16x8 wf[4][2], gf[4]; f32x4 w00, w01, a00, a01, ka0, ka1, rk; int hcur = -1;
    int itx = 0, item = item_of(0);
    if (item >= 0) prep_issue(L, Z, item, F.tid);
    for (; item >= 0; ) {
        const int item_next = item_of(++itx);
        const int h = item & 7, ck = item >> 3;
        const bool lat = ck < 512;
        const int b = lat ? ck >> 7 : (ck - 512) >> 2, c = lat ? ck & 127 : (ck - 512) & 3;
        const int rowbase = lat ? b * SEQ + c * 64 : NT + b * CTXL + c * 64;
        const int tidv = F.tid; int fr = fr0, fq = fq0; asm volatile("" : "+v"(fr), "+v"(fq));
        __syncthreads();
        { const int q8 = tidv & 7, tsl = tidv >> 3;
#pragma unroll
          for (int rr = 0; rr < 3; ++rr)
#pragma unroll
              for (int sec = 0; sec < 3; ++sec) *(LAS u32x4*)(ZS + rr * ZS_ROWB + (tsl + 1) * ZS_TOKB + sec * 128 + q8 * 16) = L.zv[rr * 3 + sec];
          if (tidv < 144) { const int hsec = (tidv >> 3) % 3, hside = (tidv >> 3) / 3 & 1, hrr = (tidv >> 3) / 6;
              *(LAS u32x4*)(ZS + hrr * ZS_ROWB + (hside ? 65 : 0) * ZS_TOKB + hsec * 128 + q8 * 16) = L.hv; }
#pragma unroll
          for (int it = 0; it < 6; ++it) {
              const u32x4 o = L.xv[it];
              if (it < 4) *(LAS u32x4*)(F.lds + XS_OFF + it * XS_ARR + tsl * 144 + q8 * 16) = o;
              else *(LAS u32x4*)(F.lds + XSG_OFF + tsl * XSG_PITCH + ((it - 4) * 8 + q8) * 16) = o; } }
        if (h != hcur) {
            hcur = h;
            const int chrow = 64 * h + 16 * ct + fr, gch0 = 64 * h + 16 * ct + 4 * fq;
#pragma unroll
            for (int q = 0; q < 4; ++q) { const bf16_t* WT = (q < 2 ? DupT : AupT) + ((size_t)(q & 1) * 512 + chrow) * 64;
#pragma unroll
                for (int s2 = 0; s2 < 2; ++s2) wf[q][s2] = *(const bf16x8*)(WT + 32 * s2 + 8 * fq); }
#pragma unroll
            for (int s2 = 0; s2 < 4; ++s2) gf[s2] = *(const bf16x8*)(GupT + (size_t)chrow * 128 + 32 * s2 + 8 * fq);
            w00 = *(const f32x4*)(p.in[I_DW0] + gch0); w01 = *(const f32x4*)(p.in[I_DW0] + 512 + gch0); a00 = *(const f32x4*)(p.in[I_A0] + gch0); a01 = *(const f32x4*)(p.in[I_A0] + 512 + gch0);
            ka0 = *(const f32x4*)(p.in[I_KA] + gch0); ka1 = *(const f32x4*)(p.in[I_KA] + 512 + gch0); rk = *(const f32x4*)(p.in[I_RK] + gch0);
            if (tidv < 432) { const f32x4 wv4 = *(const f32x4*)(cw2 + (size_t)h * 16 * 108 + tidv * 4); u32x2 hw; hw.x = pkh2(wv4[0], wv4[1]); hw.y = pkh2(wv4[2], wv4[3]); *(LAS u32x2*)(F.lds + CWL_OFF + tidv * 8) = hw; }
        }
        if (item_next >= 0) prep_issue(L, Z, item_next, tidv);
        const int gch = 64 * h + 16 * ct + 4 * fq;
        const LAS h4_t* cwl = (const LAS h4_t*)(F.lds + CWL_OFF) + (4 * ct + fq) * 27;
        __syncthreads();
        f32x4 vkeep[2];
#pragma unroll
        for (int t2 = 0; t2 < 2; ++t2) {
            const int tok = 16 * (tt0 + t2) + fr;
            f32x4 acc[5];
#pragma unroll
            for (int q = 0; q < 5; ++q) acc[q] = (f32x4){0.f, 0.f, 0.f, 0.f};
#pragma unroll
            for (int q = 0; q < 4; ++q) {
#pragma unroll
                for (int s2 = 0; s2 < 2; ++s2) { const bf16x8 bfr = *(const LAS bf16x8*)(F.lds + XS_OFF + q * XS_ARR + tok * 144 + (32 * s2 + 8 * fq) * 2);
                    acc[q] = __builtin_amdgcn_mfma_f32_16x16x32_bf16(wf[q][s2], bfr, acc[q], 0, 0, 0); }
            }
#pragma unroll
            for (int s2 = 0; s2 < 4; ++s2) { const bf16x8 bfr = *(const LAS bf16x8*)(F.lds + XSG_OFF + tok * XSG_PITCH + (32 * s2 + 8 * fq) * 2);
                acc[4] = __builtin_amdgcn_mfma_f32_16x16x32_bf16(gf[s2], bfr, acc[4], 0, 0, 0); }
            f32x4 cv[3];
            { h4_t hc[3];
#pragma unroll
              for (int s3 = 0; s3 < 3; ++s3) hc[s3] = (h4_t){(_Float16)0.f, (_Float16)0.f, (_Float16)0.f, (_Float16)0.f};
#pragma unroll
              for (int dy = 0; dy < 3; ++dy)
#pragma unroll
                  for (int s3 = 0; s3 < 3; ++s3) {
                      const LAS unsigned char* zb = ZS + dy * ZS_ROWB + s3 * 128 + (16 * ct + 4 * fq) * 2;
                      const u32x2 zc = *(const LAS u32x2*)(zb + (tok + 1) * ZS_TOKB);
                      const u32x2 ze = *(const LAS u32x2*)(zb + (16 * (tt0 + t2) + (fr < 8 ? 0 : 17)) * ZS_TOKB);
                      u32x2 zl, zr;
                      zl.x = (unsigned)__builtin_amdgcn_update_dpp((int)ze.x, (int)zc.x, 0x111, 0xf, 0xf, false); zl.y = (unsigned)__builtin_amdgcn_update_dpp((int)ze.y, (int)zc.y, 0x111, 0xf, 0xf, false);
                      zr.x = (unsigned)__builtin_amdgcn_update_dpp((int)ze.x, (int)zc.x, 0x101, 0xf, 0xf, false); zr.y = (unsigned)__builtin_amdgcn_update_dpp((int)ze.y, (int)zc.y, 0x101, 0xf, 0xf, false);
                      hc[s3] += __builtin_bit_cast(h4_t, zl) * cwl[(dy * 3 + 0) * 3 + s3] + __builtin_bit_cast(h4_t, zc) * cwl[(dy * 3 + 1) * 3 + s3] + __builtin_bit_cast(h4_t, zr) * cwl[(dy * 3 + 2) * 3 + s3];
                  }
#pragma unroll
              for (int s3 = 0; s3 < 3; ++s3) cv[s3] = (f32x4){(float)hc[s3][0], (float)hc[s3][1], (float)hc[s3][2], (float)hc[s3][3]}; }
            const size_t o = (size_t)(rowbase + tok) * 512 + gch;
            const f32x4 lg0 = sigmoid4(w00 + acc[0]) * -0.6065306597f, lg1 = sigmoid4(w01 + acc[1]) * -0.6065306597f;
            const f32x4 a0 = sigmoid4(a00 + acc[2]), a1 = sigmoid4(a01 + acc[3]);
            const f32x4 km0 = cv[0] * ((a0 - 1.f) * ka0 + 1.f), km1 = cv[0] * ((a1 - 1.f) * ka1 + 1.f);
            const f32x4 bt4 = cv[2] * (km0 + km1) * rk; float bs = (bt4.x + bt4.y) + (bt4.z + bt4.w);
            bs += __shfl_xor(bs, 16); bs += __shfl_xor(bs, 32);
            const size_t o16 = (size_t)(rowbase + tok) * 512 + 64 * h + 16 * ct + 8 * (fq >> 1); const bool oddq = (fq & 1) != 0;
            auto st_pair = [&](u32x2 qa, u32x2 qb, bf16_t* pa, bf16_t* pb, const bool bvalid) {
                const auto r0 = __builtin_amdgcn_permlane16_swap(qa.x, qb.x, false, false); const auto r1 = __builtin_amdgcn_permlane16_swap(qa.y, qb.y, false, false);
                if (!oddq || bvalid) *(u32x4*)((oddq ? pb : pa) + o16) = (u32x4){r0[0], r1[0], r0[1], r1[1]}; };
            st_pair((u32x2){pk2(cv[0][0], cv[0][1]), pk2(cv[0][2], cv[0][3])}, (u32x2){pk2(cv[1][0], cv[1][1]), pk2(cv[1][2], cv[1][3])}, Kc, Vc, true);
            st_pair((u32x2){pk2(cv[2][0], cv[2][1]), pk2(cv[2][2], cv[2][3])}, (u32x2){pk2(a0[0], a0[1]), pk2(a0[2], a0[3])}, Rc, A0, true);
            st_pair((u32x2){pk2(a1[0], a1[1]), pk2(a1[2], a1[3])}, (u32x2){pk2(lg0[0], lg0[1]), pk2(lg0[2], lg0[3])}, A1, L0, true);
            st_pair((u32x2){pk2(lg1[0], lg1[1]), pk2(lg1[2], lg1[3])}, (u32x2){pk2(acc[4][0], acc[4][1]), pk2(acc[4][2], acc[4][3])}, L1, GATE, lat);
            if (fq == 0) BON[tok * 4 + ct] = bs;
            if (t2 == 0) vkeep[0] = cv[1]; else vkeep[1] = cv[1];
        }
        __syncthreads();
        if (lat) {
#pragma unroll
            for (int t2 = 0; t2 < 2; ++t2) { const int tok = 16 * (tt0 + t2) + fr; const f32x4 bq = *(const LAS f32x4*)(BON + tok * 4); const float bon = (bq[0] + bq[1]) + (bq[2] + bq[3]);
                const size_t o = (size_t)(rowbase + tok) * 512 + gch;
                u32x2 wv2; wv2.x = pk2(bon * vkeep[t2][0], bon * vkeep[t2][1]); wv2.y = pk2(bon * vkeep[t2][2], bon * vkeep[t2][3]); *(u32x2*)(BV + o) = wv2; }
        }
        item = item_next;
    }
}

typedef short s16x4v_fw __attribute__((ext_vector_type(4)));
DI bf16x8 tr8(const LAS bf16_t* img, int r0, int c0, int fr);
DI void phase_gmlp(const Params& p, const Ctx& F) {
    const bf16_t* Z = (const bf16_t*)(p.ws + WS_Z); const bf16_t* Wsp = (const bf16_t*)(p.ws + WS_WSP);
    bf16_t* MIXED = (bf16_t*)((unsigned char*)p.out + DO_MIXED);
    constexpr int LDV = 72;
    LAS bf16_t* vnR = (LAS bf16_t*)F.lds;
    LAS float* gu = (LAS float*)(F.lds + 18432);
    constexpr int LDG = 68;
    const int fr = F.lane & 15, fq = F.lane >> 4, pq = F.tid >> 2, seg = F.tid & 3, pp = 16 * F.wave + fr;
    constexpr int NU = 4 * 64 * 8;
    struct GLd { u32x4 ua, ub, va, vb; };
    auto gissue = [&](GLd& L, int un) { const int g = un & 7, cc = (un >> 3) & 63, b = un >> 9;
        const bf16_t* zr = Z + ((size_t)b * SEQ + cc * 128 + pq) * DINP;
        L.ua = *(const u32x4*)(zr + OFF_U + 64 * g + 16 * seg); L.ub = *(const u32x4*)(zr + OFF_U + 64 * g + 16 * seg + 8);
        L.va = *(const u32x4*)(zr + OFF_VA + 64 * g + 16 * seg); L.vb = *(const u32x4*)(zr + OFF_VA + 64 * g + 16 * seg + 8); };
    GLd GL;
    if (F.bid < NU) gissue(GL, F.bid);
    int gcur = -1; f32x4 lng[4], lnb[4]; bf16x8 bfrag[4]; float bs = 0.f;
    for (int un = F.bid; un < NU; un += F.G) {
        const int g = un & 7, cc = (un >> 3) & 63, b = un >> 9;
        const size_t tok0 = (size_t)b * SEQ + cc * 128;
        if (g != gcur) { gcur = g;
#pragma unroll
            for (int q = 0; q < 4; ++q) { lng[q] = *(const f32x4*)(p.in[I_GMLNG] + 64 * g + 16 * seg + 4 * q); lnb[q] = *(const f32x4*)(p.in[I_GMLNB] + 64 * g + 16 * seg + 4 * q);
                bfrag[q] = *(const bf16x8*)(Wsp + ((size_t)(g * 128 + pp)) * 128 + 32 * q + 8 * fq); }
            bs = p.in[I_BSP][g * 128 + pp]; }
        __syncthreads();
        { const u32x4 ua = GL.ua, ub = GL.ub, va = GL.va, vb = GL.vb;
          if (un + F.G < NU) gissue(GL, un + F.G);
          float u[16], v[16];
#pragma unroll
          for (int j = 0; j < 4; ++j) { u[2 * j] = bflo(ua[j]); u[2 * j + 1] = bfhi(ua[j]); u[8 + 2 * j] = bflo(ub[j]); u[8 + 2 * j + 1] = bfhi(ub[j]);
              v[2 * j] = bflo(va[j]); v[2 * j + 1] = bfhi(va[j]); v[8 + 2 * j] = bflo(vb[j]); v[8 + 2 * j + 1] = bfhi(vb[j]); }
          float s = 0.f;
#pragma unroll
          for (int j = 0; j < 16; ++j) s += v[j];
          s += __shfl_xor(s, 1); s += __shfl_xor(s, 2);
          const float mu = s * (1.f / 64.f); float q = 0.f;
#pragma unroll
          for (int j = 0; j < 16; ++j) { v[j] -= mu; q += v[j] * v[j]; }
          q += __shfl_xor(q, 1); q += __shfl_xor(q, 2);
          const float rstd = __builtin_amdgcn_rsqf(q * (1.f / 64.f) + 1e-5f);
#pragma unroll
          for (int j = 0; j < 16; ++j) { const int ch = 16 * seg + j; v[j] = v[j] * rstd * lng[j >> 2][j & 3] + lnb[j >> 2][j & 3]; gu[pq * LDG + ch] = u[j]; }
          *(LAS u32x4*)(vnR + pq * LDV + 16 * seg) = (u32x4){pk2(v[0], v[1]), pk2(v[2], v[3]), pk2(v[4], v[5]), pk2(v[6], v[7])};
          *(LAS u32x4*)(vnR + pq * LDV + 16 * seg + 8) = (u32x4){pk2(v[8], v[9]), pk2(v[10], v[11]), pk2(v[12], v[13]), pk2(v[14], v[15])};
        }
        __syncthreads();
        f32x4 acc[4];
#pragma unroll
        for (int n = 0; n < 4; ++n) acc[n] = (f32x4){0.f, 0.f, 0.f, 0.f};
#pragma unroll
        for (int s2 = 0; s2 < 4; ++s2) {
#pragma unroll
            for (int n = 0; n < 4; ++n) { const bf16x8 afrag = tr8(vnR, 32 * s2 + 8 * fq, 16 * n, fr);
                acc[n] = __builtin_amdgcn_mfma_f32_16x16x32_bf16(afrag, bfrag[s2], acc[n], 0, 0, 0); }
        }
#pragma unroll
        for (int n = 0; n < 4; ++n) { const int d0 = 16 * n + 4 * fq; const f32x4 gv = *(const LAS f32x4*)(gu + pp * LDG + d0);
            const f32x4 o = gv * (acc[n] + bs);
            u32x2 w; w.x = pk2(o[0], o[1]); w.y = pk2(o[2], o[3]);
            *(u32x2*)(MIXED + (tok0 + pp) * D + 64 * g + d0) = w; }
    }
}

DI void phase_scan_seq(const Params& p, const Ctx& F) {
    const bf16_t* Kc = (const bf16_t*)(p.ws + WS_KC); const bf16_t* Vc = (const bf16_t*)(p.ws + WS_VC); const bf16_t* Rc = (const bf16_t*)(p.ws + WS_RC);
    float* YS = (float*)(p.ws + WS_YS);
    const int vrow = F.tid >> 3, q = F.tid & 7;
    for (int ch = F.bid; ch < 64; ch += F.G) {
        const int d = ch & 1, h = (ch >> 1) & 7, b = ch >> 4;
        const bf16_t* Ad = (const bf16_t*)(p.ws + (d ? WS_A1 : WS_A0)); const bf16_t* Ld = (const bf16_t*)(p.ws + (d ? WS_L1 : WS_L0));
        float kkw[8], kaw[8];
#pragma unroll
        for (int j = 0; j < 8; ++j) { kkw[j] = p.in[I_KK][64 * h + 8 * q + j]; kaw[j] = p.in[I_KA][d * 512 + 64 * h + 8 * q + j]; }
        float S[8];
#pragma unroll
        for (int j = 0; j < 8; ++j) S[j] = 0.f;
        const int TOT = CTXL + SEQ;
        for (int step = 0; step < TOT; ++step) {
            size_t row;
            if (step < CTXL) { const int tc = d ? (CTXL - 1 - step) : step; row = (size_t)NT + b * CTXL + tc; }
            else { const int tl = d ? (SEQ - 1 - (step - CTXL)) : (step - CTXL); row = (size_t)b * SEQ + tl; }
            const size_t o = row * 512 + 64 * h + 8 * q;
            const u32x4 kq = *(const u32x4*)(Kc + o), rq = *(const u32x4*)(Rc + o), aq = *(const u32x4*)(Ad + o), lq = *(const u32x4*)(Ld + o);
            const float vv = bf2f(Vc[row * 512 + 64 * h + vrow]);
            float k[8], r[8], a[8], l[8];
#pragma unroll
            for (int j = 0; j < 4; ++j) { k[2 * j] = bflo(kq[j]); k[2 * j + 1] = bfhi(kq[j]); r[2 * j] = bflo(rq[j]); r[2 * j + 1] = bfhi(rq[j]);
                a[2 * j] = bflo(aq[j]); a[2 * j + 1] = bfhi(aq[j]); l[2 * j] = bflo(lq[j]); l[2 * j + 1] = bfhi(lq[j]); }
            float kk[8], ss = 0.f;
#pragma unroll
            for (int j = 0; j < 8; ++j) { kk[j] = k[j] * kkw[j]; ss += kk[j] * kk[j]; }
            ss += __shfl_xor(ss, 1); ss += __shfl_xor(ss, 2); ss += __shfl_xor(ss, 4);
            const float rn = 1.f / sqrtf(fmaxf(ss, 1e-24f));
            float dot = 0.f;
#pragma unroll
            for (int j = 0; j < 8; ++j) { kk[j] *= rn; dot += S[j] * kk[j]; }
            dot += __shfl_xor(dot, 1); dot += __shfl_xor(dot, 2); dot += __shfl_xor(dot, 4);
            float y = 0.f;
#pragma unroll
            for (int j = 0; j < 8; ++j) { const float w = __expf(l[j]); const float km = k[j] * (1.f + (a[j] - 1.f) * kaw[j]);
                S[j] = S[j] * w - dot * (kk[j] * a[j]) + vv * km; y += S[j] * r[j]; }
            y += __shfl_xor(y, 1); y += __shfl_xor(y, 2); y += __shfl_xor(y, 4);
            if (step >= CTXL && q == 0) YS[((size_t)d * NT + row) * 512 + 64 * h + vrow] = y;
        }
    }
}


constexpr int LDP = 72;
constexpr int SLOTB = 64 * LDP * 2;
constexpr int CP_CUM = 12 * SLOTB, CP_TOT = CP_CUM + 16384, CP_ADIAG = CP_TOT + 2048, CP_GC = CP_ADIAG + 4096;

DI void mm64(f32x4 (&acc)[2], const LAS bf16_t* P, const LAS bf16_t* Q, int r0, int c0, int fr, int fq) {
#pragma unroll
    for (int s = 0; s < 2; ++s) { const bf16x8 b = *(const LAS bf16x8*)(Q + (c0 + fr) * LDP + 32 * s + 8 * fq);
#pragma unroll
        for (int m = 0; m < 2; ++m) { const bf16x8 a = *(const LAS bf16x8*)(P + (r0 + 16 * m + fr) * LDP + 32 * s + 8 * fq);
            acc[m] = __builtin_amdgcn_mfma_f32_16x16x32_bf16(a, b, acc[m], 0, 0, 0); } }
}
DI void zero2(f32x4 (&a)[2]) { a[0] = (f32x4){0.f, 0.f, 0.f, 0.f}; a[1] = a[0]; }
DI void writeT(LAS bf16_t* dst, const f32x4 (&acc)[2], int r0, int c0, int fr, int fq) {
#pragma unroll
    for (int m = 0; m < 2; ++m) { u32x2 w; w.x = pk2(acc[m][0], acc[m][1]); w.y = pk2(acc[m][2], acc[m][3]); *(LAS u32x2*)(dst + (c0 + fr) * LDP + r0 + 16 * m + 4 * fq) = w; }
}
DI void writeN(LAS bf16_t* dst, const f32x4 (&acc)[2], int r0, int c0, int fr, int fq) {
#pragma unroll
    for (int m = 0; m < 2; ++m)
#pragma unroll
        for (int i = 0; i < 4; ++i) dst[(r0 + 16 * m + 4 * fq + i) * LDP + c0 + fr] = (bf16_t)f2bf(acc[m][i]);
}
DI size_t chunk_row(int d, int b, int pc, int pp) {
    const int base = pc < 4 ? NT + b * CTXL : b * SEQ, len = pc < 4 ? CTXL : SEQ, q = 64 * (pc < 4 ? pc : pc - 4) + pp;
    return (size_t)(d ? base + len - 1 - q : base + q);
}

DI void phase_chunkprep(const Params& p, const Ctx& F) {
    const bf16_t* Kc = (const bf16_t*)(p.ws + WS_KC); const bf16_t* Vc = (const bf16_t*)(p.ws + WS_VC); const bf16_t* Rc = (const bf16_t*)(p.ws + WS_RC);
    unsigned char* OPS = p.ws + WS_OPS;
    LAS bf16_t* SL[12];
#pragma unroll
    for (int i = 0; i < 12; ++i) SL[i] = (LAS bf16_t*)(F.lds + i * SLOTB);
    LAS float* CUM = (LAS float*)(F.lds + CP_CUM); LAS float* TOT = (LAS float*)(F.lds + CP_TOT); LAS float* ADIAG = (LAS float*)(F.lds + CP_ADIAG); LAS float* GC = (LAS float*)(F.lds + CP_GC);
    const int w = F.wave, fr = F.lane & 15, fq = F.lane >> 4, r0 = 32 * (w >> 2), c0 = 16 * (w & 3);
    const int pp = F.tid >> 3, cg8 = F.tid & 7;
    const bool fixedmap = (F.G == 256);
    auto unit_of = [&](int i) -> int { if (fixedmap) return i < 33 ? (F.bid >> 2) * 132 + (F.bid & 3) * 33 + i : -1; const int u = F.bid + i * F.G; return u < 2 * 32 * 132 ? u : -1; };
    struct RawLd { u32x4 kq, vq, rq, aq, lq; };
    auto raw_issue = [&](RawLd& R, int unit) { const int d = unit / (32 * 132), chain = (unit / 132) & 31, pc = unit % 132, b = chain >> 3, h = chain & 7;
        const size_t o = chunk_row(d, b, pc, pp) * 512 + 64 * h + 8 * cg8;
        R.kq = *(const u32x4*)(Kc + o); R.vq = *(const u32x4*)(Vc + o); R.rq = *(const u32x4*)(Rc + o);
        R.aq = *(const u32x4*)((const bf16_t*)(p.ws + (d ? WS_A1 : WS_A0)) + o); R.lq = *(const u32x4*)((const bf16_t*)(p.ws + (d ? WS_L1 : WS_L0)) + o); };
    RawLd R;
    float kkw[8], kaw[8]; int hdcur = -1;
    int uix = 0, unit = unit_of(0);
    if (unit >= 0) raw_issue(R, unit);
    for (; unit >= 0; ) {
        const int unit_next = unit_of(++uix);
        const int d = unit / (32 * 132), chain = (unit / 132) & 31, pc = unit % 132, b = chain >> 3, h = chain & 7;
        if (d * 8 + h != hdcur) { hdcur = d * 8 + h;
#pragma unroll
            for (int j = 0; j < 8; ++j) { kkw[j] = p.in[I_KK][64 * h + 8 * cg8 + j]; kaw[j] = p.in[I_KA][d * 512 + 64 * h + 8 * cg8 + j]; } }
        __syncthreads();
        float kk[8], km[8], ka[8], vv[8], rr[8], ll[8];
        { float k[8], a[8]; float ss = 0.f;
#pragma unroll
          for (int j = 0; j < 4; ++j) { k[2 * j] = bflo(R.kq[j]); k[2 * j + 1] = bfhi(R.kq[j]); vv[2 * j] = bflo(R.vq[j]); vv[2 * j + 1] = bfhi(R.vq[j]); rr[2 * j] = bflo(R.rq[j]); rr[2 * j + 1] = bfhi(R.rq[j]);
              a[2 * j] = bflo(R.aq[j]); a[2 * j + 1] = bfhi(R.aq[j]); ll[2 * j] = bflo(R.lq[j]); ll[2 * j + 1] = bfhi(R.lq[j]); }
          if (unit_next >= 0) raw_issue(R, unit_next);
#pragma unroll
          for (int j = 0; j < 8; ++j) { kk[j] = k[j] * kkw[j]; ss += kk[j] * kk[j]; }
          ss += __shfl_xor(ss, 1); ss += __shfl_xor(ss, 2); ss += __shfl_xor(ss, 4);
          const float rn = 1.f / sqrtf(fmaxf(ss, 1e-24f));
#pragma unroll
          for (int j = 0; j < 8; ++j) { kk[j] *= rn; km[j] = k[j] * (1.f + (a[j] - 1.f) * kaw[j]); ka[j] = kk[j] * a[j]; }
          *(LAS f32x4*)(CUM + pp * 64 + 8 * cg8) = (f32x4){ll[0], ll[1], ll[2], ll[3]}; *(LAS f32x4*)(CUM + pp * 64 + 8 * cg8 + 4) = (f32x4){ll[4], ll[5], ll[6], ll[7]}; }
        for (int i = F.tid; i < 2 * SLOTB / 4; i += NTHREADS) ((LAS unsigned*)(F.lds + 9 * SLOTB))[i] = 0u;
        __syncthreads();
        { const int ch = F.tid & 63, seg = F.tid >> 6; float run = 0.f;
#pragma unroll
          for (int i = 0; i < 8; ++i) { run += CUM[(8 * seg + i) * 64 + ch]; CUM[(8 * seg + i) * 64 + ch] = run; }
          TOT[seg * 64 + ch] = run; }
        __syncthreads();
        { const int ch = F.tid & 63, seg = F.tid >> 6; float off = 0.f;
          for (int s2 = 0; s2 < seg; ++s2) off += TOT[s2 * 64 + ch];
#pragma unroll
          for (int i = 0; i < 8; ++i) CUM[(8 * seg + i) * 64 + ch] += off;
          if (seg == 7) GC[ch] = off + TOT[7 * 64 + ch]; }
        __syncthreads();
        { float g[8], gc[8];
          { const f32x4 g0 = *(const LAS f32x4*)(CUM + pp * 64 + 8 * cg8), g1 = *(const LAS f32x4*)(CUM + pp * 64 + 8 * cg8 + 4);
            const f32x4 c0v = *(const LAS f32x4*)(GC + 8 * cg8), c1v = *(const LAS f32x4*)(GC + 8 * cg8 + 4);
#pragma unroll
            for (int j = 0; j < 4; ++j) { g[j] = g0[j]; g[4 + j] = g1[j]; gc[j] = c0v[j]; gc[4 + j] = c1v[j]; } }
          float kkg[8], rg[8], ki[8], kai[8], kd[8], kad[8];
#pragma unroll
          for (int j = 0; j < 8; ++j) { const float eg = __expf(g[j]), egp = __expf(g[j] - ll[j]), eng = __expf(-g[j]), ecg = __expf(gc[j] - g[j]);
              kkg[j] = kk[j] * egp; rg[j] = rr[j] * eg; ki[j] = km[j] * eng; kai[j] = ka[j] * eng; kd[j] = km[j] * ecg; kad[j] = ka[j] * ecg; }
          u32x4 w4;
          w4 = (u32x4){pk2(kkg[0], kkg[1]), pk2(kkg[2], kkg[3]), pk2(kkg[4], kkg[5]), pk2(kkg[6], kkg[7])}; *(LAS u32x4*)(SL[0] + pp * LDP + 8 * cg8) = w4;
          w4 = (u32x4){pk2(rg[0], rg[1]), pk2(rg[2], rg[3]), pk2(rg[4], rg[5]), pk2(rg[6], rg[7])}; *(LAS u32x4*)(SL[1] + pp * LDP + 8 * cg8) = w4;
          w4 = (u32x4){pk2(ki[0], ki[1]), pk2(ki[2], ki[3]), pk2(ki[4], ki[5]), pk2(ki[6], ki[7])}; *(LAS u32x4*)(SL[2] + pp * LDP + 8 * cg8) = w4;
          w4 = (u32x4){pk2(kai[0], kai[1]), pk2(kai[2], kai[3]), pk2(kai[4], kai[5]), pk2(kai[6], kai[7])}; *(LAS u32x4*)(SL[3] + pp * LDP + 8 * cg8) = w4;
#pragma unroll
          for (int j = 0; j < 8; ++j) { const int ch = 8 * cg8 + j;
              SL[4][ch * LDP + pp] = (bf16_t)f2bf(kkg[j]); SL[5][ch * LDP + pp] = (bf16_t)f2bf(vv[j]); SL[6][ch * LDP + pp] = (bf16_t)f2bf(kd[j]); SL[7][ch * LDP + pp] = (bf16_t)f2bf(kad[j]); } }
        __syncthreads();
        { f32x4 aAk[2], aAa[2], aBk[2], aBa[2]; zero2(aAk); zero2(aAa); zero2(aBk); zero2(aBa);
          mm64(aAk, SL[2], SL[0], r0, c0, fr, fq);
          mm64(aAa, SL[0], SL[3], r0, c0, fr, fq);
          mm64(aBk, SL[2], SL[1], r0, c0, fr, fq);
          mm64(aBa, SL[3], SL[1], r0, c0, fr, fq);
          __syncthreads();
          const int tcol = c0 + fr;
#pragma unroll
          for (int m = 0; m < 2; ++m)
#pragma unroll
              for (int i = 0; i < 4; ++i) { const int jr = r0 + 16 * m + 4 * fq + i;
                  aAk[m][i] = jr < tcol ? aAk[m][i] : 0.f; aBk[m][i] = jr <= tcol ? aBk[m][i] : 0.f; aBa[m][i] = jr <= tcol ? aBa[m][i] : 0.f; }
          writeT(SL[0], aAk, r0, c0, fr, fq); writeT(SL[8], aBk, r0, c0, fr, fq); writeT(SL[2], aBa, r0, c0, fr, fq);
          const int jb = w & 3;
#pragma unroll
          for (int m = 0; m < 2; ++m) { const int tb = 2 * (w >> 2) + m;
              if (tb == jb) {
#pragma unroll
                  for (int i = 0; i < 4; ++i) ADIAG[tb * 256 + (4 * fq + i) * 16 + fr] = (fr < 4 * fq + i) ? aAa[m][i] : 0.f; }
#pragma unroll
              for (int i = 0; i < 4; ++i) aAa[m][i] = tb > jb ? aAa[m][i] : 0.f; }
          writeT(SL[3], aAa, r0, c0, fr, fq);
        }
        __syncthreads();
        if (F.tid < 64) { const int blk = F.tid >> 4, c = F.tid & 15; const LAS float* A = ADIAG + blk * 256; float x[16];
#pragma unroll
            for (int r = 0; r < 16; ++r) { float sa = (r == c) ? 1.f : 0.f;
#pragma unroll
                for (int j = 0; j < r; ++j) sa -= A[r * 16 + j] * x[j];
                x[r] = sa; }
#pragma unroll
            for (int r = 0; r < 16; ++r) SL[9][(16 * blk + r) * LDP + 16 * blk + c] = (bf16_t)f2bf(x[r]);
            u32x4 lo = (u32x4){pk2(x[0], x[1]), pk2(x[2], x[3]), pk2(x[4], x[5]), pk2(x[6], x[7])}, hi = (u32x4){pk2(x[8], x[9]), pk2(x[10], x[11]), pk2(x[12], x[13]), pk2(x[14], x[15])};
            *(LAS u32x4*)(SL[10] + (16 * blk + c) * LDP + 16 * blk) = lo; *(LAS u32x4*)(SL[10] + (16 * blk + c) * LDP + 16 * blk + 8) = hi; }
        __syncthreads();
        f32x4 a1[2], a2[2], a3[2];
        zero2(a1); mm64(a1, SL[3], SL[9], r0, c0, fr, fq);
        __syncthreads();
        writeT(SL[11], a1, r0, c0, fr, fq);
        writeN(SL[3], a1, r0, c0, fr, fq);
        __syncthreads();
        zero2(a2); mm64(a2, SL[11], SL[3], r0, c0, fr, fq);
#pragma unroll
        for (int m = 0; m < 2; ++m)
#pragma unroll
            for (int i = 0; i < 4; ++i) a2[m][i] += (r0 + 16 * m + 4 * fq + i == c0 + fr) ? 1.f : 0.f;
        writeT(SL[9], a2, r0, c0, fr, fq);
        __syncthreads();
        zero2(a3); mm64(a3, SL[11], SL[9], r0, c0, fr, fq);
        a3[0] = a2[0] - a3[0]; a3[1] = a2[1] - a3[1];
        writeN(SL[3], a3, r0, c0, fr, fq);
        __syncthreads();
        zero2(a1); mm64(a1, SL[3], SL[10], r0, c0, fr, fq);
        zero2(a2); mm64(a2, SL[0], SL[5], r0, c0, fr, fq);
        writeN(SL[9], a1, r0, c0, fr, fq); writeT(SL[11], a2, r0, c0, fr, fq);
        __syncthreads();
        zero2(a1); mm64(a1, SL[9], SL[4], r0, c0, fr, fq);
        zero2(a2); mm64(a2, SL[9], SL[11], r0, c0, fr, fq);
        writeT(SL[3], a1, r0, c0, fr, fq); writeT(SL[10], a2, r0, c0, fr, fq);
        __syncthreads();
        unsigned char* ob = OPS + ((size_t)(d * 32 + chain) * 132 + pc) * 32768;
        const int fragoff = (((w & 3) * 2 + (w >> 2)) * 64 + F.lane) * 16;
        {
          zero2(a1); mm64(a1, SL[3], SL[2], r0, c0, fr, fq);
          u32x4 o;
#pragma unroll
          for (int m = 0; m < 2; ++m) { const u32x2 rgv = *(const LAS u32x2*)(SL[1] + (c0 + fr) * LDP + r0 + 16 * m + 4 * fq);
              const float q0 = bflo(rgv.x) - a1[m][0], q1 = bfhi(rgv.x) - a1[m][1], q2 = bflo(rgv.y) - a1[m][2], q3 = bfhi(rgv.y) - a1[m][3];
              o[2 * m] = pk2(q0, q1); o[2 * m + 1] = pk2(q2, q3); }
          *(u32x4*)(ob + fragoff) = o; }
        {
          zero2(a1); mm64(a1, SL[3], SL[7], r0, c0, fr, fq);
          const float gcv = __expf(GC[c0 + fr]); u32x4 o;
#pragma unroll
          for (int m = 0; m < 2; ++m) { float q[4];
#pragma unroll
              for (int i = 0; i < 4; ++i) q[i] = ((r0 + 16 * m + 4 * fq + i == c0 + fr) ? gcv : 0.f) - a1[m][i];
              o[2 * m] = pk2(q[0], q[1]); o[2 * m + 1] = pk2(q[2], q[3]); }
          *(u32x4*)(ob + 8192 + fragoff) = o; }
        {
          zero2(a1); mm64(a1, SL[8], SL[5], r0, c0, fr, fq); zero2(a2); mm64(a2, SL[2], SL[10], r0, c0, fr, fq);
#pragma unroll
          for (int m = 0; m < 2; ++m) { const f32x4 q = a1[m] - a2[m]; u32x2 o; o.x = pk2(q[0], q[1]); o.y = pk2(q[2], q[3]);
              *(u32x2*)(ob + 16384 + (((w & 3) * 4 + 2 * (w >> 2) + m) * 64 + F.lane) * 8) = o; } }
        {
          zero2(a1); mm64(a1, SL[6], SL[5], r0, c0, fr, fq); zero2(a2); mm64(a2, SL[7], SL[10], r0, c0, fr, fq);
#pragma unroll
          for (int m = 0; m < 2; ++m) { const f32x4 q = a1[m] - a2[m]; u32x2 o; o.x = pk2(q[0], q[1]); o.y = pk2(q[2], q[3]);
              *(u32x2*)(ob + 24576 + (((w & 3) * 4 + 2 * (w >> 2) + m) * 64 + F.lane) * 8) = o; } }
        unit = unit_next;
    }
}


typedef short s16x4v __attribute__((ext_vector_type(4)));
DI f32x4 mfma16(s16x4v a, s16x4v b, f32x4 c) { return __builtin_amdgcn_mfma_f32_16x16x16bf16_1k(a, b, c, 0, 0, 0); }
DI s16x4v pack4(const f32x4& v) { u32x2 t; t.x = pk2(v[0], v[1]); t.y = pk2(v[2], v[3]); return __builtin_bit_cast(s16x4v, t); }
DI void slab64(f32x4 (&acc)[4], const LAS bf16_t* P, const LAS bf16_t* Q, int s4, int fr, int fq) {
#pragma unroll
    for (int s2 = 0; s2 < 2; ++s2) { const bf16x8 b = *(const LAS bf16x8*)(Q + (16 * s4 + fr) * LDP + 32 * s2 + 8 * fq);
#pragma unroll
        for (int m = 0; m < 4; ++m) { const bf16x8 a = *(const LAS bf16x8*)(P + (16 * m + fr) * LDP + 32 * s2 + 8 * fq);
            acc[m] = __builtin_amdgcn_mfma_f32_16x16x32_bf16(a, b, acc[m], 0, 0, 0); } }
}
DI s16x4v tr4(const LAS bf16_t* img, int r0, int c0, int fr) { return __builtin_amdgcn_ds_read_tr16_b64_v4i16((LAS s16x4v*)(img + (r0 + (fr >> 2)) * LDP + c0 + 4 * (fr & 3))); }
DI bf16x8 tr8(const LAS bf16_t* img, int r0, int c0, int fr) { const s16x4v lo = tr4(img, r0, c0, fr), hi = tr4(img, r0 + 4, c0, fr); return (bf16x8){lo[0], lo[1], lo[2], lo[3], hi[0], hi[1], hi[2], hi[3]}; }
template <bool PT> DI void slab64t(f32x4 (&acc)[4], const LAS bf16_t* P, const LAS bf16_t* QR, int s4, int fr, int fq) {
#pragma unroll
    for (int s2 = 0; s2 < 2; ++s2) { const bf16x8 b = tr8(QR, 32 * s2 + 8 * fq, 16 * s4, fr);
#pragma unroll
        for (int m = 0; m < 4; ++m) { const bf16x8 a = PT ? tr8(P, 32 * s2 + 8 * fq, 16 * m, fr) : *(const LAS bf16x8*)(P + (16 * m + fr) * LDP + 32 * s2 + 8 * fq);
            acc[m] = __builtin_amdgcn_mfma_f32_16x16x32_bf16(a, b, acc[m], 0, 0, 0); } }
}
constexpr int C2_NORM = 12 * SLOTB, C2_GC = C2_NORM + 4096, C2_ADIAG = C2_GC + 512, C2_DINV = C2_ADIAG + 4096;
static_assert(C2_DINV + 2048 <= LDS_MISC, "chunkprep2 LDS");
DI void phase_chunkprep2(const Params& p, const Ctx& F) {
    const bf16_t* Kc = (const bf16_t*)(p.ws + WS_KC); const bf16_t* Vc = (const bf16_t*)(p.ws + WS_VC); const bf16_t* Rc = (const bf16_t*)(p.ws + WS_RC);
    unsigned char* OPS = p.ws + WS_OPS;
    LAS bf16_t* SL[12];
#pragma unroll
    for (int i = 0; i < 12; ++i) SL[i] = (LAS bf16_t*)(F.lds + i * SLOTB);
    LAS float* ADIAG = (LAS float*)(F.lds + C2_ADIAG); LAS bf16_t* DINV = (LAS bf16_t*)(F.lds + C2_DINV);
    const int w = F.wave, s4 = w & 3, g2 = w >> 2;
    const bool fixedmap = (F.G == 256);
    auto unit_of = [&](int i) -> int { if (fixedmap) return i < 33 ? (F.bid >> 2) * 132 + (F.bid & 3) * 33 + i : -1; const int u = F.bid + i * F.G; return u < 2 * 32 * 132 ? u : -1; };
    struct RawLd { u32x4 kq, vq, rq, aq, lq; };
    auto raw_issue = [&](RawLd& R, int unit, int lane) { const int d = unit / (32 * 132), chain = (unit / 132) & 31, pc = unit % 132, b = chain >> 3, h = chain & 7;
        const size_t o = chunk_row(d, b, pc, lane) * 512 + 64 * h + 8 * w;
        R.kq = *(const u32x4*)(Kc + o); R.vq = *(const u32x4*)(Vc + o); R.rq = *(const u32x4*)(Rc + o);
        R.aq = *(const u32x4*)((const bf16_t*)(p.ws + (d ? WS_A1 : WS_A0)) + o); R.lq = *(const u32x4*)((const bf16_t*)(p.ws + (d ? WS_L1 : WS_L0)) + o); };
    unsigned MW[4][2];
    { const int fr_ = F.lane & 15, fq_ = F.lane >> 4;
#pragma unroll
      for (int m = 0; m < 4; ++m)
#pragma unroll
          for (int hh = 0; hh < 2; ++hh) { unsigned mk = 0u;
#pragma unroll
              for (int e = 0; e < 2; ++e) { const int jl = 4 * fq_ + 2 * hh + e; const bool keep = m < s4 ? true : (m > s4 ? false : (g2 == 0 ? jl < fr_ : jl <= fr_)); mk |= keep ? (0xffffu << (16 * e)) : 0u; }
              MW[m][hh] = mk; } }
    RawLd R;
    float kkw[8], kaw[8]; int hdcur = -1;
    int uix = 0, unit = unit_of(0);
    if (unit >= 0) raw_issue(R, unit, F.lane);
    for (; unit >= 0; ) {
        const int unit_next = unit_of(++uix);
        const int d = unit / (32 * 132), chain = (unit / 132) & 31, pc = unit % 132, h = chain & 7;
        if (d * 8 + h != hdcur) { hdcur = d * 8 + h;
#pragma unroll
            for (int j = 0; j < 8; ++j) { kkw[j] = p.in[I_KK][64 * h + 8 * w + j]; kaw[j] = p.in[I_KA][d * 512 + 64 * h + 8 * w + j]; } }
        int lane = F.lane; asm volatile("" : "+v"(lane));
        const int fr = lane & 15, fq = lane >> 4, pp = lane;
        LAS float* NORM = (LAS float*)(F.lds + C2_NORM) + (uix & 1) * 512; LAS float* GC = (LAS float*)(F.lds + C2_GC) + (uix & 1) * 64;
        float k[8], a[8], rr[8], ll[8], kk[8]; const u32x4 R0v = R.vq;
        { float ss = 0.f;
#pragma unroll
          for (int j = 0; j < 4; ++j) { k[2 * j] = bflo(R.kq[j]); k[2 * j + 1] = bfhi(R.kq[j]); rr[2 * j] = bflo(R.rq[j]); rr[2 * j + 1] = bfhi(R.rq[j]);
              a[2 * j] = bflo(R.aq[j]); a[2 * j + 1] = bfhi(R.aq[j]); ll[2 * j] = bflo(R.lq[j]); ll[2 * j + 1] = bfhi(R.lq[j]); }
          if (unit_next >= 0) raw_issue(R, unit_next, lane);
#pragma unroll
          for (int j = 0; j < 8; ++j) { kk[j] = k[j] * kkw[j]; ss += kk[j] * kk[j]; }
          NORM[w * 64 + pp] = ss; }
        float g[8], gc[8];
#pragma unroll
        for (int j = 0; j < 8; ++j) { g[j] = wave_scan_incl(ll[j]); gc[j] = lane63(g[j]); }
        if (lane == 0) { *(LAS f32x4*)(GC + 8 * w) = (f32x4){__expf(gc[0]), __expf(gc[1]), __expf(gc[2]), __expf(gc[3])}; *(LAS f32x4*)(GC + 8 * w + 4) = (f32x4){__expf(gc[4]), __expf(gc[5]), __expf(gc[6]), __expf(gc[7])}; }
        __syncthreads();
        { float ss = 0.f;
#pragma unroll
          for (int q = 0; q < 8; ++q) ss += NORM[q * 64 + pp];
          const float rn = __builtin_amdgcn_rsqf(fmaxf(ss, 1e-24f));
          float kkg[8], rg[8], ki[8], kai[8];
#pragma unroll
          for (int j = 0; j < 8; ++j) { const float kkn = kk[j] * rn, km = k[j] * (1.f + (a[j] - 1.f) * kaw[j]), kan = kkn * a[j];
              const float eg = __expf(g[j]), eng = __builtin_amdgcn_rcpf(eg);
              const float egp = __builtin_bit_cast(float, __builtin_amdgcn_update_dpp(0x3f800000, __builtin_bit_cast(int, eg), 0x138, 0xf, 0xf, false));
              kkg[j] = kkn * egp; rg[j] = rr[j] * eg; ki[j] = km * eng; kai[j] = kan * eng; }
          const u32x4 wkkg = (u32x4){pk2(kkg[0], kkg[1]), pk2(kkg[2], kkg[3]), pk2(kkg[4], kkg[5]), pk2(kkg[6], kkg[7])};
          const u32x4 wki = (u32x4){pk2(ki[0], ki[1]), pk2(ki[2], ki[3]), pk2(ki[4], ki[5]), pk2(ki[6], ki[7])};
          const u32x4 wkai = (u32x4){pk2(kai[0], kai[1]), pk2(kai[2], kai[3]), pk2(kai[4], kai[5]), pk2(kai[6], kai[7])};
          *(LAS u32x4*)(SL[0] + pp * LDP + 8 * w) = wkkg;
          *(LAS u32x4*)(SL[1] + pp * LDP + 8 * w) = (u32x4){pk2(rg[0], rg[1]), pk2(rg[2], rg[3]), pk2(rg[4], rg[5]), pk2(rg[6], rg[7])};
          *(LAS u32x4*)(SL[2] + pp * LDP + 8 * w) = wki;
          *(LAS u32x4*)(SL[3] + pp * LDP + 8 * w) = wkai;
          *(LAS u32x4*)(SL[5] + pp * LDP + 8 * w) = R0v; }
        __syncthreads();
        { f32x4 accA[4], accK[4];
#pragma unroll
          for (int m = 0; m < 4; ++m) { accA[m] = (f32x4){0.f, 0.f, 0.f, 0.f}; accK[m] = accA[m]; }
          const LAS bf16_t* Qop = g2 == 0 ? SL[0] : SL[1];
          slab64(accA, SL[3], Qop, s4, fr, fq);
          slab64(accK, SL[2], Qop, s4, fr, fq);
          const int tcol = 16 * s4 + fr;
#pragma unroll
          for (int m = 0; m < 4; ++m) {
              u32x2 wa, wk; wa.x = pk2(accA[m][0], accA[m][1]) & MW[m][0]; wa.y = pk2(accA[m][2], accA[m][3]) & MW[m][1]; wk.x = pk2(accK[m][0], accK[m][1]) & MW[m][0]; wk.y = pk2(accK[m][2], accK[m][3]) & MW[m][1];
              *(LAS u32x2*)((g2 == 0 ? SL[9] : SL[8]) + tcol * LDP + 16 * m + 4 * fq) = wa;
              *(LAS u32x2*)((g2 == 0 ? SL[10] : SL[11]) + tcol * LDP + 16 * m + 4 * fq) = wk;
              }
          if (g2 == 0) {
              f32x4 atc = accA[0];
#pragma unroll
              for (int m = 1; m < 4; ++m) if (m == s4) atc = accA[m];
#pragma unroll
              for (int i = 0; i < 4; ++i) atc[i] = (4 * fq + i < fr) ? atc[i] : 0.f;
              f32x4 ac = (f32x4){0.f, 0.f, 0.f, 0.f};
#pragma unroll
              for (int s2 = 0; s2 < 2; ++s2) { const bf16x8 pa = *(const LAS bf16x8*)(SL[3] + (16 * s4 + fr) * LDP + 32 * s2 + 8 * fq), qb = *(const LAS bf16x8*)(SL[0] + (16 * s4 + fr) * LDP + 32 * s2 + 8 * fq);
                  ac = __builtin_amdgcn_mfma_f32_16x16x32_bf16(qb, pa, ac, 0, 0, 0); }
#pragma unroll
              for (int i = 0; i < 4; ++i) ac[i] = (fr < 4 * fq + i) ? ac[i] : 0.f;
              f32x4 idc;
#pragma unroll
              for (int i = 0; i < 4; ++i) idc[i] = (4 * fq + i == fr) ? 1.f : 0.f;
              const f32x4 z4 = (f32x4){0.f, 0.f, 0.f, 0.f};
              const s16x4v pac = pack4(ac), patc = pack4(atc);
              const f32x4 a2c = mfma16(patc, pac, z4), a2tc = mfma16(pac, patc, z4);
              const s16x4v p2c = pack4(a2c), p2tc = pack4(a2tc);
              const f32x4 a4c = mfma16(p2tc, p2c, z4), a4tc = mfma16(p2c, p2tc, z4);
              const f32x4 a8c = mfma16(pack4(a4tc), pack4(a4c), z4);
              const f32x4 P2c = mfma16(pack4(idc + a4tc), pack4(idc + a8c), z4);
              const f32x4 P3c = mfma16(pack4(idc + a2tc), pack4(P2c), z4);
              const f32x4 ttc = mfma16(pack4(P3c), pack4(idc - atc), z4);
              u32x2 wd; wd.x = pk2(ttc[0], ttc[1]); wd.y = pk2(ttc[2], ttc[3]);
              *(LAS u32x2*)(DINV + (s4 * 16 + fr) * 16 + 4 * fq) = wd; } }
        __syncthreads();
        f32x4 X[4];
        if (g2 == 0) {
#pragma unroll
            for (int m = 0; m < 4; ++m) { const u32x2 v2 = __builtin_bit_cast(u32x2, tr4(SL[0], 16 * m + 4 * fq, 16 * s4, fr)); X[m] = (f32x4){bflo(v2.x), bfhi(v2.x), bflo(v2.y), bfhi(v2.y)}; }
        } else {
#pragma unroll
            for (int m = 0; m < 4; ++m) X[m] = (f32x4){0.f, 0.f, 0.f, 0.f};
            slab64t<false>(X, SL[10], SL[5], s4, fr, fq);
        }
        s16x4v xb[4];
#pragma unroll
        for (int bi = 0; bi < 4; ++bi) {
            f32x4 sacc = (f32x4){0.f, 0.f, 0.f, 0.f};
#pragma unroll
            for (int bj = 0; bj < bi; ++bj) { const s16x4v af = *(const LAS s16x4v*)(SL[9] + (16 * bi + fr) * LDP + 16 * bj + 4 * fq); sacc = mfma16(af, xb[bj], sacc); }
            const f32x4 rhs = X[bi] - sacc;
            const s16x4v df = *(const LAS s16x4v*)(DINV + (bi * 16 + fr) * 16 + 4 * fq);
            X[bi] = mfma16(df, pack4(rhs), (f32x4){0.f, 0.f, 0.f, 0.f});
            xb[bi] = pack4(X[bi]);
        }
        unsigned char* ob = OPS + (size_t)unit * 32768;
        if (g2 == 0) {
#pragma unroll
            for (int mt = 0; mt < 4; ++mt) {
                f32x4 aq = (f32x4){0.f, 0.f, 0.f, 0.f}, am = aq;
#pragma unroll
                for (int kb = 0; kb < 4; ++kb) { const s16x4v bq = *(const LAS s16x4v*)(SL[8] + (16 * mt + fr) * LDP + 16 * kb + 4 * fq);
                    const s16x4v bm = tr4(SL[3], 16 * kb + 4 * fq, 16 * mt, fr);
                    aq = mfma16(xb[kb], bq, aq); am = mfma16(xb[kb], bm, am); }
                const u32x2 rgv = *(const LAS u32x2*)(SL[1] + (16 * mt + fr) * LDP + 16 * s4 + 4 * fq);
                u32x2 oq; oq.x = pk2(bflo(rgv.x) - aq[0], bfhi(rgv.x) - aq[1]); oq.y = pk2(bflo(rgv.y) - aq[2], bfhi(rgv.y) - aq[3]);
                *(u32x2*)(ob + ((mt * 2 + (s4 >> 1)) * 64 + lane) * 16 + (s4 & 1) * 8) = oq;
                const float egc = GC[16 * mt + fr]; float mv[4];
#pragma unroll
                for (int i = 0; i < 4; ++i) mv[i] = egc * (((16 * s4 + 4 * fq + i) == (16 * mt + fr) ? 1.f : 0.f) - am[i]);
                u32x2 om; om.x = pk2(mv[0], mv[1]); om.y = pk2(mv[2], mv[3]);
                *(u32x2*)(ob + 8192 + ((mt * 2 + (s4 >> 1)) * 64 + lane) * 16 + (s4 & 1) * 8) = om;
            }
        } else {
            f32x4 y1[4], b1[4];
#pragma unroll
            for (int m = 0; m < 4; ++m) { y1[m] = (f32x4){0.f, 0.f, 0.f, 0.f}; b1[m] = y1[m]; }
            slab64t<false>(y1, SL[11], SL[5], s4, fr, fq);
            slab64t<true>(b1, SL[2], SL[5], s4, fr, fq);
            u32x2 oyp[2], obp[2];
#pragma unroll
            for (int m = 0; m < 4; ++m) {
                f32x4 y2 = (f32x4){0.f, 0.f, 0.f, 0.f}, b2 = y2;
#pragma unroll
                for (int kb = 0; kb < 4; ++kb) { const s16x4v ay = *(const LAS s16x4v*)(SL[8] + (16 * m + fr) * LDP + 16 * kb + 4 * fq);
                    const s16x4v ab = tr4(SL[3], 16 * kb + 4 * fq, 16 * m, fr);
                    y2 = mfma16(ay, xb[kb], y2); b2 = mfma16(ab, xb[kb], b2); }
                const f32x4 yv = y1[m] - y2; oyp[m & 1].x = pk2(yv[0], yv[1]); oyp[m & 1].y = pk2(yv[2], yv[3]);
                const f32x4 gcv = *(const LAS f32x4*)(GC + 16 * m + 4 * fq);
                const f32x4 bv = (b1[m] - b2) * gcv; obp[m & 1].x = pk2(bv[0], bv[1]); obp[m & 1].y = pk2(bv[2], bv[3]);
                if (m & 1) { *(u32x4*)(ob + 16384 + ((s4 * 2 + (m >> 1)) * 64 + lane) * 16) = (u32x4){oyp[0].x, oyp[0].y, oyp[1].x, oyp[1].y};
                             *(u32x4*)(ob + 24576 + ((s4 * 2 + (m >> 1)) * 64 + lane) * 16) = (u32x4){obp[0].x, obp[0].y, obp[1].x, obp[1].y}; }
            }
        }
        unit = unit_next;
    }
}

constexpr int SC_SLOT = 10240, SC_NSLOT = 8, SC_TILE = SC_NSLOT * SC_SLOT, CV_TP = 264;
static_assert(SC_TILE + 64 * CV_TP * 2 <= LDS_MISC, "scan ring + conversion tile");
DI void scan_issue(const unsigned char* st, LAS unsigned char* slot, int w4, int wave, int lane) {
    if (wave == 0 || wave > 3) return;
#pragma unroll
    for (int i = 0; i < 4; ++i) { const int f = wave - 1 + 3 * i;
        if (f < 10) { const unsigned char* src = f < 8 ? st + 8192 + f * 1024 : st + 24576 + w4 * 2048 + (f - 8) * 1024;
            __builtin_amdgcn_global_load_lds((const unsigned*)(src + lane * 16), (LAS unsigned*)(slot + f * 1024), 16, 0, 0); } }
}
struct CvTile { const float* src; bf16_t* dst; int ldn, ldk, k0, n0, rowmap; bool ok; };
DI CvTile cv_tile(const Params& p, int it) {
    CvTile t; t.ok = it < 32 * 2 * 16 + 32 * 16; t.n0 = 0;
    if (it < 1024) { const int e = it >> 5, up = (it >> 4) & 1, kt = it & 15; t.src = (up ? p.in[I_WU] : p.in[I_WG]) + (size_t)e * 1024 * 256 + (size_t)kt * 64 * 256; t.ldn = 256;
        t.dst = (bf16_t*)(p.ws + WS_WGUT) + (size_t)e * 512 * 1024; t.ldk = 1024; t.k0 = kt * 64; t.rowmap = 1 + up; }
    else { const int r = (it - 1024) & 511, e = r >> 4, kt = (r >> 2) & 3, ntl = r & 3; t.src = p.in[I_WD] + (size_t)e * 256 * 1024 + (size_t)kt * 64 * 1024 + ntl * 256; t.ldn = 1024;
        t.dst = (bf16_t*)(p.ws + WS_WDT) + (size_t)e * 1024 * 256; t.ldk = 256; t.k0 = kt * 64; t.rowmap = 0; t.n0 = ntl * 256; }
    return t;
}
DI void phase_scan_chunk(const Params& p, const Ctx& F) {
    unsigned char* OPS = p.ws + WS_OPS;
    LAS unsigned char* ring = F.lds; LAS bf16_t* tile = (LAS bf16_t*)(F.lds + SC_TILE);
    const bool fused_cv = false;
    for (int item = F.bid; item < 256; item += F.G) {
        const int xq = item & 7, yq = item >> 3, w4 = yq & 3, chainid = xq + 8 * (yq >> 2);
        unsigned char* ops = OPS + (size_t)chainid * 132 * 32768;
        f32x4 H[4];
#pragma unroll
        for (int m = 0; m < 4; ++m) H[m] = (f32x4){0.f, 0.f, 0.f, 0.f};
        f32x4 cvr[8];
#pragma unroll
        for (int i = 0; i < 8; ++i) cvr[i] = (f32x4){0.f, 0.f, 0.f, 0.f};
        __syncthreads();
#pragma unroll
        for (int i = 0; i < SC_NSLOT - 1; ++i) scan_issue(ops + (size_t)i * 32768, ring + i * SC_SLOT, w4, F.wave, F.lane);
        auto scan_step = [&](int pc) {
            if (F.wave == 1) asm volatile("s_waitcnt vmcnt(24)" ::: "memory"); else if (F.wave == 2 || F.wave == 3) asm volatile("s_waitcnt vmcnt(18)" ::: "memory");
            __builtin_amdgcn_s_barrier();
            const LAS unsigned char* slot = ring + (pc % SC_NSLOT) * SC_SLOT;
            { const int nx = pc + SC_NSLOT - 1 < 132 ? pc + SC_NSLOT - 1 : 131;
              scan_issue(ops + (size_t)nx * 32768, ring + ((pc + SC_NSLOT - 1) % SC_NSLOT) * SC_SLOT, w4, F.wave, F.lane); }
            if (F.wave == 0) {
                bf16x8 ma[4][2]; u32x2 bc[4];
#pragma unroll
                for (int m = 0; m < 4; ++m) {
#pragma unroll
                    for (int s2 = 0; s2 < 2; ++s2) ma[m][s2] = *(const LAS bf16x8*)(slot + ((m * 2 + s2) * 64 + F.lane) * 16);
                    bc[m] = *(const LAS u32x2*)(slot + 8192 + ((m >> 1) * 64 + F.lane) * 16 + (m & 1) * 8); }
                asm volatile("s_waitcnt lgkmcnt(0)" ::: "memory");
                bf16x8 hb[2];
#pragma unroll
                for (int s2 = 0; s2 < 2; ++s2) { u32x4 t; t.x = pk2(H[2 * s2][0], H[2 * s2][1]); t.y = pk2(H[2 * s2][2], H[2 * s2][3]); t.z = pk2(H[2 * s2 + 1][0], H[2 * s2 + 1][1]); t.w = pk2(H[2 * s2 + 1][2], H[2 * s2 + 1][3]);
                    hb[s2] = __builtin_bit_cast(bf16x8, t); }
                if (pc >= 4) {
#pragma unroll
                    for (int s2 = 0; s2 < 2; ++s2) *(bf16x8*)(ops + (size_t)pc * 32768 + 24576 + w4 * 2048 + (s2 * 64 + F.lane) * 16) = hb[s2]; }
#pragma unroll
                for (int m = 0; m < 4; ++m) {
                    f32x4 hn = (f32x4){bflo(bc[m].x), bfhi(bc[m].x), bflo(bc[m].y), bfhi(bc[m].y)};
#pragma unroll
                    for (int s2 = 0; s2 < 2; ++s2) hn = __builtin_amdgcn_mfma_f32_16x16x32_bf16(ma[m][s2], hb[s2], hn, 0, 0, 0);
                    H[m] = hn;
                }
            }
        };
#pragma unroll 1
        for (int pc4 = 0; pc4 < 132; pc4 += 4) {
            const CvTile T = cv_tile(p, item + 256 * (pc4 / 4));
            const bool cvon = fused_cv && F.wave >= 4 && T.ok;
            const int r0 = 16 * (F.wave - 4);
            scan_step(pc4);
            if (cvon) {
#pragma unroll
                for (int i = 0; i < 8; ++i) cvr[i] = *(const f32x4*)(T.src + (size_t)(r0 + i) * T.ldn + 4 * F.lane); }
            scan_step(pc4 + 1);
            if (cvon) {
#pragma unroll
                for (int i = 0; i < 8; ++i) { u32x2 o; o.x = pk2(cvr[i][0], cvr[i][1]); o.y = pk2(cvr[i][2], cvr[i][3]); *(LAS u32x2*)(tile + (r0 + i) * CV_TP + 4 * F.lane) = o; }
#pragma unroll
                for (int i = 0; i < 8; ++i) cvr[i] = *(const f32x4*)(T.src + (size_t)(r0 + 8 + i) * T.ldn + 4 * F.lane); }
            scan_step(pc4 + 2);
            if (cvon) {
#pragma unroll
                for (int i = 0; i < 8; ++i) { u32x2 o; o.x = pk2(cvr[i][0], cvr[i][1]); o.y = pk2(cvr[i][2], cvr[i][3]); *(LAS u32x2*)(tile + (r0 + 8 + i) * CV_TP + 4 * F.lane) = o; } }
            scan_step(pc4 + 3);
            if (cvon) {
                const int n = F.tid - 256;
                const int drow = T.rowmap == 0 ? T.n0 + n : ((n >> 7) * 256 + (n & 127) + (T.rowmap == 2 ? 128 : 0));
                bf16_t* dp = T.dst + (size_t)drow * T.ldk + T.k0;
#pragma unroll
                for (int q = 0; q < 8; ++q) { unsigned wds[4];
#pragma unroll
                    for (int jj = 0; jj < 4; ++jj) { const int k = 8 * q + 2 * jj; wds[jj] = (unsigned)tile[k * CV_TP + n] | ((unsigned)tile[(k + 1) * CV_TP + n] << 16); }
                    *(u32x4*)(dp + 8 * q) = (u32x4){wds[0], wds[1], wds[2], wds[3]}; } }
        }
        asm volatile("s_waitcnt vmcnt(0)" ::: "memory");
    }
}

DI void phase_post2(const Params& p, const Ctx& F) {
    const unsigned char* OPS = p.ws + WS_OPS;
    const bf16_t* GATE = (const bf16_t*)((unsigned char*)p.out + DO_GATE); const bf16_t* BV = (const bf16_t*)((unsigned char*)p.out + DO_BV);
    bf16_t* MIXED = (bf16_t*)((unsigned char*)p.out + DO_MIXED);
    constexpr int LDY = 68;
    const int fr = F.lane & 15, fq = F.lane >> 4, w4 = F.wave & 3, dd = F.wave >> 2, tk = F.tid >> 3, cg8 = F.tid & 7;
    constexpr int NU = 4 * 128 * 8;
    struct PLd { bf16x8 qa[4][2], hb[2]; u32x2 y0[4]; u32x4 gq, bq; };
    auto issue = [&](PLd& L, int unit) { const int h = unit & 7, j = (unit >> 3) & 127, b = unit >> 10, chain = b * 8 + h;
        const unsigned char* ops = OPS + ((size_t)(dd * 32 + chain) * 132 + 4 + (dd ? 127 - j : j)) * 32768;
#pragma unroll
        for (int m = 0; m < 4; ++m) {
#pragma unroll
            for (int s2 = 0; s2 < 2; ++s2) L.qa[m][s2] = *(const bf16x8*)(ops + ((m * 2 + s2) * 64 + F.lane) * 16);
            L.y0[m] = *(const u32x2*)(ops + 16384 + ((w4 * 2 + (m >> 1)) * 64 + F.lane) * 16 + (m & 1) * 8); }
#pragma unroll
        for (int s2 = 0; s2 < 2; ++s2) L.hb[s2] = *(const bf16x8*)(ops + 24576 + w4 * 2048 + (s2 * 64 + F.lane) * 16);
        const size_t o = ((size_t)b * SEQ + 64 * j + tk) * 512 + 64 * h + 8 * cg8;
        L.gq = *(const u32x4*)(GATE + o); L.bq = *(const u32x4*)(BV + o); };
    PLd L;
    if (F.bid < NU) issue(L, F.bid);
    int par = 0, hcur = -1; f32x4 lg0, lg1, lb0, lb1;
    for (int unit = F.bid; unit < NU; unit += F.G, par ^= 1) {
        const int h = unit & 7, j = (unit >> 3) & 127, b = unit >> 10;
        if (h != hcur) { hcur = h;
            lg0 = *(const f32x4*)(p.in[I_LNXG] + 64 * h + 8 * cg8); lg1 = *(const f32x4*)(p.in[I_LNXG] + 64 * h + 8 * cg8 + 4); lb0 = *(const f32x4*)(p.in[I_LNXB] + 64 * h + 8 * cg8); lb1 = *(const f32x4*)(p.in[I_LNXB] + 64 * h + 8 * cg8 + 4); }
        LAS float* ys = (LAS float*)F.lds + par * 64 * LDY;
        f32x4 y[4];
#pragma unroll
        for (int m = 0; m < 4; ++m) { y[m] = (f32x4){bflo(L.y0[m].x), bfhi(L.y0[m].x), bflo(L.y0[m].y), bfhi(L.y0[m].y)};
#pragma unroll
            for (int s2 = 0; s2 < 2; ++s2) y[m] = __builtin_amdgcn_mfma_f32_16x16x32_bf16(L.qa[m][s2], L.hb[s2], y[m], 0, 0, 0); }
        const u32x4 gq = L.gq, bq = L.bq;
        if (unit + F.G < NU) issue(L, unit + F.G);
        const int n = 16 * w4 + fr;
        if (dd == 0) {
#pragma unroll
            for (int m = 0; m < 4; ++m) { const int t0 = 16 * m + 4 * fq;
#pragma unroll
                for (int i = 0; i < 4; ++i) ys[(t0 + i) * LDY + n] = y[m][i]; } }
        __syncthreads();
        if (dd == 1) {
#pragma unroll
            for (int m = 0; m < 4; ++m) { const int t0 = 16 * m + 4 * fq;
#pragma unroll
                for (int i = 0; i < 4; ++i) ys[(63 - t0 - i) * LDY + n] += y[m][i]; } }
        __syncthreads();
        { const size_t row = (size_t)b * SEQ + 64 * j + tk;
          const f32x4 ya = *(const LAS f32x4*)(ys + tk * LDY + 8 * cg8), yb = *(const LAS f32x4*)(ys + tk * LDY + 8 * cg8 + 4);
          float yv[8] = {ya[0], ya[1], ya[2], ya[3], yb[0], yb[1], yb[2], yb[3]};
          float s1 = 0.f;
#pragma unroll
          for (int i = 0; i < 8; ++i) s1 += yv[i];
          s1 += __shfl_xor(s1, 1); s1 += __shfl_xor(s1, 2); s1 += __shfl_xor(s1, 4);
          const float mu = s1 * (1.f / 64.f); float s2 = 0.f;
#pragma unroll
          for (int i = 0; i < 8; ++i) { yv[i] -= mu; s2 += yv[i] * yv[i]; }
          s2 += __shfl_xor(s2, 1); s2 += __shfl_xor(s2, 2); s2 += __shfl_xor(s2, 4);
          const float rstd = __builtin_amdgcn_rsqf(s2 * (1.f / 64.f) + 64e-5f);
          float ov[8];
#pragma unroll
          for (int i = 0; i < 8; ++i) { const float yn = yv[i] * rstd * (i < 4 ? lg0[i & 3] : lg1[i & 3]) + (i < 4 ? lb0[i & 3] : lb1[i & 3]);
              const float gt = (i & 1) ? bfhi(gq[i >> 1]) : bflo(gq[i >> 1]), bb = (i & 1) ? bfhi(bq[i >> 1]) : bflo(bq[i >> 1]);
              ov[i] = (yn + bb) * gt; }
          u32x4 ow = (u32x4){pk2(ov[0], ov[1]), pk2(ov[2], ov[3]), pk2(ov[4], ov[5]), pk2(ov[6], ov[7])};
          *(u32x4*)(MIXED + row * D + 512 + 64 * h + 8 * cg8) = ow; }
    }
}

DI void phase_post(const Params& p, const Ctx& F) {
    const float* YS = (const float*)(p.ws + WS_YS);
    const bf16_t* GATE = (const bf16_t*)((unsigned char*)p.out + DO_GATE); const bf16_t* BV = (const bf16_t*)((unsigned char*)p.out + DO_BV);
    bf16_t* MIXED = (bf16_t*)((unsigned char*)p.out + DO_MIXED);
    const int t = F.tid; const float lg = p.in[I_LNXG][t], lb = p.in[I_LNXB][t];
    for (int row = F.bid; row < NT; row += F.G) {
        const size_t o = (size_t)row * 512 + t;
        const float y = YS[o] + YS[(size_t)NT * 512 + o];
        const float mu = wave_sum(y) * (1.f / 64.f); const float dd = y - mu; const float var = wave_sum(dd * dd) * (1.f / 64.f);
        const float yn = dd * (1.f / sqrtf(var + 64e-5f)) * lg + lb;
        const float ob = (yn + bf2f(BV[o])) * bf2f(GATE[o]);
        MIXED[(size_t)row * D + 512 + t] = (bf16_t)f2bf(ob);
    }
}

DI void phase_gemm2(const Params& p, const Ctx& F) {
    pg8::StaticOrder S; S.init((unsigned char*)p.out + DO_MIXED, p.ws + WS_WOUTT, NT, 1024, 1024, F.G, F.bid);
    pg8::EpiBf16 E{(bf16_t*)(p.ws + WS_Y), 1024, false};
    pg8::gemm_phase<pg8::EpiBf16, pg8::StaticOrder, false>(F.lds, 1024, S, E);
}

DI void phase_route_valu(const Params& p, const Ctx& F, const bool dry = false) {
    LAS float* wr_ = (LAS float*)F.lds;
    { const f32x4* wsrc = (const f32x4*)(p.ws + WS_WRT);
#pragma unroll 6
      for (int i = F.tid; i < 9 * 1024; i += NTHREADS) *(LAS f32x4*)(wr_ + 4 * i) = wsrc[i]; }
    __syncthreads();
    const float* mod = (const float*)(p.ws + WS_MOD); const bf16_t* Y = (const bf16_t*)(p.ws + WS_Y);
    bf16_t* H2 = (bf16_t*)(p.ws + WS_H2); int* cnt = (int*)(p.ws + WS_CTL); int* perm = (int*)(p.ws + WS_PERM); float* ew = (float*)(p.ws + WS_EW);
    const int gw = F.bid * NWAVES + F.wave, NGW = F.G * NWAVES;
    LAS int* hist = (LAS int*)(F.lds + LDS_MISC + 64); LAS int* basel = (LAS int*)(F.lds + LDS_MISC + 192); LAS int* sel = (LAS int*)(F.lds + LDS_MISC + 320);
    if (F.tid < 32) hist[F.tid] = 0;
    __syncthreads();
    u32x2 nyy[2][4]; f32x4 nxx[2][4];
    auto rissue = [&](int r, int row) { const u32x2* yr = (const u32x2*)(Y + (size_t)row * D) + F.lane; const f32x4* xr = (const f32x4*)(p.in[I_X] + (size_t)row * D) + F.lane;
#pragma unroll
        for (int j = 0; j < 4; ++j) { nyy[r][j] = yr[64 * j]; nxx[r][j] = __builtin_nontemporal_load(xr + 64 * j); } };
    auto rowof = [&](int it, int r) { return 2 * (gw + it * NGW) + r; };
    if (rowof(0, 0) < NT) { rissue(0, rowof(0, 0)); rissue(1, rowof(0, 1)); }
    int btcur = -1; f32x4 g1p[4], gsc2[4], sh2[4];
    const float bias_l = (F.lane < 4) ? p.in[I_BRG][F.lane & 3] : p.in[I_BRE][(F.lane - 4) & 31];
    const bool b5 = (F.lane & 32) != 0, b4 = (F.lane & 16) != 0, b3 = (F.lane & 8) != 0, b2 = (F.lane & 4) != 0, b1 = (F.lane & 2) != 0, b0 = (F.lane & 1) != 0;
    auto fold = [&](const float (&pp)[9]) {
        float v32[8], v16[4], v8[2];
#pragma unroll
        for (int m = 0; m < 8; ++m) { const float lo = pp[m], hi = (m == 0) ? pp[8] : 0.f; const float mine = b5 ? hi : lo, th = b5 ? lo : hi; v32[m] = mine + __shfl_xor(th, 32); }
#pragma unroll
        for (int m = 0; m < 4; ++m) { const float mine = b4 ? v32[4 + m] : v32[m], th = b4 ? v32[m] : v32[4 + m]; v16[m] = mine + __shfl_xor(th, 16); }
#pragma unroll
        for (int m = 0; m < 2; ++m) { const float mine = b3 ? v16[2 + m] : v16[m], th = b3 ? v16[m] : v16[2 + m]; v8[m] = mine + __shfl_xor(th, 8); }
        const float mine = b2 ? v8[1] : v8[0], th = b2 ? v8[0] : v8[1]; return mine + __shfl_xor(th, 4);
    };
    auto finish = [&](const float (&v4)[4], const int row, const int itn) {
        float v2[2], mylg;
#pragma unroll
        for (int i = 0; i < 2; ++i) { const float mine = b1 ? v4[2 + i] : v4[i], th = b1 ? v4[i] : v4[2 + i]; v2[i] = mine + __shfl_xor(th, 2); }
        { const float mine = b0 ? v2[1] : v2[0], th = b0 ? v2[0] : v2[1]; mylg = mine + __shfl_xor(th, 1); }
        mylg += bias_l;
        float gl[4];
#pragma unroll
        for (int j = 0; j < 4; ++j) gl[j] = __shfl(mylg, j);
        int gi = 0; float gm = gl[0];
#pragma unroll
        for (int j = 1; j < 4; ++j) if (gl[j] > gm) { gm = gl[j]; gi = j; }
        float gsum = 0.f;
#pragma unroll
        for (int j = 0; j < 4; ++j) gsum += __expf(gl[j] - gm);
        const float gw_ = 1.f / gsum;
        float el[8];
#pragma unroll
        for (int j = 0; j < 8; ++j) el[j] = __shfl(mylg, 4 + gi * 8 + j);
        int i1 = 0; float m1 = el[0];
#pragma unroll
        for (int j = 1; j < 8; ++j) if (el[j] > m1) { m1 = el[j]; i1 = j; }
        int i2 = 0; float m2 = -3.0e38f;
#pragma unroll
        for (int j = 0; j < 8; ++j) if (j != i1 && el[j] > m2) { m2 = el[j]; i2 = j; }
        const float p2 = __expf(m2 - m1);
        const float w1 = gw_ / (1.f + p2), w2 = gw_ * p2 / (1.f + p2);
        if (F.lane == 0 && !dry) {
            const int e1 = gi * 8 + i1, e2 = gi * 8 + i2;
            if (itn < 16) {
                const int s1 = atomicAdd((int*)(hist + e1), 1), s2 = atomicAdd((int*)(hist + e2), 1);
                sel[(F.wave * 16 + itn) * 2] = (e1 << 16) | s1; sel[(F.wave * 16 + itn) * 2 + 1] = (e2 << 16) | s2;
            } else {
                const int p1 = atomicAdd(&cnt[e1 * 64], 1); perm[(size_t)e1 * NT + p1] = row * 2;
                const int q2 = atomicAdd(&cnt[e2 * 64], 1); perm[(size_t)e2 * NT + q2] = row * 2 + 1;
            }
            ew[row * 2] = w1; ew[row * 2 + 1] = w2;
        }
    };
    for (int it = 0; rowof(it, 0) < NT; ++it) {
        const int row0 = rowof(it, 0), row1 = row0 + 1;
        const int bt = row0 / SEQ;
        if (bt != btcur) { btcur = bt;
#pragma unroll
            for (int j = 0; j < 4; ++j) { const int col = 4 * (F.lane + 64 * j);
                g1p[j] = *(const f32x4*)(mod + bt * 6144 + 2048 + col) * *(const f32x4*)(p.in[I_GPOST1] + col);
                gsc2[j] = *(const f32x4*)(p.in[I_GPRE2] + col) * (*(const f32x4*)(mod + bt * 6144 + 4096 + col) + 1.f); sh2[j] = *(const f32x4*)(mod + bt * 6144 + 3072 + col); } }
        f32x4 v[2][4]; float ss[2] = {0.f, 0.f};
#pragma unroll
        for (int r = 0; r < 2; ++r)
#pragma unroll
            for (int j = 0; j < 4; ++j) { const u32x2 yy = nyy[r][j]; v[r][j] = (f32x4){bflo(yy.x), bfhi(yy.x), bflo(yy.y), bfhi(yy.y)}; ss[r] += (v[r][j].x * v[r][j].x + v[r][j].y * v[r][j].y) + (v[r][j].z * v[r][j].z + v[r][j].w * v[r][j].w); }
        f32x4 xv[2][4];
#pragma unroll
        for (int r = 0; r < 2; ++r)
#pragma unroll
            for (int j = 0; j < 4; ++j) xv[r][j] = nxx[r][j];
        if (rowof(it + 1, 0) < NT) { rissue(0, rowof(it + 1, 0)); rissue(1, rowof(it + 1, 1)); }
#pragma unroll
        for (int r = 0; r < 2; ++r) {
            const int row = r ? row1 : row0;
            const float rstd = __builtin_amdgcn_rsqf(wave_sum(ss[r]) * (1.f / D) + 1e-6f);
            float s2 = 0.f;
            u32x2* xo = (u32x2*)(p.ws + WS_X1 + (size_t)row * D * 2) + F.lane;
#pragma unroll
            for (int j = 0; j < 4; ++j) {
                v[r][j] = xv[r][j] + g1p[j] * (v[r][j] * rstd);
                xo[64 * j] = (u32x2){pkh2(v[r][j].x, v[r][j].y), pkh2(v[r][j].z, v[r][j].w)};
                s2 += (v[r][j].x * v[r][j].x + v[r][j].y * v[r][j].y) + (v[r][j].z * v[r][j].z + v[r][j].w * v[r][j].w); }
            const float rstd2 = __builtin_amdgcn_rsqf(wave_sum(s2) * (1.f / D) + 1e-6f);
            unsigned long long* o8 = (unsigned long long*)(H2 + (size_t)row * D) + F.lane;
#pragma unroll
            for (int j = 0; j < 4; ++j) {
                v[r][j] = v[r][j] * rstd2 * gsc2[j] + sh2[j];
                o8[64 * j] = (unsigned long long)pk2(v[r][j].x, v[r][j].y) | ((unsigned long long)pk2(v[r][j].z, v[r][j].w) << 32); }
        }
        float q0[4], q1[4];
#pragma unroll
        for (int i = 0; i < 4; ++i) { float pa[9], pb[9];
#pragma unroll
            for (int m = 0; m < 9; ++m) { const int o = i + 4 * m; float a0, a1;
                f32x2 c0 = (f32x2){0.f, 0.f}, d0 = c0, c1 = c0, d1 = c0;
#pragma unroll
                for (int j = 0; j < 4; ++j) { const f32x4 w = *(const LAS f32x4*)(wr_ + o * 1024 + 4 * (F.lane + 64 * j)); const f32x2 wl = (f32x2){w.x, w.y}, wh = (f32x2){w.z, w.w};
                    c0 = __builtin_elementwise_fma((f32x2){v[0][j].x, v[0][j].y}, wl, c0); d0 = __builtin_elementwise_fma((f32x2){v[0][j].z, v[0][j].w}, wh, d0);
                    c1 = __builtin_elementwise_fma((f32x2){v[1][j].x, v[1][j].y}, wl, c1); d1 = __builtin_elementwise_fma((f32x2){v[1][j].z, v[1][j].w}, wh, d1); }
                c0 += d0; c1 += d1; a0 = c0.x + c0.y; a1 = c1.x + c1.y;
                pa[m] = a0; pb[m] = a1; }
            q0[i] = fold(pa); q1[i] = fold(pb); __builtin_amdgcn_sched_barrier(0); }
        finish(q0, row0, 2 * it);
        finish(q1, row1, 2 * it + 1);
    }
    if (!dry) {
        __syncthreads();
        if (F.tid < 32) basel[F.tid] = atomicAdd(&cnt[F.tid * 64], (int)hist[F.tid]);
        __syncthreads();
        if (F.tid < 256) { const int wv = F.tid >> 5, it2 = (F.tid >> 1) & 15, sl = F.tid & 1; const int row = 2 * (F.bid * NWAVES + wv + (it2 >> 1) * NGW) + (it2 & 1);
            if (row < NT) { const int sv = sel[F.tid]; const int e = sv >> 16, ps = sv & 0xffff; perm[(size_t)e * NT + basel[e] + ps] = row * 2 + sl; } }
    }
}


constexpr int RT_PITCH = 1032;
constexpr int RT_WRG = 0, RT_HI = 16384, RT_LO = RT_HI + 16 * RT_PITCH * 2, RT_PART = RT_LO + 16 * RT_PITCH * 2;
static_assert(RT_PART + 16384 <= LDS_MISC, "route LDS");
DI void phase_route(const Params& p, const Ctx& F, const bool dry = false) {
    if (F.G != 256 || dry) { phase_route_valu(p, F, dry); return; }
    LAS float* wrg = (LAS float*)(F.lds + RT_WRG);
    { const f32x4* wsrc = (const f32x4*)(p.ws + WS_WRT);
      for (int i = F.tid; i < 1024; i += NTHREADS) *(LAS f32x4*)(wrg + 4 * i) = wsrc[i]; }
    const float* mod = (const float*)(p.ws + WS_MOD); const bf16_t* Y = (const bf16_t*)(p.ws + WS_Y);
    bf16_t* H2 = (bf16_t*)(p.ws + WS_H2); int* cnt = (int*)(p.ws + WS_CTL); int* perm = (int*)(p.ws + WS_PERM); float* ew = (float*)(p.ws + WS_EW);
    const int gw = F.bid * NWAVES + F.wave, NGW = F.G * NWAVES;
    LAS int* hist = (LAS int*)(F.lds + LDS_MISC + 64); LAS int* basel = (LAS int*)(F.lds + LDS_MISC + 192); LAS int* sel = (LAS int*)(F.lds + LDS_MISC + 320);
    if (F.tid < 32) hist[F.tid] = 0;
    bf16x8 wbh[2][4], wbl[2][4];
    { const bf16_t* wrh = (const bf16_t*)(p.ws + WS_WRH); const bf16_t* wrl = (const bf16_t*)(p.ws + WS_WRL);
#pragma unroll
      for (int t = 0; t < 2; ++t)
#pragma unroll
          for (int sk = 0; sk < 4; ++sk) { const size_t o = (size_t)(16 * t + (F.lane & 15)) * 1024 + 128 * F.wave + 32 * sk + 8 * (F.lane >> 4);
              wbh[t][sk] = *(const bf16x8*)(wrh + o); wbl[t][sk] = *(const bf16x8*)(wrl + o); } }
    const float bias_e = p.in[I_BRE][F.lane & 31];
    float gbias[4];
#pragma unroll
    for (int j = 0; j < 4; ++j) gbias[j] = p.in[I_BRG][j];
    __syncthreads();
    u32x2 nyy[2][4]; f32x4 nxx[2][4];
    auto rissue = [&](int r, int row) { const u32x2* yr = (const u32x2*)(Y + (size_t)row * D) + F.lane; const f32x4* xr = (const f32x4*)(p.in[I_X] + (size_t)row * D) + F.lane;
#pragma unroll
        for (int j = 0; j < 4; ++j) { nyy[r][j] = yr[64 * j]; nxx[r][j] = __builtin_nontemporal_load(xr + 64 * j); } };
    auto rowof = [&](int it, int r) { return 2 * (gw + it * NGW) + r; };
    rissue(0, rowof(0, 0)); rissue(1, rowof(0, 1));
    int btcur = -1; f32x4 g1p[4], gsc2[4], sh2[4];
    auto finish = [&](const float (&gl)[4], const float elog, const int eb, const int row, const int itn) {
        int gi = 0; float gm = gl[0];
#pragma unroll
        for (int j = 1; j < 4; ++j) if (gl[j] > gm) { gm = gl[j]; gi = j; }
        float gsum = 0.f;
#pragma unroll
        for (int j = 0; j < 4; ++j) gsum += __expf(gl[j] - gm);
        const float gw_ = 1.f / gsum;
        const int elogi = __builtin_bit_cast(int, elog); const int gis = __builtin_amdgcn_readfirstlane(gi);
        float el[8];
#pragma unroll
        for (int j = 0; j < 8; ++j) el[j] = __builtin_bit_cast(float, __builtin_amdgcn_readlane(elogi, eb + gis * 8 + j));
        int i1 = 0; float m1 = el[0];
#pragma unroll
        for (int j = 1; j < 8; ++j) if (el[j] > m1) { m1 = el[j]; i1 = j; }
        int i2 = 0; float m2 = -3.0e38f;
#pragma unroll
        for (int j = 0; j < 8; ++j) if (j != i1 && el[j] > m2) { m2 = el[j]; i2 = j; }
        const float p2 = __expf(m2 - m1);
        const float w1 = gw_ / (1.f + p2), w2 = gw_ * p2 / (1.f + p2);
        if (F.lane == 0) {
            const int e1 = gi * 8 + i1, e2 = gi * 8 + i2;
            const int s1 = atomicAdd((int*)(hist + e1), 1), s2 = atomicAdd((int*)(hist + e2), 1);
            sel[(F.wave * 16 + itn) * 2] = (e1 << 16) | s1; sel[(F.wave * 16 + itn) * 2 + 1] = (e2 << 16) | s2;
            ew[row * 2] = w1; ew[row * 2 + 1] = w2;
        }
    };
    LAS bf16_t* thi = (LAS bf16_t*)(F.lds + RT_HI); LAS bf16_t* tlo = (LAS bf16_t*)(F.lds + RT_LO); LAS float* part = (LAS float*)(F.lds + RT_PART);
    const int fr = F.lane & 15, fq = F.lane >> 4;
#pragma unroll 1
    for (int it = 0; it < 8; ++it) {
        const int row0 = rowof(it, 0), row1 = row0 + 1;
        const int bt = row0 / SEQ;
        if (bt != btcur) { btcur = bt;
#pragma unroll
            for (int j = 0; j < 4; ++j) { const int col = 4 * (F.lane + 64 * j);
                g1p[j] = *(const f32x4*)(mod + bt * 6144 + 2048 + col) * *(const f32x4*)(p.in[I_GPOST1] + col);
                gsc2[j] = *(const f32x4*)(p.in[I_GPRE2] + col) * (*(const f32x4*)(mod + bt * 6144 + 4096 + col) + 1.f); sh2[j] = *(const f32x4*)(mod + bt * 6144 + 3072 + col); } }
        f32x4 v[2][4]; float ss[2] = {0.f, 0.f};
#pragma unroll
        for (int r = 0; r < 2; ++r)
#pragma unroll
            for (int j = 0; j < 4; ++j) { const u32x2 yy = nyy[r][j]; v[r][j] = (f32x4){bflo(yy.x), bfhi(yy.x), bflo(yy.y), bfhi(yy.y)}; ss[r] += (v[r][j].x * v[r][j].x + v[r][j].y * v[r][j].y) + (v[r][j].z * v[r][j].z + v[r][j].w * v[r][j].w); }
        float gl[2][4];
#pragma unroll
        for (int r = 0; r < 2; ++r) {
            const int row = r ? row1 : row0;
            const float rstd = __builtin_amdgcn_rsqf(wave_sum(ss[r]) * (1.f / D) + 1e-6f);
            float s2 = 0.f;
            u32x2* xo = (u32x2*)(p.ws + WS_X1 + (size_t)row * D * 2) + F.lane;
#pragma unroll
            for (int j = 0; j < 4; ++j) {
                v[r][j] = nxx[r][j] + g1p[j] * (v[r][j] * rstd);
                __builtin_nontemporal_store((u32x2){pkh2(v[r][j].x, v[r][j].y), pkh2(v[r][j].z, v[r][j].w)}, xo + 64 * j);
                s2 += (v[r][j].x * v[r][j].x + v[r][j].y * v[r][j].y) + (v[r][j].z * v[r][j].z + v[r][j].w * v[r][j].w); }
            const float rstd2 = __builtin_amdgcn_rsqf(wave_sum(s2) * (1.f / D) + 1e-6f);
            unsigned long long* o8 = (unsigned long long*)(H2 + (size_t)row * D) + F.lane;
            float gp[4] = {0.f, 0.f, 0.f, 0.f};
#pragma unroll
            for (int j = 0; j < 4; ++j) {
                v[r][j] = v[r][j] * rstd2 * gsc2[j] + sh2[j];
                const unsigned h01 = pk2(v[r][j].x, v[r][j].y), h23 = pk2(v[r][j].z, v[r][j].w);
                o8[64 * j] = (unsigned long long)h01 | ((unsigned long long)h23 << 32);
                const unsigned l01 = pk2(v[r][j].x - bflo(h01), v[r][j].y - bfhi(h01)), l23 = pk2(v[r][j].z - bflo(h23), v[r][j].w - bfhi(h23));
                *(LAS u32x2*)(thi + (2 * F.wave + r) * RT_PITCH + 4 * (F.lane + 64 * j)) = (u32x2){h01, h23};
                *(LAS u32x2*)(tlo + (2 * F.wave + r) * RT_PITCH + 4 * (F.lane + 64 * j)) = (u32x2){l01, l23};
#pragma unroll
                for (int o = 0; o < 4; ++o) { const f32x4 w = *(const LAS f32x4*)(wrg + o * 1024 + 4 * (F.lane + 64 * j)); gp[o] += (v[r][j].x * w.x + v[r][j].y * w.y) + (v[r][j].z * w.z + v[r][j].w * w.w); } }
#pragma unroll
            for (int o = 0; o < 4; ++o) gl[r][o] = wave_sum(gp[o]) + gbias[o];
        }
        if (it + 1 < 8) { rissue(0, rowof(it + 1, 0)); rissue(1, rowof(it + 1, 1)); }
        __syncthreads();
        { f32x4 acc[2] = {(f32x4){0.f, 0.f, 0.f, 0.f}, (f32x4){0.f, 0.f, 0.f, 0.f}};
#pragma unroll
          for (int sk = 0; sk < 4; ++sk) { const int ko = fr * RT_PITCH + 128 * F.wave + 32 * sk + 8 * fq;
              const bf16x8 ah = *(const LAS bf16x8*)(thi + ko), al = *(const LAS bf16x8*)(tlo + ko);
#pragma unroll
              for (int t = 0; t < 2; ++t) { acc[t] = __builtin_amdgcn_mfma_f32_16x16x32_bf16(ah, wbh[t][sk], acc[t], 0, 0, 0); acc[t] = __builtin_amdgcn_mfma_f32_16x16x32_bf16(ah, wbl[t][sk], acc[t], 0, 0, 0);
                  acc[t] = __builtin_amdgcn_mfma_f32_16x16x32_bf16(al, wbh[t][sk], acc[t], 0, 0, 0); } }
#pragma unroll
          for (int t = 0; t < 2; ++t)
#pragma unroll
              for (int i = 0; i < 4; ++i) part[((F.wave * 2 + t) * 16 + 4 * fq + i) * 16 + fr] = acc[t][i]; }
        __syncthreads();
        float elog = bias_e;
        { const int o = F.lane & 31, rl = 2 * F.wave + (F.lane >> 5);
#pragma unroll
          for (int w2 = 0; w2 < 8; ++w2) elog += part[((w2 * 2 + (o >> 4)) * 16 + rl) * 16 + (o & 15)]; }
        finish(gl[0], elog, 0, row0, 2 * it);
        finish(gl[1], elog, 32, row1, 2 * it + 1);
    }
    __syncthreads();
    if (F.tid < 32) basel[F.tid] = atomicAdd(&cnt[F.tid * 64], (int)hist[F.tid]);
    __syncthreads();
    if (F.tid < 256) { const int wv = F.tid >> 5, it2 = (F.tid >> 1) & 15, sl = F.tid & 1; const int row = 2 * (F.bid * NWAVES + wv + (it2 >> 1) * NGW) + (it2 & 1);
        if (row < NT) { const int sv = sel[F.tid]; const int e = sv >> 16, ps = sv & 0xffff; perm[(size_t)e * NT + basel[e] + ps] = row * 2 + sl; } }
}

DI void moe_tile_prefix(const Params& p, const Ctx& F, LAS int* tp) {
    __syncthreads();
    if (F.tid == 0) { const int* cnt = (const int*)(p.ws + WS_CTL); int acc = 0; for (int e = 0; e < 32; ++e) { const int ce = cnt[e * 64]; tp[e] = acc; tp[36 + e] = ce; acc += (ce + 255) / 256; } tp[32] = acc; }
    __syncthreads();
    for (int rt = F.tid; rt < tp[32]; rt += NTHREADS) { int e = 0; for (int j = 1; j < 32; ++j) e += (tp[j] <= rt) ? 1 : 0; tp[72 + rt] = e; }
    __syncthreads();
}
DI void phase_moe_up(const Params& p, const Ctx& F) {
    LAS int* tp = (LAS int*)(F.lds + pg8::STAGE_BYTES);
    moe_tile_prefix(p, F, tp);
    MoeOrder S{tp, (const int*)(p.ws + WS_CTL), 2, F.G, F.bid, 1024, (const char*)(p.ws + WS_H2), (const char*)(p.ws + WS_WGUT), (size_t)512 * 1024 * 2, (size_t)256 * 1024 * 2, (const int*)(p.ws + WS_PERM), true};
    pg8::EpiMoeUp E{(bf16_t*)(p.ws + WS_HID)};
    pg8::gemm_phase<pg8::EpiMoeUp, MoeOrder, true>(F.lds, 1024, S, E);
}
DI void phase_moe_down(const Params& p, const Ctx& F) {
    LAS int* tp = (LAS int*)(F.lds + pg8::STAGE_BYTES);
    moe_tile_prefix(p, F, tp);
    MoeOrder S{tp, (const int*)(p.ws + WS_CTL), 4, F.G, F.bid, 256, (const char*)(p.ws + WS_HID), (const char*)(p.ws + WS_WDT), (size_t)1024 * 256 * 2, (size_t)256 * 256 * 2, (const int*)(p.ws + WS_PERM), false};
    pg8::EpiMoeDown E{(bf16_t*)(p.ws + WS_YMOE), (const int*)(p.ws + WS_PERM), (const float*)(p.ws + WS_EW)};
    pg8::gemm_phase<pg8::EpiMoeDown, MoeOrder, false>(F.lds, 256, S, E);
}

DI void phase_final(const Params& p, const Ctx& F, const float fsc = 1.f) {
    const float* mod = (const float*)(p.ws + WS_MOD); const bf16_t* YM = (const bf16_t*)(p.ws + WS_YMOE);
    const int gw = F.bid * NWAVES + F.wave, NGW = F.G * NWAVES;
    struct FL { u32x2 a[4], b[4], x[4]; };
    auto issue = [&](FL& L, int row) { const u32x2* y0 = (const u32x2*)(YM + (size_t)row * D) + F.lane; const u32x2* y1 = (const u32x2*)(YM + ((size_t)NT + row) * D) + F.lane;
        const u32x2* xo = (const u32x2*)(p.ws + WS_X1 + (size_t)row * D * 2) + F.lane;
#pragma unroll
        for (int j = 0; j < 4; ++j) { L.a[j] = y0[64 * j]; L.b[j] = y1[64 * j]; L.x[j] = xo[64 * j]; } };
    FL L;
    if (gw < NT) issue(L, gw);
    int btcur = -1; f32x4 gsc[4];
    for (int row = gw; row < NT; row += NGW) {
        const int bt = row / SEQ;
        const FL C = L;
        if (bt != btcur) { btcur = bt;
#pragma unroll
            for (int j = 0; j < 4; ++j) { const int col = 4 * (F.lane + 64 * j); gsc[j] = *(const f32x4*)(mod + bt * 6144 + 5120 + col) * *(const f32x4*)(p.in[I_GPOST2] + col); } }
        if (row + NGW < NT) issue(L, row + NGW);
        f32x4 v[4]; float ss = 0.f;
#pragma unroll
        for (int j = 0; j < 4; ++j) { const u32x2 a = C.a[j], b = C.b[j];
            v[j] = (f32x4){bflo(a.x) + bflo(b.x), bfhi(a.x) + bfhi(b.x), bflo(a.y) + bflo(b.y), bfhi(a.y) + bfhi(b.y)};
            ss += (v[j].x * v[j].x + v[j].y * v[j].y) + (v[j].z * v[j].z + v[j].w * v[j].w); }
        const float rstd = __builtin_amdgcn_rsqf(wave_sum(ss) * (1.f / D) + 1e-6f);
        f32x4* xo = (f32x4*)(p.out + (size_t)row * D) + F.lane;
#pragma unroll
        for (int j = 0; j < 4; ++j) { const f32x2 xl = unpkh2(C.x[j].x), xh = unpkh2(C.x[j].y); xo[64 * j] = (f32x4){xl.x, xl.y, xh.x, xh.y} + gsc[j] * (v[j] * (rstd * fsc)); }
    }
}

#define XB_TMO      128
#define XB_XCNT(j)  (256  + 64 * (j))
#define XB_XSUB(j)  (1280 + 64 * (j))
#define XB_XGEN(j)  (2304 + 64 * (j))
#define XB_TOP      3328
#define XB_TOPGEN   3392
#define XCD_BAR_WORDS 3456
#define XB_SPIN_CAP (1u << 20)
constexpr int CW_BAR = 4096;
DI unsigned xb_ld(unsigned* p)              { return __hip_atomic_load(p, __ATOMIC_RELAXED, __HIP_MEMORY_SCOPE_AGENT); }
DI unsigned xb_add(unsigned* p, unsigned v) { return __hip_atomic_fetch_add(p, v, __ATOMIC_RELAXED, __HIP_MEMORY_SCOPE_AGENT); }
DI unsigned xb_xcc_id() { return (unsigned)__builtin_amdgcn_s_getreg((3 << 11) | 20) & 0xFu; }
#define XB_SPIN(cond, bar) do { unsigned _sp = 0; while (cond) { __builtin_amdgcn_s_sleep(1); \
    if ((++_sp & 255u) == 0u) { if (xb_ld(&(bar)[XB_TMO])) break; if (_sp > XB_SPIN_CAP) { atomicAdd(&(bar)[XB_TMO], 1u); break; } } } } while (0)
struct XcdBarrier { unsigned* bar; unsigned x; volatile LAS unsigned* st; };
DI XcdBarrier xcd_barrier_post(unsigned* bar, volatile LAS unsigned* st) {
    XcdBarrier b; b.bar = bar; b.x = xb_xcc_id(); b.st = st;
    if (threadIdx.x == 0) (void)xb_add(&bar[XB_XCNT(b.x)], 1u);
    return b;
}
DI void xcd_barrier_complete(unsigned* bar, unsigned x, unsigned& nloc, unsigned& nx) {
    const unsigned G = gridDim.x * gridDim.y * gridDim.z;
    unsigned sum, cnt, mine, sp = 0u;
    for (;;) {
        sum = 0u; cnt = 0u; mine = 0u;
#pragma unroll
        for (unsigned j = 0; j < 16; ++j) { const unsigned c = xb_ld(&bar[XB_XCNT(j)]); sum += c; cnt += (c > 0u) ? 1u : 0u; mine = (j == x) ? c : mine; }
        if (sum == G) break;
        __builtin_amdgcn_s_sleep(1);
        if ((++sp & 255u) == 0u) { if (xb_ld(&bar[XB_TMO])) break; if (sp > XB_SPIN_CAP) { atomicAdd(&bar[XB_TMO], 1u); break; } }
    }
    nloc = mine > 0u ? mine : 1u; nx = cnt > 0u ? cnt : 1u;
}
DI void xcd_barrier(const XcdBarrier& b) {
    asm volatile("s_waitcnt vmcnt(0)" ::: "memory");
    __syncthreads();
    if (threadIdx.x == 0) {
        unsigned* bar = b.bar;
        __builtin_amdgcn_s_waitcnt(0);
        unsigned nloc = b.st[0], nx = b.st[1];
        if (nloc == 0u) { xcd_barrier_complete(bar, b.x, nloc, nx); b.st[0] = nloc; b.st[1] = nx; }
        const unsigned old = xb_add(&bar[XB_XSUB(b.x)], 1u);
        const unsigned gen = old / nloc;
        if (old + 1u == (gen + 1u) * nloc) {
            __builtin_amdgcn_fence(__ATOMIC_RELEASE, "agent");
            asm volatile("s_waitcnt vmcnt(0)" ::: "memory");
            const unsigned og = xb_add(&bar[XB_TOP], 1u);
            const unsigned tg = og / nx;
            if (og + 1u == (tg + 1u) * nx) xb_add(&bar[XB_TOPGEN], 1u);
            else XB_SPIN(xb_ld(&bar[XB_TOPGEN]) == tg, bar);
            __builtin_amdgcn_fence(__ATOMIC_ACQUIRE, "agent");
            xb_add(&bar[XB_XGEN(b.x)], 1u);
            asm volatile("s_waitcnt vmcnt(0)" ::: "memory");
        } else {
            XB_SPIN(xb_ld(&bar[XB_XGEN(b.x)]) == gen, bar);
            __builtin_amdgcn_fence(__ATOMIC_ACQUIRE, "agent");
            asm volatile("s_waitcnt vmcnt(0)" ::: "memory");
        }
    }
    __syncthreads();
}

constexpr int NPHASES = 12;
#ifndef SEQ_SCAN
#define SEQ_SCAN 0
#endif
#ifndef DUP_PHASE
#define DUP_PHASE -1
#endif
#ifndef PROBE_T
#define PROBE_T -1
#endif
DI Ctx make_ctx(unsigned char* lds) {
    int tid = threadIdx.x; asm volatile("" : "+v"(tid));
    Ctx F; F.lds = (LAS unsigned char*)lds; F.tid = tid; F.lane = F.tid & 63; F.wave = __builtin_amdgcn_readfirstlane(F.tid >> 6); F.G = gridDim.x; F.bid = blockIdx.x; return F;
}
template <int PH> DI void run_phase(const Params& p, const Ctx& F0) {
    const Ctx F = make_ctx((unsigned char*)F0.lds);
    if constexpr (PH == 0) phase_adaln(p, F);
    if constexpr (PH == 1) phase_convert(p, F);
    if constexpr (PH == 2) phase_hrows(p, F);
    if constexpr (PH == 3) phase_gemm1(p, F);
#ifndef OLD_PREP
#define OLD_PREP 0
#endif
    if constexpr (PH == 4) { if (OLD_PREP) phase_prep(p, F); else phase_prep2(p, F); __syncthreads(); phase_gmlp(p, F); }
#ifndef OLD_CHUNKPREP
#define OLD_CHUNKPREP 0
#endif
    if constexpr (PH == 5) { if (OLD_CHUNKPREP) phase_chunkprep(p, F); else phase_chunkprep2(p, F); }
    if constexpr (PH == 12) { phase_convert_experts(p, F); __syncthreads(); phase_scan_chunk(p, F); }
    if constexpr (PH == 6) phase_post2(p, F);
    if constexpr (PH == 7) phase_gemm2(p, F);
    if constexpr (PH == 8) phase_route(p, F);
    if constexpr (PH == 28) phase_route(p, F, true);
    if constexpr (PH == 9) phase_moe_up(p, F);
    if constexpr (PH == 10) phase_moe_down(p, F);
    if constexpr (PH == 11) phase_final(p, F, DUP_PHASE == 11 ? 0.5f : 1.f);
}
template <int PH> __global__ void __launch_bounds__(NTHREADS, 2) k_phase(Params p) {
    extern __shared__ __attribute__((aligned(16))) unsigned char lds[];
    const Ctx F = make_ctx(lds);
    run_phase<PH>(p, F);
}
#ifndef USE_CG_SYNC
#define USE_CG_SYNC 0
#endif
__global__ void __launch_bounds__(NTHREADS, 2) k_mega(Params p) {
    extern __shared__ __attribute__((aligned(16))) unsigned char lds[];
    const Ctx F = make_ctx(lds);
#if USE_CG_SYNC
    cg::grid_group grid = cg::this_grid();
#define GSYNC() grid.sync()
#else
    volatile LAS unsigned* misc = (volatile LAS unsigned*)(F.lds + LDS_MISC);
    if (F.tid < 4) misc[F.tid] = 0u;
    __syncthreads();
    const XcdBarrier bar = xcd_barrier_post((unsigned*)(p.ws + WS_CTL) + CW_BAR, misc);
#define GSYNC() xcd_barrier(bar)
#endif
#define DUP(X) if (DUP_PHASE == X) { run_phase<X>(p, F); GSYNC(); }
    unsigned long long ts_a = 0, ts_b = 0; int nst = 0;
#define STAMP() do { if (PROBE_T >= 0) { const unsigned long long t_ = __builtin_amdgcn_s_memrealtime(); if (nst == PROBE_T) ts_a = t_; if (nst == PROBE_T + 1) ts_b = t_; ++nst; } } while (0)
    STAMP();
    DUP(0) DUP(1)
    run_phase<0>(p, F); run_phase<1>(p, F); GSYNC(); STAMP();
    DUP(2) run_phase<2>(p, F); GSYNC(); STAMP();
    DUP(3) run_phase<3>(p, F); GSYNC(); STAMP();
    DUP(4) run_phase<4>(p, F); GSYNC(); STAMP();
    DUP(5) run_phase<5>(p, F); GSYNC(); STAMP();
    DUP(12)
    run_phase<12>(p, F); GSYNC(); STAMP();
    DUP(6) run_phase<6>(p, F); GSYNC(); STAMP();
    DUP(7) run_phase<7>(p, F); GSYNC(); STAMP();
    if (DUP_PHASE == 8) { run_phase<28>(p, F); GSYNC(); STAMP(); }
    run_phase<8>(p, F); GSYNC(); STAMP();
    DUP(9) run_phase<9>(p, F); GSYNC(); STAMP();
    DUP(10) run_phase<10>(p, F); GSYNC(); STAMP();
    if (DUP_PHASE == 11) { run_phase<11>(p, F); GSYNC(); STAMP(); }
    run_phase<11>(p, F); STAMP();
    if (PROBE_T >= 0 && F.bid == 0 && F.tid == 0) { const unsigned long long t0 = __builtin_amdgcn_s_memrealtime(); const unsigned long long w_ = ts_b - ts_a; while (__builtin_amdgcn_s_memrealtime() - t0 < w_) __builtin_amdgcn_s_sleep(8); }
}

template <int PH> static void launch_phase(const Params& p, int grid, hipStream_t stream) {
    static bool attr = false;
    if (!attr) { (void)hipFuncSetAttribute((const void*)k_phase<PH>, hipFuncAttributeMaxDynamicSharedMemorySize, LDS_BYTES); attr = true; }
    hipLaunchKernelGGL(k_phase<PH>, dim3(grid), dim3(NTHREADS), LDS_BYTES, stream, p);
}

extern "C" void kernel_launch(void* const* d_in, const int* in_sizes, int n_in, void* d_out, int out_size, void* d_ws, size_t ws_size, hipStream_t stream) {
    static int grid = 0;
    if (grid == 0) {
        int dev = 0, cus = 0, per_cu = 0;
        (void)hipGetDevice(&dev); (void)hipDeviceGetAttribute(&cus, hipDeviceAttributeMultiprocessorCount, dev);
        (void)hipFuncSetAttribute((const void*)k_mega, hipFuncAttributeMaxDynamicSharedMemorySize, LDS_BYTES);
        (void)hipOccupancyMaxActiveBlocksPerMultiprocessor(&per_cu, (const void*)k_mega, NTHREADS, LDS_BYTES);
        (void)hipGetLastError();
        grid = cus > 0 ? cus : 256;
        if (n_in != 34 || ws_size < 512 * MiB) fprintf(stderr, "kernel_launch: unexpected n_in %d / ws_size %zu\n", n_in, ws_size);
    }
    Params p{};
    for (int i = 0; i < 34; ++i) p.in[i] = (const float*)d_in[i];
    p.out = (float*)d_out; p.ws = (unsigned char*)d_ws;
    (void)hipMemsetAsync((char*)d_ws + WS_CTL, 0, CTL_BYTES, stream);
#if ONE_LAUNCH
    void* args[] = {&p};
    hipError_t e = hipLaunchCooperativeKernel((const void*)k_mega, dim3(grid), dim3(NTHREADS), args, LDS_BYTES, stream);
    if (e != hipSuccess) fprintf(stderr, "cooperative launch failed: %s (grid %d)\n", hipGetErrorString(e), grid);
#else
    launch_phase<0>(p, grid, stream); launch_phase<1>(p, grid, stream); launch_phase<2>(p, grid, stream); launch_phase<3>(p, grid, stream);
    launch_phase<4>(p, grid, stream); launch_phase<5>(p, grid, stream);
    launch_phase<12>(p, grid, stream);
    launch_phase<6>(p, grid, stream); launch_phase<7>(p, grid, stream);
    launch_phase<8>(p, grid, stream); launch_phase<9>(p, grid, stream); launch_phase<10>(p, grid, stream); launch_phase<11>(p, grid, stream);
#endif
}
```
